# Optimizing an MI355X kernel written in HIP

```python
import jax, jax.numpy as jnp
from jax import lax
import numpy as np

D_MODEL = 1024
BATCH = 8
SEQ = 2048
DEPTH = 1
DEC_BATCH = 16
DEC_SEQ = 64
PAST_LEN = 1024

CHUNK = 64
N_HEADS = 16
HEAD_DIM = 64
ATTN_DIM = N_HEADS * HEAD_DIM
CONV_DIM = 1024
CONV_WIDTH = 3
D_FF = 2816
Q_BLOCK = 128
N_MOD = 9
EPS = 1e-6

OFF_Q = 0
OFF_K = OFF_Q + ATTN_DIM
OFF_V = OFF_K + ATTN_DIM
OFF_F = OFF_V + ATTN_DIM
OFF_B = OFF_F + N_HEADS
OFF_C = OFF_B + CONV_DIM
OFF_X = OFF_C + CONV_DIM
OFF_GA = OFF_X + CONV_DIM
OFF_GC = OFF_GA + ATTN_DIM
IN_COLS = OFF_GC + CONV_DIM
MIX_DIM = ATTN_DIM

kernel_name = "fox_shortconv_macaron_adaln_stream"


def rmsnorm(x, g):
    xf = x.astype(jnp.float32)
    y = xf * lax.rsqrt(jnp.mean(xf * xf, axis=-1, keepdims=True) + EPS)
    return (y * g.astype(jnp.float32)).astype(x.dtype)


def modulate(h, shift, scale):
    return h * (1 + scale[:, None, :]) + shift[:, None, :]


def swiglu(h, w_in, w_out):
    a, b = jnp.split(h @ w_in, 2, axis=-1)
    return (jax.nn.silu(a) * b) @ w_out


def fox_attention(q, k, v, logf, past_k, past_v, past_logf):
    B, H, T, _ = q.shape
    P = past_k.shape[2]
    k_all = jnp.concatenate([past_k.astype(k.dtype), k], axis=2)
    v_all = jnp.concatenate([past_v.astype(v.dtype), v], axis=2)
    F = jnp.cumsum(jnp.concatenate([past_logf.astype(jnp.float32), logf], axis=-1), axis=-1)
    k_pos = jnp.arange(P + T)
    q_pos = P + jnp.arange(T)
    Fq = F[..., P:]
    scale = HEAD_DIM ** -0.5

    def attend(args):
        qb, Fqb, qpb = args
        s = jnp.einsum('bhqd,bhkd->bhqk', qb, k_all, preferred_element_type=jnp.float32) * scale
        s = s + (Fqb[..., :, None] - F[..., None, :])
        s = jnp.where(k_pos[None, :] <= qpb[:, None], s, -jnp.inf)
        p = jax.nn.softmax(s, axis=-1)
        return jnp.einsum('bhqk,bhkd->bhqd', p.astype(v_all.dtype), v_all)

    if T <= Q_BLOCK:
        return attend((q, Fq, q_pos))
    nb = T // Q_BLOCK
    qb = q.reshape(B, H, nb, Q_BLOCK, HEAD_DIM).transpose(2, 0, 1, 3, 4)
    Fqb = Fq.reshape(B, H, nb, Q_BLOCK).transpose(2, 0, 1, 3)
    qpb = q_pos.reshape(nb, Q_BLOCK)
    o = lax.map(attend, (qb, Fqb, qpb))
    return o.transpose(1, 2, 0, 3, 4).reshape(B, H, T, HEAD_DIM)


def short_conv(u, past_u, w):
    T = u.shape[1]
    up = jnp.concatenate([past_u.astype(u.dtype), u], axis=1)
    y = w[0] * up[:, 0:T]
    for j in range(1, CONV_WIDTH):
        y = y + w[j] * up[:, j:j + T]
    return y, up[:, -(CONV_WIDTH - 1):]


def encoder_layer(x, c, past_k, past_v, past_logf, past_u,
                  w_ada, b_ada, g_ffn1, w_ffn1_in, w_ffn1_out, g_mix, w_in, b_f,
                  conv_w, w_out, g_ffn2, w_ffn2_in, w_ffn2_out):
    B, T, _ = x.shape
    mod = jax.nn.silu(c) @ w_ada + b_ada
    sh1, sc1, gt1, sh2, sc2, gt2, sh3, sc3, gt3 = jnp.split(mod, N_MOD, axis=-1)

    h = modulate(rmsnorm(x, g_ffn1), sh1, sc1)
    x = x + 0.5 * gt1[:, None, :] * swiglu(h, w_ffn1_in, w_ffn1_out)

    h = modulate(rmsnorm(x, g_mix), sh2, sc2)
    z = h @ w_in

    def heads(a):
        return a.reshape(B, T, N_HEADS, HEAD_DIM).transpose(0, 2, 1, 3)

    q = heads(z[..., OFF_Q:OFF_K])
    k = heads(z[..., OFF_K:OFF_V])
    v = heads(z[..., OFF_V:OFF_F])
    logf = jax.nn.log_sigmoid((z[..., OFF_F:OFF_B] + b_f).astype(jnp.float32)).transpose(0, 2, 1)
    o_attn = fox_attention(q, k, v, logf, past_k, past_v, past_logf)
    o_attn = o_attn.transpose(0, 2, 1, 3).reshape(B, T, ATTN_DIM)

    u = z[..., OFF_C:OFF_X] * z[..., OFF_X:OFF_GA]
    conv_y, new_u = short_conv(u, past_u, conv_w)
    o_conv = z[..., OFF_B:OFF_C] * conv_y

    m = (jax.nn.sigmoid(z[..., OFF_GA:OFF_GC]) * o_attn
         + jax.nn.sigmoid(z[..., OFF_GC:IN_COLS]) * o_conv)
    x = x + gt2[:, None, :] * (m @ w_out)

    h = modulate(rmsnorm(x, g_ffn2), sh3, sc3)
    x = x + 0.5 * gt3[:, None, :] * swiglu(h, w_ffn2_in, w_ffn2_out)
    return x, k, v, logf, new_u


def setup_inputs(seed: int = 0) -> dict:
    key = jax.random.key(seed)
    ks = jax.random.split(key, 24)
    f32 = jnp.float32
    nrm = lambda k, s, sc: jax.random.normal(k, s, f32) * sc
    gain = lambda k, s: 1.0 + 0.05 * jax.random.normal(k, s, f32)
    return {
        "x_prompt": nrm(ks[0], (BATCH, SEQ, D_MODEL), 1.0),
        "x_sample": nrm(ks[1], (DEC_BATCH, DEC_SEQ, D_MODEL), 1.0),
        "cache_k": nrm(ks[2], (DEPTH, DEC_BATCH, N_HEADS, PAST_LEN, HEAD_DIM), 1.0),
        "cache_v": nrm(ks[3], (DEPTH, DEC_BATCH, N_HEADS, PAST_LEN, HEAD_DIM), 1.0),
        "cache_logf": jax.nn.log_sigmoid(2.5 + jax.random.normal(ks[4], (DEPTH, DEC_BATCH, N_HEADS, PAST_LEN), f32)),
        "state_conv": nrm(ks[5], (DEPTH, DEC_BATCH, CONV_WIDTH - 1, CONV_DIM), 1.0),
        "c_prompt": nrm(ks[6], (BATCH, D_MODEL), 1.0),
        "c_sample": nrm(ks[7], (DEC_BATCH, D_MODEL), 1.0),
        "w_ada": nrm(ks[8], (DEPTH, D_MODEL, N_MOD * D_MODEL), D_MODEL ** -0.5),
        "b_ada": nrm(ks[9], (DEPTH, N_MOD * D_MODEL), 0.02),
        "g_ffn1": gain(ks[10], (DEPTH, D_MODEL)),
        "w_ffn1_in": nrm(ks[11], (DEPTH, D_MODEL, 2 * D_FF), D_MODEL ** -0.5),
        "w_ffn1_out": nrm(ks[12], (DEPTH, D_FF, D_MODEL), D_FF ** -0.5),
        "g_mix": gain(ks[13], (DEPTH, D_MODEL)),
        "w_in": nrm(ks[14], (DEPTH, D_MODEL, IN_COLS), D_MODEL ** -0.5),
        "b_f": jax.random.uniform(ks[15], (DEPTH, N_HEADS), f32, 1.0, 4.0),
        "conv_w": nrm(ks[16], (DEPTH, CONV_WIDTH, CONV_DIM), CONV_WIDTH ** -0.5),
        "w_out": nrm(ks[17], (DEPTH, MIX_DIM, D_MODEL), MIX_DIM ** -0.5),
        "g_ffn2": gain(ks[18], (DEPTH, D_MODEL)),
        "w_ffn2_in": nrm(ks[19], (DEPTH, D_MODEL, 2 * D_FF), D_MODEL ** -0.5),
        "w_ffn2_out": nrm(ks[20], (DEPTH, D_FF, D_MODEL), D_FF ** -0.5),
        "g_final": gain(ks[21], (D_MODEL,)),
    }


def reference(x_prompt, x_sample, cache_k, cache_v, cache_logf, state_conv, c_prompt, c_sample,
              w_ada, b_ada, g_ffn1, w_ffn1_in, w_ffn1_out, g_mix, w_in, b_f, conv_w, w_out,
              g_ffn2, w_ffn2_in, w_ffn2_out, g_final):
    Bp = x_prompt.shape[0]
    empty_kv = jnp.zeros((Bp, N_HEADS, 0, HEAD_DIM), x_prompt.dtype)
    empty_f = jnp.zeros((Bp, N_HEADS, 0), jnp.float32)
    zero_u = jnp.zeros((Bp, CONV_WIDTH - 1, CONV_DIM), x_prompt.dtype)
    xp, xs = x_prompt, x_sample
    kp, vp, fp, up, ksm, vsm, fsm, usm = [], [], [], [], [], [], [], []
    for l in range(DEPTH):
        w = (w_ada[l], b_ada[l], g_ffn1[l], w_ffn1_in[l], w_ffn1_out[l], g_mix[l], w_in[l], b_f[l],
             conv_w[l], w_out[l], g_ffn2[l], w_ffn2_in[l], w_ffn2_out[l])
        xp, k_, v_, f_, u_ = encoder_layer(xp, c_prompt, empty_kv, empty_kv, empty_f, zero_u, *w)
        kp.append(k_); vp.append(v_); fp.append(f_); up.append(u_)
        xs, k_, v_, f_, u_ = encoder_layer(xs, c_sample, cache_k[l], cache_v[l], cache_logf[l],
                                           state_conv[l], *w)
        ksm.append(k_); vsm.append(v_); fsm.append(f_); usm.append(u_)
    y_prompt = rmsnorm(xp, g_final)
    y_sample = rmsnorm(xs, g_final)
    return (y_prompt, y_sample,
            jnp.stack(kp), jnp.stack(vp), jnp.stack(fp), jnp.stack(up),
            jnp.stack(ksm), jnp.stack(vsm), jnp.stack(fsm), jnp.stack(usm))
```

```cpp
#include <hip/hip_runtime.h>
#include <hip/hip_cooperative_groups.h>
#include <cstdio>
#include <cstdint>
constexpr int MODLD = 9216;
constexpr int DM = 1024, MP = 16384, MS = 1024, MT = MP + MS, TP = 2048, TS = 64, PAST = 1024, NH = 16, HD = 64, DFF = 2816, NIN = 8208, NINP = 8448, NMOD = 9;
constexpr int OFF_Q = 0, OFF_K = 1024, OFF_V = 2048, OFF_F = 3072, OFF_B = 3088, OFF_C = 4112, OFF_X = 5136, OFF_GA = 6160, OFF_GC = 7184;
constexpr float EPS = 1e-6f;
constexpr size_t O_Y = 0, O_KP = (size_t)MT * DM, O_VP = O_KP + (size_t)MP * DM, O_LFP = O_VP + (size_t)MP * DM, O_CVP = O_LFP + 8 * 16 * 2048, O_KS = O_CVP + 8 * 2 * 1024,
                 O_VS = O_KS + (size_t)MS * DM, O_LFS = O_VS + (size_t)MS * DM, O_CVS = O_LFS + 16 * 16 * 64, O_END = O_CVS + 16 * 2 * 1024;
static_assert(O_END == 53805056, "d_out map");
namespace pg8 {
#define PG8_LAS __attribute__((address_space(3)))
typedef unsigned short bf16_t;
typedef short bf16x8 __attribute__((ext_vector_type(8)));
typedef float f32x4 __attribute__((ext_vector_type(4)));
typedef unsigned u32x4 __attribute__((ext_vector_type(4)));
constexpr int BM = 256, BK = 64, HALF = 128, HTB = HALF * BK * 2  , STAGE_BYTES = 8 * HTB, NXCD = 8, WGM = 8;

__host__ __device__ __forceinline__ int lds_byte(int r, int c) { const int st = (r >> 4) * 2 + (c >> 5), rr = r & 15, cc = c & 31, ob = rr * 64 + cc * 2; return st * 1024 + (ob ^ (((ob >> 9) & 1) << 5)); }
__host__ __device__ __forceinline__ void stage_rc(int b, int& R, int& C) { const int st = b / 1024, sb = b % 1024, swz = sb ^ (((sb >> 9) & 1) << 5); R = (st >> 1) * 16 + swz / 64; C = (st & 1) * 32 + (swz % 64) / 2; }
__host__ __device__ __forceinline__ int perm32(int rho) { const int n = rho >> 4, i = rho & 15; return 8 * (i >> 2) + 4 * n + (i & 3); }

struct Unit { int pm, pn; };
struct Gemm { const bf16_t* A; const bf16_t* Bt; int M, N, K; };

struct StaticOrder {
    int nM, nN, nwg, G, c;
    __host__ __device__ void init(int M, int N, int G_, int c_) { nM = M / BM; nN = N / BM; nwg = nM * nN; G = G_; c = c_; }
    __host__ __device__ bool next(int i, Unit& u) const {
        const long L = (long)i * G + c; if (L >= nwg) return false;
        int wgid = (int)L; { const int q = nwg / NXCD, r = nwg % NXCD, xcd = wgid % NXCD, off = wgid / NXCD; wgid = (xcd < r ? xcd * (q + 1) : r * (q + 1) + (xcd - r) * q) + off; }
        const int nig = WGM * nN, gid = wgid / nig, fm = gid * WGM, gsz = (nM - fm) < WGM ? (nM - fm) : WGM;
        u.pm = fm + ((wgid % nig) % gsz); u.pn = (wgid % nig) / gsz; return true;
    }
    __device__ __forceinline__ void a_ready(const Unit&) const {}
    __device__ __forceinline__ void done(const Unit&) const {}
};

__device__ __forceinline__ unsigned cvt_pk_bf16(float lo, float hi) { unsigned r; asm volatile("v_cvt_pk_bf16_f32 %0, %1, %2" : "=v"(r) : "v"(lo), "v"(hi)); return r; }

constexpr int MPROMPT = 16384;
__device__ __forceinline__ int mod_batch(int pm, int ai, int wr) { return pm < 64 ? (pm >> 3) : 8 + (pm - 64) * 4 + 2 * ai + wr; }
__device__ __forceinline__ float sigmoid_f(float x) { return __builtin_amdgcn_rcpf(1.0f + __builtin_amdgcn_exp2f(-1.4426950408889634f * x)); }
__device__ __forceinline__ f32x4 sigmoid4(f32x4 x) { return (f32x4){sigmoid_f(x[0]), sigmoid_f(x[1]), sigmoid_f(x[2]), sigmoid_f(x[3])}; }
__device__ __forceinline__ u32x4 pack8(f32x4 v0, f32x4 v1) { u32x4 w; w.x = cvt_pk_bf16(v0[0], v0[1]); w.y = cvt_pk_bf16(v0[2], v0[3]); w.z = cvt_pk_bf16(v1[0], v1[1]); w.w = cvt_pk_bf16(v1[2], v1[3]); return w; }

struct EpiSwiGLU {
    static constexpr bool PERM = true, AFTER_DRAIN = false;
    bf16_t* O; int ldc;
    __device__ __forceinline__ void operator()(const f32x4 (&acc)[2][2][4][2], const Unit& u, int wr, int wc, int fr, int fq) const {
        const int row0 = u.pm * BM + wr * 64 + fr, col0 = u.pn * HALF + wc * 32 + 8 * fq;
#pragma unroll
        for (int ai = 0; ai < 2; ++ai)
#pragma unroll
            for (int m = 0; m < 4; ++m) {
                const f32x4 a0 = acc[ai][0][m][0], a1 = acc[ai][0][m][1];
                const f32x4 v0 = a0 * sigmoid4(a0) * acc[ai][1][m][0], v1 = a1 * sigmoid4(a1) * acc[ai][1][m][1];
                *(u32x4*)(O + (size_t)(row0 + ai * HALF + m * 16) * ldc + col0) = pack8(v0, v1);
            }
    }
};
template <bool NTB> struct EpiResid {
    static constexpr bool PERM = true, AFTER_DRAIN = false;
    const float* baseP; const float* baseS; float* out; const float* gate; float coef;
    __device__ __forceinline__ void operator()(const f32x4 (&acc)[2][2][4][2], const Unit& u, int wr, int wc, int fr, int fq) const {
        const int col0 = u.pn * BM + wc * 32 + 8 * fq;
#pragma unroll
        for (int ai = 0; ai < 2; ++ai) {
            const float* gp = gate + (size_t)mod_batch(u.pm, ai, wr) * MODLD + col0;
            f32x4 g[2][2];
#pragma unroll
            for (int bj = 0; bj < 2; ++bj)
#pragma unroll
                for (int n = 0; n < 2; ++n) g[bj][n] = *(const f32x4*)(gp + bj * HALF + 4 * n) * coef;
            f32x4 bsv[4][2][2];
#pragma unroll
            for (int m = 0; m < 4; ++m) {
                const int row = u.pm * BM + ai * HALF + wr * 64 + m * 16 + fr;
                const float* bp = (u.pm < 64 ? baseP + (size_t)row * 1024 : baseS + (size_t)(row - MPROMPT) * 1024) + col0;
#pragma unroll
                for (int bj = 0; bj < 2; ++bj)
#pragma unroll
                    for (int n = 0; n < 2; ++n) { const f32x4* p = (const f32x4*)(bp + bj * HALF + 4 * n); bsv[m][bj][n] = NTB ? __builtin_nontemporal_load(p) : *p; }
            }
            asm volatile("" ::: "memory");
#pragma unroll
            for (int m = 0; m < 4; ++m) {
                const int row = u.pm * BM + ai * HALF + wr * 64 + m * 16 + fr;
                float* op = out + (size_t)row * 1024 + col0;
#pragma unroll
                for (int bj = 0; bj < 2; ++bj)
#pragma unroll
                    for (int n = 0; n < 2; ++n) *(f32x4*)(op + bj * HALF + 4 * n) = bsv[m][bj][n] + g[bj][n] * acc[ai][bj][m][n];
            }
        }
    }
};
struct EpiMix {
    static constexpr bool PERM = true, AFTER_DRAIN = false;
    bf16_t* QB; float* outp; const float* b_f; float qscale;
    static constexpr size_t BSTRIDE = (size_t)MT * DM;
    __device__ __forceinline__ void operator()(const f32x4 (&acc)[2][2][4][2], const Unit& u, int wr, int wc, int fr, int fq) const {
        const int pn = u.pn; const bool prm = u.pm < 64;
        const int row0 = u.pm * BM + wr * 64 + fr;
        if (pn < 16) {
            const int seg = pn >> 2, colt = (pn & 3) * BM + wc * 32 + 8 * fq;
            bf16_t* dst = QB + (size_t)seg * BSTRIDE;
            const float sc = seg == 0 ? qscale : 1.f;
            float* fo = outp + (seg == 1 ? (prm ? O_KP : O_KS) : (prm ? O_VP : O_VS));
#pragma unroll
            for (int ai = 0; ai < 2; ++ai)
#pragma unroll
                for (int m = 0; m < 4; ++m) {
                    const int row = row0 + ai * HALF + m * 16;
                    const int rr = prm ? row : row - MPROMPT; const int bb = prm ? (rr >> 11) : (rr >> 6), tt = prm ? (rr & 2047) : (rr & 63), TT = prm ? 2048 : 64;
#pragma unroll
                    for (int bj = 0; bj < 2; ++bj) {
                        f32x4 v0 = acc[ai][bj][m][0], v1 = acc[ai][bj][m][1]; const int col = colt + bj * HALF;
                        if (seg == 1 || seg == 2) { float* p = fo + ((size_t)(bb * 16 + (col >> 6)) * TT + tt) * 64 + (col & 63); __builtin_nontemporal_store(v0, (f32x4*)p); __builtin_nontemporal_store(v1, (f32x4*)(p + 4)); }
                        if (seg == 3) { v0 = sigmoid4(v0); v1 = sigmoid4(v1); }
                        v0 = v0 * sc; v1 = v1 * sc;
                        *(u32x4*)(dst + (size_t)row * 1024 + col) = pack8(v0, v1);
                    }
                }
        } else if (pn < 32) {
            const bool cx = pn >= 24; const int col = ((pn - 16) & 7) * HALF + wc * 32 + 8 * fq;
            bf16_t* dst = QB + (size_t)(cx ? 5 : 4) * BSTRIDE;
#pragma unroll
            for (int ai = 0; ai < 2; ++ai)
#pragma unroll
                for (int m = 0; m < 4; ++m) {
                    const int row = row0 + ai * HALF + m * 16;
                    f32x4 v0, v1;
                    if (cx) { v0 = acc[ai][0][m][0] * acc[ai][1][m][0]; v1 = acc[ai][0][m][1] * acc[ai][1][m][1]; }
                    else { v0 = acc[ai][0][m][0] * sigmoid4(acc[ai][1][m][0]); v1 = acc[ai][0][m][1] * sigmoid4(acc[ai][1][m][1]); }
                    *(u32x4*)(dst + (size_t)row * 1024 + col) = pack8(v0, v1);
                    if (cx) {
                        const int rr = prm ? row : row - MPROMPT; const int bb = prm ? (rr >> 11) : (rr >> 6), tt = prm ? (rr & 2047) : (rr & 63), TT = prm ? 2048 : 64;
                        if (tt >= TT - 2) { float* p = outp + (prm ? O_CVP : O_CVS) + (size_t)(bb * 2 + (tt - (TT - 2))) * 1024 + col; *(f32x4*)p = v0; *(f32x4*)(p + 4) = v1; }
                    }
                }
        } else {
            if (wc == 0 && fq < 2) {
                const f32x4 bf0 = *(const f32x4*)(b_f + 8 * fq), bf1 = *(const f32x4*)(b_f + 8 * fq + 4);
                asm volatile("" ::: "memory");
#pragma unroll
                for (int ai = 0; ai < 2; ++ai)
#pragma unroll
                    for (int m = 0; m < 4; ++m) {
                        const int row = row0 + ai * HALF + m * 16;
                        const int rr = prm ? row : row - MPROMPT; const int bb = prm ? (rr >> 11) : (rr >> 6), tt = prm ? (rr & 2047) : (rr & 63), TT = prm ? 2048 : 64;
                        float* fo = outp + (prm ? O_LFP : O_LFS);
#pragma unroll
                        for (int n = 0; n < 2; ++n)
#pragma unroll
                            for (int e = 0; e < 4; ++e) {
                                const int hh = 8 * fq + 4 * n + e; const float v = acc[ai][0][m][n][e] + (n ? bf1[e] : bf0[e]);
                                const float ls = fminf(v, 0.f) - __logf(1.0f + __expf(-fabsf(v)));
                                fo[(size_t)(bb * 16 + hh) * TT + tt] = ls;
                            }
                    }
            }
        }
    }
};
template <class Epi, class Sched, bool ALIGN_EPI = false, bool SP2 = false>
__device__ __forceinline__ void gemm_phase(PG8_LAS unsigned char* lds, const Gemm g, const Sched& S, const Epi& E) {
    const int tid = threadIdx.x, wid = __builtin_amdgcn_readfirstlane(tid >> 6), lane = tid & 63, wr = wid >> 2, wc = wid & 3, fr = lane & 15, fq = lane >> 4;
    const int K = g.K, nt = K / BK;
    unsigned voffA[2], voffB[2];
#pragma unroll
    for (int i = 0; i < 2; ++i) { int R, C; stage_rc(tid * 16 + i * 8192, R, C); const int Rb = Epi::PERM ? ((R & ~31) + perm32(R & 31)) : R;
        voffA[i] = (unsigned)(R * K + C) * 2u; voffB[i] = (unsigned)(Rb * K + C) * 2u; }
    const size_t kstep = (size_t)(BK * 2);
    const size_t hstep = (size_t)HALF * K * 2;
    const size_t tstep = 2 * hstep;
    const unsigned ldsw = (unsigned)wid * 1024u;
    const int aoff = lds_byte(wr * 64 + fr, fq * 8), boff = lds_byte(wc * 32 + fr, fq * 8);
#define PG8_SA(b, h) (((b) * 2 + (h)) * HTB)
#define PG8_SB(b, h) ((4 + (b) * 2 + (h)) * HTB)
#define PG8_STAGE(bufoff, gbase, voff) do { _Pragma("unroll") for (int _i = 0; _i < 2; ++_i) \
        __builtin_amdgcn_global_load_lds((const unsigned*)((const char*)(gbase) + (voff)[_i]), (PG8_LAS unsigned*)(lds + (bufoff) + ldsw + _i * 8192), 16, 0, 0); } while (0)
#define PG8_LDA(dst, b, h) do { _Pragma("unroll") for (int m = 0; m < 4; ++m) _Pragma("unroll") for (int k = 0; k < 2; ++k) dst[m][k] = *(const PG8_LAS bf16x8*)(lds + PG8_SA(b, h) + aoff + m * 2048 + k * 1024); } while (0)
#define PG8_LDB(dst, b, h) do { _Pragma("unroll") for (int n = 0; n < 2; ++n) _Pragma("unroll") for (int k = 0; k < 2; ++k) dst[n][k] = *(const PG8_LAS bf16x8*)(lds + PG8_SB(b, h) + boff + n * 2048 + k * 1024); } while (0)
#define PG8_MMA(ai, bj, At, Bt) do { __builtin_amdgcn_s_setprio(1); _Pragma("unroll") for (int m = 0; m < 4; ++m) _Pragma("unroll") for (int n = 0; n < 2; ++n) _Pragma("unroll") for (int k = 0; k < 2; ++k) \
        acc[ai][bj][m][n] = __builtin_amdgcn_mfma_f32_16x16x32_bf16(Bt[n][k], At[m][k], acc[ai][bj][m][n], 0, 0, 0); __builtin_amdgcn_s_setprio(0); } while (0)
#define PG8_WAIT_V(n) asm volatile("s_waitcnt vmcnt(" #n ")" ::: "memory")
#define PG8_WAIT_L(n) asm volatile("s_waitcnt lgkmcnt(" #n ")" ::: "memory")
#define PG8_BAR __builtin_amdgcn_s_barrier()
#define PG8_SCHED __builtin_amdgcn_sched_barrier(0)
    Unit cur, nxt; int ui = 0;
    if (!S.next(0, cur)) return;
    f32x4 acc[2][2][4][2];
#pragma unroll
    for (int a = 0; a < 2; ++a)
#pragma unroll
        for (int b = 0; b < 2; ++b)
#pragma unroll
            for (int m = 0; m < 4; ++m)
#pragma unroll
                for (int n = 0; n < 2; ++n) acc[a][b][m][n] = (f32x4){0.f, 0.f, 0.f, 0.f};
    bf16x8 At[4][2], B0[2][2], B1[2][2];
    const char* cA = (const char*)g.A + (size_t)cur.pm * tstep; const char* cB = (const char*)g.Bt + (size_t)cur.pn * tstep;
    S.a_ready(cur);
    if constexpr (SP2) {
        PG8_STAGE(PG8_SB(0, 0), cB, voffB); PG8_STAGE(PG8_SB(0, 1), cB + hstep, voffB); PG8_STAGE(PG8_SA(0, 0), cA, voffA); PG8_STAGE(PG8_SA(0, 1), cA + hstep, voffA);
        if (wr == 1) PG8_BAR;
        PG8_WAIT_V(2); PG8_BAR;
        PG8_STAGE(PG8_SB(1, 0), cB + kstep, voffB); PG8_STAGE(PG8_SA(1, 0), cA + kstep, voffA); PG8_STAGE(PG8_SB(1, 1), cB + hstep + kstep, voffB);
        PG8_WAIT_V(6); PG8_BAR;
    } else {
        PG8_STAGE(PG8_SB(0, 0), cB, voffB); PG8_STAGE(PG8_SA(0, 0), cA, voffA); PG8_STAGE(PG8_SB(0, 1), cB + hstep, voffB); PG8_STAGE(PG8_SA(0, 1), cA + hstep, voffA);
        if (wr == 1) PG8_BAR;
        PG8_WAIT_V(4); PG8_BAR;
        PG8_STAGE(PG8_SB(1, 0), cB + kstep, voffB); PG8_STAGE(PG8_SA(1, 0), cA + kstep, voffA); PG8_STAGE(PG8_SB(1, 1), cB + hstep + kstep, voffB);
        PG8_WAIT_V(6); PG8_BAR;
    }
    for (;;) {
        const bool has_next = S.next(ui + 1, nxt);
        const char* nA = has_next ? (const char*)g.A + (size_t)nxt.pm * tstep : cA; const char* nB = has_next ? (const char*)g.Bt + (size_t)nxt.pn * tstep : cB;
        for (int t = 0; t < nt; t += 2) {
            const bool last = (t == nt - 2);
            const char* a1 = cA + (size_t)(t + 1) * kstep;
            const char* a2 = last ? nA : cA + (size_t)(t + 2) * kstep; const char* b2 = last ? nB : cB + (size_t)(t + 2) * kstep;
            const char* a3 = a2 + kstep; const char* b3 = b2 + kstep;
            if (last && has_next) S.a_ready(nxt);
            if constexpr (SP2) {
            PG8_LDB(B0, 0, 0); PG8_LDB(B1, 0, 1); PG8_SCHED; PG8_LDA(At, 0, 0); PG8_STAGE(PG8_SA(1, 1), a1 + hstep, voffA);
            PG8_WAIT_V(8); PG8_WAIT_L(0); PG8_BAR; PG8_MMA(0, 0, At, B0); PG8_MMA(0, 1, At, B1); PG8_BAR; PG8_SCHED;
            PG8_LDA(At, 0, 1); PG8_STAGE(PG8_SB(0, 0), b2, voffB); PG8_STAGE(PG8_SB(0, 1), b2 + hstep, voffB); PG8_STAGE(PG8_SA(0, 0), a2, voffA);
            PG8_WAIT_V(8); PG8_WAIT_L(0); PG8_BAR; PG8_MMA(1, 0, At, B0); PG8_MMA(1, 1, At, B1); PG8_BAR; PG8_SCHED;
            PG8_LDB(B0, 1, 0); PG8_LDB(B1, 1, 1); PG8_SCHED; PG8_LDA(At, 1, 0); PG8_STAGE(PG8_SA(0, 1), a2 + hstep, voffA);
            PG8_WAIT_V(8); PG8_WAIT_L(0); PG8_BAR; PG8_MMA(0, 0, At, B0); PG8_MMA(0, 1, At, B1); PG8_BAR; PG8_SCHED;
            PG8_LDA(At, 1, 1); PG8_STAGE(PG8_SB(1, 0), b3, voffB); PG8_STAGE(PG8_SB(1, 1), b3 + hstep, voffB); PG8_STAGE(PG8_SA(1, 0), a3, voffA);
            PG8_WAIT_V(8); PG8_WAIT_L(0); PG8_BAR; PG8_MMA(1, 0, At, B0); PG8_MMA(1, 1, At, B1); PG8_BAR; PG8_SCHED;
            } else {
            PG8_LDB(B0, 0, 0); PG8_SCHED; PG8_LDA(At, 0, 0); PG8_STAGE(PG8_SA(1, 1), a1 + hstep, voffA);
            PG8_WAIT_L(8); PG8_BAR; PG8_WAIT_L(0); PG8_MMA(0, 0, At, B0); PG8_BAR; PG8_SCHED;
            PG8_LDB(B1, 0, 1); PG8_STAGE(PG8_SB(0, 0), b2, voffB);
            PG8_BAR; PG8_WAIT_L(0); PG8_MMA(0, 1, At, B1); PG8_BAR;
            PG8_LDA(At, 0, 1); PG8_STAGE(PG8_SA(0, 0), a2, voffA);
            PG8_BAR; PG8_WAIT_L(0); PG8_MMA(1, 0, At, B0); PG8_BAR; PG8_SCHED;
            PG8_STAGE(PG8_SB(0, 1), b2 + hstep, voffB);
            PG8_WAIT_V(6); PG8_BAR; PG8_MMA(1, 1, At, B1); PG8_BAR;
            PG8_LDB(B0, 1, 0); PG8_SCHED; PG8_LDA(At, 1, 0); PG8_STAGE(PG8_SA(0, 1), a2 + hstep, voffA);
            PG8_WAIT_L(8); PG8_BAR; PG8_WAIT_L(0); PG8_MMA(0, 0, At, B0); PG8_BAR; PG8_SCHED;
            PG8_LDB(B1, 1, 1); PG8_STAGE(PG8_SB(1, 0), b3, voffB);
            PG8_BAR; PG8_WAIT_L(0); PG8_MMA(0, 1, At, B1); PG8_BAR;
            PG8_LDA(At, 1, 1); PG8_STAGE(PG8_SA(1, 0), a3, voffA);
            PG8_BAR; PG8_WAIT_L(0); PG8_MMA(1, 0, At, B0); PG8_BAR; PG8_SCHED;
            PG8_STAGE(PG8_SB(1, 1), b3 + hstep, voffB);
            PG8_WAIT_V(6); PG8_BAR; PG8_MMA(1, 1, At, B1); PG8_BAR;
            }
        }
        if constexpr (ALIGN_EPI) { if (wr == 0) PG8_BAR; }
        if constexpr (!Epi::AFTER_DRAIN) { E(acc, cur, wr, wc, fr, fq); S.done(cur); }
        if (!has_next) break;
#pragma unroll
        for (int a = 0; a < 2; ++a)
#pragma unroll
            for (int b = 0; b < 2; ++b)
#pragma unroll
                for (int m = 0; m < 4; ++m)
#pragma unroll
                    for (int n = 0; n < 2; ++n) acc[a][b][m][n] = (f32x4){0.f, 0.f, 0.f, 0.f};
        cur = nxt; cA = nA; cB = nB; ++ui;
        if constexpr (ALIGN_EPI) { if (wr == 1) PG8_BAR; }
    }
    PG8_WAIT_V(0);
    if constexpr (!ALIGN_EPI) { if (wr == 0) PG8_BAR; }
    PG8_BAR;
    if constexpr (Epi::AFTER_DRAIN) { E.fused(acc, cur, wr, wc, fr, fq, lds, wid, lane); S.done(cur); }
#undef PG8_SA
#undef PG8_SB
#undef PG8_STAGE
#undef PG8_LDA
#undef PG8_LDB
#undef PG8_MMA
#undef PG8_WAIT_V
#undef PG8_WAIT_L
#undef PG8_BAR
#undef PG8_SCHED
}
}

#ifndef PG8_SP2
#define PG8_SP2 true
#endif
#ifndef PG8_ALIGN
#define PG8_ALIGN true
#endif
#include <hip/hip_bf16.h>
#include <cmath>
namespace attn_body {
using bf16=__hip_bfloat16;
using bf16x8=__attribute__((ext_vector_type(8)))short;
using s16x4=__attribute__((ext_vector_type(4)))short;
using f32x16=__attribute__((ext_vector_type(16)))float;
using u32x4=__attribute__((ext_vector_type(4)))unsigned;
using f32x4=__attribute__((ext_vector_type(4)))float;
#define LASF __attribute__((address_space(3)))
constexpr int BATCH=8,NHEAD=16,SEQ=2048,D=64,DM=NHEAD*D;
constexpr int NW=8,QBLK=32,QB=QBLK*NW,KVBLK=64,NQB=SEQ/QB;
constexpr int ATTN_PITCH=DM, ATTN_UNIT_ROWS=QB;
__device__ __forceinline__ int crow(int r,int hi){return (r&3)+8*(r>>2)+4*hi;}
#define SBAR() __builtin_amdgcn_sched_barrier(0)
__device__ __forceinline__ void cmask(f32x16&p0,f32x16&p1,int jb,int qrel,int hi){
  const float NEG=-INFINITY; int kb=64*jb+4*hi;
  #pragma unroll
  for(int r=0;r<16;++r){int kv=kb+(r&3)+8*(r>>2); if(kv>qrel)p0[r]=NEG; if(kv+32>qrel)p1[r]=NEG;}
}

constexpr int NSLOT=3, SLOTB=8192;
constexpr int LDS_K=0, LDS_V=NSLOT*SLOTB, LDS_WS=2*NSLOT*SLOTB, LDS_OST=LDS_WS+NW*64*4, LDS_BYTES=LDS_OST+NW*4096;
constexpr float C2=0.125f*1.4426950408889634f;
__device__ __forceinline__ void glds16(const void*gsrc,unsigned lds_dst){unsigned keep;
  asm volatile("s_mov_b32 %0, m0\n\ts_mov_b32 m0, %2\n\ts_nop 0\n\tglobal_load_lds_dwordx4 %1, off\n\ts_mov_b32 m0, %0":"=&s"(keep):"v"(gsrc),"s"(lds_dst):"memory");}
__device__ __forceinline__ float max3f(float a,float b,float c){float r;asm("v_max3_f32 %0, %1, %2, %3":"=v"(r):"v"(a),"v"(b),"v"(c));return r;}
__device__ __forceinline__ float max2f(float a,float b){float r;asm("v_max_f32_e32 %0, %1, %2":"=v"(r):"v"(a),"v"(b));return r;}
__device__ __forceinline__ float fadd_s(float a,float b){float r;asm("v_add_f32_e32 %0, %1, %2":"=v"(r):"v"(a),"v"(b));return r;}
__device__ __forceinline__ float fsub_s(float a,float b){float r;asm("v_sub_f32_e32 %0, %1, %2":"=v"(r):"v"(a),"v"(b));return r;}
typedef float f32x2_t __attribute__((ext_vector_type(2))); typedef __bf16 bf16x2_t __attribute__((ext_vector_type(2)));
__device__ __forceinline__ unsigned cvtpk_s(float lo,float hi){f32x2_t v={lo,hi};bf16x2_t b=__builtin_convertvector(v,bf16x2_t);return __builtin_bit_cast(unsigned,b);}
#define WAIT_BAR(N) asm volatile("s_waitcnt vmcnt(" #N ") lgkmcnt(0)\n\ts_barrier":::"memory")

__device__ __forceinline__ void qkt(f32x16&p0,f32x16&p1,const char*Kslot,const bf16x8*qr,int r32,int hi){
  const char*kb=Kslot+hi*1024+r32*16;
  #pragma unroll
  for(int d0=0;d0<4;++d0){
    const bf16x8 b0=*reinterpret_cast<const bf16x8*>(kb+d0*2048);
    const bf16x8 b1=*reinterpret_cast<const bf16x8*>(kb+d0*2048+512);
    p0=__builtin_amdgcn_mfma_f32_32x32x16_bf16(b0,qr[d0],p0,0,0,0);p1=__builtin_amdgcn_mfma_f32_32x32x16_bf16(b1,qr[d0],p1,0,0,0);}
}
typedef __attribute__((address_space(3))) const char* lds_cptr;
typedef short v4i16_t __attribute__((ext_vector_type(4)));
__device__ __forceinline__ void kload8(bf16x8*kf,lds_cptr kp){
  kf[0]=*(const __attribute__((address_space(3))) bf16x8*)(kp);      kf[1]=*(const __attribute__((address_space(3))) bf16x8*)(kp+512);
  kf[2]=*(const __attribute__((address_space(3))) bf16x8*)(kp+2048); kf[3]=*(const __attribute__((address_space(3))) bf16x8*)(kp+2560);
  kf[4]=*(const __attribute__((address_space(3))) bf16x8*)(kp+4096); kf[5]=*(const __attribute__((address_space(3))) bf16x8*)(kp+4608);
  kf[6]=*(const __attribute__((address_space(3))) bf16x8*)(kp+6144); kf[7]=*(const __attribute__((address_space(3))) bf16x8*)(kp+6656);
}
__device__ __forceinline__ void kload2(bf16x8*kf,lds_cptr kp,int j){ kf[2*j]=*(const __attribute__((address_space(3))) bf16x8*)(kp+j*2048); kf[2*j+1]=*(const __attribute__((address_space(3))) bf16x8*)(kp+j*2048+512); }
__device__ __forceinline__ s16x4 vtr(lds_cptr p){ return __builtin_bit_cast(s16x4,__builtin_amdgcn_ds_read_tr16_b64_v4i16((__attribute__((address_space(3))) v4i16_t*)p)); }
__device__ __forceinline__ float rowmax(const f32x16&p0,const f32x16&p1){
  float a=max3f(p0[0],p0[1],p1[0]),b=max3f(p0[2],p0[3],p1[1]);a=max3f(a,p1[2],p1[3]);
  #pragma unroll
  for(int r=4;r<16;r+=4){a=max3f(a,p0[r],p0[r+1]);b=max3f(b,p0[r+2],p0[r+3]);a=max3f(a,p1[r],p1[r+1]);b=max3f(b,p1[r+2],p1[r+3]);}
  const float m=max2f(a,b);
  auto rr=__builtin_amdgcn_permlane32_swap(__float_as_uint(m),__float_as_uint(m),false,false);
  return max2f(__uint_as_float(rr[0]),__uint_as_float(rr[1]));
}
__device__ __forceinline__ void pv(f32x16*o,int vb,bf16x8 pa0,bf16x8 pa1,bf16x8 pa2,bf16x8 pa3){
  #pragma unroll
  for(int d0=0;d0<2;++d0){s16x4 lo[4],hi[4];
    #pragma unroll
    for(int ks=0;ks<4;++ks){
      asm volatile("ds_read_b64_tr_b16 %0,%1 offset:%c2":"=&v"(lo[ks]):"v"(vb),"i"(d0*4096+ks*1024):"memory");
      asm volatile("ds_read_b64_tr_b16 %0,%1 offset:%c2":"=&v"(hi[ks]):"v"(vb),"i"(d0*4096+ks*1024+512):"memory");}
    asm volatile("s_waitcnt lgkmcnt(0)":::"memory");SBAR();
    #define PK(k) (bf16x8){lo[k][0],lo[k][1],lo[k][2],lo[k][3],hi[k][0],hi[k][1],hi[k][2],hi[k][3]}
    o[d0]=__builtin_amdgcn_mfma_f32_32x32x16_bf16(pa0,PK(0),o[d0],0,0,0);
    o[d0]=__builtin_amdgcn_mfma_f32_32x32x16_bf16(pa1,PK(1),o[d0],0,0,0);
    o[d0]=__builtin_amdgcn_mfma_f32_32x32x16_bf16(pa2,PK(2),o[d0],0,0,0);
    o[d0]=__builtin_amdgcn_mfma_f32_32x32x16_bf16(pa3,PK(3),o[d0],0,0,0);
    #undef PK
  }
}


struct MergeCtx { const unsigned short* GA; const unsigned short* G2; const unsigned short* U; const float* cw; const float* st; unsigned short* out; };
__device__ __forceinline__ float mbflo(unsigned w){return __builtin_bit_cast(float,w<<16);}
__device__ __forceinline__ float mbfhi(unsigned w){return __builtin_bit_cast(float,w&0xffff0000u);}
__device__ __forceinline__ void munpack8(u32x4 w,float*f){f[0]=mbflo(w.x);f[1]=mbfhi(w.x);f[2]=mbflo(w.y);f[3]=mbfhi(w.y);f[4]=mbflo(w.z);f[5]=mbfhi(w.z);f[6]=mbflo(w.w);f[7]=mbfhi(w.w);}
__device__ __forceinline__ void merge_store8(const MergeCtx&c,size_t grow,int t,bool prm,int bb,int col,u32x4 ov){
  const size_t off=grow*1024+col; float ga[8],o[8],g2[8],u0[8],u1[8],u2[8];
  munpack8(*(const u32x4*)(c.GA+off),ga); munpack8(ov,o); munpack8(*(const u32x4*)(c.G2+off),g2); munpack8(*(const u32x4*)(c.U+off),u2);
  if(t>=1)munpack8(*(const u32x4*)(c.U+off-1024),u1);
  else if(prm){_Pragma("unroll") for(int e=0;e<8;++e)u1[e]=0.f;} else {const float*p=c.st+(size_t)(bb*2+1)*1024+col; _Pragma("unroll") for(int e=0;e<8;++e)u1[e]=p[e];}
  if(t>=2)munpack8(*(const u32x4*)(c.U+off-2048),u0);
  else if(prm){_Pragma("unroll") for(int e=0;e<8;++e)u0[e]=0.f;} else {const float*p=c.st+(size_t)(bb*2+t)*1024+col; _Pragma("unroll") for(int e=0;e<8;++e)u0[e]=p[e];}
  float r[8];
  _Pragma("unroll") for(int e=0;e<8;++e){const float cy=c.cw[col+e]*u0[e]+c.cw[1024+col+e]*u1[e]+c.cw[2048+col+e]*u2[e]; r[e]=ga[e]*o[e]+g2[e]*cy;}
  u32x4 w; w.x=cvtpk_s(r[0],r[1]); w.y=cvtpk_s(r[2],r[3]); w.z=cvtpk_s(r[4],r[5]); w.w=cvtpk_s(r[6],r[7]);
  *(u32x4*)(c.out+off)=w;
}
#ifndef ATTN_STORE16
#define ATTN_STORE16(p,v) (*(u32x4*)(p)=(v))
#endif
template<int THRL> __device__ __forceinline__ void attn_unit(int b,int h,int qb,const bf16*Q,const bf16*__restrict__ K,const bf16*__restrict__ V,const MergeCtx&mc,char*shm,const LASF float*fb){
  int tid_=threadIdx.x; asm volatile("":"+v"(tid_));
  const int tid=tid_,lane=tid&63,r32=lane&31,hi=lane>>5; const int wid=__builtin_amdgcn_readfirstlane(tid>>6);
  const long rowbase=(long)b*SEQ; const int q0=qb*QB;
  const bf16*Qw=Q+(rowbase+q0+wid*QBLK)*DM+h*D;
  const bf16*Kh=K+rowbase*DM+h*D,*Vh=V+rowbase*DM+h*D;
  const unsigned lds0=(unsigned)(uintptr_t)shm;
  float*wsf=(float*)(shm+LDS_WS)+wid*64;
  const bf16*ksrc=Kh+(long)lane*DM+wid*8;
  const bf16*vsrc=Vh+(long)(16*(wid&3)+(lane>>2))*DM+(wid>>2)*32+(lane&3)*8;
  const unsigned kdst=lds0+LDS_K+wid*1024, vdst=lds0+LDS_V+wid*1024;
  #define DMA_K(t,slot) glds16(ksrc+(long)(t)*KVBLK*DM,(unsigned)__builtin_amdgcn_readfirstlane(kdst+(slot)))
  #define DMA_V(t,slot) glds16(vsrc+(long)(t)*KVBLK*DM,(unsigned)__builtin_amdgcn_readfirstlane(vdst+(slot)))
  const int vb0=(int)(lds0+LDS_V)+((lane>>4)&1)*32+(lane&3)*8+(4*hi+((lane&15)>>2))*64;
  const char*Kbase=shm+LDS_K; bf16x8 kf[8];
  const lds_cptr shm3=(lds_cptr)shm; const lds_cptr kp0=shm3+LDS_K+hi*1024+r32*16; const lds_cptr vp0=shm3+LDS_V+((lane>>4)&1)*32+(lane&3)*8+(4*hi+((lane&15)>>2))*64;
  const int NT=(q0+QB)/KVBLK;
  DMA_K(0,0);DMA_V(0,0);DMA_K(1,SLOTB);
  bf16x8 qr[4];
  #pragma unroll
  for(int d0=0;d0<4;++d0)qr[d0]=*reinterpret_cast<const bf16x8*>(&Qw[(long)r32*DM+d0*16+hi*8]);
  float mhat=fb[q0+wid*QBLK+r32],l_reg=0.f;f32x16 o[2];o[0]=f32x16{};o[1]=f32x16{};
  #define FBINIT(C0,C1,t) do{ const LASF float*fp_=fb+64*(t)+4*hi; \
    _Pragma("unroll") for(int i_=0;i_<4;++i_){ const f32x4 a_=*(const LASF f32x4*)(fp_+8*i_),b_=*(const LASF f32x4*)(fp_+32+8*i_); \
      C0[4*i_]=a_[0]-mhat;C0[4*i_+1]=a_[1]-mhat;C0[4*i_+2]=a_[2]-mhat;C0[4*i_+3]=a_[3]-mhat; \
      C1[4*i_]=b_[0]-mhat;C1[4*i_+1]=b_[1]-mhat;C1[4*i_+2]=b_[2]-mhat;C1[4*i_+3]=b_[3]-mhat; } }while(0)
  const int qrel=wid*QBLK+r32;
  #define CMASK(P0,P1,t) do{int jb_=(t)-(NT-4); if(jb_>=0)cmask(P0,P1,jb_,qrel,hi);}while(0)
  bool resc=false;
  #define START(P0,P1) do{ const float rm=rowmax(P0,P1); resc=false; \
    if(__any(rm>(float)THRL)){ const float dl=__builtin_fmaxf(rm,0.f); mhat=fadd_s(mhat,dl); \
      _Pragma("unroll") for(int r=0;r<16;++r){P0[r]=fsub_s(P0[r],dl);P1[r]=fsub_s(P1[r],dl);} } \
    _Pragma("unroll") for(int r=0;r<16;++r)P0[r]=__builtin_amdgcn_exp2f(P0[r]); }while(0)
  #define RESC() do{ if(resc){ asm volatile("s_waitcnt lgkmcnt(0)":::"memory"); \
      _Pragma("unroll") for(int d_=0;d_<2;++d_) _Pragma("unroll") for(int r=0;r<16;++r)o[d_][r]*=wsf[crow(r,hi)]; } }while(0)
  f32x16 pA0,pA1,pB0,pB1;
  int sl_prev=0,sl_cur=0,sl_next=SLOTB;
  #define ROT() do{sl_prev=sl_cur;sl_cur=sl_next;sl_next=(sl_next==(NSLOT-1)*SLOTB)?0:sl_next+SLOTB;}while(0)
  DMA_K(2,2*SLOTB);
  WAIT_BAR(3);
  FBINIT(pA0,pA1,0);
  qkt(pA0,pA1,Kbase,qr,r32,hi);asm volatile("s_nop 15\n\ts_nop 7":"+v"(pA0),"+v"(pA1));CMASK(pA0,pA1,0);
  START(pA0,pA1);
  _Pragma("unroll") for(int r=0;r<16;++r)pA1[r]=__builtin_amdgcn_exp2f(pA1[r]);
  WAIT_BAR(0);
  DMA_K(3,0);DMA_V(1,SLOTB);
  ROT();
  kload8(kf,kp0+sl_cur);
  WAIT_BAR(2);
  s16x4 vlo[8],vhi[8]; u32x4 pw0,pw1,pw2,pw3;
  #define PKW(P,B) cvtpk_s(P[B],P[B+1])
  #define PAF(k) __builtin_bit_cast(bf16x8,pw##k)
  #define VFR(i) (bf16x8){vlo[i][0],vlo[i][1],vlo[i][2],vlo[i][3],vhi[i][0],vhi[i][1],vhi[i][2],vhi[i][3]}
  #define PIN(x) asm volatile("":"+v"(x))
  #define MX3(a,b,c) __builtin_fmaxf(__builtin_fmaxf((a),(b)),(c))
  #define GAPA(MF,A0,A1,A2,A3,W0,W1,PW) do{ MF; sacc+=A0; sacc+=A1; sacc+=A2; sacc+=A3; PIN(sacc); W0; W1; PIN(PW); SBAR(); }while(0)
  #define EX(v) __builtin_amdgcn_exp2f(v)
  #define GAPB(MF,X,B) do{ MF; X[B]=EX(X[B]); X[B+1]=EX(X[B+1]); X[B+2]=EX(X[B+2]); X[B+3]=EX(X[B+3]); PIN(X); SBAR(); }while(0)
  #define VRD(i) do{ vlo[i]=vtr(vp_+(((i)>>2)*4096+((i)&3)*1024)); vhi[i]=vtr(vp_+(((i)>>2)*4096+((i)&3)*1024+512)); }while(0)
  #define KRD(G,j) do{ if(G){ kload2(kf,kp0+sl_next,j); SBAR(); } }while(0)
  #define STEP(C0,C1,P0,P1,t,GK,GV,GL) do{ SBAR(); FBINIT(C0,C1,t); SBAR(); \
    const lds_cptr vp_=vp0+sl_prev; \
    VRD(0); SBAR(); float sacc=(P0[0]+P0[1]); \
    GAPA(C0=__builtin_amdgcn_mfma_f32_32x32x16_bf16(kf[0],qr[0],C0,0,0,0), P0[2],P0[3],P0[4],P0[5],     pw0[0]=PKW(P0,0), pw0[1]=PKW(P0,2), pw0); \
    VRD(4); SBAR(); GAPA(C1=__builtin_amdgcn_mfma_f32_32x32x16_bf16(kf[1],qr[0],C1,0,0,0), P0[6],P0[7],P0[8],P0[9],     pw0[2]=PKW(P0,4), pw0[3]=PKW(P0,6), pw0); \
    VRD(1); SBAR(); GAPA(C0=__builtin_amdgcn_mfma_f32_32x32x16_bf16(kf[2],qr[1],C0,0,0,0),   P0[10],P0[11],P0[12],P0[13], pw1[0]=PKW(P0,8), pw1[1]=PKW(P0,10), pw1); \
    VRD(5); SBAR(); GAPA(C1=__builtin_amdgcn_mfma_f32_32x32x16_bf16(kf[3],qr[1],C1,0,0,0),   P0[14],P0[15],P1[0],P1[1],   pw1[2]=PKW(P0,12),pw1[3]=PKW(P0,14), pw1); \
    VRD(2); SBAR(); GAPA(C0=__builtin_amdgcn_mfma_f32_32x32x16_bf16(kf[4],qr[2],C0,0,0,0),   P1[2],P1[3],P1[4],P1[5],     pw2[0]=PKW(P1,0), pw2[1]=PKW(P1,2), pw2); \
    VRD(6); SBAR(); GAPA(C1=__builtin_amdgcn_mfma_f32_32x32x16_bf16(kf[5],qr[2],C1,0,0,0),   P1[6],P1[7],P1[8],P1[9],     pw2[2]=PKW(P1,4), pw2[3]=PKW(P1,6), pw2); \
    VRD(3); SBAR(); GAPA(C0=__builtin_amdgcn_mfma_f32_32x32x16_bf16(kf[6],qr[3],C0,0,0,0),   P1[10],P1[11],P1[12],P1[13], pw3[0]=PKW(P1,8), pw3[1]=PKW(P1,10), pw3); \
    VRD(7); SBAR(); GAPA(C1=__builtin_amdgcn_mfma_f32_32x32x16_bf16(kf[7],qr[3],C1,0,0,0),   P1[14],P1[15],0.f,0.f,       pw3[2]=PKW(P1,12),pw3[3]=PKW(P1,14), pw3); \
    l_reg+=sacc; \
    if(GK){DMA_K((t)+3,sl_cur);} if(GV){DMA_V((t)+1,sl_next);} \
    CMASK(C0,C1,t); \
    { float a=MX3(C0[0],C0[1],C1[0]),b=MX3(C0[2],C0[3],C1[1]); a=MX3(a,C1[2],C1[3]); \
      _Pragma("unroll") for(int r=4;r<16;r+=4){a=MX3(a,C0[r],C0[r+1]);b=MX3(b,C0[r+2],C0[r+3]);a=MX3(a,C1[r],C1[r+1]);b=MX3(b,C1[r+2],C1[r+3]);} \
      float rm=__builtin_fmaxf(a,b); { auto rr=__builtin_amdgcn_permlane32_swap(__float_as_uint(rm),__float_as_uint(rm),false,false); rm=__builtin_fmaxf(__uint_as_float(rr[0]),__uint_as_float(rr[1])); } \
      resc=false; \
      if(__builtin_expect(__any(rm>(float)THRL),0)){ const float dl=__builtin_fmaxf(rm,0.f); mhat+=dl; \
        _Pragma("unroll") for(int r=0;r<16;++r){C0[r]-=dl;C1[r]-=dl;} \
        const float f=__builtin_amdgcn_exp2f(-dl); l_reg*=f; if(hi==0)wsf[r32]=f; resc=true; } } \
    SBAR(); \
    GAPB(o[0]=__builtin_amdgcn_mfma_f32_32x32x16_bf16(PAF(0),VFR(0),o[0],0,0,0), C0,0); \
    GAPB(o[1]=__builtin_amdgcn_mfma_f32_32x32x16_bf16(PAF(0),VFR(4),o[1],0,0,0), C0,4); \
    KRD(GL,0); GAPB(o[0]=__builtin_amdgcn_mfma_f32_32x32x16_bf16(PAF(1),VFR(1),o[0],0,0,0), C0,8); \
    KRD(GL,1); GAPB(o[1]=__builtin_amdgcn_mfma_f32_32x32x16_bf16(PAF(1),VFR(5),o[1],0,0,0), C0,12); \
    KRD(GL,2); GAPB(o[0]=__builtin_amdgcn_mfma_f32_32x32x16_bf16(PAF(2),VFR(2),o[0],0,0,0), C1,0); \
    KRD(GL,3); GAPB(o[1]=__builtin_amdgcn_mfma_f32_32x32x16_bf16(PAF(2),VFR(6),o[1],0,0,0), C1,4); \
    GAPB(o[0]=__builtin_amdgcn_mfma_f32_32x32x16_bf16(PAF(3),VFR(3),o[0],0,0,0), C1,8); \
    GAPB(o[1]=__builtin_amdgcn_mfma_f32_32x32x16_bf16(PAF(3),VFR(7),o[1],0,0,0), C1,12); \
    }while(0)
  int t=1;
  #undef CMASK
  #define CMASK(P0,P1,t) do{}while(0)
  for(;t+5<NT;t+=2){
    STEP(pB0,pB1,pA0,pA1,t,true,true,true);     WAIT_BAR(2); RESC(); ROT();
    STEP(pA0,pA1,pB0,pB1,t+1,true,true,true);   WAIT_BAR(2); RESC(); ROT();
  }
  #undef CMASK
  #define CMASK(P0,P1,t) do{int jb_=(t)-(NT-4); if(jb_>=0)cmask(P0,P1,jb_,qrel,hi);}while(0)
  #define ENDW(tt) do{ if((tt)+3<NT){WAIT_BAR(2);} else if((tt)+2<NT){WAIT_BAR(1);} else {WAIT_BAR(0);} }while(0)
  for(;t+1<NT;t+=2){
    STEP(pB0,pB1,pA0,pA1,t,(t+3<NT),(t+1<NT),(t+1<NT));       ENDW(t);   RESC(); ROT();
    STEP(pA0,pA1,pB0,pB1,t+1,(t+4<NT),(t+2<NT),(t+2<NT));     ENDW(t+1); RESC(); ROT();
  }
  STEP(pB0,pB1,pA0,pA1,NT-1,false,false,false); RESC();
  u32x4 mg[4][5]; f32x4 mcw[3][2];
  { const int mcol=h*D+(lane&7)*8;
    _Pragma("unroll") for(int j=0;j<3;++j){ mcw[j][0]=*(const f32x4*)(mc.cw+j*1024+mcol); mcw[j][1]=*(const f32x4*)(mc.cw+j*1024+mcol+4); }
    _Pragma("unroll") for(int i=0;i<4;++i){ const int t_=q0+wid*QBLK+i*8+(lane>>3); const size_t off=(size_t)(rowbase+t_)*1024+mcol;
      mg[i][0]=__builtin_nontemporal_load((const u32x4*)(mc.GA+off)); mg[i][1]=__builtin_nontemporal_load((const u32x4*)(mc.G2+off)); mg[i][2]=*(const u32x4*)(mc.U+off);
      mg[i][3]=(t_>=1)?*(const u32x4*)(mc.U+off-1024):(u32x4){0u,0u,0u,0u}; mg[i][4]=(t_>=2)?*(const u32x4*)(mc.U+off-2048):(u32x4){0u,0u,0u,0u}; } }
  { float sacc=pB0[0]+pB0[1]; _Pragma("unroll") for(int r=2;r<16;++r)sacc+=pB0[r]; _Pragma("unroll") for(int r=0;r<16;++r)sacc+=pB1[r]; l_reg+=sacc;
    pw0=(u32x4){PKW(pB0,0),PKW(pB0,2),PKW(pB0,4),PKW(pB0,6)};pw1=(u32x4){PKW(pB0,8),PKW(pB0,10),PKW(pB0,12),PKW(pB0,14)};pw2=(u32x4){PKW(pB1,0),PKW(pB1,2),PKW(pB1,4),PKW(pB1,6)};pw3=(u32x4){PKW(pB1,8),PKW(pB1,10),PKW(pB1,12),PKW(pB1,14)};
    SBAR(); pv(o,vb0+sl_cur,PAF(0),PAF(1),PAF(2),PAF(3)); }
  #undef PKW
  #undef PAF
  #undef VFR
  #undef PIN
  #undef MX3
  #undef GAPA
  #undef GAPB
  #undef EX
  #undef VRD
  #undef KRD
  #undef STEP
  #undef ENDW
  {auto rr=__builtin_amdgcn_permlane32_swap(__float_as_uint(l_reg),__float_as_uint(l_reg),false,false);l_reg=__uint_as_float(rr[0])+__uint_as_float(rr[1]);}
  if(hi==0)wsf[32+r32]=l_reg;asm volatile("s_waitcnt lgkmcnt(0)":::"memory");
  float rli[16];
  #pragma unroll
  for(int r=0;r<16;++r)rli[r]=__builtin_amdgcn_rcpf(wsf[32+crow(r,hi)]);
  { bf16*stg=(bf16*)(shm+LDS_OST)+wid*2048;
    #pragma unroll
    for(int r=0;r<16;++r){const int orow=crow(r,hi);
      #pragma unroll
      for(int d0=0;d0<2;++d0)stg[orow*64+d0*32+r32]=__float2bfloat16(o[d0][r]*rli[r]);}
    asm volatile("s_waitcnt lgkmcnt(0)":::"memory");
    #pragma unroll
    for(int i=0;i<4;++i){const int row=i*8+(lane>>3),ch=lane&7; const u32x4 v=*(const u32x4*)(stg+row*64+ch*8); const int t_=q0+wid*QBLK+row;
      float ga[8],ov[8],g2[8],u2[8],u1[8],u0[8],r[8]; munpack8(mg[i][0],ga); munpack8(v,ov); munpack8(mg[i][1],g2); munpack8(mg[i][2],u2); munpack8(mg[i][3],u1); munpack8(mg[i][4],u0);
      _Pragma("unroll") for(int e=0;e<8;++e){ const float cy=mcw[0][e>>2][e&3]*u0[e]+mcw[1][e>>2][e&3]*u1[e]+mcw[2][e>>2][e&3]*u2[e]; r[e]=ga[e]*ov[e]+g2[e]*cy; }
      u32x4 w; w.x=cvtpk_s(r[0],r[1]); w.y=cvtpk_s(r[2],r[3]); w.z=cvtpk_s(r[4],r[5]); w.w=cvtpk_s(r[6],r[7]);
      *(u32x4*)(mc.out+(size_t)(rowbase+t_)*1024+h*D+ch*8)=w; } }
  asm volatile("s_waitcnt lgkmcnt(0)\n\ts_barrier":::"memory");
  #undef DMA_K
  #undef DMA_V
  #undef CMASK
  #undef START
  #undef RESC
  #undef ROT
  #undef FBINIT
}
constexpr int ATTN_LDS_BYTES=LDS_BYTES;
#undef SBAR
#undef WAIT_BAR
}

#define XB_TMO      128
#define XB_XCNT(j)  (256  + 64 * (j))
#define XB_XSUB(j)  (1280 + 64 * (j))
#define XB_XGEN(j)  (2304 + 64 * (j))
#define XB_TOP      3328
#define XB_TOPGEN   3392
#define XCD_BAR_WORDS 3456
#define XB_SPIN_CAP (1u << 18)

__device__ __forceinline__ unsigned xb_ld(unsigned* p)              { return __hip_atomic_load(p, __ATOMIC_RELAXED, __HIP_MEMORY_SCOPE_AGENT); }
__device__ __forceinline__ unsigned xb_add(unsigned* p, unsigned v) { return __hip_atomic_fetch_add(p, v, __ATOMIC_RELAXED, __HIP_MEMORY_SCOPE_AGENT); }
__device__ __forceinline__ unsigned xb_xcc_id() { return (unsigned)__builtin_amdgcn_s_getreg((3 << 11) | 20) & 0xFu; }
#define XB_SPIN(cond, bar) do { unsigned _sp = 0; while (cond) { __builtin_amdgcn_s_sleep(1); \
    if ((++_sp & 255u) == 0u) { if (xb_ld(&(bar)[XB_TMO])) break; if (_sp > XB_SPIN_CAP) { atomicAdd(&(bar)[XB_TMO], 1u); break; } } } } while (0)

struct XcdBarrier {
    unsigned* bar; unsigned x;
    volatile __attribute__((address_space(3))) unsigned* st;
};

__device__ __forceinline__ XcdBarrier xcd_barrier_post(unsigned* bar, volatile __attribute__((address_space(3))) unsigned* st) {
    XcdBarrier b; b.bar = bar; b.x = xb_xcc_id(); b.st = st;
    if (threadIdx.x == 0) (void)xb_add(&bar[XB_XCNT(b.x)], 1u);
    return b;
}
__device__ __forceinline__ void xcd_barrier_complete(unsigned* bar, unsigned x, unsigned& nloc, unsigned& nx) {
    const unsigned G = gridDim.x * gridDim.y * gridDim.z;
    unsigned sum, cnt, mine, sp = 0u;
    for (;;) {
        sum = 0u; cnt = 0u; mine = 0u;
#pragma unroll
        for (unsigned j = 0; j < 16; ++j) { const unsigned c = xb_ld(&bar[XB_XCNT(j)]); sum += c; cnt += (c > 0u) ? 1u : 0u; mine = (j == x) ? c : mine; }
        if (sum == G) break;
        __builtin_amdgcn_s_sleep(1);
        if ((++sp & 255u) == 0u) { if (xb_ld(&bar[XB_TMO])) break; if (sp > XB_SPIN_CAP) { atomicAdd(&bar[XB_TMO], 1u); break; } }
    }
    nloc = mine > 0u ? mine : 1u; nx = cnt > 0u ? cnt : 1u;
}

__device__ __forceinline__ void xcd_barrier(const XcdBarrier& b) {
    asm volatile("s_waitcnt vmcnt(0)" ::: "memory");
    __syncthreads();
    if (threadIdx.x == 0) {
        unsigned* bar = b.bar;
        __builtin_amdgcn_s_waitcnt(0);
        unsigned nloc = b.st[0], nx = b.st[1];
        if (nloc == 0u) { xcd_barrier_complete(bar, b.x, nloc, nx); b.st[0] = nloc; b.st[1] = nx; }
        const unsigned old = xb_add(&bar[XB_XSUB(b.x)], 1u);
        const unsigned gen = old / nloc;
        if (old + 1u == (gen + 1u) * nloc) {
            __builtin_amdgcn_fence(__ATOMIC_RELEASE, "agent");
            asm volatile("s_waitcnt vmcnt(0)" ::: "memory");
            const unsigned og = xb_add(&bar[XB_TOP], 1u);
            const unsigned tg = og / nx;
            if (og + 1u == (tg + 1u) * nx) xb_add(&bar[XB_TOPGEN], 1u);
            else XB_SPIN(xb_ld(&bar[XB_TOPGEN]) == tg, bar);
            __builtin_amdgcn_fence(__ATOMIC_ACQUIRE, "agent");
            xb_add(&bar[XB_XGEN(b.x)], 1u);
            asm volatile("s_waitcnt vmcnt(0)" ::: "memory");
        } else {
            XB_SPIN(xb_ld(&bar[XB_XGEN(b.x)]) == gen, bar);
            __builtin_amdgcn_fence(__ATOMIC_ACQUIRE, "agent");
            asm volatile("s_waitcnt vmcnt(0)" ::: "memory");
        }
    }
    __syncthreads();
}


namespace cg = cooperative_groups;
constexpr int NWAVES = 8, NTHREADS = 512;
constexpr size_t MiB = 1u << 20;
constexpr size_t WS_CNT = 912 * 1024;
constexpr int CNT_WORDS = 3 * 80 * 16;
constexpr size_t WS_BAR = 896 * 1024;
constexpr size_t WS_MOD = 0, WS_W1IN = 1 * MiB, WS_W1OUT = 12 * MiB, WS_WIN = 18 * MiB, WS_WOUT = 35 * MiB, WS_W2IN = 37 * MiB, WS_W2OUT = 48 * MiB, WS_H = 54 * MiB,
                 WS_QB = 88 * MiB, WS_KB = 122 * MiB, WS_VB = 156 * MiB, WS_GAB = 190 * MiB, WS_G2B = 224 * MiB, WS_UB = 258 * MiB, WS_END = 292 * MiB, WS_ACT = WS_QB;
static_assert((size_t)MT * DM * 2 == 34 * MiB && WS_KB - WS_QB == 34 * MiB && WS_VB - WS_KB == 34 * MiB && WS_GAB - WS_VB == 34 * MiB && WS_G2B - WS_GAB == 34 * MiB && WS_UB - WS_G2B == 34 * MiB && WS_ACT + (size_t)MT * DFF * 2 <= WS_GAB && WS_WIN + (size_t)NINP * DM * 2 <= WS_WOUT && WS_W1IN + (size_t)2 * DFF * DM * 2 <= WS_W1OUT, "d_ws map");
constexpr int RING_OFF = 0, RING_BYTES = 131072, FB_OFF = RING_BYTES, STAT_OFF = FB_OFF + 8192, QL_OFF = STAT_OFF + 8192, LDS_BYTES = 163840;
static_assert(QL_OFF + 64 * 144 <= LDS_BYTES && 98304 + 8 * 8192 <= LDS_BYTES && LDS_BYTES <= 163840 && STAT_OFF + 8192 <= LDS_BYTES && attn_body::LDS_BYTES <= RING_BYTES, "LDS map");

#define LAS __attribute__((address_space(3)))
typedef unsigned short bf16;
typedef unsigned v4u __attribute__((ext_vector_type(4)));
typedef unsigned v2u __attribute__((ext_vector_type(2)));
typedef float f32x4 __attribute__((ext_vector_type(4)));
typedef float f32x16 __attribute__((ext_vector_type(16)));
typedef short bf16x8 __attribute__((ext_vector_type(8)));
#define LDS_WAIT() asm volatile("s_waitcnt lgkmcnt(0)" ::: "memory")
__device__ __forceinline__ unsigned f2bf(float f) { unsigned u = __builtin_bit_cast(unsigned, f); return (u + 0x7fffu + ((u >> 16) & 1u)) >> 16; }
__device__ __forceinline__ unsigned pk2(float lo, float hi) { return attn_body::cvtpk_s(lo, hi); }
__device__ __forceinline__ float bflo(unsigned w) { return __builtin_bit_cast(float, w << 16); }
__device__ __forceinline__ float bfhi(unsigned w) { return __builtin_bit_cast(float, w & 0xffff0000u); }
__device__ __forceinline__ float wave_sum(float v) {
#pragma unroll
    for (int o = 1; o < 64; o <<= 1) v += __shfl_xor(v, o);
    return v;
}

struct Args { const float* in[22]; float* out; unsigned char* ws; int ph_lo, ph_hi; };

__device__ __forceinline__ void p0_mod(const Args& a, LAS unsigned char* lds, int vcu, int G) {
    const int tid = threadIdx.x, lane = tid & 63, wid = tid >> 6;
    LAS float* sc = (LAS float*)lds;
    const float* w_ada = a.in[8]; const float* b_ada = a.in[9]; float* mod = (float*)(a.ws + WS_MOD);
    for (int item = vcu; item < MODLD / 64; item += G) {
        for (int i = tid; i < 24 * 1024; i += NTHREADS) { const int b = i >> 10, k = i & 1023; const float c = b < 8 ? a.in[6][b * 1024 + k] : a.in[7][(b - 8) * 1024 + k]; sc[i] = c / (1.0f + __expf(-c)); }
        __syncthreads();
        float acc[24];
#pragma unroll
        for (int b = 0; b < 24; ++b) acc[b] = 0.f;
        const int n = item * 64 + lane; const float* wp = w_ada + (size_t)(wid * 128) * MODLD + n;
        LAS float* wl = (LAS float*)(lds + 98304 + wid * 8192);
        float nx[32];
#pragma unroll
        for (int i = 0; i < 32; ++i) nx[i] = __builtin_nontemporal_load(wp + (size_t)i * MODLD);
#pragma unroll 1
        for (int kb = 0; kb < 128; kb += 32) {
#pragma unroll
            for (int i = 0; i < 32; ++i) wl[i * 64 + lane] = nx[i];
            if (kb + 32 < 128) {
#pragma unroll
                for (int i = 0; i < 32; ++i) nx[i] = __builtin_nontemporal_load(wp + (size_t)(kb + 32 + i) * MODLD);
            }
#pragma unroll 1
            for (int k4 = 0; k4 < 32; k4 += 4) {
                const float w0 = wl[(k4 + 0) * 64 + lane], w1 = wl[(k4 + 1) * 64 + lane], w2 = wl[(k4 + 2) * 64 + lane], w3 = wl[(k4 + 3) * 64 + lane];
#pragma unroll
                for (int b = 0; b < 24; ++b) { const f32x4 s = *(const LAS f32x4*)(sc + b * 1024 + wid * 128 + kb + k4); acc[b] += s[0] * w0 + s[1] * w1 + s[2] * w2 + s[3] * w3; }
            }
        }
        __syncthreads();
#pragma unroll
        for (int b = 0; b < 24; ++b) sc[(wid * 24 + b) * 64 + lane] = acc[b];
        __syncthreads();
        for (int o = tid; o < 24 * 64; o += NTHREADS) { const int b = o >> 6, c = o & 63; float s = b_ada[item * 64 + c];
#pragma unroll
            for (int w = 0; w < 8; ++w) s += sc[(w * 24 + b) * 64 + c];
            mod[(size_t)b * MODLD + item * 64 + c] = s; }
        __syncthreads();
    }
}
__device__ __forceinline__ void p0_transpose_item(const float* W, int K, int N, bf16* WT, int dst_row0, int src_col0, int nvalid, int kb, LAS float* scr, int lane) {
    const int k0 = 64 * kb; const int cl = lane & 31; const bool ok = cl < nvalid;
    float tv[32];
#pragma unroll
    for (int i = 0; i < 32; ++i) { const int kk = 2 * i + (lane >> 5); tv[i] = ok ? __builtin_nontemporal_load(W + (size_t)(k0 + kk) * N + src_col0 + cl) : 0.f; }
#pragma unroll
    for (int i = 0; i < 32; ++i) { const int kk = 2 * i + (lane >> 5); scr[kk * 33 + cl] = tv[i]; }
    LDS_WAIT(); asm volatile("" ::: "memory");
    const int c = lane & 7;
#pragma unroll
    for (int j = 0; j < 4; ++j) { const int n = (lane >> 3) + 8 * j; const LAS float* s = scr + (8 * c) * 33 + n;
        v4u o; o.x = pk2(s[0 * 33], s[1 * 33]); o.y = pk2(s[2 * 33], s[3 * 33]); o.z = pk2(s[4 * 33], s[5 * 33]); o.w = pk2(s[6 * 33], s[7 * 33]);
        *(v4u*)(WT + (size_t)(dst_row0 + n) * K + k0 + 8 * c) = o; }
    LDS_WAIT(); asm volatile("" ::: "memory");
}
__device__ __forceinline__ void map_ffn_in(int db, int& src, int& nv) { const int r = db * 32, t = r >> 8, w = r & 255; src = (w < 128 ? 0 : DFF) + t * 128 + (w & 127); nv = 32; }
__device__ __forceinline__ void map_win(int db, int& src, int& nv) {
    const int r = db * 32; nv = 32;
    if (r < 3072) { src = r; return; }
    if (r < 4096) { src = OFF_GA + (r - 3072); return; }
    if (r < 6144) { const int q = r - 4096, t = q >> 8, w = q & 255; src = (w < 128 ? OFF_B : OFF_GC) + t * 128 + (w & 127); return; }
    if (r < 8192) { const int q = r - 6144, t = q >> 8, w = q & 255; src = (w < 128 ? OFF_C : OFF_X) + t * 128 + (w & 127); return; }
    src = OFF_F; nv = (r == 8192) ? 16 : 0;
}
constexpr int I_1IN = 16 * 176, I_1OUT = 44 * 32, I_WIN = 16 * 264, I_WOUT = 16 * 32, WITEMS = 2 * I_1IN + 2 * I_1OUT + I_WIN + I_WOUT;
constexpr int WCUT0 = 2 * I_1IN + I_WIN, WCUT1 = WCUT0 + I_1OUT;
__device__ __forceinline__ void weight_item(const Args& a, int it, LAS float* scr, int lane) {
    int r = it; int src, nv;
    if (r < I_1IN) { map_ffn_in(r % 176, src, nv); p0_transpose_item(a.in[11], 1024, 2 * DFF, (bf16*)(a.ws + WS_W1IN), (r % 176) * 32, src, nv, r / 176, scr, lane); return; } r -= I_1IN;
    if (r < I_1IN) { map_ffn_in(r % 176, src, nv); p0_transpose_item(a.in[19], 1024, 2 * DFF, (bf16*)(a.ws + WS_W2IN), (r % 176) * 32, src, nv, r / 176, scr, lane); return; } r -= I_1IN;
    if (r < I_WIN) { map_win(r % 264, src, nv); p0_transpose_item(a.in[14], 1024, NIN, (bf16*)(a.ws + WS_WIN), (r % 264) * 32, src, nv, r / 264, scr, lane); return; } r -= I_WIN;
    if (r < I_1OUT) { p0_transpose_item(a.in[12], DFF, 1024, (bf16*)(a.ws + WS_W1OUT), (r % 32) * 32, (r % 32) * 32, 32, r / 32, scr, lane); return; } r -= I_1OUT;
    if (r < I_1OUT) { p0_transpose_item(a.in[20], DFF, 1024, (bf16*)(a.ws + WS_W2OUT), (r % 32) * 32, (r % 32) * 32, 32, r / 32, scr, lane); return; } r -= I_1OUT;
    p0_transpose_item(a.in[17], 1024, 1024, (bf16*)(a.ws + WS_WOUT), (r % 32) * 32, (r % 32) * 32, 32, r / 32, scr, lane);
}
__device__ __forceinline__ void p0_weights(const Args& a, LAS unsigned char* lds, int vcu, int G) {
    const int tid = threadIdx.x, lane = tid & 63, wid = tid >> 6;
    LAS float* scr = (LAS float*)(lds + wid * 16384);
    const int nitems = (G == 256) ? WCUT0 : WITEMS;
    constexpr int NMODWG = MODLD / 64;
    const bool skew = (G > NMODWG);
    const int nslot = skew ? NMODWG * NWAVES + (G - NMODWG) * NWAVES * 2 : G * NWAVES;
    const int slot0 = !skew ? vcu * NWAVES + wid : (vcu < NMODWG ? vcu * NWAVES + wid : NMODWG * NWAVES + ((vcu - NMODWG) * NWAVES + wid) * 2);
    const int nmine = (skew && vcu >= NMODWG) ? 2 : 1;
    for (int sl = 0; sl < nmine; ++sl)
        for (int it = slot0 + sl; it < nitems; it += nslot) weight_item(a, it, scr, lane);
}
__device__ __forceinline__ void weight_items_tail(const Args& a, LAS unsigned char* lds, int first, int last, int wk, int nwk) {
    const int tid = threadIdx.x, lane = tid & 63, wid = tid >> 6;
    LAS float* scr = (LAS float*)(lds + wid * 16384);
    for (int it = first + wk; it < last; it += nwk) weight_item(a, it, scr, lane);
}
template <bool FINAL, bool NT = false> __device__ __forceinline__ void norm_rows4(int m0, const float* xP, const float* xS, const float* g, const float* mod, int sh_off, int sc_off, bf16* H, float* Y, int lane) {
    const float* x0 = m0 < MP ? xP + (size_t)m0 * DM : xS + (size_t)(m0 - MP) * DM;
    const int mb = m0 < MP ? (m0 >> 11) : 8 + ((m0 - MP) >> 6);
    f32x4 v[4][4]; float s[4];
#pragma unroll
    for (int r = 0; r < 4; ++r)
#pragma unroll
        for (int j = 0; j < 4; ++j) { const f32x4* p = (const f32x4*)(x0 + (size_t)r * DM) + lane + 64 * j; v[r][j] = NT ? __builtin_nontemporal_load(p) : *p; }
    f32x4 gg[4], sh[4], sc[4];
#pragma unroll
    for (int j = 0; j < 4; ++j) { gg[j] = ((const f32x4*)g + lane)[64 * j];
        if (!FINAL) { sh[j] = ((const f32x4*)(mod + (size_t)mb * MODLD + sh_off) + lane)[64 * j]; sc[j] = ((const f32x4*)(mod + (size_t)mb * MODLD + sc_off) + lane)[64 * j]; } }
#pragma unroll
    for (int r = 0; r < 4; ++r) { s[r] = 0.f;
#pragma unroll
        for (int j = 0; j < 4; ++j) s[r] += (v[r][j].x * v[r][j].x + v[r][j].y * v[r][j].y) + (v[r][j].z * v[r][j].z + v[r][j].w * v[r][j].w); }
#pragma unroll
    for (int o = 1; o < 64; o <<= 1) {
#pragma unroll
        for (int r = 0; r < 4; ++r) s[r] += __shfl_xor(s[r], o); }
#pragma unroll
    for (int r = 0; r < 4; ++r) { const float rstd = 1.0f / sqrtf(s[r] * (1.f / DM) + EPS);
        if (FINAL) { f32x4* yr = (f32x4*)(Y + (size_t)(m0 + r) * DM) + lane;
#pragma unroll
            for (int j = 0; j < 4; ++j) __builtin_nontemporal_store((v[r][j] * rstd) * gg[j], yr + 64 * j); }
        else { v2u* o8 = (v2u*)(H + (size_t)(m0 + r) * DM) + lane;
#pragma unroll
            for (int j = 0; j < 4; ++j) { const f32x4 y = (v[r][j] * rstd) * gg[j] * (sc[j] + 1.0f) + sh[j]; v2u w; w.x = pk2(y.x, y.y); w.y = pk2(y.z, y.w); o8[64 * j] = w; } } }
}
__device__ __forceinline__ void norm_mod_rows(const float* xP, const float* xS, const float* g, const float* mod, int sh_off, int sc_off, bf16* H, int vcu, int G) {
    const int tid = threadIdx.x, lane = tid & 63, wid = tid >> 6;
    const int gw = vcu * NWAVES + wid, NGW = G * NWAVES;
    for (int q = gw; q < MT / 4; q += NGW) norm_rows4<false, true>(4 * q, xP, xS, g, mod, sh_off, sc_off, H, nullptr, lane);
}
__device__ __forceinline__ void final_norm_rows(float* X, const float* g, int vcu, int G) {
    const int tid = threadIdx.x, lane = tid & 63, wid = tid >> 6;
    const int gw = vcu * NWAVES + wid, NGW = G * NWAVES;
    for (int q = gw; q < MT / 4; q += NGW) norm_rows4<true>(4 * q, X, X + (size_t)MP * DM, g, nullptr, 0, 0, nullptr, X, lane);
}
__device__ __forceinline__ void panel_handoff(unsigned* cP, unsigned* cS) {
    asm volatile("s_waitcnt vmcnt(0)" ::: "memory");
    __syncthreads();
    if (threadIdx.x == 0) {
        __builtin_amdgcn_fence(__ATOMIC_RELEASE, "agent");
        asm volatile("s_waitcnt vmcnt(0)" ::: "memory");
        __hip_atomic_fetch_add(cP, 1u, __ATOMIC_RELAXED, __HIP_MEMORY_SCOPE_AGENT);
        __hip_atomic_fetch_add(cS, 1u, __ATOMIC_RELAXED, __HIP_MEMORY_SCOPE_AGENT);
        unsigned sp = 0;
        while (__hip_atomic_load(cP, __ATOMIC_RELAXED, __HIP_MEMORY_SCOPE_AGENT) < 4u || __hip_atomic_load(cS, __ATOMIC_RELAXED, __HIP_MEMORY_SCOPE_AGENT) < 16u) { __builtin_amdgcn_s_sleep(2); if (++sp > (1u << 22)) break; }
        __builtin_amdgcn_fence(__ATOMIC_ACQUIRE, "agent");
        asm volatile("s_waitcnt vmcnt(0)" ::: "memory");
    }
    __syncthreads();
}
__device__ __forceinline__ void unpack8(v4u w, float* f) { f[0] = bflo(w.x); f[1] = bfhi(w.x); f[2] = bflo(w.y); f[3] = bfhi(w.y); f[4] = bflo(w.z); f[5] = bfhi(w.z); f[6] = bflo(w.w); f[7] = bfhi(w.w); }
__device__ __forceinline__ void merge_phase(const Args& a, int vcu, int G) {
    const bf16* GAB = (const bf16*)(a.ws + WS_GAB); const bf16* OB = (const bf16*)(a.ws + WS_QB); const bf16* G2B = (const bf16*)(a.ws + WS_G2B); const bf16* UB = (const bf16*)(a.ws + WS_UB);
    bf16* Hm = (bf16*)(a.ws + WS_H); const float* cw = a.in[16]; const float* st = a.in[5];
    const size_t total = (size_t)MT * 128, stride = (size_t)G * NTHREADS;
    for (size_t idx = (size_t)vcu * NTHREADS + threadIdx.x; idx < total; idx += stride) {
        const int row = (int)(idx >> 7), c8 = (int)(idx & 127) * 8;
        const bool prm = row < MP; const int rr = prm ? row : row - MP; const int t = prm ? (rr & 2047) : (rr & 63), bb = prm ? (rr >> 11) : (rr >> 6);
        const size_t off = (size_t)row * DM + c8;
        float ga[8], o[8], g2[8], u0[8], u1[8], u2[8];
        unpack8(*(const v4u*)(GAB + off), ga); unpack8(*(const v4u*)(OB + off), o); unpack8(*(const v4u*)(G2B + off), g2); unpack8(*(const v4u*)(UB + off), u2);
        if (t >= 1) unpack8(*(const v4u*)(UB + off - DM), u1);
        else { if (prm) { for (int e = 0; e < 8; ++e) u1[e] = 0.f; } else { const float* p = st + (size_t)(bb * 2 + 1) * 1024 + c8; for (int e = 0; e < 8; ++e) u1[e] = p[e]; } }
        if (t >= 2) unpack8(*(const v4u*)(UB + off - 2 * DM), u0);
        else { if (prm) { for (int e = 0; e < 8; ++e) u0[e] = 0.f; } else { const float* p = st + (size_t)(bb * 2 + t) * 1024 + c8; for (int e = 0; e < 8; ++e) u0[e] = p[e]; } }
        float r[8];
#pragma unroll
        for (int e = 0; e < 8; ++e) { const float cy = cw[c8 + e] * u0[e] + cw[1024 + c8 + e] * u1[e] + cw[2048 + c8 + e] * u2[e]; r[e] = ga[e] * o[e] + g2[e] * cy; }
        v4u w; w.x = pk2(r[0], r[1]); w.y = pk2(r[2], r[3]); w.z = pk2(r[4], r[5]); w.w = pk2(r[6], r[7]);
        *(v4u*)(Hm + off) = w;
    }
}

__device__ __forceinline__ void small_gemm_sample(const bf16* A, const bf16* Wt, int K, const float* base, float* outp, const float* gate, float coef, LAS unsigned char* ring, int vcu, int G) {
    int tid = threadIdx.x; asm volatile("" : "+v"(tid));
    const int lane = tid & 63, wid = tid >> 6, fr = lane & 15, fq = lane >> 4; const int KW = K >> 3;
    for (int item = vcu; item < 256; item += G) {
        const int rt = (item >> 4) * 64, ct = (item & 15) * 64;
        const bf16* ap = A + (size_t)(rt + fr) * K + wid * KW + 8 * fq; const bf16* bp = Wt + (size_t)(ct + fr) * K + wid * KW + 8 * fq;
        f32x4 acc[4][4];
#pragma unroll
        for (int mi = 0; mi < 4; ++mi)
#pragma unroll
            for (int nj = 0; nj < 4; ++nj) acc[mi][nj] = (f32x4){0.f, 0.f, 0.f, 0.f};
#pragma unroll 2
        for (int k0 = 0; k0 < KW; k0 += 32) {
            bf16x8 a[4], b[4];
#pragma unroll
            for (int i = 0; i < 4; ++i) { a[i] = *(const bf16x8*)(ap + (size_t)(16 * i) * K + k0); b[i] = *(const bf16x8*)(bp + (size_t)(16 * i) * K + k0); }
#pragma unroll
            for (int mi = 0; mi < 4; ++mi)
#pragma unroll
                for (int nj = 0; nj < 4; ++nj) acc[mi][nj] = __builtin_amdgcn_mfma_f32_16x16x32_bf16(b[nj], a[mi], acc[mi][nj], 0, 0, 0);
        }
        LAS float* P = (LAS float*)(ring + wid * 16384);
#pragma unroll
        for (int mi = 0; mi < 4; ++mi)
#pragma unroll
            for (int nj = 0; nj < 4; ++nj) { const int row = mi * 16 + fr, grp = (nj * 4 + fq) ^ (row & 15); *(LAS f32x4*)(P + row * 64 + grp * 4) = acc[mi][nj]; }
        __syncthreads();
        { const int row = tid >> 3, j = tid & 7; const int g0 = (2 * j) ^ (row & 15), g1 = (2 * j + 1) ^ (row & 15);
          f32x4 s0 = (f32x4){0.f, 0.f, 0.f, 0.f}, s1 = s0;
#pragma unroll
          for (int w = 0; w < 8; ++w) { const LAS float* p = (const LAS float*)(ring + w * 16384) + row * 64; s0 += *(const LAS f32x4*)(p + g0 * 4); s1 += *(const LAS f32x4*)(p + g1 * 4); }
          const int grow = rt + row, c0 = ct + 8 * j; const int mb = 8 + (grow >> 6);
          const f32x4 ga = *(const f32x4*)(gate + (size_t)mb * MODLD + c0) * coef, gb = *(const f32x4*)(gate + (size_t)mb * MODLD + c0 + 4) * coef;
          const f32x4 r0 = *(const f32x4*)(base + (size_t)grow * DM + c0), r1 = *(const f32x4*)(base + (size_t)grow * DM + c0 + 4);
          *(f32x4*)(outp + (size_t)grow * DM + c0) = r0 + ga * s0; *(f32x4*)(outp + (size_t)grow * DM + c0 + 4) = r1 + gb * s1; }
        __syncthreads();
    }
}
__device__ __forceinline__ void stage_fb(LAS float* fb, LAS float* wtot, const float* src0, int n0, const float* src1, int n1) {
    int tid = threadIdx.x; asm volatile("" : "+v"(tid)); const int lane = tid & 63, wid = tid >> 6; const int n = n0 + n1, e = 4 * tid;
    f32x4 v = (f32x4){0.f, 0.f, 0.f, 0.f};
    if (e < n) v = (e < n0) ? *(const f32x4*)(src0 + e) : *(const f32x4*)(src1 + (e - n0));
    const float s0 = v[0], s1 = s0 + v[1], s2 = s1 + v[2], s3 = s2 + v[3];
    float inc = s3;
#pragma unroll
    for (int o = 1; o < 64; o <<= 1) { const float t = __shfl_up(inc, o); if (lane >= o) inc += t; }
    if (lane == 63) wtot[wid] = inc;
    __syncthreads();
    float base = inc - s3;
#pragma unroll
    for (int w = 0; w < 8; ++w) { const float tw = wtot[w]; if (w < wid) base += tw; }
    const float c = -1.4426950408889634f;
    if (e < n) *(LAS f32x4*)(fb + e) = (f32x4){(base + s0) * c, (base + s1) * c, (base + s2) * c, (base + s3) * c};
    __syncthreads();
}
__device__ __forceinline__ void attn_sample_unit(int b, int h, const float* cK, const float* cV, const bf16* QB, const bf16* KB, const bf16* VB, const attn_body::MergeCtx& mc,
                                                 LAS unsigned char* ring, const LAS float* fb, LAS float* stats) {
    using attn_body::crow;
    int tid = threadIdx.x; asm volatile("" : "+v"(tid));
    const int lane = tid & 63, r32 = lane & 31, hi = lane >> 5; const int wid = __builtin_amdgcn_readfirstlane(tid >> 6);
    const size_t rowbase = (size_t)MP + (size_t)b * TS;
    LAS unsigned char* Ks = ring + wid * 16384; LAS unsigned char* Vs = Ks + 8192;
    LAS float* wsf = stats + 1024 + wid * 64;
    LAS unsigned char* QL = ring + (QL_OFF - RING_OFF);
    { const int row = tid >> 3, ch = tid & 7; *(LAS v4u*)(QL + row * 144 + ch * 16) = *(const v4u*)(QB + (rowbase + row) * DM + h * HD + ch * 8); }
    __syncthreads();
    float mhat[2], lsum[2] = {0.f, 0.f}; f32x16 o[2][2];
#pragma unroll
    for (int g = 0; g < 2; ++g) { mhat[g] = fb[PAST + 32 * g + r32]; o[g][0] = f32x16{}; o[g][1] = f32x16{}; }
    const int vb = (int)(unsigned)(uintptr_t)Vs + ((lane >> 4) & 1) * 32 + (lane & 3) * 8 + (4 * hi + ((lane & 15) >> 2)) * 64;
#pragma unroll 1
    for (int tl = wid; tl < 17; tl += 8) {
        if (tl < 16) {
            const f32x4* ksrc = (const f32x4*)(cK + ((size_t)(b * NH + h) * PAST + tl * 64) * HD); const f32x4* vsrc = (const f32x4*)(cV + ((size_t)(b * NH + h) * PAST + tl * 64) * HD);
#pragma unroll 1
            for (int hb = 0; hb < 16; hb += 8) {
                f32x4 kva[8], vva[8];
#pragma unroll
                for (int i = 0; i < 8; ++i) { kva[i] = __builtin_nontemporal_load(ksrc + (hb + i) * 64 + lane); vva[i] = __builtin_nontemporal_load(vsrc + (hb + i) * 64 + lane); }
#pragma unroll
                for (int i = 0; i < 8; ++i) { const int key = 4 * (hb + i) + (lane >> 4), d = (lane & 15) * 4; const f32x4 kv = kva[i], vv = vva[i];
                    v2u kw, vw; kw.x = pk2(kv.x, kv.y); kw.y = pk2(kv.z, kv.w); vw.x = pk2(vv.x, vv.y); vw.y = pk2(vv.z, vv.w);
                    *(LAS v2u*)(Ks + (d >> 3) * 1024 + key * 16 + (d & 7) * 2) = kw;
                    *(LAS v2u*)(Vs + ((d >> 5) * 4 + (key >> 4)) * 1024 + (key & 15) * 64 + (d & 31) * 2) = vw; }
            }
        } else {
#pragma unroll 1
            for (int hb = 0; hb < 8; hb += 4) {
                v4u kvb[4], vvb[4];
#pragma unroll
                for (int i = 0; i < 4; ++i) { const int key = 8 * (hb + i) + (lane >> 3), ch = lane & 7; const size_t off = (rowbase + key) * DM + h * HD + ch * 8; kvb[i] = *(const v4u*)(KB + off); vvb[i] = *(const v4u*)(VB + off); }
#pragma unroll
                for (int i = 0; i < 4; ++i) { const int key = 8 * (hb + i) + (lane >> 3), ch = lane & 7;
                    *(LAS v4u*)(Ks + ch * 1024 + key * 16) = kvb[i];
                    *(LAS v4u*)(Vs + ((ch >> 2) * 4 + (key >> 4)) * 1024 + (key & 15) * 64 + (ch & 3) * 16) = vvb[i]; }
            }
        }
        LDS_WAIT();
#pragma unroll
        for (int g = 0; g < 2; ++g) {
            __builtin_amdgcn_sched_barrier(0);
            f32x16 p0, p1;
            { const LAS float* fp = fb + 64 * tl + 4 * hi;
#pragma unroll
              for (int i = 0; i < 4; ++i) { const f32x4 x = *(const LAS f32x4*)(fp + 8 * i), y = *(const LAS f32x4*)(fp + 32 + 8 * i);
#pragma unroll
                  for (int e = 0; e < 4; ++e) { p0[4 * i + e] = x[e] - mhat[g]; p1[4 * i + e] = y[e] - mhat[g]; } } }
            { const LAS unsigned char* kb = Ks + hi * 1024 + r32 * 16;
#pragma unroll
              for (int d0 = 0; d0 < 4; ++d0) { const bf16x8 b0 = *(const LAS bf16x8*)(kb + d0 * 2048), b1 = *(const LAS bf16x8*)(kb + d0 * 2048 + 512);
                  const bf16x8 qf = *(const LAS bf16x8*)(QL + (32 * g + r32) * 144 + d0 * 32 + hi * 16);
                  p0 = __builtin_amdgcn_mfma_f32_32x32x16_bf16(b0, qf, p0, 0, 0, 0); p1 = __builtin_amdgcn_mfma_f32_32x32x16_bf16(b1, qf, p1, 0, 0, 0); } }
            if (tl == 16) { const int qi = 32 * g + r32;
#pragma unroll
                for (int r = 0; r < 16; ++r) { const int kj = crow(r, hi); if (kj > qi) p0[r] = -INFINITY; if (kj + 32 > qi) p1[r] = -INFINITY; } }
            float rm = p0[0];
#pragma unroll
            for (int r = 1; r < 16; ++r) rm = fmaxf(rm, p0[r]);
#pragma unroll
            for (int r = 0; r < 16; ++r) rm = fmaxf(rm, p1[r]);
            rm = fmaxf(rm, __shfl_xor(rm, 32));
            const float dl = fmaxf(rm, 0.f);
            mhat[g] += dl;
            const float f = __builtin_amdgcn_exp2f(-dl);
            float sacc = 0.f;
#pragma unroll
            for (int r = 0; r < 16; ++r) { p0[r] = __builtin_amdgcn_exp2f(p0[r] - dl); p1[r] = __builtin_amdgcn_exp2f(p1[r] - dl); sacc += p0[r] + p1[r]; }
            lsum[g] = lsum[g] * f + sacc;
            if (hi == 0) wsf[32 * g + r32] = f;
            LDS_WAIT();
#pragma unroll
            for (int r = 0; r < 16; ++r) { const float fr_ = wsf[32 * g + crow(r, hi)]; o[g][0][r] *= fr_; o[g][1][r] *= fr_; }
            v4u pw0, pw1, pw2, pw3;
#define PKW(P, B) attn_body::cvtpk_s(P[B], P[B + 1])
            pw0 = (v4u){PKW(p0, 0), PKW(p0, 2), PKW(p0, 4), PKW(p0, 6)}; pw1 = (v4u){PKW(p0, 8), PKW(p0, 10), PKW(p0, 12), PKW(p0, 14)};
            pw2 = (v4u){PKW(p1, 0), PKW(p1, 2), PKW(p1, 4), PKW(p1, 6)}; pw3 = (v4u){PKW(p1, 8), PKW(p1, 10), PKW(p1, 12), PKW(p1, 14)};
#undef PKW
            attn_body::pv(o[g], vb, __builtin_bit_cast(bf16x8, pw0), __builtin_bit_cast(bf16x8, pw1), __builtin_bit_cast(bf16x8, pw2), __builtin_bit_cast(bf16x8, pw3));
        }
        LDS_WAIT();
    }
#pragma unroll
    for (int g = 0; g < 2; ++g) { const float lt = lsum[g] + __shfl_xor(lsum[g], 32); if (hi == 0) { stats[wid * 64 + 32 * g + r32] = mhat[g]; stats[512 + wid * 64 + 32 * g + r32] = lt; } }
    __syncthreads();
    LAS float* Op = (LAS float*)(ring + wid * 16384);
#pragma unroll
    for (int g = 0; g < 2; ++g)
#pragma unroll
        for (int r = 0; r < 16; ++r) { const int q = 32 * g + crow(r, hi); float mx = stats[q];
#pragma unroll
            for (int w = 1; w < 8; ++w) mx = fmaxf(mx, stats[w * 64 + q]);
            const float scl = __builtin_amdgcn_exp2f(stats[wid * 64 + q] - mx);
            Op[q * 64 + r32] = o[g][0][r] * scl; Op[q * 64 + 32 + r32] = o[g][1][r] * scl; }
    __syncthreads();
    { const int q = tid >> 3, d0 = (tid & 7) * 8; float mx = stats[q];
#pragma unroll
      for (int w = 1; w < 8; ++w) mx = fmaxf(mx, stats[w * 64 + q]);
      float Lq = 0.f; f32x4 s0 = (f32x4){0.f, 0.f, 0.f, 0.f}, s1 = s0;
#pragma unroll
      for (int w = 0; w < 8; ++w) { Lq += stats[512 + w * 64 + q] * __builtin_amdgcn_exp2f(stats[w * 64 + q] - mx);
          const LAS float* p = (const LAS float*)(ring + w * 16384) + q * 64 + d0; s0 += *(const LAS f32x4*)p; s1 += *(const LAS f32x4*)(p + 4); }
      const float rl = 1.0f / Lq; s0 = s0 * rl; s1 = s1 * rl;
      v4u w; w.x = pk2(s0.x, s0.y); w.y = pk2(s0.z, s0.w); w.z = pk2(s1.x, s1.y); w.w = pk2(s1.z, s1.w);
      merge_store8(mc, rowbase + q, q, false, b, h * HD + d0, w); }
    __syncthreads();
}

__global__ void __launch_bounds__(NTHREADS, 2) fwd_mega(Args args) {
    extern __shared__ __attribute__((aligned(16))) unsigned char lds[];
    cg::grid_group grid = cg::this_grid();
    LAS unsigned char* L = (LAS unsigned char*)lds;
    const int G = gridDim.x; const int bx = blockIdx.x; const int vcu = (G % 8 == 0) ? (bx % 8) * (G / 8) + bx / 8 : bx;
    unsigned char* ws = args.ws; float* out = args.out; const float* mod = (const float*)(ws + WS_MOD);
    bf16* Hb = (bf16*)(ws + WS_H); bf16* ACT = (bf16*)(ws + WS_ACT);
    float* XR = out + O_Y;
    const int lo = args.ph_lo, hi = args.ph_hi;
#ifndef PH_MASK
#define PH_MASK 0x1fff
#endif
#define IN(k) (((PH_MASK >> (k)) & 1) && lo <= (k) && (k) < hi)
#define SEAM(k) do { if (IN(k) && IN((k) + 1)) xcd_barrier(bar); } while (0)

    unsigned* barw = (unsigned*)(ws + WS_BAR);
    volatile LAS unsigned* bst = (volatile LAS unsigned*)(L + STAT_OFF + 8000);
    unsigned* cntw = (unsigned*)(ws + WS_CNT);
    if (bx == 0) { for (int i = threadIdx.x; i < XCD_BAR_WORDS; i += NTHREADS) __hip_atomic_store(barw + i, 0u, __ATOMIC_RELAXED, __HIP_MEMORY_SCOPE_AGENT);
                   for (int i = threadIdx.x; i < CNT_WORDS; i += NTHREADS) __hip_atomic_store(cntw + i, 0u, __ATOMIC_RELAXED, __HIP_MEMORY_SCOPE_AGENT); }
    const bool fuse_rows = (G == 256);
    const int wv = threadIdx.x >> 6, ln = threadIdx.x & 63;
    bf16* Hb2 = (bf16*)(ws + WS_GAB);
#define HANDOFF(inst, S) pg8::Unit hu; S.next(0, hu); const int rt_ = vcu >> 4, ct_ = vcu & 15; \
        panel_handoff(cntw + ((inst) * 80 + hu.pm) * 16, cntw + ((inst) * 80 + 64 + rt_) * 16)
    if (IN(0)) { p0_mod(args, L, vcu, G); p0_weights(args, L, vcu, G); }
    if (threadIdx.x < 2) bst[threadIdx.x] = 0u;
    grid.sync();
    const XcdBarrier bar = xcd_barrier_post(barw, bst);
    if (IN(1)) norm_mod_rows(args.in[0], args.in[1], args.in[10], mod, 0 * DM, 1 * DM, Hb, vcu, G);
    SEAM(1);
    if (IN(2)) { pg8::Gemm g{Hb, (const bf16*)(ws + WS_W1IN), MT, 2 * DFF, DM}; pg8::StaticOrder S; S.init(MT, 2 * DFF, G, bx);
        pg8::EpiSwiGLU E{ACT, DFF}; pg8::gemm_phase<pg8::EpiSwiGLU, pg8::StaticOrder, PG8_ALIGN, PG8_SP2>(L + RING_OFF, g, S, E);
        constexpr int NF = (68 * 22) % 256;
        if (G == 256 && bx >= NF) weight_items_tail(args, L, WCUT0, WCUT1, (bx - NF) * NWAVES + (int)(threadIdx.x >> 6), (256 - NF) * NWAVES); }
    SEAM(2);
    if (IN(3)) { pg8::Gemm g{ACT, (const bf16*)(ws + WS_W1OUT), MP, DM, DFF}; pg8::StaticOrder S; S.init(MP, DM, G, bx);
        pg8::EpiResid<true> E{args.in[0], args.in[1], XR, mod + 2 * DM, 0.5f}; pg8::gemm_phase<pg8::EpiResid<true>, pg8::StaticOrder, false, PG8_SP2>(L + RING_OFF, g, S, E);
        small_gemm_sample(ACT + (size_t)MP * DFF, (const bf16*)(ws + WS_W1OUT), DFF, args.in[1], XR + (size_t)MP * DM, mod + 2 * DM, 0.5f, L + RING_OFF, vcu, G);
        if (fuse_rows) { HANDOFF(0, S);
#pragma unroll 1
            for (int i = 0; i < 8; i += 4) norm_rows4<false>(hu.pm * 256 + hu.pn * 64 + wv * 8 + i, XR, XR + (size_t)MP * DM, args.in[13], mod, 3 * DM, 4 * DM, Hb, nullptr, ln);
            if (wv == 0) norm_rows4<false>(MP + rt_ * 64 + ct_ * 4, XR, XR + (size_t)MP * DM, args.in[13], mod, 3 * DM, 4 * DM, Hb, nullptr, ln); } }
    if (!fuse_rows) { SEAM(3); if (IN(4)) norm_mod_rows(XR, XR + (size_t)MP * DM, args.in[13], mod, 3 * DM, 4 * DM, Hb, vcu, G); }
    SEAM(4);
    if (IN(5)) { pg8::Gemm g{Hb, (const bf16*)(ws + WS_WIN), MT, NINP, DM}; pg8::StaticOrder S; S.init(MT, NINP, G, bx);
        pg8::EpiMix E{(bf16*)(ws + WS_QB), out, args.in[15], attn_body::C2};
        pg8::gemm_phase<pg8::EpiMix, pg8::StaticOrder, PG8_ALIGN, PG8_SP2>(L + RING_OFF, g, S, E);
        constexpr int NF = (68 * 33) % 256;
        if (G == 256 && bx >= NF) weight_items_tail(args, L, WCUT1, WITEMS, (bx - NF) * NWAVES + (int)(threadIdx.x >> 6), (256 - NF) * NWAVES); }
    SEAM(5);
    if (IN(6)) {
        const attn_body::bf16* Q = (const attn_body::bf16*)(ws + WS_QB); const attn_body::bf16* K = (const attn_body::bf16*)(ws + WS_KB); const attn_body::bf16* V = (const attn_body::bf16*)(ws + WS_VB);
        LAS float* fb = (LAS float*)(L + FB_OFF); LAS float* stats = (LAS float*)(L + STAT_OFF);
        const attn_body::MergeCtx mc{(const bf16*)(ws + WS_GAB), (const bf16*)(ws + WS_G2B), (const bf16*)(ws + WS_UB), args.in[16], args.in[5], Hb};
#pragma unroll 1
        for (int pass = 0; pass < 2; ++pass) {
        const bool do_sample = ((vcu & 1) != 0) == (pass == 0);
        if (!do_sample) {
        for (int it = vcu; it < 512; it += G) {
            const int bh = it >> 2, k = it & 3;
            stage_fb(fb, stats, out + O_LFP + (size_t)bh * TP, TP, nullptr, 0);
#pragma unroll 1
            for (int j = 0; j < 2; ++j) attn_body::attn_unit<8>(bh >> 4, bh & 15, j ? k : 7 - k, Q, K, V, mc, (char*)lds + RING_OFF, fb);
        }
        } else {
        for (int it = vcu; it < 256; it += G) {
            const int b = it >> 4, h = it & 15;
            stage_fb(fb, stats, args.in[4] + (size_t)it * PAST, PAST, out + O_LFS + (size_t)it * TS, TS);
            attn_sample_unit(b, h, args.in[2], args.in[3], (const bf16*)(ws + WS_QB), (const bf16*)(ws + WS_KB), (const bf16*)(ws + WS_VB), mc, L + RING_OFF, fb, stats);
        }
        }
        }
    }
    SEAM(6);
    if (IN(8)) { pg8::Gemm g{Hb, (const bf16*)(ws + WS_WOUT), MP, DM, DM}; pg8::StaticOrder S; S.init(MP, DM, G, bx);
        pg8::EpiResid<false> E{XR, XR + (size_t)MP * DM, XR, mod + 5 * DM, 1.0f}; pg8::gemm_phase<pg8::EpiResid<false>, pg8::StaticOrder, false, PG8_SP2>(L + RING_OFF, g, S, E);
        small_gemm_sample(Hb + (size_t)MP * DM, (const bf16*)(ws + WS_WOUT), DM, XR + (size_t)MP * DM, XR + (size_t)MP * DM, mod + 5 * DM, 1.0f, L + RING_OFF, vcu, G);
        if (fuse_rows) { HANDOFF(1, S);
#pragma unroll 1
            for (int i = 0; i < 8; i += 4) norm_rows4<false>(hu.pm * 256 + hu.pn * 64 + wv * 8 + i, XR, XR + (size_t)MP * DM, args.in[18], mod, 6 * DM, 7 * DM, Hb2, nullptr, ln);
            if (wv == 0) norm_rows4<false>(MP + rt_ * 64 + ct_ * 4, XR, XR + (size_t)MP * DM, args.in[18], mod, 6 * DM, 7 * DM, Hb2, nullptr, ln); } }
    if (!fuse_rows) { SEAM(8); if (IN(9)) norm_mod_rows(XR, XR + (size_t)MP * DM, args.in[18], mod, 6 * DM, 7 * DM, Hb2, vcu, G); }
    SEAM(9);
    if (IN(10)) { pg8::Gemm g{Hb2, (const bf16*)(ws + WS_W2IN), MT, 2 * DFF, DM}; pg8::StaticOrder S; S.init(MT, 2 * DFF, G, bx);
        pg8::EpiSwiGLU E{ACT, DFF}; pg8::gemm_phase<pg8::EpiSwiGLU, pg8::StaticOrder, PG8_ALIGN, PG8_SP2>(L + RING_OFF, g, S, E); }
    SEAM(10);
    if (IN(11)) { pg8::Gemm g{ACT, (const bf16*)(ws + WS_W2OUT), MP, DM, DFF}; pg8::StaticOrder S; S.init(MP, DM, G, bx);
        pg8::EpiResid<false> E{XR, XR + (size_t)MP * DM, XR, mod + 8 * DM, 0.5f}; pg8::gemm_phase<pg8::EpiResid<false>, pg8::StaticOrder, false, PG8_SP2>(L + RING_OFF, g, S, E);
        small_gemm_sample(ACT + (size_t)MP * DFF, (const bf16*)(ws + WS_W2OUT), DFF, XR + (size_t)MP * DM, XR + (size_t)MP * DM, mod + 8 * DM, 0.5f, L + RING_OFF, vcu, G);
        if (fuse_rows) { HANDOFF(2, S);
#pragma unroll 1
            for (int i = 0; i < 8; i += 4) norm_rows4<true>(hu.pm * 256 + hu.pn * 64 + wv * 8 + i, XR, XR + (size_t)MP * DM, args.in[21], nullptr, 0, 0, nullptr, XR, ln);
            if (wv == 0) norm_rows4<true>(MP + rt_ * 64 + ct_ * 4, XR, XR + (size_t)MP * DM, args.in[21], nullptr, 0, 0, nullptr, XR, ln); } }
    if (!fuse_rows) { SEAM(11); if (IN(12)) final_norm_rows(XR, args.in[21], vcu, G); }
#undef IN
#undef SEAM
}

#ifndef MK_N_LAUNCHES
#define MK_N_LAUNCHES 1
#endif
constexpr int N_PHASES = 13;
extern "C" void kernel_launch(void* const* d_in, const int* in_sizes, int n_in, void* d_out, int out_size, void* d_ws, size_t ws_size, hipStream_t stream) {
    static int grid = 0;
    if (grid == 0) {
        if (n_in != 22 || out_size != (int)O_END || ws_size < WS_END) { fprintf(stderr, "kernel_launch: unexpected sizes n_in %d out %d ws %zu; nothing launched\n", n_in, out_size, ws_size); grid = -1; return; }
        int dev = 0, cus = 0, per_cu = 0;
        if (hipGetDevice(&dev) != hipSuccess || hipDeviceGetAttribute(&cus, hipDeviceAttributeMultiprocessorCount, dev) != hipSuccess) { grid = -1; return; }
        if (hipFuncSetAttribute((const void*)fwd_mega, hipFuncAttributeMaxDynamicSharedMemorySize, LDS_BYTES) != hipSuccess) { fprintf(stderr, "kernel_launch: hipFuncSetAttribute failed\n"); grid = -1; return; }
        if (hipOccupancyMaxActiveBlocksPerMultiprocessor(&per_cu, (const void*)fwd_mega, NTHREADS, LDS_BYTES) != hipSuccess || per_cu < 1) { fprintf(stderr, "kernel_launch: occupancy query says %d\n", per_cu); (void)hipGetLastError(); grid = -1; return; }
        grid = cus * 1;
        fprintf(stderr, "kernel_launch: grid %d (cus %d, per_cu %d), ws %zu\n", grid, cus, per_cu, ws_size);
    }
    if (grid < 0) return;
    Args a{};
    for (int i = 0; i < 22; ++i) a.in[i] = (const float*)d_in[i];
    a.out = (float*)d_out; a.ws = (unsigned char*)d_ws;
#if MK_N_LAUNCHES == 1
    a.ph_lo = 0; a.ph_hi = N_PHASES;
    void* kargs[] = {&a};
    hipError_t e = hipLaunchCooperativeKernel((const void*)fwd_mega, dim3(grid), dim3(NTHREADS), kargs, LDS_BYTES, stream);
    if (e != hipSuccess) fprintf(stderr, "kernel_launch: cooperative launch failed: %s (grid %d)\n", hipGetErrorString(e), grid);
#else
    for (int p = 0; p < N_PHASES; ++p) { a.ph_lo = p; a.ph_hi = p + 1; void* kargs[] = {&a};
        hipError_t e = hipLaunchCooperativeKernel((const void*)fwd_mega, dim3(grid), dim3(NTHREADS), kargs, LDS_BYTES, stream);
        if (e != hipSuccess) { fprintf(stderr, "kernel_launch: launch %d failed: %s\n", p, hipGetErrorString(e)); break; } }
#endif
}
```

```cpp
#include <hip/hip_runtime.h>
#include <hip/hip_cooperative_groups.h>
#include <cstdio>
#include <cstdint>
constexpr int MODLD = 9216;
constexpr int DM = 1024, MP = 16384, MS = 1024, MT = MP + MS, TP = 2048, TS = 64, PAST = 1024, NH = 16, HD = 64, DFF = 2816, NIN = 8208, NINP = 8448, NMOD = 9;
constexpr int OFF_Q = 0, OFF_K = 1024, OFF_V = 2048, OFF_F = 3072, OFF_B = 3088, OFF_C = 4112, OFF_X = 5136, OFF_GA = 6160, OFF_GC = 7184;
constexpr float EPS = 1e-6f;
constexpr size_t O_Y = 0, O_KP = (size_t)MT * DM, O_VP = O_KP + (size_t)MP * DM, O_LFP = O_VP + (size_t)MP * DM, O_CVP = O_LFP + 8 * 16 * 2048, O_KS = O_CVP + 8 * 2 * 1024,
                 O_VS = O_KS + (size_t)MS * DM, O_LFS = O_VS + (size_t)MS * DM, O_CVS = O_LFS + 16 * 16 * 64, O_END = O_CVS + 16 * 2 * 1024;
static_assert(O_END == 53805056, "d_out map");
namespace pg8 {
#define PG8_LAS __attribute__((address_space(3)))
typedef unsigned short bf16_t;
typedef short bf16x8 __attribute__((ext_vector_type(8)));
typedef float f32x4 __attribute__((ext_vector_type(4)));
typedef unsigned u32x4 __attribute__((ext_vector_type(4)));
constexpr int BM = 256, BK = 64, HALF = 128, HTB = HALF * BK * 2  , STAGE_BYTES = 8 * HTB, NXCD = 8, WGM = 8;

__host__ __device__ __forceinline__ int lds_byte(int r, int c) { const int st = (r >> 4) * 2 + (c >> 5), rr = r & 15, cc = c & 31, ob = rr * 64 + cc * 2; return st * 1024 + (ob ^ (((ob >> 9) & 1) << 5)); }
__host__ __device__ __forceinline__ void stage_rc(int b, int& R, int& C) { const int st = b / 1024, sb = b % 1024, swz = sb ^ (((sb >> 9) & 1) << 5); R = (st >> 1) * 16 + swz / 64; C = (st & 1) * 32 + (swz % 64) / 2; }
__host__ __device__ __forceinline__ int perm32(int rho) { const int n = rho >> 4, i = rho & 15; return 8 * (i >> 2) + 4 * n + (i & 3); }

struct Unit { int pm, pn; };
struct Gemm { const bf16_t* A; const bf16_t* Bt; int M, N, K; };

struct StaticOrder {
    int nM, nN, nwg, G, c;
    __host__ __device__ void init(int M, int N, int G_, int c_) { nM = M / BM; nN = N / BM; nwg = nM * nN; G = G_; c = c_; }
    __host__ __device__ bool next(int i, Unit& u) const {
        const long L = (long)i * G + c; if (L >= nwg) return false;
        int wgid = (int)L; { const int q = nwg / NXCD, r = nwg % NXCD, xcd = wgid % NXCD, off = wgid / NXCD; wgid = (xcd < r ? xcd * (q + 1) : r * (q + 1) + (xcd - r) * q) + off; }
        const int nig = WGM * nN, gid = wgid / nig, fm = gid * WGM, gsz = (nM - fm) < WGM ? (nM - fm) : WGM;
        u.pm = fm + ((wgid % nig) % gsz); u.pn = (wgid % nig) / gsz; return true;
    }
    __device__ __forceinline__ void a_ready(const Unit&) const {}
    __device__ __forceinline__ void done(const Unit&) const {}
};

__device__ __forceinline__ unsigned cvt_pk_bf16(float lo, float hi) { unsigned r; asm volatile("v_cvt_pk_bf16_f32 %0, %1, %2" : "=v"(r) : "v"(lo), "v"(hi)); return r; }

constexpr int MPROMPT = 16384;
__device__ __forceinline__ int mod_batch(int pm, int ai, int wr) { return pm < 64 ? (pm >> 3) : 8 + (pm - 64) * 4 + 2 * ai + wr; }
__device__ __forceinline__ float sigmoid_f(float x) { return __builtin_amdgcn_rcpf(1.0f + __builtin_amdgcn_exp2f(-1.4426950408889634f * x)); }
__device__ __forceinline__ f32x4 sigmoid4(f32x4 x) { return (f32x4){sigmoid_f(x[0]), sigmoid_f(x[1]), sigmoid_f(x[2]), sigmoid_f(x[3])}; }
__device__ __forceinline__ u32x4 pack8(f32x4 v0, f32x4 v1) { u32x4 w; w.x = cvt_pk_bf16(v0[0], v0[1]); w.y = cvt_pk_bf16(v0[2], v0[3]); w.z = cvt_pk_bf16(v1[0], v1[1]); w.w = cvt_pk_bf16(v1[2], v1[3]); return w; }

struct EpiSwiGLU {
    static constexpr bool PERM = true, AFTER_DRAIN = false;
    bf16_t* O; int ldc;
    __device__ __forceinline__ void operator()(const f32x4 (&acc)[2][2][4][2], const Unit& u, int wr, int wc, int fr, int fq) const {
        const int row0 = u.pm * BM + wr * 64 + fr, col0 = u.pn * HALF + wc * 32 + 8 * fq;
#pragma unroll
        for (int ai = 0; ai < 2; ++ai)
#pragma unroll
            for (int m = 0; m < 4; ++m) {
                const f32x4 a0 = acc[ai][0][m][0], a1 = acc[ai][0][m][1];
                const f32x4 v0 = a0 * sigmoid4(a0) * acc[ai][1][m][0], v1 = a1 * sigmoid4(a1) * acc[ai][1][m][1];
                *(u32x4*)(O + (size_t)(row0 + ai * HALF + m * 16) * ldc + col0) = pack8(v0, v1);
            }
    }
};
template <bool NTB> struct EpiResid {
    static constexpr bool PERM = true, AFTER_DRAIN = false;
    const float* baseP; const float* baseS; float* out; const float* gate; float coef;
    __device__ __forceinline__ void operator()(const f32x4 (&acc)[2][2][4][2], const Unit& u, int wr, int wc, int fr, int fq) const {
        const int col0 = u.pn * BM + wc * 32 + 8 * fq;
#pragma unroll
        for (int ai = 0; ai < 2; ++ai) {
            const float* gp = gate + (size_t)mod_batch(u.pm, ai, wr) * MODLD + col0;
            f32x4 g[2][2];
#pragma unroll
            for (int bj = 0; bj < 2; ++bj)
#pragma unroll
                for (int n = 0; n < 2; ++n) g[bj][n] = *(const f32x4*)(gp + bj * HALF + 4 * n) * coef;
            f32x4 bsv[4][2][2];
#pragma unroll
            for (int m = 0; m < 4; ++m) {
                const int row = u.pm * BM + ai * HALF + wr * 64 + m * 16 + fr;
                const float* bp = (u.pm < 64 ? baseP + (size_t)row * 1024 : baseS + (size_t)(row - MPROMPT) * 1024) + col0;
#pragma unroll
                for (int bj = 0; bj < 2; ++bj)
#pragma unroll
                    for (int n = 0; n < 2; ++n) { const f32x4* p = (const f32x4*)(bp + bj * HALF + 4 * n); bsv[m][bj][n] = NTB ? __builtin_nontemporal_load(p) : *p; }
            }
            asm volatile("" ::: "memory");
#pragma unroll
            for (int m = 0; m < 4; ++m) {
                const int row = u.pm * BM + ai * HALF + wr * 64 + m * 16 + fr;
                float* op = out + (size_t)row * 1024 + col0;
#pragma unroll
                for (int bj = 0; bj < 2; ++bj)
#pragma unroll
                    for (int n = 0; n < 2; ++n) *(f32x4*)(op + bj * HALF + 4 * n) = bsv[m][bj][n] + g[bj][n] * acc[ai][bj][m][n];
            }
        }
    }
};
struct EpiMix {
    static constexpr bool PERM = true, AFTER_DRAIN = false;
    bf16_t* QB; float* outp; const float* b_f; float qscale;
    static constexpr size_t BSTRIDE = (size_t)MT * DM;
    __device__ __forceinline__ void operator()(const f32x4 (&acc)[2][2][4][2], const Unit& u, int wr, int wc, int fr, int fq) const {
        const int pn = u.pn; const bool prm = u.pm < 64;
        const int row0 = u.pm * BM + wr * 64 + fr;
        if (pn < 16) {
            const int seg = pn >> 2, colt = (pn & 3) * BM + wc * 32 + 8 * fq;
            bf16_t* dst = QB + (size_t)seg * BSTRIDE;
            const float sc = seg == 0 ? qscale : 1.f;
            float* fo = outp + (seg == 1 ? (prm ? O_KP : O_KS) : (prm ? O_VP : O_VS));
#pragma unroll
            for (int ai = 0; ai < 2; ++ai)
#pragma unroll
                for (int m = 0; m < 4; ++m) {
                    const int row = row0 + ai * HALF + m * 16;
                    const int rr = prm ? row : row - MPROMPT; const int bb = prm ? (rr >> 11) : (rr >> 6), tt = prm ? (rr & 2047) : (rr & 63), TT = prm ? 2048 : 64;
#pragma unroll
                    for (int bj = 0; bj < 2; ++bj) {
                        f32x4 v0 = acc[ai][bj][m][0], v1 = acc[ai][bj][m][1]; const int col = colt + bj * HALF;
                        if (seg == 1 || seg == 2) { float* p = fo + ((size_t)(bb * 16 + (col >> 6)) * TT + tt) * 64 + (col & 63); __builtin_nontemporal_store(v0, (f32x4*)p); __builtin_nontemporal_store(v1, (f32x4*)(p + 4)); }
                        if (seg == 3) { v0 = sigmoid4(v0); v1 = sigmoid4(v1); }
                        v0 = v0 * sc; v1 = v1 * sc;
                        *(u32x4*)(dst + (size_t)row * 1024 + col) = pack8(v0, v1);
                    }
                }
        } else if (pn < 32) {
            const bool cx = pn >= 24; const int col = ((pn - 16) & 7) * HALF + wc * 32 + 8 * fq;
            bf16_t* dst = QB + (size_t)(cx ? 5 : 4) * BSTRIDE;
#pragma unroll
            for (int ai = 0; ai < 2; ++ai)
#pragma unroll
                for (int m = 0; m < 4; ++m) {
                    const int row = row0 + ai * HALF + m * 16;
                    f32x4 v0, v1;
                    if (cx) { v0 = acc[ai][0][m][0] * acc[ai][1][m][0]; v1 = acc[ai][0][m][1] * acc[ai][1][m][1]; }
                    else { v0 = acc[ai][0][m][0] * sigmoid4(acc[ai][1][m][0]); v1 = acc[ai][0][m][1] * sigmoid4(acc[ai][1][m][1]); }
                    *(u32x4*)(dst + (size_t)row * 1024 + col) = pack8(v0, v1);
                    if (cx) {
                        const int rr = prm ? row : row - MPROMPT; const int bb = prm ? (rr >> 11) : (rr >> 6), tt = prm ? (rr & 2047) : (rr & 63), TT = prm ? 2048 : 64;
                        if (tt >= TT - 2) { float* p = outp + (prm ? O_CVP : O_CVS) + (size_t)(bb * 2 + (tt - (TT - 2))) * 1024 + col; *(f32x4*)p = v0; *(f32x4*)(p + 4) = v1; }
                    }
                }
        } else {
            if (wc == 0 && fq < 2) {
                const f32x4 bf0 = *(const f32x4*)(b_f + 8 * fq), bf1 = *(const f32x4*)(b_f + 8 * fq + 4);
                asm volatile("" ::: "memory");
#pragma unroll
                for (int ai = 0; ai < 2; ++ai)
#pragma unroll
                    for (int m = 0; m < 4; ++m) {
                        const int row = row0 + ai * HALF + m * 16;
                        const int rr = prm ? row : row - MPROMPT; const int bb = prm ? (rr >> 11) : (rr >> 6), tt = prm ? (rr & 2047) : (rr & 63), TT = prm ? 2048 : 64;
                        float* fo = outp + (prm ? O_LFP : O_LFS);
#pragma unroll
                        for (int n = 0; n < 2; ++n)
#pragma unroll
                            for (int e = 0; e < 4; ++e) {
                                const int hh = 8 * fq + 4 * n + e; const float v = acc[ai][0][m][n][e] + (n ? bf1[e] : bf0[e]);
                                const float ls = fminf(v, 0.f) - __logf(1.0f + __expf(-fabsf(v)));
                                fo[(size_t)(bb * 16 + hh) * TT + tt] = ls;
                            }
                    }
            }
        }
    }
};
template <class Epi, class Sched, bool ALIGN_EPI = false, bool SP2 = false>
__device__ __forceinline__ void gemm_phase(PG8_LAS unsigned char* lds, const Gemm g, const Sched& S, const Epi& E) {
    const int tid = threadIdx.x, wid = __builtin_amdgcn_readfirstlane(tid >> 6), lane = tid & 63, wr = wid >> 2, wc = wid & 3, fr = lane & 15, fq = lane >> 4;
    const int K = g.K, nt = K / BK;
    unsigned voffA[2], voffB[2];
#pragma unroll
    for (int i = 0; i < 2; ++i) { int R, C; stage_rc(tid * 16 + i * 8192, R, C); const int Rb = Epi::PERM ? ((R & ~31) + perm32(R & 31)) : R;
        voffA[i] = (unsigned)(R * K + C) * 2u; voffB[i] = (unsigned)(Rb * K + C) * 2u; }
    const size_t kstep = (size_t)(BK * 2);
    const size_t hstep = (size_t)HALF * K * 2;
    const size_t tstep = 2 * hstep;
    const unsigned ldsw = (unsigned)wid * 1024u;
    const int aoff = lds_byte(wr * 64 + fr, fq * 8), boff = lds_byte(wc * 32 + fr, fq * 8);
#define PG8_SA(b, h) (((b) * 2 + (h)) * HTB)
#define PG8_SB(b, h) ((4 + (b) * 2 + (h)) * HTB)
#define PG8_STAGE(bufoff, gbase, voff) do { _Pragma("unroll") for (int _i = 0; _i < 2; ++_i) \
        __builtin_amdgcn_global_load_lds((const unsigned*)((const char*)(gbase) + (voff)[_i]), (PG8_LAS unsigned*)(lds + (bufoff) + ldsw + _i * 8192), 16, 0, 0); } while (0)
#define PG8_LDA(dst, b, h) do { _Pragma("unroll") for (int m = 0; m < 4; ++m) _Pragma("unroll") for (int k = 0; k < 2; ++k) dst[m][k] = *(const PG8_LAS bf16x8*)(lds + PG8_SA(b, h) + aoff + m * 2048 + k * 1024); } while (0)
#define PG8_LDB(dst, b, h) do { _Pragma("unroll") for (int n = 0; n < 2; ++n) _Pragma("unroll") for (int k = 0; k < 2; ++k) dst[n][k] = *(const PG8_LAS bf16x8*)(lds + PG8_SB(b, h) + boff + n * 2048 + k * 1024); } while (0)
#define PG8_MMA(ai, bj, At, Bt) do { __builtin_amdgcn_s_setprio(1); _Pragma("unroll") for (int m = 0; m < 4; ++m) _Pragma("unroll") for (int n = 0; n < 2; ++n) _Pragma("unroll") for (int k = 0; k < 2; ++k) \
        acc[ai][bj][m][n] = __builtin_amdgcn_mfma_f32_16x16x32_bf16(Bt[n][k], At[m][k], acc[ai][bj][m][n], 0, 0, 0); __builtin_amdgcn_s_setprio(0); } while (0)
#define PG8_WAIT_V(n) asm volatile("s_waitcnt vmcnt(" #n ")" ::: "memory")
#define PG8_WAIT_L(n) asm volatile("s_waitcnt lgkmcnt(" #n ")" ::: "memory")
#define PG8_BAR __builtin_amdgcn_s_barrier()
#define PG8_SCHED __builtin_amdgcn_sched_barrier(0)
    Unit cur, nxt; int ui = 0;
    if (!S.next(0, cur)) return;
    f32x4 acc[2][2][4][2];
#pragma unroll
    for (int a = 0; a < 2; ++a)
#pragma unroll
        for (int b = 0; b < 2; ++b)
#pragma unroll
            for (int m = 0; m < 4; ++m)
#pragma unroll
                for (int n = 0; n < 2; ++n) acc[a][b][m][n] = (f32x4){0.f, 0.f, 0.f, 0.f};
    bf16x8 At[4][2], B0[2][2], B1[2][2];
    const char* cA = (const char*)g.A + (size_t)cur.pm * tstep; const char* cB = (const char*)g.Bt + (size_t)cur.pn * tstep;
    S.a_ready(cur);
    if constexpr (SP2) {
        PG8_STAGE(PG8_SB(0, 0), cB, voffB); PG8_STAGE(PG8_SB(0, 1), cB + hstep, voffB); PG8_STAGE(PG8_SA(0, 0), cA, voffA); PG8_STAGE(PG8_SA(0, 1), cA + hstep, voffA);
        if (wr == 1) PG8_BAR;
        PG8_WAIT_V(2); PG8_BAR;
        PG8_STAGE(PG8_SB(1, 0), cB + kstep, voffB); PG8_STAGE(PG8_SA(1, 0), cA + kstep, voffA); PG8_STAGE(PG8_SB(1, 1), cB + hstep + kstep, voffB);
        PG8_WAIT_V(6); PG8_BAR;
    } else {
        PG8_STAGE(PG8_SB(0, 0), cB, voffB); PG8_STAGE(PG8_SA(0, 0), cA, voffA); PG8_STAGE(PG8_SB(0, 1), cB + hstep, voffB); PG8_STAGE(PG8_SA(0, 1), cA + hstep, voffA);
        if (wr == 1) PG8_BAR;
        PG8_WAIT_V(4); PG8_BAR;
        PG8_STAGE(PG8_SB(1, 0), cB + kstep, voffB); PG8_STAGE(PG8_SA(1, 0), cA + kstep, voffA); PG8_STAGE(PG8_SB(1, 1), cB + hstep + kstep, voffB);
        PG8_WAIT_V(6); PG8_BAR;
    }
    for (;;) {
        const bool has_next = S.next(ui + 1, nxt);
        const char* nA = has_next ? (const char*)g.A + (size_t)nxt.pm * tstep : cA; const char* nB = has_next ? (const char*)g.Bt + (size_t)nxt.pn * tstep : cB;
        for (int t = 0; t < nt; t += 2) {
            const bool last = (t == nt - 2);
            const char* a1 = cA + (size_t)(t + 1) * kstep;
            const char* a2 = last ? nA : cA + (size_t)(t + 2) * kstep; const char* b2 = last ? nB : cB + (size_t)(t + 2) * kstep;
            const char* a3 = a2 + kstep; const char* b3 = b2 + kstep;
            if (last && has_next) S.a_ready(nxt);
            if constexpr (SP2) {
            PG8_LDB(B0, 0, 0); PG8_LDB(B1, 0, 1); PG8_SCHED; PG8_LDA(At, 0, 0); PG8_STAGE(PG8_SA(1, 1), a1 + hstep, voffA);
            PG8_WAIT_V(8); PG8_WAIT_L(0); PG8_BAR; PG8_MMA(0, 0, At, B0); PG8_MMA(0, 1, At, B1); PG8_BAR; PG8_SCHED;
            PG8_LDA(At, 0, 1); PG8_STAGE(PG8_SB(0, 0), b2, voffB); PG8_STAGE(PG8_SB(0, 1), b2 + hstep, voffB); PG8_STAGE(PG8_SA(0, 0), a2, voffA);
            PG8_WAIT_V(8); PG8_WAIT_L(0); PG8_BAR; PG8_MMA(1, 0, At, B0); PG8_MMA(1, 1, At, B1); PG8_BAR; PG8_SCHED;
            PG8_LDB(B0, 1, 0); PG8_LDB(B1, 1, 1); PG8_SCHED; PG8_LDA(At, 1, 0); PG8_STAGE(PG8_SA(0, 1), a2 + hstep, voffA);
            PG8_WAIT_V(8); PG8_WAIT_L(0); PG8_BAR; PG8_MMA(0, 0, At, B0); PG8_MMA(0, 1, At, B1); PG8_BAR; PG8_SCHED;
            PG8_LDA(At, 1, 1); PG8_STAGE(PG8_SB(1, 0), b3, voffB); PG8_STAGE(PG8_SB(1, 1), b3 + hstep, voffB); PG8_STAGE(PG8_SA(1, 0), a3, voffA);
            PG8_WAIT_V(8); PG8_WAIT_L(0); PG8_BAR; PG8_MMA(1, 0, At, B0); PG8_MMA(1, 1, At, B1); PG8_BAR; PG8_SCHED;
            } else {
            PG8_LDB(B0, 0, 0); PG8_SCHED; PG8_LDA(At, 0, 0); PG8_STAGE(PG8_SA(1, 1), a1 + hstep, voffA);
            PG8_WAIT_L(8); PG8_BAR; PG8_WAIT_L(0); PG8_MMA(0, 0, At, B0); PG8_BAR; PG8_SCHED;
            PG8_LDB(B1, 0, 1); PG8_STAGE(PG8_SB(0, 0), b2, voffB);
            PG8_BAR; PG8_WAIT_L(0); PG8_MMA(0, 1, At, B1); PG8_BAR;
            PG8_LDA(At, 0, 1); PG8_STAGE(PG8_SA(0, 0), a2, voffA);
            PG8_BAR; PG8_WAIT_L(0); PG8_MMA(1, 0, At, B0); PG8_BAR; PG8_SCHED;
            PG8_STAGE(PG8_SB(0, 1), b2 + hstep, voffB);
            PG8_WAIT_V(6); PG8_BAR; PG8_MMA(1, 1, At, B1); PG8_BAR;
            PG8_LDB(B0, 1, 0); PG8_SCHED; PG8_LDA(At, 1, 0); PG8_STAGE(PG8_SA(0, 1), a2 + hstep, voffA);
            PG8_WAIT_L(8); PG8_BAR; PG8_WAIT_L(0); PG8_MMA(0, 0, At, B0); PG8_BAR; PG8_SCHED;
            PG8_LDB(B1, 1, 1); PG8_STAGE(PG8_SB(1, 0), b3, voffB);
            PG8_BAR; PG8_WAIT_L(0); PG8_MMA(0, 1, At, B1); PG8_BAR;
            PG8_LDA(At, 1, 1); PG8_STAGE(PG8_SA(1, 0), a3, voffA);
            PG8_BAR; PG8_WAIT_L(0); PG8_MMA(1, 0, At, B0); PG8_BAR; PG8_SCHED;
            PG8_STAGE(PG8_SB(1, 1), b3 + hstep, voffB);
            PG8_WAIT_V(6); PG8_BAR; PG8_MMA(1, 1, At, B1); PG8_BAR;
            }
        }
        if constexpr (ALIGN_EPI) { if (wr == 0) PG8_BAR; }
        if constexpr (!Epi::AFTER_DRAIN) { E(acc, cur, wr, wc, fr, fq); S.done(cur); }
        if (!has_next) break;
#pragma unroll
        for (int a = 0; a < 2; ++a)
#pragma unroll
            for (int b = 0; b < 2; ++b)
#pragma unroll
                for (int m = 0; m < 4; ++m)
#pragma unroll
                    for (int n = 0; n < 2; ++n) acc[a][b][m][n] = (f32x4){0.f, 0.f, 0.f, 0.f};
        cur = nxt; cA = nA; cB = nB; ++ui;
        if constexpr (ALIGN_EPI) { if (wr == 1) PG8_BAR; }
    }
    PG8_WAIT_V(0);
    if constexpr (!ALIGN_EPI) { if (wr == 0) PG8_BAR; }
    PG8_BAR;
    if constexpr (Epi::AFTER_DRAIN) { E.fused(acc, cur, wr, wc, fr, fq, lds, wid, lane); S.done(cur); }
#undef PG8_SA
#undef PG8_SB
#undef PG8_STAGE
#undef PG8_LDA
#undef PG8_LDB
#undef PG8_MMA
#undef PG8_WAIT_V
#undef PG8_WAIT_L
#undef PG8_BAR
#undef PG8_SCHED
}
}

#ifndef PG8_SP2
#define PG8_SP2 true
#endif
#ifndef PG8_ALIGN
#define PG8_ALIGN true
#endif
#include <hip/hip_bf16.h>
#include <cmath>
namespace attn_body {
using bf16=__hip_bfloat16;
using bf16x8=__attribute__((ext_vector_type(8)))short;
using s16x4=__attribute__((ext_vector_type(4)))short;
using f32x16=__attribute__((ext_vector_type(16)))float;
using u32x4=__attribute__((ext_vector_type(4)))unsigned;
using f32x4=__attribute__((ext_vector_type(4)))float;
#define LASF __attribute__((address_space(3)))
constexpr int BATCH=8,NHEAD=16,SEQ=2048,D=64,DM=NHEAD*D;
constexpr int NW=8,QBLK=32,QB=QBLK*NW,KVBLK=64,NQB=SEQ/QB;
constexpr int ATTN_PITCH=DM, ATTN_UNIT_ROWS=QB;
__device__ __forceinline__ int crow(int r,int hi){return (r&3)+8*(r>>2)+4*hi;}
#define SBAR() __builtin_amdgcn_sched_barrier(0)
__device__ __forceinline__ void cmask(f32x16&p0,f32x16&p1,int jb,int qrel,int hi){
  const float NEG=-INFINITY; int kb=64*jb+4*hi;
  #pragma unroll
  for(int r=0;r<16;++r){int kv=kb+(r&3)+8*(r>>2); if(kv>qrel)p0[r]=NEG; if(kv+32>qrel)p1[r]=NEG;}
}

constexpr int NSLOT=3, SLOTB=8192;
constexpr int LDS_K=0, LDS_V=NSLOT*SLOTB, LDS_WS=2*NSLOT*SLOTB, LDS_OST=LDS_WS+NW*64*4, LDS_BYTES=LDS_OST+NW*4096;
constexpr float C2=0.125f*1.4426950408889634f;
__device__ __forceinline__ void glds16(const void*gsrc,unsigned lds_dst){unsigned keep;
  asm volatile("s_mov_b32 %0, m0\n\ts_mov_b32 m0, %2\n\ts_nop 0\n\tglobal_load_lds_dwordx4 %1, off\n\ts_mov_b32 m0, %0":"=&s"(keep):"v"(gsrc),"s"(lds_dst):"memory");}
__device__ __forceinline__ float max3f(float a,float b,float c){float r;asm("v_max3_f32 %0, %1, %2, %3":"=v"(r):"v"(a),"v"(b),"v"(c));return r;}
__device__ __forceinline__ float max2f(float a,float b){float r;asm("v_max_f32_e32 %0, %1, %2":"=v"(r):"v"(a),"v"(b));return r;}
__device__ __forceinline__ float fadd_s(float a,float b){float r;asm("v_add_f32_e32 %0, %1, %2":"=v"(r):"v"(a),"v"(b));return r;}
__device__ __forceinline__ float fsub_s(float a,float b){float r;asm("v_sub_f32_e32 %0, %1, %2":"=v"(r):"v"(a),"v"(b));return r;}
typedef float f32x2_t __attribute__((ext_vector_type(2))); typedef __bf16 bf16x2_t __attribute__((ext_vector_type(2)));
__device__ __forceinline__ unsigned cvtpk_s(float lo,float hi){f32x2_t v={lo,hi};bf16x2_t b=__builtin_convertvector(v,bf16x2_t);return __builtin_bit_cast(unsigned,b);}
#define WAIT_BAR(N) asm volatile("s_waitcnt vmcnt(" #N ") lgkmcnt(0)\n\ts_barrier":::"memory")

__device__ __forceinline__ void qkt(f32x16&p0,f32x16&p1,const char*Kslot,const bf16x8*qr,int r32,int hi){
  const char*kb=Kslot+hi*1024+r32*16;
  #pragma unroll
  for(int d0=0;d0<4;++d0){
    const bf16x8 b0=*reinterpret_cast<const bf16x8*>(kb+d0*2048);
    const bf16x8 b1=*reinterpret_cast<const bf16x8*>(kb+d0*2048+512);
    p0=__builtin_amdgcn_mfma_f32_32x32x16_bf16(b0,qr[d0],p0,0,0,0);p1=__builtin_amdgcn_mfma_f32_32x32x16_bf16(b1,qr[d0],p1,0,0,0);}
}
typedef __attribute__((address_space(3))) const char* lds_cptr;
typedef short v4i16_t __attribute__((ext_vector_type(4)));
__device__ __forceinline__ void kload8(bf16x8*kf,lds_cptr kp){
  kf[0]=*(const __attribute__((address_space(3))) bf16x8*)(kp);      kf[1]=*(const __attribute__((address_space(3))) bf16x8*)(kp+512);
  kf[2]=*(const __attribute__((address_space(3))) bf16x8*)(kp+2048); kf[3]=*(const __attribute__((address_space(3))) bf16x8*)(kp+2560);
  kf[4]=*(const __attribute__((address_space(3))) bf16x8*)(kp+4096); kf[5]=*(const __attribute__((address_space(3))) bf16x8*)(kp+4608);
  kf[6]=*(const __attribute__((address_space(3))) bf16x8*)(kp+6144); kf[7]=*(const __attribute__((address_space(3))) bf16x8*)(kp+6656);
}
__device__ __forceinline__ void kload2(bf16x8*kf,lds_cptr kp,int j){ kf[2*j]=*(const __attribute__((address_space(3))) bf16x8*)(kp+j*2048); kf[2*j+1]=*(const __attribute__((address_space(3))) bf16x8*)(kp+j*2048+512); }
__device__ __forceinline__ s16x4 vtr(lds_cptr p){ return __builtin_bit_cast(s16x4,__builtin_amdgcn_ds_read_tr16_b64_v4i16((__attribute__((address_space(3))) v4i16_t*)p)); }
__device__ __forceinline__ float rowmax(const f32x16&p0,const f32x16&p1){
  float a=max3f(p0[0],p0[1],p1[0]),b=max3f(p0[2],p0[3],p1[1]);a=max3f(a,p1[2],p1[3]);
  #pragma unroll
  for(int r=4;r<16;r+=4){a=max3f(a,p0[r],p0[r+1]);b=max3f(b,p0[r+2],p0[r+3]);a=max3f(a,p1[r],p1[r+1]);b=max3f(b,p1[r+2],p1[r+3]);}
  const float m=max2f(a,b);
  auto rr=__builtin_amdgcn_permlane32_swap(__float_as_uint(m),__float_as_uint(m),false,false);
  return max2f(__uint_as_float(rr[0]),__uint_as_float(rr[1]));
}
__device__ __forceinline__ void pv(f32x16*o,int vb,bf16x8 pa0,bf16x8 pa1,bf16x8 pa2,bf16x8 pa3){
  #pragma unroll
  for(int d0=0;d0<2;++d0){s16x4 lo[4],hi[4];
    #pragma unroll
    for(int ks=0;ks<4;++ks){
      asm volatile("ds_read_b64_tr_b16 %0,%1 offset:%c2":"=&v"(lo[ks]):"v"(vb),"i"(d0*4096+ks*1024):"memory");
      asm volatile("ds_read_b64_tr_b16 %0,%1 offset:%c2":"=&v"(hi[ks]):"v"(vb),"i"(d0*4096+ks*1024+512):"memory");}
    asm volatile("s_waitcnt lgkmcnt(0)":::"memory");SBAR();
    #define PK(k) (bf16x8){lo[k][0],lo[k][1],lo[k][2],lo[k][3],hi[k][0],hi[k][1],hi[k][2],hi[k][3]}
    o[d0]=__builtin_amdgcn_mfma_f32_32x32x16_bf16(pa0,PK(0),o[d0],0,0,0);
    o[d0]=__builtin_amdgcn_mfma_f32_32x32x16_bf16(pa1,PK(1),o[d0],0,0,0);
    o[d0]=__builtin_amdgcn_mfma_f32_32x32x16_bf16(pa2,PK(2),o[d0],0,0,0);
    o[d0]=__builtin_amdgcn_mfma_f32_32x32x16_bf16(pa3,PK(3),o[d0],0,0,0);
    #undef PK
  }
}


struct MergeCtx { const unsigned short* GA; const unsigned short* G2; const unsigned short* U; const float* cw; const float* st; unsigned short* out; };
__device__ __forceinline__ float mbflo(unsigned w){return __builtin_bit_cast(float,w<<16);}
__device__ __forceinline__ float mbfhi(unsigned w){return __builtin_bit_cast(float,w&0xffff0000u);}
__device__ __forceinline__ void munpack8(u32x4 w,float*f){f[0]=mbflo(w.x);f[1]=mbfhi(w.x);f[2]=mbflo(w.y);f[3]=mbfhi(w.y);f[4]=mbflo(w.z);f[5]=mbfhi(w.z);f[6]=mbflo(w.w);f[7]=mbfhi(w.w);}
__device__ __forceinline__ void merge_store8(const MergeCtx&c,size_t grow,int t,bool prm,int bb,int col,u32x4 ov){
  const size_t off=grow*1024+col; float ga[8],o[8],g2[8],u0[8],u1[8],u2[8];
  munpack8(*(const u32x4*)(c.GA+off),ga); munpack8(ov,o); munpack8(*(const u32x4*)(c.G2+off),g2); munpack8(*(const u32x4*)(c.U+off),u2);
  if(t>=1)munpack8(*(const u32x4*)(c.U+off-1024),u1);
  else if(prm){_Pragma("unroll") for(int e=0;e<8;++e)u1[e]=0.f;} else {const float*p=c.st+(size_t)(bb*2+1)*1024+col; _Pragma("unroll") for(int e=0;e<8;++e)u1[e]=p[e];}
  if(t>=2)munpack8(*(const u32x4*)(c.U+off-2048),u0);
  else if(prm){_Pragma("unroll") for(int e=0;e<8;++e)u0[e]=0.f;} else {const float*p=c.st+(size_t)(bb*2+t)*1024+col; _Pragma("unroll") for(int e=0;e<8;++e)u0[e]=p[e];}
  float r[8];
  _Pragma("unroll") for(int e=0;e<8;++e){const float cy=c.cw[col+e]*u0[e]+c.cw[1024+col+e]*u1[e]+c.cw[2048+col+e]*u2[e]; r[e]=ga[e]*o[e]+g2[e]*cy;}
  u32x4 w; w.x=cvtpk_s(r[0],r[1]); w.y=cvtpk_s(r[2],r[3]); w.z=cvtpk_s(r[4],r[5]); w.w=cvtpk_s(r[6],r[7]);
  *(u32x4*)(c.out+off)=w;
}
#ifndef ATTN_STORE16
#define ATTN_STORE16(p,v) (*(u32x4*)(p)=(v))
#endif
template<int THRL> __device__ __forceinline__ void attn_unit(int b,int h,int qb,const bf16*Q,const bf16*__restrict__ K,const bf16*__restrict__ V,const MergeCtx&mc,char*shm,const LASF float*fb){
  int tid_=threadIdx.x; asm volatile("":"+v"(tid_));
  const int tid=tid_,lane=tid&63,r32=lane&31,hi=lane>>5; const int wid=__builtin_amdgcn_readfirstlane(tid>>6);
  const long rowbase=(long)b*SEQ; const int q0=qb*QB;
  const bf16*Qw=Q+(rowbase+q0+wid*QBLK)*DM+h*D;
  const bf16*Kh=K+rowbase*DM+h*D,*Vh=V+rowbase*DM+h*D;
  const unsigned lds0=(unsigned)(uintptr_t)shm;
  float*wsf=(float*)(shm+LDS_WS)+wid*64;
  const bf16*ksrc=Kh+(long)lane*DM+wid*8;
  const bf16*vsrc=Vh+(long)(16*(wid&3)+(lane>>2))*DM+(wid>>2)*32+(lane&3)*8;
  const unsigned kdst=lds0+LDS_K+wid*1024, vdst=lds0+LDS_V+wid*1024;
  #define DMA_K(t,slot) glds16(ksrc+(long)(t)*KVBLK*DM,(unsigned)__builtin_amdgcn_readfirstlane(kdst+(slot)))
  #define DMA_V(t,slot) glds16(vsrc+(long)(t)*KVBLK*DM,(unsigned)__builtin_amdgcn_readfirstlane(vdst+(slot)))
  const int vb0=(int)(lds0+LDS_V)+((lane>>4)&1)*32+(lane&3)*8+(4*hi+((lane&15)>>2))*64;
  const char*Kbase=shm+LDS_K; bf16x8 kf[8];
  const lds_cptr shm3=(lds_cptr)shm; const lds_cptr kp0=shm3+LDS_K+hi*1024+r32*16; const lds_cptr vp0=shm3+LDS_V+((lane>>4)&1)*32+(lane&3)*8+(4*hi+((lane&15)>>2))*64;
  const int NT=(q0+QB)/KVBLK;
  DMA_K(0,0);DMA_V(0,0);DMA_K(1,SLOTB);
  bf16x8 qr[4];
  #pragma unroll
  for(int d0=0;d0<4;++d0)qr[d0]=*reinterpret_cast<const bf16x8*>(&Qw[(long)r32*DM+d0*16+hi*8]);
  float mhat=fb[q0+wid*QBLK+r32],l_reg=0.f;f32x16 o[2];o[0]=f32x16{};o[1]=f32x16{};
  #define FBINIT(C0,C1,t) do{ const LASF float*fp_=fb+64*(t)+4*hi; \
    _Pragma("unroll") for(int i_=0;i_<4;++i_){ const f32x4 a_=*(const LASF f32x4*)(fp_+8*i_),b_=*(const LASF f32x4*)(fp_+32+8*i_); \
      C0[4*i_]=a_[0]-mhat;C0[4*i_+1]=a_[1]-mhat;C0[4*i_+2]=a_[2]-mhat;C0[4*i_+3]=a_[3]-mhat; \
      C1[4*i_]=b_[0]-mhat;C1[4*i_+1]=b_[1]-mhat;C1[4*i_+2]=b_[2]-mhat;C1[4*i_+3]=b_[3]-mhat; } }while(0)
  #define FBLOAD(P0,P1,tn) do{ const LASF float*fp_=fb+64*(tn)+4*hi; \
    _Pragma("unroll") for(int i_=0;i_<4;++i_){ const f32x4 a_=*(const LASF f32x4*)(fp_+8*i_),b_=*(const LASF f32x4*)(fp_+32+8*i_); \
      P0[4*i_]=a_[0];P0[4*i_+1]=a_[1];P0[4*i_+2]=a_[2];P0[4*i_+3]=a_[3]; P1[4*i_]=b_[0];P1[4*i_+1]=b_[1];P1[4*i_+2]=b_[2];P1[4*i_+3]=b_[3]; } }while(0)
  #define FBSUB(X,B) do{ X[B]-=mhat; X[B+1]-=mhat; X[B+2]-=mhat; X[B+3]-=mhat; }while(0)
  const int qrel=wid*QBLK+r32;
  #define CMASK(P0,P1,t) do{int jb_=(t)-(NT-4); if(jb_>=0)cmask(P0,P1,jb_,qrel,hi);}while(0)
  bool resc=false;
  #define START(P0,P1) do{ const float rm=rowmax(P0,P1); resc=false; \
    if(__any(rm>(float)THRL)){ const float dl=__builtin_fmaxf(rm,0.f); mhat=fadd_s(mhat,dl); \
      _Pragma("unroll") for(int r=0;r<16;++r){P0[r]=fsub_s(P0[r],dl);P1[r]=fsub_s(P1[r],dl);} } \
    _Pragma("unroll") for(int r=0;r<16;++r)P0[r]=__builtin_amdgcn_exp2f(P0[r]); }while(0)
  #define RESC() do{ if(resc){ asm volatile("s_waitcnt lgkmcnt(0)":::"memory"); \
      _Pragma("unroll") for(int d_=0;d_<2;++d_) _Pragma("unroll") for(int r=0;r<16;++r)o[d_][r]*=wsf[crow(r,hi)]; } }while(0)
  f32x16 pA0,pA1,pB0,pB1;
  int sl_prev=0,sl_cur=0,sl_next=SLOTB;
  #define ROT() do{sl_prev=sl_cur;sl_cur=sl_next;sl_next=(sl_next==(NSLOT-1)*SLOTB)?0:sl_next+SLOTB;}while(0)
  DMA_K(2,2*SLOTB);
  WAIT_BAR(3);
  FBINIT(pA0,pA1,0);
  qkt(pA0,pA1,Kbase,qr,r32,hi);asm volatile("s_nop 15\n\ts_nop 7":"+v"(pA0),"+v"(pA1));CMASK(pA0,pA1,0);
  START(pA0,pA1);
  _Pragma("unroll") for(int r=0;r<16;++r)pA1[r]=__builtin_amdgcn_exp2f(pA1[r]);
  FBINIT(pB0,pB1,1);
  WAIT_BAR(0);
  DMA_K(3,0);DMA_V(1,SLOTB);
  ROT();
  kload8(kf,kp0+sl_cur);
  WAIT_BAR(2);
  s16x4 vlo[8],vhi[8]; u32x4 pw0,pw1,pw2,pw3;
  #define PKW(P,B) cvtpk_s(P[B],P[B+1])
  #define PAF(k) __builtin_bit_cast(bf16x8,pw##k)
  #define VFR(i) (bf16x8){vlo[i][0],vlo[i][1],vlo[i][2],vlo[i][3],vhi[i][0],vhi[i][1],vhi[i][2],vhi[i][3]}
  #define PIN(x) asm volatile("":"+v"(x))
  #define MX3(a,b,c) __builtin_fmaxf(__builtin_fmaxf((a),(b)),(c))
  #define GAPA(MF,A0,A1,A2,A3,W0,W1,PW) do{ MF; sacc+=A0; sacc+=A1; sacc+=A2; sacc+=A3; PIN(sacc); W0; W1; PIN(PW); SBAR(); }while(0)
  #define EX(v) __builtin_amdgcn_exp2f(v)
  #define GAPB(MF,X,B,Y,YB) do{ MF; X[B]=EX(X[B]); X[B+1]=EX(X[B+1]); X[B+2]=EX(X[B+2]); X[B+3]=EX(X[B+3]); PIN(X); FBSUB(Y,YB); PIN(Y); SBAR(); }while(0)
  #define VRD(i) do{ vlo[i]=vtr(vp_+(((i)>>2)*4096+((i)&3)*1024)); vhi[i]=vtr(vp_+(((i)>>2)*4096+((i)&3)*1024+512)); }while(0)
  #define KRD(G,j) do{ if(G){ kload2(kf,kp0+sl_next,j); SBAR(); } }while(0)
  #define STEP(C0,C1,P0,P1,t,GK,GV,GL) do{ SBAR(); \
    const lds_cptr vp_=vp0+sl_prev; \
    VRD(0); SBAR(); float sacc=(P0[0]+P0[1]); \
    GAPA(C0=__builtin_amdgcn_mfma_f32_32x32x16_bf16(kf[0],qr[0],C0,0,0,0), P0[2],P0[3],P0[4],P0[5],     pw0[0]=PKW(P0,0), pw0[1]=PKW(P0,2), pw0); \
    VRD(4); SBAR(); GAPA(C1=__builtin_amdgcn_mfma_f32_32x32x16_bf16(kf[1],qr[0],C1,0,0,0), P0[6],P0[7],P0[8],P0[9],     pw0[2]=PKW(P0,4), pw0[3]=PKW(P0,6), pw0); \
    VRD(1); SBAR(); GAPA(C0=__builtin_amdgcn_mfma_f32_32x32x16_bf16(kf[2],qr[1],C0,0,0,0),   P0[10],P0[11],P0[12],P0[13], pw1[0]=PKW(P0,8), pw1[1]=PKW(P0,10), pw1); \
    VRD(5); SBAR(); GAPA(C1=__builtin_amdgcn_mfma_f32_32x32x16_bf16(kf[3],qr[1],C1,0,0,0),   P0[14],P0[15],P1[0],P1[1],   pw1[2]=PKW(P0,12),pw1[3]=PKW(P0,14), pw1); \
    VRD(2); SBAR(); GAPA(C0=__builtin_amdgcn_mfma_f32_32x32x16_bf16(kf[4],qr[2],C0,0,0,0),   P1[2],P1[3],P1[4],P1[5],     pw2[0]=PKW(P1,0), pw2[1]=PKW(P1,2), pw2); \
    VRD(6); SBAR(); GAPA(C1=__builtin_amdgcn_mfma_f32_32x32x16_bf16(kf[5],qr[2],C1,0,0,0),   P1[6],P1[7],P1[8],P1[9],     pw2[2]=PKW(P1,4), pw2[3]=PKW(P1,6), pw2); \
    VRD(3); SBAR(); GAPA(C0=__builtin_amdgcn_mfma_f32_32x32x16_bf16(kf[6],qr[3],C0,0,0,0),   P1[10],P1[11],P1[12],P1[13], pw3[0]=PKW(P1,8), pw3[1]=PKW(P1,10), pw3); \
    VRD(7); SBAR(); GAPA(C1=__builtin_amdgcn_mfma_f32_32x32x16_bf16(kf[7],qr[3],C1,0,0,0),   P1[14],P1[15],0.f,0.f,       pw3[2]=PKW(P1,12),pw3[3]=PKW(P1,14), pw3); \
    l_reg+=sacc; \
    if(GK){DMA_K((t)+3,sl_cur);} if(GV){DMA_V((t)+1,sl_next);} \
    CMASK(C0,C1,t); \
    { float a=MX3(C0[0],C0[1],C1[0]),b=MX3(C0[2],C0[3],C1[1]); a=MX3(a,C1[2],C1[3]); \
      _Pragma("unroll") for(int r=4;r<16;r+=4){a=MX3(a,C0[r],C0[r+1]);b=MX3(b,C0[r+2],C0[r+3]);a=MX3(a,C1[r],C1[r+1]);b=MX3(b,C1[r+2],C1[r+3]);} \
      float rm=__builtin_fmaxf(a,b); { auto rr=__builtin_amdgcn_permlane32_swap(__float_as_uint(rm),__float_as_uint(rm),false,false); rm=__builtin_fmaxf(__uint_as_float(rr[0]),__uint_as_float(rr[1])); } \
      resc=false; \
      if(__builtin_expect(__any(rm>(float)THRL),0)){ const float dl=__builtin_fmaxf(rm,0.f); mhat+=dl; \
        _Pragma("unroll") for(int r=0;r<16;++r){C0[r]-=dl;C1[r]-=dl;} \
        const float f=__builtin_amdgcn_exp2f(-dl); l_reg*=f; if(hi==0)wsf[r32]=f; resc=true; } } \
    SBAR(); FBLOAD(P0,P1,(t)+1); SBAR(); \
    GAPB(o[0]=__builtin_amdgcn_mfma_f32_32x32x16_bf16(PAF(0),VFR(0),o[0],0,0,0), C0,0, P0,0); \
    GAPB(o[1]=__builtin_amdgcn_mfma_f32_32x32x16_bf16(PAF(0),VFR(4),o[1],0,0,0), C0,4, P0,4); \
    KRD(GL,0); GAPB(o[0]=__builtin_amdgcn_mfma_f32_32x32x16_bf16(PAF(1),VFR(1),o[0],0,0,0), C0,8, P0,8); \
    KRD(GL,1); GAPB(o[1]=__builtin_amdgcn_mfma_f32_32x32x16_bf16(PAF(1),VFR(5),o[1],0,0,0), C0,12, P0,12); \
    KRD(GL,2); GAPB(o[0]=__builtin_amdgcn_mfma_f32_32x32x16_bf16(PAF(2),VFR(2),o[0],0,0,0), C1,0, P1,0); \
    KRD(GL,3); GAPB(o[1]=__builtin_amdgcn_mfma_f32_32x32x16_bf16(PAF(2),VFR(6),o[1],0,0,0), C1,4, P1,4); \
    GAPB(o[0]=__builtin_amdgcn_mfma_f32_32x32x16_bf16(PAF(3),VFR(3),o[0],0,0,0), C1,8, P1,8); \
    GAPB(o[1]=__builtin_amdgcn_mfma_f32_32x32x16_bf16(PAF(3),VFR(7),o[1],0,0,0), C1,12, P1,12); \
    }while(0)
  int t=1;
  #undef CMASK
  #define CMASK(P0,P1,t) do{}while(0)
  for(;t+5<NT;t+=2){
    STEP(pB0,pB1,pA0,pA1,t,true,true,true);     WAIT_BAR(2); RESC(); ROT();
    STEP(pA0,pA1,pB0,pB1,t+1,true,true,true);   WAIT_BAR(2); RESC(); ROT();
  }
  #undef CMASK
  #define CMASK(P0,P1,t) do{int jb_=(t)-(NT-4); if(jb_>=0)cmask(P0,P1,jb_,qrel,hi);}while(0)
  #define ENDW(tt) do{ if((tt)+3<NT){WAIT_BAR(2);} else if((tt)+2<NT){WAIT_BAR(1);} else {WAIT_BAR(0);} }while(0)
  for(;t+1<NT;t+=2){
    STEP(pB0,pB1,pA0,pA1,t,(t+3<NT),(t+1<NT),(t+1<NT));       ENDW(t);   RESC(); ROT();
    STEP(pA0,pA1,pB0,pB1,t+1,(t+4<NT),(t+2<NT),(t+2<NT));     ENDW(t+1); RESC(); ROT();
  }
  STEP(pB0,pB1,pA0,pA1,NT-1,false,false,false); RESC();
  u32x4 mg[4][5]; f32x4 mcw[3][2];
  { const int mcol=h*D+(lane&7)*8;
    _Pragma("unroll") for(int j=0;j<3;++j){ mcw[j][0]=*(const f32x4*)(mc.cw+j*1024+mcol); mcw[j][1]=*(const f32x4*)(mc.cw+j*1024+mcol+4); }
    _Pragma("unroll") for(int i=0;i<4;++i){ const int t_=q0+wid*QBLK+i*8+(lane>>3); const size_t off=(size_t)(rowbase+t_)*1024+mcol;
      mg[i][0]=__builtin_nontemporal_load((const u32x4*)(mc.GA+off)); mg[i][1]=__builtin_nontemporal_load((const u32x4*)(mc.G2+off)); mg[i][2]=*(const u32x4*)(mc.U+off);
      mg[i][3]=(t_>=1)?*(const u32x4*)(mc.U+off-1024):(u32x4){0u,0u,0u,0u}; mg[i][4]=(t_>=2)?*(const u32x4*)(mc.U+off-2048):(u32x4){0u,0u,0u,0u}; } }
  { float sacc=pB0[0]+pB0[1]; _Pragma("unroll") for(int r=2;r<16;++r)sacc+=pB0[r]; _Pragma("unroll") for(int r=0;r<16;++r)sacc+=pB1[r]; l_reg+=sacc;
    pw0=(u32x4){PKW(pB0,0),PKW(pB0,2),PKW(pB0,4),PKW(pB0,6)};pw1=(u32x4){PKW(pB0,8),PKW(pB0,10),PKW(pB0,12),PKW(pB0,14)};pw2=(u32x4){PKW(pB1,0),PKW(pB1,2),PKW(pB1,4),PKW(pB1,6)};pw3=(u32x4){PKW(pB1,8),PKW(pB1,10),PKW(pB1,12),PKW(pB1,14)};
    SBAR(); pv(o,vb0+sl_cur,PAF(0),PAF(1),PAF(2),PAF(3)); }
  #undef PKW
  #undef PAF
  #undef VFR
  #undef PIN
  #undef MX3
  #undef GAPA
  #undef GAPB
  #undef EX
  #undef VRD
  #undef KRD
  #undef STEP
  #undef ENDW
  {auto rr=__builtin_amdgcn_permlane32_swap(__float_as_uint(l_reg),__float_as_uint(l_reg),false,false);l_reg=__uint_as_float(rr[0])+__uint_as_float(rr[1]);}
  if(hi==0)wsf[32+r32]=l_reg;asm volatile("s_waitcnt lgkmcnt(0)":::"memory");
  float rli[16];
  #pragma unroll
  for(int r=0;r<16;++r)rli[r]=__builtin_amdgcn_rcpf(wsf[32+crow(r,hi)]);
  { bf16*stg=(bf16*)(shm+LDS_OST)+wid*2048;
    #pragma unroll
    for(int r=0;r<16;++r){const int orow=crow(r,hi);
      #pragma unroll
      for(int d0=0;d0<2;++d0)stg[orow*64+d0*32+r32]=__float2bfloat16(o[d0][r]*rli[r]);}
    asm volatile("s_waitcnt lgkmcnt(0)":::"memory");
    #pragma unroll
    for(int i=0;i<4;++i){const int row=i*8+(lane>>3),ch=lane&7; const u32x4 v=*(const u32x4*)(stg+row*64+ch*8); const int t_=q0+wid*QBLK+row;
      float ga[8],ov[8],g2[8],u2[8],u1[8],u0[8],r[8]; munpack8(mg[i][0],ga); munpack8(v,ov); munpack8(mg[i][1],g2); munpack8(mg[i][2],u2); munpack8(mg[i][3],u1); munpack8(mg[i][4],u0);
      _Pragma("unroll") for(int e=0;e<8;++e){ const float cy=mcw[0][e>>2][e&3]*u0[e]+mcw[1][e>>2][e&3]*u1[e]+mcw[2][e>>2][e&3]*u2[e]; r[e]=ga[e]*ov[e]+g2[e]*cy; }
      u32x4 w; w.x=cvtpk_s(r[0],r[1]); w.y=cvtpk_s(r[2],r[3]); w.z=cvtpk_s(r[4],r[5]); w.w=cvtpk_s(r[6],r[7]);
      *(u32x4*)(mc.out+(size_t)(rowbase+t_)*1024+h*D+ch*8)=w; } }
  asm volatile("s_waitcnt lgkmcnt(0)\n\ts_barrier":::"memory");
  #undef DMA_K
  #undef DMA_V
  #undef CMASK
  #undef START
  #undef RESC
  #undef ROT
  #undef FBINIT
  #undef FBLOAD
  #undef FBSUB
}
constexpr int ATTN_LDS_BYTES=LDS_BYTES;
#undef SBAR
#undef WAIT_BAR
}

#define XB_TMO      128
#define XB_XCNT(j)  (256  + 64 * (j))
#define XB_XSUB(j)  (1280 + 64 * (j))
#define XB_XGEN(j)  (2304 + 64 * (j))
#define XB_TOP      3328
#define XB_TOPGEN   3392
#define XCD_BAR_WORDS 3456
#define XB_SPIN_CAP (1u << 18)

__device__ __forceinline__ unsigned xb_ld(unsigned* p)              { return __hip_atomic_load(p, __ATOMIC_RELAXED, __HIP_MEMORY_SCOPE_AGENT); }
__device__ __forceinline__ unsigned xb_add(unsigned* p, unsigned v) { return __hip_atomic_fetch_add(p, v, __ATOMIC_RELAXED, __HIP_MEMORY_SCOPE_AGENT); }
__device__ __forceinline__ unsigned xb_xcc_id() { return (unsigned)__builtin_amdgcn_s_getreg((3 << 11) | 20) & 0xFu; }
#define XB_SPIN(cond, bar) do { unsigned _sp = 0; while (cond) { __builtin_amdgcn_s_sleep(1); \
    if ((++_sp & 255u) == 0u) { if (xb_ld(&(bar)[XB_TMO])) break; if (_sp > XB_SPIN_CAP) { atomicAdd(&(bar)[XB_TMO], 1u); break; } } } } while (0)

struct XcdBarrier {
    unsigned* bar; unsigned x;
    volatile __attribute__((address_space(3))) unsigned* st;
};

__device__ __forceinline__ XcdBarrier xcd_barrier_post(unsigned* bar, volatile __attribute__((address_space(3))) unsigned* st) {
    XcdBarrier b; b.bar = bar; b.x = xb_xcc_id(); b.st = st;
    if (threadIdx.x == 0) (void)xb_add(&bar[XB_XCNT(b.x)], 1u);
    return b;
}
__device__ __forceinline__ void xcd_barrier_complete(unsigned* bar, unsigned x, unsigned& nloc, unsigned& nx) {
    const unsigned G = gridDim.x * gridDim.y * gridDim.z;
    unsigned sum, cnt, mine, sp = 0u;
    for (;;) {
        sum = 0u; cnt = 0u; mine = 0u;
#pragma unroll
        for (unsigned j = 0; j < 16; ++j) { const unsigned c = xb_ld(&bar[XB_XCNT(j)]); sum += c; cnt += (c > 0u) ? 1u : 0u; mine = (j == x) ? c : mine; }
        if (sum == G) break;
        __builtin_amdgcn_s_sleep(1);
        if ((++sp & 255u) == 0u) { if (xb_ld(&bar[XB_TMO])) break; if (sp > XB_SPIN_CAP) { atomicAdd(&bar[XB_TMO], 1u); break; } }
    }
    nloc = mine > 0u ? mine : 1u; nx = cnt > 0u ? cnt : 1u;
}

__device__ __forceinline__ void xcd_barrier(const XcdBarrier& b) {
    asm volatile("s_waitcnt vmcnt(0)" ::: "memory");
    __syncthreads();
    if (threadIdx.x == 0) {
        unsigned* bar = b.bar;
        __builtin_amdgcn_s_waitcnt(0);
        unsigned nloc = b.st[0], nx = b.st[1];
        if (nloc == 0u) { xcd_barrier_complete(bar, b.x, nloc, nx); b.st[0] = nloc; b.st[1] = nx; }
        const unsigned old = xb_add(&bar[XB_XSUB(b.x)], 1u);
        const unsigned gen = old / nloc;
        if (old + 1u == (gen + 1u) * nloc) {
            __builtin_amdgcn_fence(__ATOMIC_RELEASE, "agent");
            asm volatile("s_waitcnt vmcnt(0)" ::: "memory");
            const unsigned og = xb_add(&bar[XB_TOP], 1u);
            const unsigned tg = og / nx;
            if (og + 1u == (tg + 1u) * nx) xb_add(&bar[XB_TOPGEN], 1u);
            else XB_SPIN(xb_ld(&bar[XB_TOPGEN]) == tg, bar);
            __builtin_amdgcn_fence(__ATOMIC_ACQUIRE, "agent");
            xb_add(&bar[XB_XGEN(b.x)], 1u);
            asm volatile("s_waitcnt vmcnt(0)" ::: "memory");
        } else {
            XB_SPIN(xb_ld(&bar[XB_XGEN(b.x)]) == gen, bar);
            __builtin_amdgcn_fence(__ATOMIC_ACQUIRE, "agent");
            asm volatile("s_waitcnt vmcnt(0)" ::: "memory");
        }
    }
    __syncthreads();
}


namespace cg = cooperative_groups;
constexpr int NWAVES = 8, NTHREADS = 512;
constexpr size_t MiB = 1u << 20;
constexpr size_t WS_CNT = 912 * 1024;
constexpr int CNT_WORDS = 3 * 80 * 16;
constexpr size_t WS_BAR = 896 * 1024;
constexpr size_t WS_MOD = 0, WS_W1IN = 1 * MiB, WS_W1OUT = 12 * MiB, WS_WIN = 18 * MiB, WS_WOUT = 35 * MiB, WS_W2IN = 37 * MiB, WS_W2OUT = 48 * MiB, WS_H = 54 * MiB,
                 WS_QB = 88 * MiB, WS_KB = 122 * MiB, WS_VB = 156 * MiB, WS_GAB = 190 * MiB, WS_G2B = 224 * MiB, WS_UB = 258 * MiB, WS_END = 292 * MiB, WS_ACT = WS_QB;
static_assert((size_t)MT * DM * 2 == 34 * MiB && WS_KB - WS_QB == 34 * MiB && WS_VB - WS_KB == 34 * MiB && WS_GAB - WS_VB == 34 * MiB && WS_G2B - WS_GAB == 34 * MiB && WS_UB - WS_G2B == 34 * MiB && WS_ACT + (size_t)MT * DFF * 2 <= WS_GAB && WS_WIN + (size_t)NINP * DM * 2 <= WS_WOUT && WS_W1IN + (size_t)2 * DFF * DM * 2 <= WS_W1OUT, "d_ws map");
constexpr int RING_OFF = 0, RING_BYTES = 131072, FB_OFF = RING_BYTES, STAT_OFF = FB_OFF + 8192, QL_OFF = STAT_OFF + 8192, LDS_BYTES = 163840;
static_assert(QL_OFF + 64 * 144 <= LDS_BYTES && 98304 + 8 * 8192 <= LDS_BYTES && LDS_BYTES <= 163840 && STAT_OFF + 8192 <= LDS_BYTES && attn_body::LDS_BYTES <= RING_BYTES, "LDS map");

#define LAS __attribute__((address_space(3)))
typedef unsigned short bf16;
typedef unsigned v4u __attribute__((ext_vector_type(4)));
typedef unsigned v2u __attribute__((ext_vector_type(2)));
typedef float f32x4 __attribute__((ext_vector_type(4)));
typedef float f32x16 __attribute__((ext_vector_type(16)));
typedef short bf16x8 __attribute__((ext_vector_type(8)));
#define LDS_WAIT() asm volatile("s_waitcnt lgkmcnt(0)" ::: "memory")
__device__ __forceinline__ unsigned f2bf(float f) { unsigned u = __builtin_bit_cast(unsigned, f); return (u + 0x7fffu + ((u >> 16) & 1u)) >> 16; }
__device__ __forceinline__ unsigned pk2(float lo, float hi) { return attn_body::cvtpk_s(lo, hi); }
__device__ __forceinline__ float bflo(unsigned w) { return __builtin_bit_cast(float, w << 16); }
__device__ __forceinline__ float bfhi(unsigned w) { return __builtin_bit_cast(float, w & 0xffff0000u); }
__device__ __forceinline__ float wave_sum(float v) {
#pragma unroll
    for (int o = 1; o < 64; o <<= 1) v += __shfl_xor(v, o);
    return v;
}

struct Args { const float* in[22]; float* out; unsigned char* ws; int ph_lo, ph_hi; };

__device__ __forceinline__ void p0_mod(const Args& a, LAS unsigned char* lds, int vcu, int G) {
    const int tid = threadIdx.x, lane = tid & 63, wid = tid >> 6;
    LAS float* sc = (LAS float*)lds;
    const float* w_ada = a.in[8]; const float* b_ada = a.in[9]; float* mod = (float*)(a.ws + WS_MOD);
    for (int item = vcu; item < MODLD / 64; item += G) {
        for (int i = tid; i < 24 * 1024; i += NTHREADS) { const int b = i >> 10, k = i & 1023; const float c = b < 8 ? a.in[6][b * 1024 + k] : a.in[7][(b - 8) * 1024 + k]; sc[i] = c / (1.0f + __expf(-c)); }
        __syncthreads();
        float acc[24];
#pragma unroll
        for (int b = 0; b < 24; ++b) acc[b] = 0.f;
        const int n = item * 64 + lane; const float* wp = w_ada + (size_t)(wid * 128) * MODLD + n;
        LAS float* wl = (LAS float*)(lds + 98304 + wid * 8192);
        float nx[32];
#pragma unroll
        for (int i = 0; i < 32; ++i) nx[i] = __builtin_nontemporal_load(wp + (size_t)i * MODLD);
#pragma unroll 1
        for (int kb = 0; kb < 128; kb += 32) {
#pragma unroll
            for (int i = 0; i < 32; ++i) wl[i * 64 + lane] = nx[i];
            if (kb + 32 < 128) {
#pragma unroll
                for (int i = 0; i < 32; ++i) nx[i] = __builtin_nontemporal_load(wp + (size_t)(kb + 32 + i) * MODLD);
            }
#pragma unroll 1
            for (int k4 = 0; k4 < 32; k4 += 4) {
                const float w0 = wl[(k4 + 0) * 64 + lane], w1 = wl[(k4 + 1) * 64 + lane], w2 = wl[(k4 + 2) * 64 + lane], w3 = wl[(k4 + 3) * 64 + lane];
#pragma unroll
                for (int b = 0; b < 24; ++b) { const f32x4 s = *(const LAS f32x4*)(sc + b * 1024 + wid * 128 + kb + k4); acc[b] += s[0] * w0 + s[1] * w1 + s[2] * w2 + s[3] * w3; }
            }
        }
        __syncthreads();
#pragma unroll
        for (int b = 0; b < 24; ++b) sc[(wid * 24 + b) * 64 + lane] = acc[b];
        __syncthreads();
        for (int o = tid; o < 24 * 64; o += NTHREADS) { const int b = o >> 6, c = o & 63; float s = b_ada[item * 64 + c];
#pragma unroll
            for (int w = 0; w < 8; ++w) s += sc[(w * 24 + b) * 64 + c];
            mod[(size_t)b * MODLD + item * 64 + c] = s; }
        __syncthreads();
    }
}
__device__ __forceinline__ void p0_transpose_item(const float* W, int K, int N, bf16* WT, int dst_row0, int src_col0, int nvalid, int kb, LAS float* scr, int lane) {
    const int k0 = 64 * kb; const int cl = lane & 31; const bool ok = cl < nvalid;
    float tv[32];
#pragma unroll
    for (int i = 0; i < 32; ++i) { const int kk = 2 * i + (lane >> 5); tv[i] = ok ? __builtin_nontemporal_load(W + (size_t)(k0 + kk) * N + src_col0 + cl) : 0.f; }
#pragma unroll
    for (int i = 0; i < 32; ++i) { const int kk = 2 * i + (lane >> 5); scr[kk * 33 + cl] = tv[i]; }
    LDS_WAIT(); asm volatile("" ::: "memory");
    const int c = lane & 7;
#pragma unroll
    for (int j = 0; j < 4; ++j) { const int n = (lane >> 3) + 8 * j; const LAS float* s = scr + (8 * c) * 33 + n;
        v4u o; o.x = pk2(s[0 * 33], s[1 * 33]); o.y = pk2(s[2 * 33], s[3 * 33]); o.z = pk2(s[4 * 33], s[5 * 33]); o.w = pk2(s[6 * 33], s[7 * 33]);
        *(v4u*)(WT + (size_t)(dst_row0 + n) * K + k0 + 8 * c) = o; }
    LDS_WAIT(); asm volatile("" ::: "memory");
}
__device__ __forceinline__ void map_ffn_in(int db, int& src, int& nv) { const int r = db * 32, t = r >> 8, w = r & 255; src = (w < 128 ? 0 : DFF) + t * 128 + (w & 127); nv = 32; }
__device__ __forceinline__ void map_win(int db, int& src, int& nv) {
    const int r = db * 32; nv = 32;
    if (r < 3072) { src = r; return; }
    if (r < 4096) { src = OFF_GA + (r - 3072); return; }
    if (r < 6144) { const int q = r - 4096, t = q >> 8, w = q & 255; src = (w < 128 ? OFF_B : OFF_GC) + t * 128 + (w & 127); return; }
    if (r < 8192) { const int q = r - 6144, t = q >> 8, w = q & 255; src = (w < 128 ? OFF_C : OFF_X) + t * 128 + (w & 127); return; }
    src = OFF_F; nv = (r == 8192) ? 16 : 0;
}
constexpr int I_1IN = 16 * 176, I_1OUT = 44 * 32, I_WIN = 16 * 264, I_WOUT = 16 * 32, WITEMS = 2 * I_1IN + 2 * I_1OUT + I_WIN + I_WOUT;
constexpr int WCUT0 = 2 * I_1IN + I_WIN, WCUT1 = WCUT0 + I_1OUT;
__device__ __forceinline__ void weight_item(const Args& a, int it, LAS float* scr, int lane) {
    int r = it; int src, nv;
    if (r < I_1IN) { map_ffn_in(r % 176, src, nv); p0_transpose_item(a.in[11], 1024, 2 * DFF, (bf16*)(a.ws + WS_W1IN), (r % 176) * 32, src, nv, r / 176, scr, lane); return; } r -= I_1IN;
    if (r < I_1IN) { map_ffn_in(r % 176, src, nv); p0_transpose_item(a.in[19], 1024, 2 * DFF, (bf16*)(a.ws + WS_W2IN), (r % 176) * 32, src, nv, r / 176, scr, lane); return; } r -= I_1IN;
    if (r < I_WIN) { map_win(r % 264, src, nv); p0_transpose_item(a.in[14], 1024, NIN, (bf16*)(a.ws + WS_WIN), (r % 264) * 32, src, nv, r / 264, scr, lane); return; } r -= I_WIN;
    if (r < I_1OUT) { p0_transpose_item(a.in[12], DFF, 1024, (bf16*)(a.ws + WS_W1OUT), (r % 32) * 32, (r % 32) * 32, 32, r / 32, scr, lane); return; } r -= I_1OUT;
    if (r < I_1OUT) { p0_transpose_item(a.in[20], DFF, 1024, (bf16*)(a.ws + WS_W2OUT), (r % 32) * 32, (r % 32) * 32, 32, r / 32, scr, lane); return; } r -= I_1OUT;
    p0_transpose_item(a.in[17], 1024, 1024, (bf16*)(a.ws + WS_WOUT), (r % 32) * 32, (r % 32) * 32, 32, r / 32, scr, lane);
}
__device__ __forceinline__ void p0_weights(const Args& a, LAS unsigned char* lds, int vcu, int G) {
    const int tid = threadIdx.x, lane = tid & 63, wid = tid >> 6;
    LAS float* scr = (LAS float*)(lds + wid * 16384);
    const int nitems = (G == 256) ? WCUT0 : WITEMS;
    constexpr int NMODWG = MODLD / 64;
    const bool skew = (G > NMODWG);
    const int nslot = skew ? NMODWG * NWAVES + (G - NMODWG) * NWAVES * 2 : G * NWAVES;
    const int slot0 = !skew ? vcu * NWAVES + wid : (vcu < NMODWG ? vcu * NWAVES + wid : NMODWG * NWAVES + ((vcu - NMODWG) * NWAVES + wid) * 2);
    const int nmine = (skew && vcu >= NMODWG) ? 2 : 1;
    for (int sl = 0; sl < nmine; ++sl)
        for (int it = slot0 + sl; it < nitems; it += nslot) weight_item(a, it, scr, lane);
}
__device__ __forceinline__ void weight_items_tail(const Args& a, LAS unsigned char* lds, int first, int last, int wk, int nwk) {
    const int tid = threadIdx.x, lane = tid & 63, wid = tid >> 6;
    LAS float* scr = (LAS float*)(lds + wid * 16384);
    for (int it = first + wk; it < last; it += nwk) weight_item(a, it, scr, lane);
}
template <bool FINAL, bool NT = false> __device__ __forceinline__ void norm_rows4(int m0, const float* xP, const float* xS, const float* g, const float* mod, int sh_off, int sc_off, bf16* H, float* Y, int lane) {
    const float* x0 = m0 < MP ? xP + (size_t)m0 * DM : xS + (size_t)(m0 - MP) * DM;
    const int mb = m0 < MP ? (m0 >> 11) : 8 + ((m0 - MP) >> 6);
    f32x4 v[4][4]; float s[4];
#pragma unroll
    for (int r = 0; r < 4; ++r)
#pragma unroll
        for (int j = 0; j < 4; ++j) { const f32x4* p = (const f32x4*)(x0 + (size_t)r * DM) + lane + 64 * j; v[r][j] = NT ? __builtin_nontemporal_load(p) : *p; }
    f32x4 gg[4], sh[4], sc[4];
#pragma unroll
    for (int j = 0; j < 4; ++j) { gg[j] = ((const f32x4*)g + lane)[64 * j];
        if (!FINAL) { sh[j] = ((const f32x4*)(mod + (size_t)mb * MODLD + sh_off) + lane)[64 * j]; sc[j] = ((const f32x4*)(mod + (size_t)mb * MODLD + sc_off) + lane)[64 * j]; } }
#pragma unroll
    for (int r = 0; r < 4; ++r) { s[r] = 0.f;
#pragma unroll
        for (int j = 0; j < 4; ++j) s[r] += (v[r][j].x * v[r][j].x + v[r][j].y * v[r][j].y) + (v[r][j].z * v[r][j].z + v[r][j].w * v[r][j].w); }
#pragma unroll
    for (int o = 1; o < 64; o <<= 1) {
#pragma unroll
        for (int r = 0; r < 4; ++r) s[r] += __shfl_xor(s[r], o); }
#pragma unroll
    for (int r = 0; r < 4; ++r) { const float rstd = 1.0f / sqrtf(s[r] * (1.f / DM) + EPS);
        if (FINAL) { f32x4* yr = (f32x4*)(Y + (size_t)(m0 + r) * DM) + lane;
#pragma unroll
            for (int j = 0; j < 4; ++j) __builtin_nontemporal_store((v[r][j] * rstd) * gg[j], yr + 64 * j); }
        else { v2u* o8 = (v2u*)(H + (size_t)(m0 + r) * DM) + lane;
#pragma unroll
            for (int j = 0; j < 4; ++j) { const f32x4 y = (v[r][j] * rstd) * gg[j] * (sc[j] + 1.0f) + sh[j]; v2u w; w.x = pk2(y.x, y.y); w.y = pk2(y.z, y.w); o8[64 * j] = w; } } }
}
__device__ __forceinline__ void norm_mod_rows(const float* xP, const float* xS, const float* g, const float* mod, int sh_off, int sc_off, bf16* H, int vcu, int G) {
    const int tid = threadIdx.x, lane = tid & 63, wid = tid >> 6;
    const int gw = vcu * NWAVES + wid, NGW = G * NWAVES;
    for (int q = gw; q < MT / 4; q += NGW) norm_rows4<false, true>(4 * q, xP, xS, g, mod, sh_off, sc_off, H, nullptr, lane);
}
__device__ __forceinline__ void final_norm_rows(float* X, const float* g, int vcu, int G) {
    const int tid = threadIdx.x, lane = tid & 63, wid = tid >> 6;
    const int gw = vcu * NWAVES + wid, NGW = G * NWAVES;
    for (int q = gw; q < MT / 4; q += NGW) norm_rows4<true>(4 * q, X, X + (size_t)MP * DM, g, nullptr, 0, 0, nullptr, X, lane);
}
__device__ __forceinline__ void panel_handoff(unsigned* cP, unsigned* cS) {
    asm volatile("s_waitcnt vmcnt(0)" ::: "memory");
    __syncthreads();
    if (threadIdx.x == 0) {
        __builtin_amdgcn_fence(__ATOMIC_RELEASE, "agent");
        asm volatile("s_waitcnt vmcnt(0)" ::: "memory");
        __hip_atomic_fetch_add(cP, 1u, __ATOMIC_RELAXED, __HIP_MEMORY_SCOPE_AGENT);
        __hip_atomic_fetch_add(cS, 1u, __ATOMIC_RELAXED, __HIP_MEMORY_SCOPE_AGENT);
        unsigned sp = 0;
        while (__hip_atomic_load(cP, __ATOMIC_RELAXED, __HIP_MEMORY_SCOPE_AGENT) < 4u || __hip_atomic_load(cS, __ATOMIC_RELAXED, __HIP_MEMORY_SCOPE_AGENT) < 16u) { __builtin_amdgcn_s_sleep(2); if (++sp > (1u << 22)) break; }
        __builtin_amdgcn_fence(__ATOMIC_ACQUIRE, "agent");
        asm volatile("s_waitcnt vmcnt(0)" ::: "memory");
    }
    __syncthreads();
}
__device__ __forceinline__ void unpack8(v4u w, float* f) { f[0] = bflo(w.x); f[1] = bfhi(w.x); f[2] = bflo(w.y); f[3] = bfhi(w.y); f[4] = bflo(w.z); f[5] = bfhi(w.z); f[6] = bflo(w.w); f[7] = bfhi(w.w); }
__device__ __forceinline__ void merge_phase(const Args& a, int vcu, int G) {
    const bf16* GAB = (const bf16*)(a.ws + WS_GAB); const bf16* OB = (const bf16*)(a.ws + WS_QB); const bf16* G2B = (const bf16*)(a.ws + WS_G2B); const bf16* UB = (const bf16*)(a.ws + WS_UB);
    bf16* Hm = (bf16*)(a.ws + WS_H); const float* cw = a.in[16]; const float* st = a.in[5];
    const size_t total = (size_t)MT * 128, stride = (size_t)G * NTHREADS;
    for (size_t idx = (size_t)vcu * NTHREADS + threadIdx.x; idx < total; idx += stride) {
        const int row = (int)(idx >> 7), c8 = (int)(idx & 127) * 8;
        const bool prm = row < MP; const int rr = prm ? row : row - MP; const int t = prm ? (rr & 2047) : (rr & 63), bb = prm ? (rr >> 11) : (rr >> 6);
        const size_t off = (size_t)row * DM + c8;
        float ga[8], o[8], g2[8], u0[8], u1[8], u2[8];
        unpack8(*(const v4u*)(GAB + off), ga); unpack8(*(const v4u*)(OB + off), o); unpack8(*(const v4u*)(G2B + off), g2); unpack8(*(const v4u*)(UB + off), u2);
        if (t >= 1) unpack8(*(const v4u*)(UB + off - DM), u1);
        else { if (prm) { for (int e = 0; e < 8; ++e) u1[e] = 0.f; } else { const float* p = st + (size_t)(bb * 2 + 1) * 1024 + c8; for (int e = 0; e < 8; ++e) u1[e] = p[e]; } }
        if (t >= 2) unpack8(*(const v4u*)(UB + off - 2 * DM), u0);
        else { if (prm) { for (int e = 0; e < 8; ++e) u0[e] = 0.f; } else { const float* p = st + (size_t)(bb * 2 + t) * 1024 + c8; for (int e = 0; e < 8; ++e) u0[e] = p[e]; } }
        float r[8];
#pragma unroll
        for (int e = 0; e < 8; ++e) { const float cy = cw[c8 + e] * u0[e] + cw[1024 + c8 + e] * u1[e] + cw[2048 + c8 + e] * u2[e]; r[e] = ga[e] * o[e] + g2[e] * cy; }
        v4u w; w.x = pk2(r[0], r[1]); w.y = pk2(r[2], r[3]); w.z = pk2(r[4], r[5]); w.w = pk2(r[6], r[7]);
        *(v4u*)(Hm + off) = w;
    }
}

__device__ __forceinline__ void small_gemm_sample(const bf16* A, const bf16* Wt, int K, const float* base, float* outp, const float* gate, float coef, LAS unsigned char* ring, int vcu, int G) {
    int tid = threadIdx.x; asm volatile("" : "+v"(tid));
    const int lane = tid & 63, wid = tid >> 6, fr = lane & 15, fq = lane >> 4; const int KW = K >> 3;
    for (int item = vcu; item < 256; item += G) {
        const int rt = (item >> 4) * 64, ct = (item & 15) * 64;
        const bf16* ap = A + (size_t)(rt + fr) * K + wid * KW + 8 * fq; const bf16* bp = Wt + (size_t)(ct + fr) * K + wid * KW + 8 * fq;
        f32x4 acc[4][4];
#pragma unroll
        for (int mi = 0; mi < 4; ++mi)
#pragma unroll
            for (int nj = 0; nj < 4; ++nj) acc[mi][nj] = (f32x4){0.f, 0.f, 0.f, 0.f};
#pragma unroll 2
        for (int k0 = 0; k0 < KW; k0 += 32) {
            bf16x8 a[4], b[4];
#pragma unroll
            for (int i = 0; i < 4; ++i) { a[i] = *(const bf16x8*)(ap + (size_t)(16 * i) * K + k0); b[i] = *(const bf16x8*)(bp + (size_t)(16 * i) * K + k0); }
#pragma unroll
            for (int mi = 0; mi < 4; ++mi)
#pragma unroll
                for (int nj = 0; nj < 4; ++nj) acc[mi][nj] = __builtin_amdgcn_mfma_f32_16x16x32_bf16(b[nj], a[mi], acc[mi][nj], 0, 0, 0);
        }
        LAS float* P = (LAS float*)(ring + wid * 16384);
#pragma unroll
        for (int mi = 0; mi < 4; ++mi)
#pragma unroll
            for (int nj = 0; nj < 4; ++nj) { const int row = mi * 16 + fr, grp = (nj * 4 + fq) ^ (row & 15); *(LAS f32x4*)(P + row * 64 + grp * 4) = acc[mi][nj]; }
        __syncthreads();
        { const int row = tid >> 3, j = tid & 7; const int g0 = (2 * j) ^ (row & 15), g1 = (2 * j + 1) ^ (row & 15);
          f32x4 s0 = (f32x4){0.f, 0.f, 0.f, 0.f}, s1 = s0;
#pragma unroll
          for (int w = 0; w < 8; ++w) { const LAS float* p = (const LAS float*)(ring + w * 16384) + row * 64; s0 += *(const LAS f32x4*)(p + g0 * 4); s1 += *(const LAS f32x4*)(p + g1 * 4); }
          const int grow = rt + row, c0 = ct + 8 * j; const int mb = 8 + (grow >> 6);
          const f32x4 ga = *(const f32x4*)(gate + (size_t)mb * MODLD + c0) * coef, gb = *(const f32x4*)(gate + (size_t)mb * MODLD + c0 + 4) * coef;
          const f32x4 r0 = *(const f32x4*)(base + (size_t)grow * DM + c0), r1 = *(const f32x4*)(base + (size_t)grow * DM + c0 + 4);
          *(f32x4*)(outp + (size_t)grow * DM + c0) = r0 + ga * s0; *(f32x4*)(outp + (size_t)grow * DM + c0 + 4) = r1 + gb * s1; }
        __syncthreads();
    }
}
__device__ __forceinline__ void stage_fb(LAS float* fb, LAS float* wtot, const float* src0, int n0, const float* src1, int n1) {
    int tid = threadIdx.x; asm volatile("" : "+v"(tid)); const int lane = tid & 63, wid = tid >> 6; const int n = n0 + n1, e = 4 * tid;
    f32x4 v = (f32x4){0.f, 0.f, 0.f, 0.f};
    if (e < n) v = (e < n0) ? *(const f32x4*)(src0 + e) : *(const f32x4*)(src1 + (e - n0));
    const float s0 = v[0], s1 = s0 + v[1], s2 = s1 + v[2], s3 = s2 + v[3];
    float inc = s3;
#pragma unroll
    for (int o = 1; o < 64; o <<= 1) { const float t = __shfl_up(inc, o); if (lane >= o) inc += t; }
    if (lane == 63) wtot[wid] = inc;
    __syncthreads();
    float base = inc - s3;
#pragma unroll
    for (int w = 0; w < 8; ++w) { const float tw = wtot[w]; if (w < wid) base += tw; }
    const float c = -1.4426950408889634f;
    if (e < n) *(LAS f32x4*)(fb + e) = (f32x4){(base + s0) * c, (base + s1) * c, (base + s2) * c, (base + s3) * c};
    __syncthreads();
}
__device__ __forceinline__ void attn_sample_unit(int b, int h, const float* cK, const float* cV, const bf16* QB, const bf16* KB, const bf16* VB, const attn_body::MergeCtx& mc,
                                                 LAS unsigned char* ring, const LAS float* fb, LAS float* stats) {
    using attn_body::crow;
    int tid = threadIdx.x; asm volatile("" : "+v"(tid));
    const int lane = tid & 63, r32 = lane & 31, hi = lane >> 5; const int wid = __builtin_amdgcn_readfirstlane(tid >> 6);
    const size_t rowbase = (size_t)MP + (size_t)b * TS;
    LAS unsigned char* Ks = ring + wid * 16384; LAS unsigned char* Vs = Ks + 8192;
    LAS float* wsf = stats + 1024 + wid * 64;
    LAS unsigned char* QL = ring + (QL_OFF - RING_OFF);
    { const int row = tid >> 3, ch = tid & 7; *(LAS v4u*)(QL + row * 144 + ch * 16) = *(const v4u*)(QB + (rowbase + row) * DM + h * HD + ch * 8); }
    __syncthreads();
    float mhat[2], lsum[2] = {0.f, 0.f}; f32x16 o[2][2];
#pragma unroll
    for (int g = 0; g < 2; ++g) { mhat[g] = fb[PAST + 32 * g + r32]; o[g][0] = f32x16{}; o[g][1] = f32x16{}; }
    const int vb = (int)(unsigned)(uintptr_t)Vs + ((lane >> 4) & 1) * 32 + (lane & 3) * 8 + (4 * hi + ((lane & 15) >> 2)) * 64;
#pragma unroll 1
    for (int tl = wid; tl < 17; tl += 8) {
        if (tl < 16) {
            const f32x4* ksrc = (const f32x4*)(cK + ((size_t)(b * NH + h) * PAST + tl * 64) * HD); const f32x4* vsrc = (const f32x4*)(cV + ((size_t)(b * NH + h) * PAST + tl * 64) * HD);
#pragma unroll 1
            for (int hb = 0; hb < 16; hb += 8) {
                f32x4 kva[8], vva[8];
#pragma unroll
                for (int i = 0; i < 8; ++i) { kva[i] = __builtin_nontemporal_load(ksrc + (hb + i) * 64 + lane); vva[i] = __builtin_nontemporal_load(vsrc + (hb + i) * 64 + lane); }
#pragma unroll
                for (int i = 0; i < 8; ++i) { const int key = 4 * (hb + i) + (lane >> 4), d = (lane & 15) * 4; const f32x4 kv = kva[i], vv = vva[i];
                    v2u kw, vw; kw.x = pk2(kv.x, kv.y); kw.y = pk2(kv.z, kv.w); vw.x = pk2(vv.x, vv.y); vw.y = pk2(vv.z, vv.w);
                    *(LAS v2u*)(Ks + (d >> 3) * 1024 + key * 16 + (d & 7) * 2) = kw;
                    *(LAS v2u*)(Vs + ((d >> 5) * 4 + (key >> 4)) * 1024 + (key & 15) * 64 + (d & 31) * 2) = vw; }
            }
        } else {
#pragma unroll 1
            for (int hb = 0; hb < 8; hb += 4) {
                v4u kvb[4], vvb[4];
#pragma unroll
                for (int i = 0; i < 4; ++i) { const int key = 8 * (hb + i) + (lane >> 3), ch = lane & 7; const size_t off = (rowbase + key) * DM + h * HD + ch * 8; kvb[i] = *(const v4u*)(KB + off); vvb[i] = *(const v4u*)(VB + off); }
#pragma unroll
                for (int i = 0; i < 4; ++i) { const int key = 8 * (hb + i) + (lane >> 3), ch = lane & 7;
                    *(LAS v4u*)(Ks + ch * 1024 + key * 16) = kvb[i];
                    *(LAS v4u*)(Vs + ((ch >> 2) * 4 + (key >> 4)) * 1024 + (key & 15) * 64 + (ch & 3) * 16) = vvb[i]; }
            }
        }
        LDS_WAIT();
#pragma unroll
        for (int g = 0; g < 2; ++g) {
            __builtin_amdgcn_sched_barrier(0);
            f32x16 p0, p1;
            { const LAS float* fp = fb + 64 * tl + 4 * hi;
#pragma unroll
              for (int i = 0; i < 4; ++i) { const f32x4 x = *(const LAS f32x4*)(fp + 8 * i), y = *(const LAS f32x4*)(fp + 32 + 8 * i);
#pragma unroll
                  for (int e = 0; e < 4; ++e) { p0[4 * i + e] = x[e] - mhat[g]; p1[4 * i + e] = y[e] - mhat[g]; } } }
            { const LAS unsigned char* kb = Ks + hi * 1024 + r32 * 16;
#pragma unroll
              for (int d0 = 0; d0 < 4; ++d0) { const bf16x8 b0 = *(const LAS bf16x8*)(kb + d0 * 2048), b1 = *(const LAS bf16x8*)(kb + d0 * 2048 + 512);
                  const bf16x8 qf = *(const LAS bf16x8*)(QL + (32 * g + r32) * 144 + d0 * 32 + hi * 16);
                  p0 = __builtin_amdgcn_mfma_f32_32x32x16_bf16(b0, qf, p0, 0, 0, 0); p1 = __builtin_amdgcn_mfma_f32_32x32x16_bf16(b1, qf, p1, 0, 0, 0); } }
            if (tl == 16) { const int qi = 32 * g + r32;
#pragma unroll
                for (int r = 0; r < 16; ++r) { const int kj = crow(r, hi); if (kj > qi) p0[r] = -INFINITY; if (kj + 32 > qi) p1[r] = -INFINITY; } }
            float rm = p0[0];
#pragma unroll
            for (int r = 1; r < 16; ++r) rm = fmaxf(rm, p0[r]);
#pragma unroll
            for (int r = 0; r < 16; ++r) rm = fmaxf(rm, p1[r]);
            rm = fmaxf(rm, __shfl_xor(rm, 32));
            const float dl = fmaxf(rm, 0.f);
            mhat[g] += dl;
            const float f = __builtin_amdgcn_exp2f(-dl);
            float sacc = 0.f;
#pragma unroll
            for (int r = 0; r < 16; ++r) { p0[r] = __builtin_amdgcn_exp2f(p0[r] - dl); p1[r] = __builtin_amdgcn_exp2f(p1[r] - dl); sacc += p0[r] + p1[r]; }
            lsum[g] = lsum[g] * f + sacc;
            if (hi == 0) wsf[32 * g + r32] = f;
            LDS_WAIT();
#pragma unroll
            for (int r = 0; r < 16; ++r) { const float fr_ = wsf[32 * g + crow(r, hi)]; o[g][0][r] *= fr_; o[g][1][r] *= fr_; }
            v4u pw0, pw1, pw2, pw3;
#define PKW(P, B) attn_body::cvtpk_s(P[B], P[B + 1])
            pw0 = (v4u){PKW(p0, 0), PKW(p0, 2), PKW(p0, 4), PKW(p0, 6)}; pw1 = (v4u){PKW(p0, 8), PKW(p0, 10), PKW(p0, 12), PKW(p0, 14)};
            pw2 = (v4u){PKW(p1, 0), PKW(p1, 2), PKW(p1, 4), PKW(p1, 6)}; pw3 = (v4u){PKW(p1, 8), PKW(p1, 10), PKW(p1, 12), PKW(p1, 14)};
#undef PKW
            attn_body::pv(o[g], vb, __builtin_bit_cast(bf16x8, pw0), __builtin_bit_cast(bf16x8, pw1), __builtin_bit_cast(bf16x8, pw2), __builtin_bit_cast(bf16x8, pw3));
        }
        LDS_WAIT();
    }
#pragma unroll
    for (int g = 0; g < 2; ++g) { const float lt = lsum[g] + __shfl_xor(lsum[g], 32); if (hi == 0) { stats[wid * 64 + 32 * g + r32] = mhat[g]; stats[512 + wid * 64 + 32 * g + r32] = lt; } }
    __syncthreads();
    LAS float* Op = (LAS float*)(ring + wid * 16384);
#pragma unroll
    for (int g = 0; g < 2; ++g)
#pragma unroll
        for (int r = 0; r < 16; ++r) { const int q = 32 * g + crow(r, hi); float mx = stats[q];
#pragma unroll
            for (int w = 1; w < 8; ++w) mx = fmaxf(mx, stats[w * 64 + q]);
            const float scl = __builtin_amdgcn_exp2f(stats[wid * 64 + q] - mx);
            Op[q * 64 + r32] = o[g][0][r] * scl; Op[q * 64 + 32 + r32] = o[g][1][r] * scl; }
    __syncthreads();
    { const int q = tid >> 3, d0 = (tid & 7) * 8; float mx = stats[q];
#pragma unroll
      for (int w = 1; w < 8; ++w) mx = fmaxf(mx, stats[w * 64 + q]);
      float Lq = 0.f; f32x4 s0 = (f32x4){0.f, 0.f, 0.f, 0.f}, s1 = s0;
#pragma unroll
      for (int w = 0; w < 8; ++w) { Lq += stats[512 + w * 64 + q] * __builtin_amdgcn_exp2f(stats[w * 64 + q] - mx);
          const LAS float* p = (const LAS float*)(ring + w * 16384) + q * 64 + d0; s0 += *(const LAS f32x4*)p; s1 += *(const LAS f32x4*)(p + 4); }
      const float rl = 1.0f / Lq; s0 = s0 * rl; s1 = s1 * rl;
      v4u w; w.x = pk2(s0.x, s0.y); w.y = pk2(s0.z, s0.w); w.z = pk2(s1.x, s1.y); w.w = pk2(s1.z, s1.w);
      merge_store8(mc, rowbase + q, q, false, b, h * HD + d0, w); }
    __syncthreads();
}

__global__ void __launch_bounds__(NTHREADS, 2) fwd_mega(Args args) {
    extern __shared__ __attribute__((aligned(16))) unsigned char lds[];
    cg::grid_group grid = cg::this_grid();
    LAS unsigned char* L = (LAS unsigned char*)lds;
    const int G = gridDim.x; const int bx = blockIdx.x; const int vcu = (G % 8 == 0) ? (bx % 8) * (G / 8) + bx / 8 : bx;
    unsigned char* ws = args.ws; float* out = args.out; const float* mod = (const float*)(ws + WS_MOD);
    bf16* Hb = (bf16*)(ws + WS_H); bf16* ACT = (bf16*)(ws + WS_ACT);
    float* XR = out + O_Y;
    const int lo = args.ph_lo, hi = args.ph_hi;
#ifndef PH_MASK
#define PH_MASK 0x1fff
#endif
#define IN(k) (((PH_MASK >> (k)) & 1) && lo <= (k) && (k) < hi)
#define SEAM(k) do { if (IN(k) && IN((k) + 1)) xcd_barrier(bar); } while (0)

    unsigned* barw = (unsigned*)(ws + WS_BAR);
    volatile LAS unsigned* bst = (volatile LAS unsigned*)(L + STAT_OFF + 8000);
    unsigned* cntw = (unsigned*)(ws + WS_CNT);
    if (bx == 0) { for (int i = threadIdx.x; i < XCD_BAR_WORDS; i += NTHREADS) __hip_atomic_store(barw + i, 0u, __ATOMIC_RELAXED, __HIP_MEMORY_SCOPE_AGENT);
                   for (int i = threadIdx.x; i < CNT_WORDS; i += NTHREADS) __hip_atomic_store(cntw + i, 0u, __ATOMIC_RELAXED, __HIP_MEMORY_SCOPE_AGENT); }
    const bool fuse_rows = (G == 256);
    const int wv = threadIdx.x >> 6, ln = threadIdx.x & 63;
    bf16* Hb2 = (bf16*)(ws + WS_GAB);
#define HANDOFF(inst, S) pg8::Unit hu; S.next(0, hu); const int rt_ = vcu >> 4, ct_ = vcu & 15; \
        panel_handoff(cntw + ((inst) * 80 + hu.pm) * 16, cntw + ((inst) * 80 + 64 + rt_) * 16)
    if (IN(0)) { p0_mod(args, L, vcu, G); p0_weights(args, L, vcu, G); }
    if (threadIdx.x < 2) bst[threadIdx.x] = 0u;
    grid.sync();
    const XcdBarrier bar = xcd_barrier_post(barw, bst);
    if (IN(1)) norm_mod_rows(args.in[0], args.in[1], args.in[10], mod, 0 * DM, 1 * DM, Hb, vcu, G);
    SEAM(1);
    if (IN(2)) { pg8::Gemm g{Hb, (const bf16*)(ws + WS_W1IN), MT, 2 * DFF, DM}; pg8::StaticOrder S; S.init(MT, 2 * DFF, G, bx);
        pg8::EpiSwiGLU E{ACT, DFF}; pg8::gemm_phase<pg8::EpiSwiGLU, pg8::StaticOrder, PG8_ALIGN, PG8_SP2>(L + RING_OFF, g, S, E);
        constexpr int NF = (68 * 22) % 256;
        if (G == 256 && bx >= NF) weight_items_tail(args, L, WCUT0, WCUT1, (bx - NF) * NWAVES + (int)(threadIdx.x >> 6), (256 - NF) * NWAVES); }
    SEAM(2);
    if (IN(3)) { pg8::Gemm g{ACT, (const bf16*)(ws + WS_W1OUT), MP, DM, DFF}; pg8::StaticOrder S; S.init(MP, DM, G, bx);
        pg8::EpiResid<true> E{args.in[0], args.in[1], XR, mod + 2 * DM, 0.5f}; pg8::gemm_phase<pg8::EpiResid<true>, pg8::StaticOrder, false, PG8_SP2>(L + RING_OFF, g, S, E);
        small_gemm_sample(ACT + (size_t)MP * DFF, (const bf16*)(ws + WS_W1OUT), DFF, args.in[1], XR + (size_t)MP * DM, mod + 2 * DM, 0.5f, L + RING_OFF, vcu, G);
        if (fuse_rows) { HANDOFF(0, S);
#pragma unroll 1
            for (int i = 0; i < 8; i += 4) norm_rows4<false>(hu.pm * 256 + hu.pn * 64 + wv * 8 + i, XR, XR + (size_t)MP * DM, args.in[13], mod, 3 * DM, 4 * DM, Hb, nullptr, ln);
            if (wv == 0) norm_rows4<false>(MP + rt_ * 64 + ct_ * 4, XR, XR + (size_t)MP * DM, args.in[13], mod, 3 * DM, 4 * DM, Hb, nullptr, ln); } }
    if (!fuse_rows) { SEAM(3); if (IN(4)) norm_mod_rows(XR, XR + (size_t)MP * DM, args.in[13], mod, 3 * DM, 4 * DM, Hb, vcu, G); }
    SEAM(4);
    if (IN(5)) { pg8::Gemm g{Hb, (const bf16*)(ws + WS_WIN), MT, NINP, DM}; pg8::StaticOrder S; S.init(MT, NINP, G, bx);
        pg8::EpiMix E{(bf16*)(ws + WS_QB), out, args.in[15], attn_body::C2};
        pg8::gemm_phase<pg8::EpiMix, pg8::StaticOrder, PG8_ALIGN, PG8_SP2>(L + RING_OFF, g, S, E);
        constexpr int NF = (68 * 33) % 256;
        if (G == 256 && bx >= NF) weight_items_tail(args, L, WCUT1, WITEMS, (bx - NF) * NWAVES + (int)(threadIdx.x >> 6), (256 - NF) * NWAVES); }
    SEAM(5);
    if (IN(6)) {
        const attn_body::bf16* Q = (const attn_body::bf16*)(ws + WS_QB); const attn_body::bf16* K = (const attn_body::bf16*)(ws + WS_KB); const attn_body::bf16* V = (const attn_body::bf16*)(ws + WS_VB);
        LAS float* fb = (LAS float*)(L + FB_OFF); LAS float* stats = (LAS float*)(L + STAT_OFF);
        const attn_body::MergeCtx mc{(const bf16*)(ws + WS_GAB), (const bf16*)(ws + WS_G2B), (const bf16*)(ws + WS_UB), args.in[16], args.in[5], Hb};
#pragma unroll 1
        for (int pass = 0; pass < 2; ++pass) {
        const bool do_sample = ((vcu & 1) != 0) == (pass == 0);
        if (!do_sample) {
        for (int it = vcu; it < 512; it += G) {
            const int bh = it >> 2, k = it & 3;
            stage_fb(fb, stats, out + O_LFP + (size_t)bh * TP, TP, nullptr, 0);
#pragma unroll 1
            for (int j = 0; j < 2; ++j) attn_body::attn_unit<8>(bh >> 4, bh & 15, j ? k : 7 - k, Q, K, V, mc, (char*)lds + RING_OFF, fb);
        }
        } else {
        for (int it = vcu; it < 256; it += G) {
            const int b = it >> 4, h = it & 15;
            stage_fb(fb, stats, args.in[4] + (size_t)it * PAST, PAST, out + O_LFS + (size_t)it * TS, TS);
            attn_sample_unit(b, h, args.in[2], args.in[3], (const bf16*)(ws + WS_QB), (const bf16*)(ws + WS_KB), (const bf16*)(ws + WS_VB), mc, L + RING_OFF, fb, stats);
        }
        }
        }
    }
    SEAM(6);
    if (IN(8)) { pg8::Gemm g{Hb, (const bf16*)(ws + WS_WOUT), MP, DM, DM}; pg8::StaticOrder S; S.init(MP, DM, G, bx);
        pg8::EpiResid<false> E{XR, XR + (size_t)MP * DM, XR, mod + 5 * DM, 1.0f}; pg8::gemm_phase<pg8::EpiResid<false>, pg8::StaticOrder, false, PG8_SP2>(L + RING_OFF, g, S, E);
        small_gemm_sample(Hb + (size_t)MP * DM, (const bf16*)(ws + WS_WOUT), DM, XR + (size_t)MP * DM, XR + (size_t)MP * DM, mod + 5 * DM, 1.0f, L + RING_OFF, vcu, G);
        if (fuse_rows) { HANDOFF(1, S);
#pragma unroll 1
            for (int i = 0; i < 8; i += 4) norm_rows4<false>(hu.pm * 256 + hu.pn * 64 + wv * 8 + i, XR, XR + (size_t)MP * DM, args.in[18], mod, 6 * DM, 7 * DM, Hb2, nullptr, ln);
            if (wv == 0) norm_rows4<false>(MP + rt_ * 64 + ct_ * 4, XR, XR + (size_t)MP * DM, args.in[18], mod, 6 * DM, 7 * DM, Hb2, nullptr, ln); } }
    if (!fuse_rows) { SEAM(8); if (IN(9)) norm_mod_rows(XR, XR + (size_t)MP * DM, args.in[18], mod, 6 * DM, 7 * DM, Hb2, vcu, G); }
    SEAM(9);
    if (IN(10)) { pg8::Gemm g{Hb2, (const bf16*)(ws + WS_W2IN), MT, 2 * DFF, DM}; pg8::StaticOrder S; S.init(MT, 2 * DFF, G, bx);
        pg8::EpiSwiGLU E{ACT, DFF}; pg8::gemm_phase<pg8::EpiSwiGLU, pg8::StaticOrder, PG8_ALIGN, PG8_SP2>(L + RING_OFF, g, S, E); }
    SEAM(10);
    if (IN(11)) { pg8::Gemm g{ACT, (const bf16*)(ws + WS_W2OUT), MP, DM, DFF}; pg8::StaticOrder S; S.init(MP, DM, G, bx);
        pg8::EpiResid<false> E{XR, XR + (size_t)MP * DM, XR, mod + 8 * DM, 0.5f}; pg8::gemm_phase<pg8::EpiResid<false>, pg8::StaticOrder, false, PG8_SP2>(L + RING_OFF, g, S, E);
        small_gemm_sample(ACT + (size_t)MP * DFF, (const bf16*)(ws + WS_W2OUT), DFF, XR + (size_t)MP * DM, XR + (size_t)MP * DM, mod + 8 * DM, 0.5f, L + RING_OFF, vcu, G);
        if (fuse_rows) { HANDOFF(2, S);
#pragma unroll 1
            for (int i = 0; i < 8; i += 4) norm_rows4<true>(hu.pm * 256 + hu.pn * 64 + wv * 8 + i, XR, XR + (size_t)MP * DM, args.in[21], nullptr, 0, 0, nullptr, XR, ln);
            if (wv == 0) norm_rows4<true>(MP + rt_ * 64 + ct_ * 4, XR, XR + (size_t)MP * DM, args.in[21], nullptr, 0, 0, nullptr, XR, ln); } }
    if (!fuse_rows) { SEAM(11); if (IN(12)) final_norm_rows(XR, args.in[21], vcu, G); }
#undef IN
#undef SEAM
}

#ifndef MK_N_LAUNCHES
#define MK_N_LAUNCHES 1
#endif
constexpr int N_PHASES = 13;
extern "C" void kernel_launch(void* const* d_in, const int* in_sizes, int n_in, void* d_out, int out_size, void* d_ws, size_t ws_size, hipStream_t stream) {
    static int grid = 0;
    if (grid == 0) {
        if (n_in != 22 || out_size != (int)O_END || ws_size < WS_END) { fprintf(stderr, "kernel_launch: unexpected sizes n_in %d out %d ws %zu; nothing launched\n", n_in, out_size, ws_size); grid = -1; return; }
        int dev = 0, cus = 0, per_cu = 0;
        if (hipGetDevice(&dev) != hipSuccess || hipDeviceGetAttribute(&cus, hipDeviceAttributeMultiprocessorCount, dev) != hipSuccess) { grid = -1; return; }
        if (hipFuncSetAttribute((const void*)fwd_mega, hipFuncAttributeMaxDynamicSharedMemorySize, LDS_BYTES) != hipSuccess) { fprintf(stderr, "kernel_launch: hipFuncSetAttribute failed\n"); grid = -1; return; }
        if (hipOccupancyMaxActiveBlocksPerMultiprocessor(&per_cu, (const void*)fwd_mega, NTHREADS, LDS_BYTES) != hipSuccess || per_cu < 1) { fprintf(stderr, "kernel_launch: occupancy query says %d\n", per_cu); (void)hipGetLastError(); grid = -1; return; }
        grid = cus * 1;
        fprintf(stderr, "kernel_launch: grid %d (cus %d, per_cu %d), ws %zu\n", grid, cus, per_cu, ws_size);
    }
    if (grid < 0) return;
    Args a{};
    for (int i = 0; i < 22; ++i) a.in[i] = (const float*)d_in[i];
    a.out = (float*)d_out; a.ws = (unsigned char*)d_ws;
#if MK_N_LAUNCHES == 1
    a.ph_lo = 0; a.ph_hi = N_PHASES;
    void* kargs[] = {&a};
    hipError_t e = hipLaunchCooperativeKernel((const void*)fwd_mega, dim3(grid), dim3(NTHREADS), kargs, LDS_BYTES, stream);
    if (e != hipSuccess) fprintf(stderr, "kernel_launch: cooperative launch failed: %s (grid %d)\n", hipGetErrorString(e), grid);
#else
    for (int p = 0; p < N_PHASES; ++p) { a.ph_lo = p; a.ph_hi = p + 1; void* kargs[] = {&a};
        hipError_t e = hipLaunchCooperativeKernel((const void*)fwd_mega, dim3(grid), dim3(NTHREADS), kargs, LDS_BYTES, stream);
        if (e != hipSuccess) { fprintf(stderr, "kernel_launch: launch %d failed: %s\n", p, hipGetErrorString(e)); break; } }
#endif
}
```

```cpp
#include <hip/hip_runtime.h>
#include <hip/hip_cooperative_groups.h>
#include <cstdio>
#include <cstdint>
constexpr int MODLD = 9216;
constexpr int DM = 1024, MP = 16384, MS = 1024, MT = MP + MS, TP = 2048, TS = 64, PAST = 1024, NH = 16, HD = 64, DFF = 2816, NIN = 8208, NINP = 8448, NMOD = 9;
constexpr int OFF_Q = 0, OFF_K = 1024, OFF_V = 2048, OFF_F = 3072, OFF_B = 3088, OFF_C = 4112, OFF_X = 5136, OFF_GA = 6160, OFF_GC = 7184;
constexpr float EPS = 1e-6f;
constexpr size_t O_Y = 0, O_KP = (size_t)MT * DM, O_VP = O_KP + (size_t)MP * DM, O_LFP = O_VP + (size_t)MP * DM, O_CVP = O_LFP + 8 * 16 * 2048, O_KS = O_CVP + 8 * 2 * 1024,
                 O_VS = O_KS + (size_t)MS * DM, O_LFS = O_VS + (size_t)MS * DM, O_CVS = O_LFS + 16 * 16 * 64, O_END = O_CVS + 16 * 2 * 1024;
static_assert(O_END == 53805056, "d_out map");
namespace pg8 {
#define PG8_LAS __attribute__((address_space(3)))
typedef unsigned short bf16_t;
typedef short bf16x8 __attribute__((ext_vector_type(8)));
typedef float f32x4 __attribute__((ext_vector_type(4)));
typedef unsigned u32x4 __attribute__((ext_vector_type(4)));
constexpr int BM = 256, BK = 64, HALF = 128, HTB = HALF * BK * 2  , STAGE_BYTES = 8 * HTB, NXCD = 8, WGM = 8;

__host__ __device__ __forceinline__ int lds_byte(int r, int c) { const int st = (r >> 4) * 2 + (c >> 5), rr = r & 15, cc = c & 31, ob = rr * 64 + cc * 2; return st * 1024 + (ob ^ (((ob >> 9) & 1) << 5)); }
__host__ __device__ __forceinline__ void stage_rc(int b, int& R, int& C) { const int st = b / 1024, sb = b % 1024, swz = sb ^ (((sb >> 9) & 1) << 5); R = (st >> 1) * 16 + swz / 64; C = (st & 1) * 32 + (swz % 64) / 2; }
__host__ __device__ __forceinline__ int perm32(int rho) { const int n = rho >> 4, i = rho & 15; return 8 * (i >> 2) + 4 * n + (i & 3); }

struct Unit { int pm, pn; };
struct Gemm { const bf16_t* A; const bf16_t* Bt; int M, N, K; };

struct StaticOrder {
    int nM, nN, nwg, G, c;
    __host__ __device__ void init(int M, int N, int G_, int c_) { nM = M / BM; nN = N / BM; nwg = nM * nN; G = G_; c = c_; }
    __host__ __device__ bool next(int i, Unit& u) const {
        const long L = (long)i * G + c; if (L >= nwg) return false;
        int wgid = (int)L; { const int q = nwg / NXCD, r = nwg % NXCD, xcd = wgid % NXCD, off = wgid / NXCD; wgid = (xcd < r ? xcd * (q + 1) : r * (q + 1) + (xcd - r) * q) + off; }
        const int nig = WGM * nN, gid = wgid / nig, fm = gid * WGM, gsz = (nM - fm) < WGM ? (nM - fm) : WGM;
        u.pm = fm + ((wgid % nig) % gsz); u.pn = (wgid % nig) / gsz; return true;
    }
    __device__ __forceinline__ void a_ready(const Unit&) const {}
    __device__ __forceinline__ void done(const Unit&) const {}
};

__device__ __forceinline__ unsigned cvt_pk_bf16(float lo, float hi) { unsigned r; asm volatile("v_cvt_pk_bf16_f32 %0, %1, %2" : "=v"(r) : "v"(lo), "v"(hi)); return r; }

constexpr int MPROMPT = 16384;
__device__ __forceinline__ int mod_batch(int pm, int ai, int wr) { return pm < 64 ? (pm >> 3) : 8 + (pm - 64) * 4 + 2 * ai + wr; }
__device__ __forceinline__ float sigmoid_f(float x) { return __builtin_amdgcn_rcpf(1.0f + __builtin_amdgcn_exp2f(-1.4426950408889634f * x)); }
__device__ __forceinline__ f32x4 sigmoid4(f32x4 x) { return (f32x4){sigmoid_f(x[0]), sigmoid_f(x[1]), sigmoid_f(x[2]), sigmoid_f(x[3])}; }
__device__ __forceinline__ u32x4 pack8(f32x4 v0, f32x4 v1) { u32x4 w; w.x = cvt_pk_bf16(v0[0], v0[1]); w.y = cvt_pk_bf16(v0[2], v0[3]); w.z = cvt_pk_bf16(v1[0], v1[1]); w.w = cvt_pk_bf16(v1[2], v1[3]); return w; }

struct EpiSwiGLU {
    static constexpr bool PERM = true, AFTER_DRAIN = false;
    bf16_t* O; int ldc;
    __device__ __forceinline__ void operator()(const f32x4 (&acc)[2][2][4][2], const Unit& u, int wr, int wc, int fr, int fq) const {
        const int row0 = u.pm * BM + wr * 64 + fr, col0 = u.pn * HALF + wc * 32 + 8 * fq;
#pragma unroll
        for (int ai = 0; ai < 2; ++ai)
#pragma unroll
            for (int m = 0; m < 4; ++m) {
                const f32x4 a0 = acc[ai][0][m][0], a1 = acc[ai][0][m][1];
                const f32x4 v0 = a0 * sigmoid4(a0) * acc[ai][1][m][0], v1 = a1 * sigmoid4(a1) * acc[ai][1][m][1];
                *(u32x4*)(O + (size_t)(row0 + ai * HALF + m * 16) * ldc + col0) = pack8(v0, v1);
            }
    }
};
template <bool NTB> struct EpiResid {
    static constexpr bool PERM = true, AFTER_DRAIN = false;
    const float* baseP; const float* baseS; float* out; const float* gate; float coef;
    __device__ __forceinline__ void operator()(const f32x4 (&acc)[2][2][4][2], const Unit& u, int wr, int wc, int fr, int fq) const {
        const int col0 = u.pn * BM + wc * 32 + 8 * fq;
#pragma unroll
        for (int ai = 0; ai < 2; ++ai) {
            const float* gp = gate + (size_t)mod_batch(u.pm, ai, wr) * MODLD + col0;
            f32x4 g[2][2];
#pragma unroll
            for (int bj = 0; bj < 2; ++bj)
#pragma unroll
                for (int n = 0; n < 2; ++n) g[bj][n] = *(const f32x4*)(gp + bj * HALF + 4 * n) * coef;
            f32x4 bsv[4][2][2];
#pragma unroll
            for (int m = 0; m < 4; ++m) {
                const int row = u.pm * BM + ai * HALF + wr * 64 + m * 16 + fr;
                const float* bp = (u.pm < 64 ? baseP + (size_t)row * 1024 : baseS + (size_t)(row - MPROMPT) * 1024) + col0;
#pragma unroll
                for (int bj = 0; bj < 2; ++bj)
#pragma unroll
                    for (int n = 0; n < 2; ++n) { const f32x4* p = (const f32x4*)(bp + bj * HALF + 4 * n); bsv[m][bj][n] = NTB ? __builtin_nontemporal_load(p) : *p; }
            }
            asm volatile("" ::: "memory");
#pragma unroll
            for (int m = 0; m < 4; ++m) {
                const int row = u.pm * BM + ai * HALF + wr * 64 + m * 16 + fr;
                float* op = out + (size_t)row * 1024 + col0;
#pragma unroll
                for (int bj = 0; bj < 2; ++bj)
#pragma unroll
                    for (int n = 0; n < 2; ++n) *(f32x4*)(op + bj * HALF + 4 * n) = bsv[m][bj][n] + g[bj][n] * acc[ai][bj][m][n];
            }
        }
    }
};
struct EpiMix {
    static constexpr bool PERM = true, AFTER_DRAIN = false;
    bf16_t* QB; float* outp; const float* b_f; float qscale;
    static constexpr size_t BSTRIDE = (size_t)MT * DM;
    __device__ __forceinline__ void operator()(const f32x4 (&acc)[2][2][4][2], const Unit& u, int wr, int wc, int fr, int fq) const {
        const int pn = u.pn; const bool prm = u.pm < 64;
        const int row0 = u.pm * BM + wr * 64 + fr;
        if (pn < 16) {
            const int seg = pn >> 2, colt = (pn & 3) * BM + wc * 32 + 8 * fq;
            bf16_t* dst = QB + (size_t)seg * BSTRIDE;
            const float sc = seg == 0 ? qscale : 1.f;
            float* fo = outp + (seg == 1 ? (prm ? O_KP : O_KS) : (prm ? O_VP : O_VS));
#pragma unroll
            for (int ai = 0; ai < 2; ++ai)
#pragma unroll
                for (int m = 0; m < 4; ++m) {
                    const int row = row0 + ai * HALF + m * 16;
                    const int rr = prm ? row : row - MPROMPT; const int bb = prm ? (rr >> 11) : (rr >> 6), tt = prm ? (rr & 2047) : (rr & 63), TT = prm ? 2048 : 64;
#pragma unroll
                    for (int bj = 0; bj < 2; ++bj) {
                        f32x4 v0 = acc[ai][bj][m][0], v1 = acc[ai][bj][m][1]; const int col = colt + bj * HALF;
                        if (seg == 1 || seg == 2) { float* p = fo + ((size_t)(bb * 16 + (col >> 6)) * TT + tt) * 64 + (col & 63); __builtin_nontemporal_store(v0, (f32x4*)p); __builtin_nontemporal_store(v1, (f32x4*)(p + 4)); }
                        if (seg == 3) { v0 = sigmoid4(v0); v1 = sigmoid4(v1); }
                        v0 = v0 * sc; v1 = v1 * sc;
                        *(u32x4*)(dst + (size_t)row * 1024 + col) = pack8(v0, v1);
                    }
                }
        } else if (pn < 32) {
            const bool cx = pn >= 24; const int col = ((pn - 16) & 7) * HALF + wc * 32 + 8 * fq;
            bf16_t* dst = QB + (size_t)(cx ? 5 : 4) * BSTRIDE;
#pragma unroll
            for (int ai = 0; ai < 2; ++ai)
#pragma unroll
                for (int m = 0; m < 4; ++m) {
                    const int row = row0 + ai * HALF + m * 16;
                    f32x4 v0, v1;
                    if (cx) { v0 = acc[ai][0][m][0] * acc[ai][1][m][0]; v1 = acc[ai][0][m][1] * acc[ai][1][m][1]; }
                    else { v0 = acc[ai][0][m][0] * sigmoid4(acc[ai][1][m][0]); v1 = acc[ai][0][m][1] * sigmoid4(acc[ai][1][m][1]); }
                    *(u32x4*)(dst + (size_t)row * 1024 + col) = pack8(v0, v1);
                    if (cx) {
                        const int rr = prm ? row : row - MPROMPT; const int bb = prm ? (rr >> 11) : (rr >> 6), tt = prm ? (rr & 2047) : (rr & 63), TT = prm ? 2048 : 64;
                        if (tt >= TT - 2) { float* p = outp + (prm ? O_CVP : O_CVS) + (size_t)(bb * 2 + (tt - (TT - 2))) * 1024 + col; *(f32x4*)p = v0; *(f32x4*)(p + 4) = v1; }
                    }
                }
        } else {
            if (wc == 0 && fq < 2) {
                const f32x4 bf0 = *(const f32x4*)(b_f + 8 * fq), bf1 = *(const f32x4*)(b_f + 8 * fq + 4);
                asm volatile("" ::: "memory");
#pragma unroll
                for (int ai = 0; ai < 2; ++ai)
#pragma unroll
                    for (int m = 0; m < 4; ++m) {
                        const int row = row0 + ai * HALF + m * 16;
                        const int rr = prm ? row : row - MPROMPT; const int bb = prm ? (rr >> 11) : (rr >> 6), tt = prm ? (rr & 2047) : (rr & 63), TT = prm ? 2048 : 64;
                        float* fo = outp + (prm ? O_LFP : O_LFS);
#pragma unroll
                        for (int n = 0; n < 2; ++n)
#pragma unroll
                            for (int e = 0; e < 4; ++e) {
                                const int hh = 8 * fq + 4 * n + e; const float v = acc[ai][0][m][n][e] + (n ? bf1[e] : bf0[e]);
                                const float ls = fminf(v, 0.f) - __logf(1.0f + __expf(-fabsf(v)));
                                fo[(size_t)(bb * 16 + hh) * TT + tt] = ls;
                            }
                    }
            }
        }
    }
};
template <class Epi, class Sched, bool ALIGN_EPI = false, bool SP2 = false>
__device__ __forceinline__ void gemm_phase(PG8_LAS unsigned char* lds, const Gemm g, const Sched& S, const Epi& E) {
    const int tid = threadIdx.x, wid = __builtin_amdgcn_readfirstlane(tid >> 6), lane = tid & 63, wr = wid >> 2, wc = wid & 3, fr = lane & 15, fq = lane >> 4;
    const int K = g.K, nt = K / BK;
    unsigned voffA[2], voffB[2];
#pragma unroll
    for (int i = 0; i < 2; ++i) { int R, C; stage_rc(tid * 16 + i * 8192, R, C); const int Rb = Epi::PERM ? ((R & ~31) + perm32(R & 31)) : R;
        voffA[i] = (unsigned)(R * K + C) * 2u; voffB[i] = (unsigned)(Rb * K + C) * 2u; }
    const size_t kstep = (size_t)(BK * 2);
    const size_t hstep = (size_t)HALF * K * 2;
    const size_t tstep = 2 * hstep;
    const unsigned ldsw = (unsigned)wid * 1024u;
    const int aoff = lds_byte(wr * 64 + fr, fq * 8), boff = lds_byte(wc * 32 + fr, fq * 8);
#define PG8_SA(b, h) (((b) * 2 + (h)) * HTB)
#define PG8_SB(b, h) ((4 + (b) * 2 + (h)) * HTB)
#define PG8_STAGE(bufoff, gbase, voff) do { _Pragma("unroll") for (int _i = 0; _i < 2; ++_i) \
        __builtin_amdgcn_global_load_lds((const unsigned*)((const char*)(gbase) + (voff)[_i]), (PG8_LAS unsigned*)(lds + (bufoff) + ldsw + _i * 8192), 16, 0, 0); } while (0)
#define PG8_LDA(dst, b, h) do { _Pragma("unroll") for (int m = 0; m < 4; ++m) _Pragma("unroll") for (int k = 0; k < 2; ++k) dst[m][k] = *(const PG8_LAS bf16x8*)(lds + PG8_SA(b, h) + aoff + m * 2048 + k * 1024); } while (0)
#define PG8_LDB(dst, b, h) do { _Pragma("unroll") for (int n = 0; n < 2; ++n) _Pragma("unroll") for (int k = 0; k < 2; ++k) dst[n][k] = *(const PG8_LAS bf16x8*)(lds + PG8_SB(b, h) + boff + n * 2048 + k * 1024); } while (0)
#define PG8_MMA(ai, bj, At, Bt) do { __builtin_amdgcn_s_setprio(1); _Pragma("unroll") for (int m = 0; m < 4; ++m) _Pragma("unroll") for (int n = 0; n < 2; ++n) _Pragma("unroll") for (int k = 0; k < 2; ++k) \
        acc[ai][bj][m][n] = __builtin_amdgcn_mfma_f32_16x16x32_bf16(Bt[n][k], At[m][k], acc[ai][bj][m][n], 0, 0, 0); __builtin_amdgcn_s_setprio(0); } while (0)
#define PG8_WAIT_V(n) asm volatile("s_waitcnt vmcnt(" #n ")" ::: "memory")
#define PG8_WAIT_L(n) asm volatile("s_waitcnt lgkmcnt(" #n ")" ::: "memory")
#define PG8_BAR __builtin_amdgcn_s_barrier()
#define PG8_SCHED __builtin_amdgcn_sched_barrier(0)
    Unit cur, nxt; int ui = 0;
    if (!S.next(0, cur)) return;
    f32x4 acc[2][2][4][2];
#pragma unroll
    for (int a = 0; a < 2; ++a)
#pragma unroll
        for (int b = 0; b < 2; ++b)
#pragma unroll
            for (int m = 0; m < 4; ++m)
#pragma unroll
                for (int n = 0; n < 2; ++n) acc[a][b][m][n] = (f32x4){0.f, 0.f, 0.f, 0.f};
    bf16x8 At[4][2], B0[2][2], B1[2][2];
    const char* cA = (const char*)g.A + (size_t)cur.pm * tstep; const char* cB = (const char*)g.Bt + (size_t)cur.pn * tstep;
    S.a_ready(cur);
    if constexpr (SP2) {
        PG8_STAGE(PG8_SB(0, 0), cB, voffB); PG8_STAGE(PG8_SB(0, 1), cB + hstep, voffB); PG8_STAGE(PG8_SA(0, 0), cA, voffA); PG8_STAGE(PG8_SA(0, 1), cA + hstep, voffA);
        if (wr == 1) PG8_BAR;
        PG8_WAIT_V(2); PG8_BAR;
        PG8_STAGE(PG8_SB(1, 0), cB + kstep, voffB); PG8_STAGE(PG8_SA(1, 0), cA + kstep, voffA); PG8_STAGE(PG8_SB(1, 1), cB + hstep + kstep, voffB);
        PG8_WAIT_V(6); PG8_BAR;
    } else {
        PG8_STAGE(PG8_SB(0, 0), cB, voffB); PG8_STAGE(PG8_SA(0, 0), cA, voffA); PG8_STAGE(PG8_SB(0, 1), cB + hstep, voffB); PG8_STAGE(PG8_SA(0, 1), cA + hstep, voffA);
        if (wr == 1) PG8_BAR;
        PG8_WAIT_V(4); PG8_BAR;
        PG8_STAGE(PG8_SB(1, 0), cB + kstep, voffB); PG8_STAGE(PG8_SA(1, 0), cA + kstep, voffA); PG8_STAGE(PG8_SB(1, 1), cB + hstep + kstep, voffB);
        PG8_WAIT_V(6); PG8_BAR;
    }
    for (;;) {
        const bool has_next = S.next(ui + 1, nxt);
        const char* nA = has_next ? (const char*)g.A + (size_t)nxt.pm * tstep : cA; const char* nB = has_next ? (const char*)g.Bt + (size_t)nxt.pn * tstep : cB;
        for (int t = 0; t < nt; t += 2) {
            const bool last = (t == nt - 2);
            const char* a1 = cA + (size_t)(t + 1) * kstep;
            const char* a2 = last ? nA : cA + (size_t)(t + 2) * kstep; const char* b2 = last ? nB : cB + (size_t)(t + 2) * kstep;
            const char* a3 = a2 + kstep; const char* b3 = b2 + kstep;
            if (last && has_next) S.a_ready(nxt);
            if constexpr (SP2) {
            PG8_LDB(B0, 0, 0); PG8_LDB(B1, 0, 1); PG8_SCHED; PG8_LDA(At, 0, 0); PG8_STAGE(PG8_SA(1, 1), a1 + hstep, voffA);
            PG8_WAIT_V(8); PG8_WAIT_L(0); PG8_BAR; PG8_MMA(0, 0, At, B0); PG8_MMA(0, 1, At, B1); PG8_BAR; PG8_SCHED;
            PG8_LDA(At, 0, 1); PG8_STAGE(PG8_SB(0, 0), b2, voffB); PG8_STAGE(PG8_SB(0, 1), b2 + hstep, voffB); PG8_STAGE(PG8_SA(0, 0), a2, voffA);
            PG8_WAIT_V(8); PG8_WAIT_L(0); PG8_BAR; PG8_MMA(1, 0, At, B0); PG8_MMA(1, 1, At, B1); PG8_BAR; PG8_SCHED;
            PG8_LDB(B0, 1, 0); PG8_LDB(B1, 1, 1); PG8_SCHED; PG8_LDA(At, 1, 0); PG8_STAGE(PG8_SA(0, 1), a2 + hstep, voffA);
            PG8_WAIT_V(8); PG8_WAIT_L(0); PG8_BAR; PG8_MMA(0, 0, At, B0); PG8_MMA(0, 1, At, B1); PG8_BAR; PG8_SCHED;
            PG8_LDA(At, 1, 1); PG8_STAGE(PG8_SB(1, 0), b3, voffB); PG8_STAGE(PG8_SB(1, 1), b3 + hstep, voffB); PG8_STAGE(PG8_SA(1, 0), a3, voffA);
            PG8_WAIT_V(8); PG8_WAIT_L(0); PG8_BAR; PG8_MMA(1, 0, At, B0); PG8_MMA(1, 1, At, B1); PG8_BAR; PG8_SCHED;
            } else {
            PG8_LDB(B0, 0, 0); PG8_SCHED; PG8_LDA(At, 0, 0); PG8_STAGE(PG8_SA(1, 1), a1 + hstep, voffA);
            PG8_WAIT_L(8); PG8_BAR; PG8_WAIT_L(0); PG8_MMA(0, 0, At, B0); PG8_BAR; PG8_SCHED;
            PG8_LDB(B1, 0, 1); PG8_STAGE(PG8_SB(0, 0), b2, voffB);
            PG8_BAR; PG8_WAIT_L(0); PG8_MMA(0, 1, At, B1); PG8_BAR;
            PG8_LDA(At, 0, 1); PG8_STAGE(PG8_SA(0, 0), a2, voffA);
            PG8_BAR; PG8_WAIT_L(0); PG8_MMA(1, 0, At, B0); PG8_BAR; PG8_SCHED;
            PG8_STAGE(PG8_SB(0, 1), b2 + hstep, voffB);
            PG8_WAIT_V(6); PG8_BAR; PG8_MMA(1, 1, At, B1); PG8_BAR;
            PG8_LDB(B0, 1, 0); PG8_SCHED; PG8_LDA(At, 1, 0); PG8_STAGE(PG8_SA(0, 1), a2 + hstep, voffA);
            PG8_WAIT_L(8); PG8_BAR; PG8_WAIT_L(0); PG8_MMA(0, 0, At, B0); PG8_BAR; PG8_SCHED;
            PG8_LDB(B1, 1, 1); PG8_STAGE(PG8_SB(1, 0), b3, voffB);
            PG8_BAR; PG8_WAIT_L(0); PG8_MMA(0, 1, At, B1); PG8_BAR;
            PG8_LDA(At, 1, 1); PG8_STAGE(PG8_SA(1, 0), a3, voffA);
            PG8_BAR; PG8_WAIT_L(0); PG8_MMA(1, 0, At, B0); PG8_BAR; PG8_SCHED;
            PG8_STAGE(PG8_SB(1, 1), b3 + hstep, voffB);
            PG8_WAIT_V(6); PG8_BAR; PG8_MMA(1, 1, At, B1); PG8_BAR;
            }
        }
        if constexpr (ALIGN_EPI) { if (wr == 0) PG8_BAR; }
        if constexpr (!Epi::AFTER_DRAIN) { E(acc, cur, wr, wc, fr, fq); S.done(cur); }
        if (!has_next) break;
#pragma unroll
        for (int a = 0; a < 2; ++a)
#pragma unroll
            for (int b = 0; b < 2; ++b)
#pragma unroll
                for (int m = 0; m < 4; ++m)
#pragma unroll
                    for (int n = 0; n < 2; ++n) acc[a][b][m][n] = (f32x4){0.f, 0.f, 0.f, 0.f};
        cur = nxt; cA = nA; cB = nB; ++ui;
        if constexpr (ALIGN_EPI) { if (wr == 1) PG8_BAR; }
    }
    PG8_WAIT_V(0);
    if constexpr (!ALIGN_EPI) { if (wr == 0) PG8_BAR; }
    PG8_BAR;
    if constexpr (Epi::AFTER_DRAIN) { E.fused(acc, cur, wr, wc, fr, fq, lds, wid, lane); S.done(cur); }
#undef PG8_SA
#undef PG8_SB
#undef PG8_STAGE
#undef PG8_LDA
#undef PG8_LDB
#undef PG8_MMA
#undef PG8_WAIT_V
#undef PG8_WAIT_L
#undef PG8_BAR
#undef PG8_SCHED
}
}

#ifndef PG8_SP2
#define PG8_SP2 true
#endif
#ifndef PG8_ALIGN
#define PG8_ALIGN true
#endif
#include <hip/hip_bf16.h>
#include <cmath>
namespace attn_body {
using bf16=__hip_bfloat16;
using bf16x8=__attribute__((ext_vector_type(8)))short;
using s16x4=__attribute__((ext_vector_type(4)))short;
using f32x16=__attribute__((ext_vector_type(16)))float;
using u32x4=__attribute__((ext_vector_type(4)))unsigned;
using f32x4=__attribute__((ext_vector_type(4)))float;
#define LASF __attribute__((address_space(3)))
constexpr int BATCH=8,NHEAD=16,SEQ=2048,D=64,DM=NHEAD*D;
constexpr int NW=8,QBLK=32,QB=QBLK*NW,KVBLK=64,NQB=SEQ/QB;
constexpr int ATTN_PITCH=DM, ATTN_UNIT_ROWS=QB;
__device__ __forceinline__ int crow(int r,int hi){return (r&3)+8*(r>>2)+4*hi;}
#define SBAR() __builtin_amdgcn_sched_barrier(0)
__device__ __forceinline__ void cmask(f32x16&p0,f32x16&p1,int jb,int qrel,int hi){
  const float NEG=-INFINITY; int kb=64*jb+4*hi;
  #pragma unroll
  for(int r=0;r<16;++r){int kv=kb+(r&3)+8*(r>>2); if(kv>qrel)p0[r]=NEG; if(kv+32>qrel)p1[r]=NEG;}
}

constexpr int NSLOT=3, SLOTB=8192;
constexpr int LDS_K=0, LDS_V=NSLOT*SLOTB, LDS_WS=2*NSLOT*SLOTB, LDS_OST=LDS_WS+NW*64*4, LDS_BYTES=LDS_OST+NW*4096;
constexpr float C2=0.125f*1.4426950408889634f;
__device__ __forceinline__ void glds16(const void*gsrc,unsigned lds_dst){unsigned keep;
  asm volatile("s_mov_b32 %0, m0\n\ts_mov_b32 m0, %2\n\ts_nop 0\n\tglobal_load_lds_dwordx4 %1, off\n\ts_mov_b32 m0, %0":"=&s"(keep):"v"(gsrc),"s"(lds_dst):"memory");}
__device__ __forceinline__ float max3f(float a,float b,float c){float r;asm("v_max3_f32 %0, %1, %2, %3":"=v"(r):"v"(a),"v"(b),"v"(c));return r;}
__device__ __forceinline__ float max2f(float a,float b){float r;asm("v_max_f32_e32 %0, %1, %2":"=v"(r):"v"(a),"v"(b));return r;}
__device__ __forceinline__ float fadd_s(float a,float b){float r;asm("v_add_f32_e32 %0, %1, %2":"=v"(r):"v"(a),"v"(b));return r;}
__device__ __forceinline__ float fsub_s(float a,float b){float r;asm("v_sub_f32_e32 %0, %1, %2":"=v"(r):"v"(a),"v"(b));return r;}
typedef float f32x2_t __attribute__((ext_vector_type(2))); typedef __bf16 bf16x2_t __attribute__((ext_vector_type(2)));
__device__ __forceinline__ unsigned cvtpk_s(float lo,float hi){f32x2_t v={lo,hi};bf16x2_t b=__builtin_convertvector(v,bf16x2_t);return __builtin_bit_cast(unsigned,b);}
#define WAIT_BAR(N) asm volatile("s_waitcnt vmcnt(" #N ") lgkmcnt(0)\n\ts_barrier":::"memory")

__device__ __forceinline__ void qkt(f32x16&p0,f32x16&p1,const char*Kslot,const bf16x8*qr,int r32,int hi){
  const char*kb=Kslot+hi*1024+r32*16;
  #pragma unroll
  for(int d0=0;d0<4;++d0){
    const bf16x8 b0=*reinterpret_cast<const bf16x8*>(kb+d0*2048);
    const bf16x8 b1=*reinterpret_cast<const bf16x8*>(kb+d0*2048+512);
    p0=__builtin_amdgcn_mfma_f32_32x32x16_bf16(b0,qr[d0],p0,0,0,0);p1=__builtin_amdgcn_mfma_f32_32x32x16_bf16(b1,qr[d0],p1,0,0,0);}
}
typedef __attribute__((address_space(3))) const char* lds_cptr;
typedef short v4i16_t __attribute__((ext_vector_type(4)));
__device__ __forceinline__ void kload8(bf16x8*kf,lds_cptr kp){
  kf[0]=*(const __attribute__((address_space(3))) bf16x8*)(kp);      kf[1]=*(const __attribute__((address_space(3))) bf16x8*)(kp+512);
  kf[2]=*(const __attribute__((address_space(3))) bf16x8*)(kp+2048); kf[3]=*(const __attribute__((address_space(3))) bf16x8*)(kp+2560);
  kf[4]=*(const __attribute__((address_space(3))) bf16x8*)(kp+4096); kf[5]=*(const __attribute__((address_space(3))) bf16x8*)(kp+4608);
  kf[6]=*(const __attribute__((address_space(3))) bf16x8*)(kp+6144); kf[7]=*(const __attribute__((address_space(3))) bf16x8*)(kp+6656);
}
__device__ __forceinline__ void kload2(bf16x8*kf,lds_cptr kp,int j){ kf[2*j]=*(const __attribute__((address_space(3))) bf16x8*)(kp+j*2048); kf[2*j+1]=*(const __attribute__((address_space(3))) bf16x8*)(kp+j*2048+512); }
__device__ __forceinline__ s16x4 vtr(lds_cptr p){ return __builtin_bit_cast(s16x4,__builtin_amdgcn_ds_read_tr16_b64_v4i16((__attribute__((address_space(3))) v4i16_t*)p)); }
__device__ __forceinline__ float rowmax(const f32x16&p0,const f32x16&p1){
  float a=max3f(p0[0],p0[1],p1[0]),b=max3f(p0[2],p0[3],p1[1]);a=max3f(a,p1[2],p1[3]);
  #pragma unroll
  for(int r=4;r<16;r+=4){a=max3f(a,p0[r],p0[r+1]);b=max3f(b,p0[r+2],p0[r+3]);a=max3f(a,p1[r],p1[r+1]);b=max3f(b,p1[r+2],p1[r+3]);}
  const float m=max2f(a,b);
  auto rr=__builtin_amdgcn_permlane32_swap(__float_as_uint(m),__float_as_uint(m),false,false);
  return max2f(__uint_as_float(rr[0]),__uint_as_float(rr[1]));
}
__device__ __forceinline__ void pv(f32x16*o,int vb,bf16x8 pa0,bf16x8 pa1,bf16x8 pa2,bf16x8 pa3){
  #pragma unroll
  for(int d0=0;d0<2;++d0){s16x4 lo[4],hi[4];
    #pragma unroll
    for(int ks=0;ks<4;++ks){
      asm volatile("ds_read_b64_tr_b16 %0,%1 offset:%c2":"=&v"(lo[ks]):"v"(vb),"i"(d0*4096+ks*1024):"memory");
      asm volatile("ds_read_b64_tr_b16 %0,%1 offset:%c2":"=&v"(hi[ks]):"v"(vb),"i"(d0*4096+ks*1024+512):"memory");}
    asm volatile("s_waitcnt lgkmcnt(0)":::"memory");SBAR();
    #define PK(k) (bf16x8){lo[k][0],lo[k][1],lo[k][2],lo[k][3],hi[k][0],hi[k][1],hi[k][2],hi[k][3]}
    o[d0]=__builtin_amdgcn_mfma_f32_32x32x16_bf16(pa0,PK(0),o[d0],0,0,0);
    o[d0]=__builtin_amdgcn_mfma_f32_32x32x16_bf16(pa1,PK(1),o[d0],0,0,0);
    o[d0]=__builtin_amdgcn_mfma_f32_32x32x16_bf16(pa2,PK(2),o[d0],0,0,0);
    o[d0]=__builtin_amdgcn_mfma_f32_32x32x16_bf16(pa3,PK(3),o[d0],0,0,0);
    #undef PK
  }
}


struct MergeCtx { const unsigned short* GA; const unsigned short* G2; const unsigned short* U; const float* cw; const float* st; unsigned short* out; };
__device__ __forceinline__ float mbflo(unsigned w){return __builtin_bit_cast(float,w<<16);}
__device__ __forceinline__ float mbfhi(unsigned w){return __builtin_bit_cast(float,w&0xffff0000u);}
__device__ __forceinline__ void munpack8(u32x4 w,float*f){f[0]=mbflo(w.x);f[1]=mbfhi(w.x);f[2]=mbflo(w.y);f[3]=mbfhi(w.y);f[4]=mbflo(w.z);f[5]=mbfhi(w.z);f[6]=mbflo(w.w);f[7]=mbfhi(w.w);}
__device__ __forceinline__ void merge_store8(const MergeCtx&c,size_t grow,int t,bool prm,int bb,int col,u32x4 ov){
  const size_t off=grow*1024+col; float ga[8],o[8],g2[8],u0[8],u1[8],u2[8];
  munpack8(*(const u32x4*)(c.GA+off),ga); munpack8(ov,o); munpack8(*(const u32x4*)(c.G2+off),g2); munpack8(*(const u32x4*)(c.U+off),u2);
  if(t>=1)munpack8(*(const u32x4*)(c.U+off-1024),u1);
  else if(prm){_Pragma("unroll") for(int e=0;e<8;++e)u1[e]=0.f;} else {const float*p=c.st+(size_t)(bb*2+1)*1024+col; _Pragma("unroll") for(int e=0;e<8;++e)u1[e]=p[e];}
  if(t>=2)munpack8(*(const u32x4*)(c.U+off-2048),u0);
  else if(prm){_Pragma("unroll") for(int e=0;e<8;++e)u0[e]=0.f;} else {const float*p=c.st+(size_t)(bb*2+t)*1024+col; _Pragma("unroll") for(int e=0;e<8;++e)u0[e]=p[e];}
  float r[8];
  _Pragma("unroll") for(int e=0;e<8;++e){const float cy=c.cw[col+e]*u0[e]+c.cw[1024+col+e]*u1[e]+c.cw[2048+col+e]*u2[e]; r[e]=ga[e]*o[e]+g2[e]*cy;}
  u32x4 w; w.x=cvtpk_s(r[0],r[1]); w.y=cvtpk_s(r[2],r[3]); w.z=cvtpk_s(r[4],r[5]); w.w=cvtpk_s(r[6],r[7]);
  *(u32x4*)(c.out+off)=w;
}
#ifndef ATTN_STORE16
#define ATTN_STORE16(p,v) (*(u32x4*)(p)=(v))
#endif
template<int THRL> __device__ __forceinline__ void attn_unit(int b,int h,int qb,const bf16*Q,const bf16*__restrict__ K,const bf16*__restrict__ V,const MergeCtx&mc,char*shm,const LASF float*fb){
  int tid_=threadIdx.x; asm volatile("":"+v"(tid_));
  const int tid=tid_,lane=tid&63,r32=lane&31,hi=lane>>5; const int wid=__builtin_amdgcn_readfirstlane(tid>>6);
  const long rowbase=(long)b*SEQ; const int q0=qb*QB;
  const bf16*Qw=Q+(rowbase+q0+wid*QBLK)*DM+h*D;
  const bf16*Kh=K+rowbase*DM+h*D,*Vh=V+rowbase*DM+h*D;
  const unsigned lds0=(unsigned)(uintptr_t)shm;
  float*wsf=(float*)(shm+LDS_WS)+wid*64;
  const bf16*ksrc=Kh+(long)lane*DM+wid*8;
  const bf16*vsrc=Vh+(long)(16*(wid&3)+(lane>>2))*DM+(wid>>2)*32+(lane&3)*8;
  const unsigned kdst=lds0+LDS_K+wid*1024, vdst=lds0+LDS_V+wid*1024;
  #define DMA_K(t,slot) glds16(ksrc+(long)(t)*KVBLK*DM,(unsigned)__builtin_amdgcn_readfirstlane(kdst+(slot)))
  #define DMA_V(t,slot) glds16(vsrc+(long)(t)*KVBLK*DM,(unsigned)__builtin_amdgcn_readfirstlane(vdst+(slot)))
  const int vb0=(int)(lds0+LDS_V)+((lane>>4)&1)*32+(lane&3)*8+(4*hi+((lane&15)>>2))*64;
  const char*Kbase=shm+LDS_K; bf16x8 kf[8];
  const lds_cptr shm3=(lds_cptr)shm; const lds_cptr kp0=shm3+LDS_K+hi*1024+r32*16; const lds_cptr vp0=shm3+LDS_V+((lane>>4)&1)*32+(lane&3)*8+(4*hi+((lane&15)>>2))*64;
  const int NT=(q0+QB)/KVBLK;
  DMA_K(0,0);DMA_V(0,0);DMA_K(1,SLOTB);
  bf16x8 qr[4];
  #pragma unroll
  for(int d0=0;d0<4;++d0)qr[d0]=*reinterpret_cast<const bf16x8*>(&Qw[(long)r32*DM+d0*16+hi*8]);
  float mhat=fb[q0+wid*QBLK+r32],l_reg=0.f;f32x16 o[2];o[0]=f32x16{};o[1]=f32x16{};
  #define FBINIT(C0,C1,t) do{ const LASF float*fp_=fb+64*(t)+4*hi; \
    _Pragma("unroll") for(int i_=0;i_<4;++i_){ const f32x4 a_=*(const LASF f32x4*)(fp_+8*i_),b_=*(const LASF f32x4*)(fp_+32+8*i_); \
      C0[4*i_]=a_[0]-mhat;C0[4*i_+1]=a_[1]-mhat;C0[4*i_+2]=a_[2]-mhat;C0[4*i_+3]=a_[3]-mhat; \
      C1[4*i_]=b_[0]-mhat;C1[4*i_+1]=b_[1]-mhat;C1[4*i_+2]=b_[2]-mhat;C1[4*i_+3]=b_[3]-mhat; } }while(0)
  #define FBLOAD(P0,P1,tn) do{ const LASF float*fp_=fb+64*(tn)+4*hi; \
    _Pragma("unroll") for(int i_=0;i_<4;++i_){ const f32x4 a_=*(const LASF f32x4*)(fp_+8*i_),b_=*(const LASF f32x4*)(fp_+32+8*i_); \
      P0[4*i_]=a_[0];P0[4*i_+1]=a_[1];P0[4*i_+2]=a_[2];P0[4*i_+3]=a_[3]; P1[4*i_]=b_[0];P1[4*i_+1]=b_[1];P1[4*i_+2]=b_[2];P1[4*i_+3]=b_[3]; } }while(0)
  #define FBSUB(X,B) do{ X[B]-=mhat; X[B+1]-=mhat; X[B+2]-=mhat; X[B+3]-=mhat; }while(0)
  const int qrel=wid*QBLK+r32;
  #define CMASK(P0,P1,t) do{int jb_=(t)-(NT-4); if(jb_>=0)cmask(P0,P1,jb_,qrel,hi);}while(0)
  bool resc=false;
  #define START(P0,P1) do{ const float rm=rowmax(P0,P1); resc=false; \
    if(__any(rm>(float)THRL)){ const float dl=__builtin_fmaxf(rm,0.f); mhat=fadd_s(mhat,dl); \
      _Pragma("unroll") for(int r=0;r<16;++r){P0[r]=fsub_s(P0[r],dl);P1[r]=fsub_s(P1[r],dl);} } \
    _Pragma("unroll") for(int r=0;r<16;++r)P0[r]=__builtin_amdgcn_exp2f(P0[r]); }while(0)
  #define RESC() do{ if(resc){ asm volatile("s_waitcnt lgkmcnt(0)":::"memory"); \
      _Pragma("unroll") for(int d_=0;d_<2;++d_) _Pragma("unroll") for(int r=0;r<16;++r)o[d_][r]*=wsf[crow(r,hi)]; } }while(0)
  f32x16 pA0,pA1,pB0,pB1;
  int sl_prev=0,sl_cur=0,sl_next=SLOTB;
  #define ROT() do{sl_prev=sl_cur;sl_cur=sl_next;sl_next=(sl_next==(NSLOT-1)*SLOTB)?0:sl_next+SLOTB;}while(0)
  DMA_K(2,2*SLOTB);
  WAIT_BAR(3);
  FBINIT(pA0,pA1,0);
  qkt(pA0,pA1,Kbase,qr,r32,hi);asm volatile("s_nop 15\n\ts_nop 7":"+v"(pA0),"+v"(pA1));CMASK(pA0,pA1,0);
  START(pA0,pA1);
  _Pragma("unroll") for(int r=0;r<16;++r)pA1[r]=__builtin_amdgcn_exp2f(pA1[r]);
  FBINIT(pB0,pB1,1);
  WAIT_BAR(0);
  DMA_K(3,0);DMA_V(1,SLOTB);
  ROT();
  kload8(kf,kp0+sl_cur);
  WAIT_BAR(2);
  s16x4 vlo[8],vhi[8]; u32x4 pw0,pw1,pw2,pw3;
  #define PKW(P,B) cvtpk_s(P[B],P[B+1])
  #define PAF(k) __builtin_bit_cast(bf16x8,pw##k)
  #define VFR(i) (bf16x8){vlo[i][0],vlo[i][1],vlo[i][2],vlo[i][3],vhi[i][0],vhi[i][1],vhi[i][2],vhi[i][3]}
  #define PIN(x) asm volatile("":"+v"(x))
  #define MX3(a,b,c) __builtin_fmaxf(__builtin_fmaxf((a),(b)),(c))
  #define GAPA(MF,A0,A1,A2,A3,W0,W1,PW) do{ MF; sacc+=A0; sacc+=A1; sacc+=A2; sacc+=A3; PIN(sacc); W0; W1; PIN(PW); SBAR(); }while(0)
  #define EX(v) __builtin_amdgcn_exp2f(v)
  #define GAPB(MF,X,B,Y,YB) do{ MF; X[B]=EX(X[B]); X[B+1]=EX(X[B+1]); X[B+2]=EX(X[B+2]); X[B+3]=EX(X[B+3]); PIN(X); FBSUB(Y,YB); PIN(Y); SBAR(); }while(0)
  #define VRD(i) do{ vlo[i]=vtr(vp_+(((i)>>2)*4096+((i)&3)*1024)); vhi[i]=vtr(vp_+(((i)>>2)*4096+((i)&3)*1024+512)); }while(0)
  #define KRD(G,j) do{ if(G){ kload2(kf,kp0+sl_next,j); SBAR(); } }while(0)
  #define STEP(C0,C1,P0,P1,t,GK,GV,GL) do{ SBAR(); \
    const lds_cptr vp_=vp0+sl_prev; \
    VRD(0); SBAR(); float sacc=(P0[0]+P0[1]); \
    GAPA(C0=__builtin_amdgcn_mfma_f32_32x32x16_bf16(kf[0],qr[0],C0,0,0,0), P0[2],P0[3],P0[4],P0[5],     pw0[0]=PKW(P0,0), pw0[1]=PKW(P0,2), pw0); \
    VRD(4); SBAR(); GAPA(C1=__builtin_amdgcn_mfma_f32_32x32x16_bf16(kf[1],qr[0],C1,0,0,0), P0[6],P0[7],P0[8],P0[9],     pw0[2]=PKW(P0,4), pw0[3]=PKW(P0,6), pw0); \
    VRD(1); SBAR(); GAPA(C0=__builtin_amdgcn_mfma_f32_32x32x16_bf16(kf[2],qr[1],C0,0,0,0),   P0[10],P0[11],P0[12],P0[13], pw1[0]=PKW(P0,8), pw1[1]=PKW(P0,10), pw1); \
    VRD(5); SBAR(); GAPA(C1=__builtin_amdgcn_mfma_f32_32x32x16_bf16(kf[3],qr[1],C1,0,0,0),   P0[14],P0[15],P1[0],P1[1],   pw1[2]=PKW(P0,12),pw1[3]=PKW(P0,14), pw1); \
    VRD(2); SBAR(); GAPA(C0=__builtin_amdgcn_mfma_f32_32x32x16_bf16(kf[4],qr[2],C0,0,0,0),   P1[2],P1[3],P1[4],P1[5],     pw2[0]=PKW(P1,0), pw2[1]=PKW(P1,2), pw2); \
    VRD(6); SBAR(); GAPA(C1=__builtin_amdgcn_mfma_f32_32x32x16_bf16(kf[5],qr[2],C1,0,0,0),   P1[6],P1[7],P1[8],P1[9],     pw2[2]=PKW(P1,4), pw2[3]=PKW(P1,6), pw2); \
    VRD(3); SBAR(); GAPA(C0=__builtin_amdgcn_mfma_f32_32x32x16_bf16(kf[6],qr[3],C0,0,0,0),   P1[10],P1[11],P1[12],P1[13], pw3[0]=PKW(P1,8), pw3[1]=PKW(P1,10), pw3); \
    VRD(7); SBAR(); GAPA(C1=__builtin_amdgcn_mfma_f32_32x32x16_bf16(kf[7],qr[3],C1,0,0,0),   P1[14],P1[15],0.f,0.f,       pw3[2]=PKW(P1,12),pw3[3]=PKW(P1,14), pw3); \
    l_reg+=sacc; \
    if(GK){DMA_K((t)+3,sl_cur);} if(GV){DMA_V((t)+1,sl_next);} \
    CMASK(C0,C1,t); \
    { float a=MX3(C0[0],C0[1],C1[0]),b=MX3(C0[2],C0[3],C1[1]); a=MX3(a,C1[2],C1[3]); \
      _Pragma("unroll") for(int r=4;r<16;r+=4){a=MX3(a,C0[r],C0[r+1]);b=MX3(b,C0[r+2],C0[r+3]);a=MX3(a,C1[r],C1[r+1]);b=MX3(b,C1[r+2],C1[r+3]);} \
      float rm=__builtin_fmaxf(a,b); { auto rr=__builtin_amdgcn_permlane32_swap(__float_as_uint(rm),__float_as_uint(rm),false,false); rm=__builtin_fmaxf(__uint_as_float(rr[0]),__uint_as_float(rr[1])); } \
      resc=false; \
      if(__builtin_expect(__any(rm>(float)THRL),0)){ const float dl=__builtin_fmaxf(rm,0.f); mhat+=dl; \
        _Pragma("unroll") for(int r=0;r<16;++r){C0[r]-=dl;C1[r]-=dl;} \
        const float f=__builtin_amdgcn_exp2f(-dl); l_reg*=f; if(hi==0)wsf[r32]=f; resc=true; } } \
    SBAR(); FBLOAD(P0,P1,(t)+1); SBAR(); \
    GAPB(o[0]=__builtin_amdgcn_mfma_f32_32x32x16_bf16(PAF(0),VFR(0),o[0],0,0,0), C0,0, P0,0); \
    GAPB(o[1]=__builtin_amdgcn_mfma_f32_32x32x16_bf16(PAF(0),VFR(4),o[1],0,0,0), C0,4, P0,4); \
    KRD(GL,0); GAPB(o[0]=__builtin_amdgcn_mfma_f32_32x32x16_bf16(PAF(1),VFR(1),o[0],0,0,0), C0,8, P0,8); \
    KRD(GL,1); GAPB(o[1]=__builtin_amdgcn_mfma_f32_32x32x16_bf16(PAF(1),VFR(5),o[1],0,0,0), C0,12, P0,12); \
    KRD(GL,2); GAPB(o[0]=__builtin_amdgcn_mfma_f32_32x32x16_bf16(PAF(2),VFR(2),o[0],0,0,0), C1,0, P1,0); \
    KRD(GL,3); GAPB(o[1]=__builtin_amdgcn_mfma_f32_32x32x16_bf16(PAF(2),VFR(6),o[1],0,0,0), C1,4, P1,4); \
    GAPB(o[0]=__builtin_amdgcn_mfma_f32_32x32x16_bf16(PAF(3),VFR(3),o[0],0,0,0), C1,8, P1,8); \
    GAPB(o[1]=__builtin_amdgcn_mfma_f32_32x32x16_bf16(PAF(3),VFR(7),o[1],0,0,0), C1,12, P1,12); \
    }while(0)
  int t=1;
  #undef CMASK
  #define CMASK(P0,P1,t) do{}while(0)
  for(;t+5<NT;t+=2){
    STEP(pB0,pB1,pA0,pA1,t,true,true,true);     WAIT_BAR(2); RESC(); ROT();
    STEP(pA0,pA1,pB0,pB1,t+1,true,true,true);   WAIT_BAR(2); RESC(); ROT();
  }
  #undef CMASK
  #define CMASK(P0,P1,t) do{int jb_=(t)-(NT-4); if(jb_>=0)cmask(P0,P1,jb_,qrel,hi);}while(0)
  #define ENDW(tt) do{ if((tt)+3<NT){WAIT_BAR(2);} else if((tt)+2<NT){WAIT_BAR(1);} else {WAIT_BAR(0);} }while(0)
  for(;t+1<NT;t+=2){
    STEP(pB0,pB1,pA0,pA1,t,(t+3<NT),(t+1<NT),(t+1<NT));       ENDW(t);   RESC(); ROT();
    STEP(pA0,pA1,pB0,pB1,t+1,(t+4<NT),(t+2<NT),(t+2<NT));     ENDW(t+1); RESC(); ROT();
  }
  STEP(pB0,pB1,pA0,pA1,NT-1,false,false,false); RESC();
  u32x4 mg[4][5]; f32x4 mcw[3][2];
  { const int mcol=h*D+(lane&7)*8;
    _Pragma("unroll") for(int j=0;j<3;++j){ mcw[j][0]=*(const f32x4*)(mc.cw+j*1024+mcol); mcw[j][1]=*(const f32x4*)(mc.cw+j*1024+mcol+4); }
    _Pragma("unroll") for(int i=0;i<4;++i){ const int t_=q0+wid*QBLK+i*8+(lane>>3); const size_t off=(size_t)(rowbase+t_)*1024+mcol;
      mg[i][0]=__builtin_nontemporal_load((const u32x4*)(mc.GA+off)); mg[i][1]=__builtin_nontemporal_load((const u32x4*)(mc.G2+off)); mg[i][2]=*(const u32x4*)(mc.U+off);
      mg[i][3]=(t_>=1)?*(const u32x4*)(mc.U+off-1024):(u32x4){0u,0u,0u,0u}; mg[i][4]=(t_>=2)?*(const u32x4*)(mc.U+off-2048):(u32x4){0u,0u,0u,0u}; } }
  { float sacc=pB0[0]+pB0[1]; _Pragma("unroll") for(int r=2;r<16;++r)sacc+=pB0[r]; _Pragma("unroll") for(int r=0;r<16;++r)sacc+=pB1[r]; l_reg+=sacc;
    pw0=(u32x4){PKW(pB0,0),PKW(pB0,2),PKW(pB0,4),PKW(pB0,6)};pw1=(u32x4){PKW(pB0,8),PKW(pB0,10),PKW(pB0,12),PKW(pB0,14)};pw2=(u32x4){PKW(pB1,0),PKW(pB1,2),PKW(pB1,4),PKW(pB1,6)};pw3=(u32x4){PKW(pB1,8),PKW(pB1,10),PKW(pB1,12),PKW(pB1,14)};
    SBAR(); pv(o,vb0+sl_cur,PAF(0),PAF(1),PAF(2),PAF(3)); }
  #undef PKW
  #undef PAF
  #undef VFR
  #undef PIN
  #undef MX3
  #undef GAPA
  #undef GAPB
  #undef EX
  #undef VRD
  #undef KRD
  #undef STEP
  #undef ENDW
  {auto rr=__builtin_amdgcn_permlane32_swap(__float_as_uint(l_reg),__float_as_uint(l_reg),false,false);l_reg=__uint_as_float(rr[0])+__uint_as_float(rr[1]);}
  if(hi==0)wsf[32+r32]=l_reg;asm volatile("s_waitcnt lgkmcnt(0)":::"memory");
  float rli[16];
  #pragma unroll
  for(int r=0;r<16;++r)rli[r]=__builtin_amdgcn_rcpf(wsf[32+crow(r,hi)]);
  { bf16*stg=(bf16*)(shm+LDS_OST)+wid*2048;
    #pragma unroll
    for(int r=0;r<16;++r){const int orow=crow(r,hi);
      #pragma unroll
      for(int d0=0;d0<2;++d0)stg[orow*64+d0*32+r32]=__float2bfloat16(o[d0][r]*rli[r]);}
    asm volatile("s_waitcnt lgkmcnt(0)":::"memory");
    #pragma unroll
    for(int i=0;i<4;++i){const int row=i*8+(lane>>3),ch=lane&7; const u32x4 v=*(const u32x4*)(stg+row*64+ch*8); const int t_=q0+wid*QBLK+row;
      float ga[8],ov[8],g2[8],u2[8],u1[8],u0[8],r[8]; munpack8(mg[i][0],ga); munpack8(v,ov); munpack8(mg[i][1],g2); munpack8(mg[i][2],u2); munpack8(mg[i][3],u1); munpack8(mg[i][4],u0);
      _Pragma("unroll") for(int e=0;e<8;++e){ const float cy=mcw[0][e>>2][e&3]*u0[e]+mcw[1][e>>2][e&3]*u1[e]+mcw[2][e>>2][e&3]*u2[e]; r[e]=ga[e]*ov[e]+g2[e]*cy; }
      u32x4 w; w.x=cvtpk_s(r[0],r[1]); w.y=cvtpk_s(r[2],r[3]); w.z=cvtpk_s(r[4],r[5]); w.w=cvtpk_s(r[6],r[7]);
      *(u32x4*)(mc.out+(size_t)(rowbase+t_)*1024+h*D+ch*8)=w; } }
  asm volatile("s_waitcnt lgkmcnt(0)\n\ts_barrier":::"memory");
  #undef DMA_K
  #undef DMA_V
  #undef CMASK
  #undef START
  #undef RESC
  #undef ROT
  #undef FBINIT
  #undef FBLOAD
  #undef FBSUB
}
constexpr int ATTN_LDS_BYTES=LDS_BYTES;
#undef SBAR
#undef WAIT_BAR
}

#define XB_TMO      128
#define XB_XCNT(j)  (256  + 64 * (j))
#define XB_XSUB(j)  (1280 + 64 * (j))
#define XB_XGEN(j)  (2304 + 64 * (j))
#define XB_TOP      3328
#define XB_TOPGEN   3392
#define XCD_BAR_WORDS 3456
#define XB_SPIN_CAP (1u << 18)

__device__ __forceinline__ unsigned xb_ld(unsigned* p)              { return __hip_atomic_load(p, __ATOMIC_RELAXED, __HIP_MEMORY_SCOPE_AGENT); }
__device__ __forceinline__ unsigned xb_add(unsigned* p, unsigned v) { return __hip_atomic_fetch_add(p, v, __ATOMIC_RELAXED, __HIP_MEMORY_SCOPE_AGENT); }
__device__ __forceinline__ unsigned xb_xcc_id() { return (unsigned)__builtin_amdgcn_s_getreg((3 << 11) | 20) & 0xFu; }
#define XB_SPIN(cond, bar) do { unsigned _sp = 0; while (cond) { __builtin_amdgcn_s_sleep(1); \
    if ((++_sp & 255u) == 0u) { if (xb_ld(&(bar)[XB_TMO])) break; if (_sp > XB_SPIN_CAP) { atomicAdd(&(bar)[XB_TMO], 1u); break; } } } } while (0)

struct XcdBarrier {
    unsigned* bar; unsigned x;
    volatile __attribute__((address_space(3))) unsigned* st;
};

__device__ __forceinline__ XcdBarrier xcd_barrier_post(unsigned* bar, volatile __attribute__((address_space(3))) unsigned* st) {
    XcdBarrier b; b.bar = bar; b.x = xb_xcc_id(); b.st = st;
    if (threadIdx.x == 0) (void)xb_add(&bar[XB_XCNT(b.x)], 1u);
    return b;
}
__device__ __forceinline__ void xcd_barrier_complete(unsigned* bar, unsigned x, unsigned& nloc, unsigned& nx) {
    const unsigned G = gridDim.x * gridDim.y * gridDim.z;
    unsigned sum, cnt, mine, sp = 0u;
    for (;;) {
        sum = 0u; cnt = 0u; mine = 0u;
#pragma unroll
        for (unsigned j = 0; j < 16; ++j) { const unsigned c = xb_ld(&bar[XB_XCNT(j)]); sum += c; cnt += (c > 0u) ? 1u : 0u; mine = (j == x) ? c : mine; }
        if (sum == G) break;
        __builtin_amdgcn_s_sleep(1);
        if ((++sp & 255u) == 0u) { if (xb_ld(&bar[XB_TMO])) break; if (sp > XB_SPIN_CAP) { atomicAdd(&bar[XB_TMO], 1u); break; } }
    }
    nloc = mine > 0u ? mine : 1u; nx = cnt > 0u ? cnt : 1u;
}

__device__ __forceinline__ void xcd_barrier(const XcdBarrier& b) {
    asm volatile("s_waitcnt vmcnt(0)" ::: "memory");
    __syncthreads();
    if (threadIdx.x == 0) {
        unsigned* bar = b.bar;
        __builtin_amdgcn_s_waitcnt(0);
        unsigned nloc = b.st[0], nx = b.st[1];
        if (nloc == 0u) { xcd_barrier_complete(bar, b.x, nloc, nx); b.st[0] = nloc; b.st[1] = nx; }
        const unsigned old = xb_add(&bar[XB_XSUB(b.x)], 1u);
        const unsigned gen = old / nloc;
        if (old + 1u == (gen + 1u) * nloc) {
            __builtin_amdgcn_fence(__ATOMIC_RELEASE, "agent");
            asm volatile("s_waitcnt vmcnt(0)" ::: "memory");
            const unsigned og = xb_add(&bar[XB_TOP], 1u);
            const unsigned tg = og / nx;
            if (og + 1u == (tg + 1u) * nx) xb_add(&bar[XB_TOPGEN], 1u);
            else XB_SPIN(xb_ld(&bar[XB_TOPGEN]) == tg, bar);
            __builtin_amdgcn_fence(__ATOMIC_ACQUIRE, "agent");
            xb_add(&bar[XB_XGEN(b.x)], 1u);
            asm volatile("s_waitcnt vmcnt(0)" ::: "memory");
        } else {
            XB_SPIN(xb_ld(&bar[XB_XGEN(b.x)]) == gen, bar);
            __builtin_amdgcn_fence(__ATOMIC_ACQUIRE, "agent");
            asm volatile("s_waitcnt vmcnt(0)" ::: "memory");
        }
    }
    __syncthreads();
}


namespace cg = cooperative_groups;
constexpr int NWAVES = 8, NTHREADS = 512;
constexpr size_t MiB = 1u << 20;
constexpr size_t WS_CNT = 912 * 1024;
constexpr int CNT_WORDS = 3 * 80 * 16;
constexpr size_t WS_BAR = 896 * 1024;
constexpr size_t WS_MOD = 0, WS_W1IN = 1 * MiB, WS_W1OUT = 12 * MiB, WS_WIN = 18 * MiB, WS_WOUT = 35 * MiB, WS_W2IN = 37 * MiB, WS_W2OUT = 48 * MiB, WS_H = 54 * MiB,
                 WS_QB = 88 * MiB, WS_KB = 122 * MiB, WS_VB = 156 * MiB, WS_GAB = 190 * MiB, WS_G2B = 224 * MiB, WS_UB = 258 * MiB, WS_END = 292 * MiB, WS_ACT = WS_QB;
static_assert((size_t)MT * DM * 2 == 34 * MiB && WS_KB - WS_QB == 34 * MiB && WS_VB - WS_KB == 34 * MiB && WS_GAB - WS_VB == 34 * MiB && WS_G2B - WS_GAB == 34 * MiB && WS_UB - WS_G2B == 34 * MiB && WS_ACT + (size_t)MT * DFF * 2 <= WS_GAB && WS_WIN + (size_t)NINP * DM * 2 <= WS_WOUT && WS_W1IN + (size_t)2 * DFF * DM * 2 <= WS_W1OUT, "d_ws map");
constexpr int RING_OFF = 0, RING_BYTES = 131072, FB_OFF = RING_BYTES, STAT_OFF = FB_OFF + 8192, QL_OFF = STAT_OFF + 8192, LDS_BYTES = 163840;
static_assert(QL_OFF + 64 * 144 <= LDS_BYTES && 98304 + 8 * 8192 <= LDS_BYTES && LDS_BYTES <= 163840 && STAT_OFF + 8192 <= LDS_BYTES && attn_body::LDS_BYTES <= RING_BYTES, "LDS map");

#define LAS __attribute__((address_space(3)))
typedef unsigned short bf16;
typedef unsigned v4u __attribute__((ext_vector_type(4)));
typedef unsigned v2u __attribute__((ext_vector_type(2)));
typedef float f32x4 __attribute__((ext_vector_type(4)));
typedef float f32x16 __attribute__((ext_vector_type(16)));
typedef short bf16x8 __attribute__((ext_vector_type(8)));
#define LDS_WAIT() asm volatile("s_waitcnt lgkmcnt(0)" ::: "memory")
__device__ __forceinline__ unsigned f2bf(float f) { unsigned u = __builtin_bit_cast(unsigned, f); return (u + 0x7fffu + ((u >> 16) & 1u)) >> 16; }
__device__ __forceinline__ unsigned pk2(float lo, float hi) { return attn_body::cvtpk_s(lo, hi); }
__device__ __forceinline__ float bflo(unsigned w) { return __builtin_bit_cast(float, w << 16); }
__device__ __forceinline__ float bfhi(unsigned w) { return __builtin_bit_cast(float, w & 0xffff0000u); }
__device__ __forceinline__ float wave_sum(float v) {
#pragma unroll
    for (int o = 1; o < 64; o <<= 1) v += __shfl_xor(v, o);
    return v;
}

struct Args { const float* in[22]; float* out; unsigned char* ws; int ph_lo, ph_hi; };

__device__ __forceinline__ void p0_mod(const Args& a, LAS unsigned char* lds, int vcu, int G) {
    const int tid = threadIdx.x, lane = tid & 63, wid = tid >> 6;
    LAS float* sc = (LAS float*)lds;
    const float* w_ada = a.in[8]; const float* b_ada = a.in[9]; float* mod = (float*)(a.ws + WS_MOD);
    for (int item = vcu; item < MODLD / 64; item += G) {
        for (int i = tid; i < 24 * 1024; i += NTHREADS) { const int b = i >> 10, k = i & 1023; const float c = b < 8 ? a.in[6][b * 1024 + k] : a.in[7][(b - 8) * 1024 + k]; sc[i] = c / (1.0f + __expf(-c)); }
        __syncthreads();
        float acc[24];
#pragma unroll
        for (int b = 0; b < 24; ++b) acc[b] = 0.f;
        const int n = item * 64 + lane; const float* wp = w_ada + (size_t)(wid * 128) * MODLD + n;
        LAS float* wl = (LAS float*)(lds + 98304 + wid * 8192);
        float nx[32];
#pragma unroll
        for (int i = 0; i < 32; ++i) nx[i] = __builtin_nontemporal_load(wp + (size_t)i * MODLD);
#pragma unroll 1
        for (int kb = 0; kb < 128; kb += 32) {
#pragma unroll
            for (int i = 0; i < 32; ++i) wl[i * 64 + lane] = nx[i];
            if (kb + 32 < 128) {
#pragma unroll
                for (int i = 0; i < 32; ++i) nx[i] = __builtin_nontemporal_load(wp + (size_t)(kb + 32 + i) * MODLD);
            }
#pragma unroll 1
            for (int k4 = 0; k4 < 32; k4 += 4) {
                const float w0 = wl[(k4 + 0) * 64 + lane], w1 = wl[(k4 + 1) * 64 + lane], w2 = wl[(k4 + 2) * 64 + lane], w3 = wl[(k4 + 3) * 64 + lane];
#pragma unroll
                for (int b = 0; b < 24; ++b) { const f32x4 s = *(const LAS f32x4*)(sc + b * 1024 + wid * 128 + kb + k4); acc[b] += s[0] * w0 + s[1] * w1 + s[2] * w2 + s[3] * w3; }
            }
        }
        __syncthreads();
#pragma unroll
        for (int b = 0; b < 24; ++b) sc[(wid * 24 + b) * 64 + lane] = acc[b];
        __syncthreads();
        for (int o = tid; o < 24 * 64; o += NTHREADS) { const int b = o >> 6, c = o & 63; float s = b_ada[item * 64 + c];
#pragma unroll
            for (int w = 0; w < 8; ++w) s += sc[(w * 24 + b) * 64 + c];
            mod[(size_t)b * MODLD + item * 64 + c] = s; }
        __syncthreads();
    }
}
__device__ __forceinline__ void p0_transpose_item(const float* W, int K, int N, bf16* WT, int dst_row0, int src_col0, int nvalid, int kb, LAS float* scr, int lane) {
    const int k0 = 64 * kb; const int cl = lane & 31; const bool ok = cl < nvalid;
    float tv[32];
#pragma unroll
    for (int i = 0; i < 32; ++i) { const int kk = 2 * i + (lane >> 5); tv[i] = ok ? __builtin_nontemporal_load(W + (size_t)(k0 + kk) * N + src_col0 + cl) : 0.f; }
#pragma unroll
    for (int i = 0; i < 32; ++i) { const int kk = 2 * i + (lane >> 5); scr[kk * 33 + cl] = tv[i]; }
    LDS_WAIT(); asm volatile("" ::: "memory");
    const int c = lane & 7;
#pragma unroll
    for (int j = 0; j < 4; ++j) { const int n = (lane >> 3) + 8 * j; const LAS float* s = scr + (8 * c) * 33 + n;
        v4u o; o.x = pk2(s[0 * 33], s[1 * 33]); o.y = pk2(s[2 * 33], s[3 * 33]); o.z = pk2(s[4 * 33], s[5 * 33]); o.w = pk2(s[6 * 33], s[7 * 33]);
        *(v4u*)(WT + (size_t)(dst_row0 + n) * K + k0 + 8 * c) = o; }
    LDS_WAIT(); asm volatile("" ::: "memory");
}
__device__ __forceinline__ void map_ffn_in(int db, int& src, int& nv) { const int r = db * 32, t = r >> 8, w = r & 255; src = (w < 128 ? 0 : DFF) + t * 128 + (w & 127); nv = 32; }
__device__ __forceinline__ void map_win(int db, int& src, int& nv) {
    const int r = db * 32; nv = 32;
    if (r < 3072) { src = r; return; }
    if (r < 4096) { src = OFF_GA + (r - 3072); return; }
    if (r < 6144) { const int q = r - 4096, t = q >> 8, w = q & 255; src = (w < 128 ? OFF_B : OFF_GC) + t * 128 + (w & 127); return; }
    if (r < 8192) { const int q = r - 6144, t = q >> 8, w = q & 255; src = (w < 128 ? OFF_C : OFF_X) + t * 128 + (w & 127); return; }
    src = OFF_F; nv = (r == 8192) ? 16 : 0;
}
constexpr int I_1IN = 16 * 176, I_1OUT = 44 * 32, I_WIN = 16 * 264, I_WOUT = 16 * 32, WITEMS = 2 * I_1IN + 2 * I_1OUT + I_WIN + I_WOUT;
constexpr int WCUT0 = 2 * I_1IN + I_WIN, WCUT1 = WCUT0 + I_1OUT;
__device__ __forceinline__ void weight_item(const Args& a, int it, LAS float* scr, int lane) {
    int r = it; int src, nv;
    if (r < I_1IN) { map_ffn_in(r % 176, src, nv); p0_transpose_item(a.in[11], 1024, 2 * DFF, (bf16*)(a.ws + WS_W1IN), (r % 176) * 32, src, nv, r / 176, scr, lane); return; } r -= I_1IN;
    if (r < I_1IN) { map_ffn_in(r % 176, src, nv); p0_transpose_item(a.in[19], 1024, 2 * DFF, (bf16*)(a.ws + WS_W2IN), (r % 176) * 32, src, nv, r / 176, scr, lane); return; } r -= I_1IN;
    if (r < I_WIN) { map_win(r % 264, src, nv); p0_transpose_item(a.in[14], 1024, NIN, (bf16*)(a.ws + WS_WIN), (r % 264) * 32, src, nv, r / 264, scr, lane); return; } r -= I_WIN;
    if (r < I_1OUT) { p0_transpose_item(a.in[12], DFF, 1024, (bf16*)(a.ws + WS_W1OUT), (r % 32) * 32, (r % 32) * 32, 32, r / 32, scr, lane); return; } r -= I_1OUT;
    if (r < I_1OUT) { p0_transpose_item(a.in[20], DFF, 1024, (bf16*)(a.ws + WS_W2OUT), (r % 32) * 32, (r % 32) * 32, 32, r / 32, scr, lane); return; } r -= I_1OUT;
    p0_transpose_item(a.in[17], 1024, 1024, (bf16*)(a.ws + WS_WOUT), (r % 32) * 32, (r % 32) * 32, 32, r / 32, scr, lane);
}
__device__ __forceinline__ void p0_weights(const Args& a, LAS unsigned char* lds, int vcu, int G) {
    const int tid = threadIdx.x, lane = tid & 63, wid = tid >> 6;
    LAS float* scr = (LAS float*)(lds + wid * 16384);
    const int nitems = (G == 256) ? WCUT0 : WITEMS;
    constexpr int NMODWG = MODLD / 64;
    const bool skew = (G > NMODWG);
    const int nslot = skew ? NMODWG * NWAVES + (G - NMODWG) * NWAVES * 2 : G * NWAVES;
    const int slot0 = !skew ? vcu * NWAVES + wid : (vcu < NMODWG ? vcu * NWAVES + wid : NMODWG * NWAVES + ((vcu - NMODWG) * NWAVES + wid) * 2);
    const int nmine = (skew && vcu >= NMODWG) ? 2 : 1;
    for (int sl = 0; sl < nmine; ++sl)
        for (int it = slot0 + sl; it < nitems; it += nslot) weight_item(a, it, scr, lane);
}
__device__ __forceinline__ void weight_items_tail(const Args& a, LAS unsigned char* lds, int first, int last, int wk, int nwk) {
    const int tid = threadIdx.x, lane = tid & 63, wid = tid >> 6;
    LAS float* scr = (LAS float*)(lds + wid * 16384);
    for (int it = first + wk; it < last; it += nwk) weight_item(a, it, scr, lane);
}
template <bool FINAL, bool NT = false, int NR = 4> __device__ __forceinline__ void norm_rows4(int m0, const float* xP, const float* xS, const float* g, const float* mod, int sh_off, int sc_off, bf16* H, float* Y, int lane) {
    const float* x0 = m0 < MP ? xP + (size_t)m0 * DM : xS + (size_t)(m0 - MP) * DM;
    const int mb = m0 < MP ? (m0 >> 11) : 8 + ((m0 - MP) >> 6);
    f32x4 v[NR][4]; float s[NR];
#pragma unroll
    for (int r = 0; r < NR; ++r)
#pragma unroll
        for (int j = 0; j < 4; ++j) { const f32x4* p = (const f32x4*)(x0 + (size_t)r * DM) + lane + 64 * j; v[r][j] = NT ? __builtin_nontemporal_load(p) : *p; }
    f32x4 gg[4], sh[4], sc[4];
#pragma unroll
    for (int j = 0; j < 4; ++j) { gg[j] = ((const f32x4*)g + lane)[64 * j];
        if (!FINAL) { sh[j] = ((const f32x4*)(mod + (size_t)mb * MODLD + sh_off) + lane)[64 * j]; sc[j] = ((const f32x4*)(mod + (size_t)mb * MODLD + sc_off) + lane)[64 * j]; } }
#pragma unroll
    for (int r = 0; r < NR; ++r) { s[r] = 0.f;
#pragma unroll
        for (int j = 0; j < 4; ++j) s[r] += (v[r][j].x * v[r][j].x + v[r][j].y * v[r][j].y) + (v[r][j].z * v[r][j].z + v[r][j].w * v[r][j].w); }
#pragma unroll
    for (int o = 1; o < 64; o <<= 1) {
#pragma unroll
        for (int r = 0; r < NR; ++r) s[r] += __shfl_xor(s[r], o); }
#pragma unroll
    for (int r = 0; r < NR; ++r) { const float rstd = 1.0f / sqrtf(s[r] * (1.f / DM) + EPS);
        if (FINAL) { f32x4* yr = (f32x4*)(Y + (size_t)(m0 + r) * DM) + lane;
#pragma unroll
            for (int j = 0; j < 4; ++j) __builtin_nontemporal_store((v[r][j] * rstd) * gg[j], yr + 64 * j); }
        else { v2u* o8 = (v2u*)(H + (size_t)(m0 + r) * DM) + lane;
#pragma unroll
            for (int j = 0; j < 4; ++j) { const f32x4 y = (v[r][j] * rstd) * gg[j] * (sc[j] + 1.0f) + sh[j]; v2u w; w.x = pk2(y.x, y.y); w.y = pk2(y.z, y.w); o8[64 * j] = w; } } }
}
__device__ __forceinline__ void norm_mod_rows(const float* xP, const float* xS, const float* g, const float* mod, int sh_off, int sc_off, bf16* H, int vcu, int G) {
    const int tid = threadIdx.x, lane = tid & 63, wid = tid >> 6;
    const int gw = vcu * NWAVES + wid, NGW = G * NWAVES;
    for (int q = gw; q < MT / 4; q += NGW) norm_rows4<false, true>(4 * q, xP, xS, g, mod, sh_off, sc_off, H, nullptr, lane);
}
__device__ __forceinline__ void final_norm_rows(float* X, const float* g, int vcu, int G) {
    const int tid = threadIdx.x, lane = tid & 63, wid = tid >> 6;
    const int gw = vcu * NWAVES + wid, NGW = G * NWAVES;
    for (int q = gw; q < MT / 4; q += NGW) norm_rows4<true>(4 * q, X, X + (size_t)MP * DM, g, nullptr, 0, 0, nullptr, X, lane);
}
__device__ __forceinline__ void panel_handoff(unsigned* cP, unsigned* cS) {
    asm volatile("s_waitcnt vmcnt(0)" ::: "memory");
    __syncthreads();
    if (threadIdx.x == 0) {
        __builtin_amdgcn_fence(__ATOMIC_RELEASE, "agent");
        asm volatile("s_waitcnt vmcnt(0)" ::: "memory");
        __hip_atomic_fetch_add(cP, 1u, __ATOMIC_RELAXED, __HIP_MEMORY_SCOPE_AGENT);
        __hip_atomic_fetch_add(cS, 1u, __ATOMIC_RELAXED, __HIP_MEMORY_SCOPE_AGENT);
        unsigned sp = 0;
        while (__hip_atomic_load(cP, __ATOMIC_RELAXED, __HIP_MEMORY_SCOPE_AGENT) < 4u || __hip_atomic_load(cS, __ATOMIC_RELAXED, __HIP_MEMORY_SCOPE_AGENT) < 16u) { __builtin_amdgcn_s_sleep(2); if (++sp > (1u << 22)) break; }
        __builtin_amdgcn_fence(__ATOMIC_ACQUIRE, "agent");
        asm volatile("s_waitcnt vmcnt(0)" ::: "memory");
    }
    __syncthreads();
}
__device__ __forceinline__ void unpack8(v4u w, float* f) { f[0] = bflo(w.x); f[1] = bfhi(w.x); f[2] = bflo(w.y); f[3] = bfhi(w.y); f[4] = bflo(w.z); f[5] = bfhi(w.z); f[6] = bflo(w.w); f[7] = bfhi(w.w); }
__device__ __forceinline__ void merge_phase(const Args& a, int vcu, int G) {
    const bf16* GAB = (const bf16*)(a.ws + WS_GAB); const bf16* OB = (const bf16*)(a.ws + WS_QB); const bf16* G2B = (const bf16*)(a.ws + WS_G2B); const bf16* UB = (const bf16*)(a.ws + WS_UB);
    bf16* Hm = (bf16*)(a.ws + WS_H); const float* cw = a.in[16]; const float* st = a.in[5];
    const size_t total = (size_t)MT * 128, stride = (size_t)G * NTHREADS;
    for (size_t idx = (size_t)vcu * NTHREADS + threadIdx.x; idx < total; idx += stride) {
        const int row = (int)(idx >> 7), c8 = (int)(idx & 127) * 8;
        const bool prm = row < MP; const int rr = prm ? row : row - MP; const int t = prm ? (rr & 2047) : (rr & 63), bb = prm ? (rr >> 11) : (rr >> 6);
        const size_t off = (size_t)row * DM + c8;
        float ga[8], o[8], g2[8], u0[8], u1[8], u2[8];
        unpack8(*(const v4u*)(GAB + off), ga); unpack8(*(const v4u*)(OB + off), o); unpack8(*(const v4u*)(G2B + off), g2); unpack8(*(const v4u*)(UB + off), u2);
        if (t >= 1) unpack8(*(const v4u*)(UB + off - DM), u1);
        else { if (prm) { for (int e = 0; e < 8; ++e) u1[e] = 0.f; } else { const float* p = st + (size_t)(bb * 2 + 1) * 1024 + c8; for (int e = 0; e < 8; ++e) u1[e] = p[e]; } }
        if (t >= 2) unpack8(*(const v4u*)(UB + off - 2 * DM), u0);
        else { if (prm) { for (int e = 0; e < 8; ++e) u0[e] = 0.f; } else { const float* p = st + (size_t)(bb * 2 + t) * 1024 + c8; for (int e = 0; e < 8; ++e) u0[e] = p[e]; } }
        float r[8];
#pragma unroll
        for (int e = 0; e < 8; ++e) { const float cy = cw[c8 + e] * u0[e] + cw[1024 + c8 + e] * u1[e] + cw[2048 + c8 + e] * u2[e]; r[e] = ga[e] * o[e] + g2[e] * cy; }
        v4u w; w.x = pk2(r[0], r[1]); w.y = pk2(r[2], r[3]); w.z = pk2(r[4], r[5]); w.w = pk2(r[6], r[7]);
        *(v4u*)(Hm + off) = w;
    }
}

__device__ __forceinline__ void small_gemm_sample(const bf16* A, const bf16* Wt, int K, const float* base, float* outp, const float* gate, float coef, LAS unsigned char* ring, int vcu, int G) {
    int tid = threadIdx.x; asm volatile("" : "+v"(tid));
    const int lane = tid & 63, wid = tid >> 6, fr = lane & 15, fq = lane >> 4; const int KW = K >> 3;
    for (int item = vcu; item < 256; item += G) {
        const int rt = (item >> 4) * 64, ct = (item & 15) * 64;
        const bf16* ap = A + (size_t)(rt + fr) * K + wid * KW + 8 * fq; const bf16* bp = Wt + (size_t)(ct + fr) * K + wid * KW + 8 * fq;
        const int erow = rt + (tid >> 3), ec0 = ct + 8 * (tid & 7), emb = 8 + (erow >> 6);
        const f32x4 pga = *(const f32x4*)(gate + (size_t)emb * MODLD + ec0), pgb = *(const f32x4*)(gate + (size_t)emb * MODLD + ec0 + 4);
        const f32x4 pr0 = *(const f32x4*)(base + (size_t)erow * DM + ec0), pr1 = *(const f32x4*)(base + (size_t)erow * DM + ec0 + 4);
        f32x4 acc[4][4];
#pragma unroll
        for (int mi = 0; mi < 4; ++mi)
#pragma unroll
            for (int nj = 0; nj < 4; ++nj) acc[mi][nj] = (f32x4){0.f, 0.f, 0.f, 0.f};
#pragma unroll 2
        for (int k0 = 0; k0 < KW; k0 += 32) {
            bf16x8 a[4], b[4];
#pragma unroll
            for (int i = 0; i < 4; ++i) { a[i] = *(const bf16x8*)(ap + (size_t)(16 * i) * K + k0); b[i] = *(const bf16x8*)(bp + (size_t)(16 * i) * K + k0); }
#pragma unroll
            for (int mi = 0; mi < 4; ++mi)
#pragma unroll
                for (int nj = 0; nj < 4; ++nj) acc[mi][nj] = __builtin_amdgcn_mfma_f32_16x16x32_bf16(b[nj], a[mi], acc[mi][nj], 0, 0, 0);
        }
        LAS float* P = (LAS float*)(ring + wid * 16384);
#pragma unroll
        for (int mi = 0; mi < 4; ++mi)
#pragma unroll
            for (int nj = 0; nj < 4; ++nj) { const int row = mi * 16 + fr, grp = (nj * 4 + fq) ^ (row & 15); *(LAS f32x4*)(P + row * 64 + grp * 4) = acc[mi][nj]; }
        __syncthreads();
        { const int row = tid >> 3, j = tid & 7; const int g0 = (2 * j) ^ (row & 15), g1 = (2 * j + 1) ^ (row & 15);
          f32x4 s0 = (f32x4){0.f, 0.f, 0.f, 0.f}, s1 = s0;
#pragma unroll
          for (int w = 0; w < 8; ++w) { const LAS float* p = (const LAS float*)(ring + w * 16384) + row * 64; s0 += *(const LAS f32x4*)(p + g0 * 4); s1 += *(const LAS f32x4*)(p + g1 * 4); }
          const int grow = rt + row, c0 = ct + 8 * j; const int mb = 8 + (grow >> 6);
          const f32x4 ga = pga * coef, gb = pgb * coef; const f32x4 r0 = pr0, r1 = pr1; (void)mb;
          *(f32x4*)(outp + (size_t)grow * DM + c0) = r0 + ga * s0; *(f32x4*)(outp + (size_t)grow * DM + c0 + 4) = r1 + gb * s1; }
        __syncthreads();
    }
}
__device__ __forceinline__ void stage_fb(LAS float* fb, LAS float* wtot, const float* src0, int n0, const float* src1, int n1) {
    int tid = threadIdx.x; asm volatile("" : "+v"(tid)); const int lane = tid & 63, wid = tid >> 6; const int n = n0 + n1, e = 4 * tid;
    f32x4 v = (f32x4){0.f, 0.f, 0.f, 0.f};
    if (e < n) v = (e < n0) ? *(const f32x4*)(src0 + e) : *(const f32x4*)(src1 + (e - n0));
    const float s0 = v[0], s1 = s0 + v[1], s2 = s1 + v[2], s3 = s2 + v[3];
    float inc = s3;
#pragma unroll
    for (int o = 1; o < 64; o <<= 1) { const float t = __shfl_up(inc, o); if (lane >= o) inc += t; }
    if (lane == 63) wtot[wid] = inc;
    __syncthreads();
    float base = inc - s3;
#pragma unroll
    for (int w = 0; w < 8; ++w) { const float tw = wtot[w]; if (w < wid) base += tw; }
    const float c = -1.4426950408889634f;
    if (e < n) *(LAS f32x4*)(fb + e) = (f32x4){(base + s0) * c, (base + s1) * c, (base + s2) * c, (base + s3) * c};
    __syncthreads();
}
__device__ __forceinline__ void attn_sample_unit(int b, int h, const float* cK, const float* cV, const bf16* QB, const bf16* KB, const bf16* VB, const attn_body::MergeCtx& mc,
                                                 LAS unsigned char* ring, const LAS float* fb, LAS float* stats) {
    using attn_body::crow;
    int tid = threadIdx.x; asm volatile("" : "+v"(tid));
    const int lane = tid & 63, r32 = lane & 31, hi = lane >> 5; const int wid = __builtin_amdgcn_readfirstlane(tid >> 6);
    const size_t rowbase = (size_t)MP + (size_t)b * TS;
    LAS unsigned char* Ks = ring + wid * 16384; LAS unsigned char* Vs = Ks + 8192;
    LAS float* wsf = stats + 1024 + wid * 64;
    LAS unsigned char* QL = ring + (QL_OFF - RING_OFF);
    { const int row = tid >> 3, ch = tid & 7; *(LAS v4u*)(QL + row * 144 + ch * 16) = *(const v4u*)(QB + (rowbase + row) * DM + h * HD + ch * 8); }
    __syncthreads();
    float mhat[2], lsum[2] = {0.f, 0.f}; f32x16 o[2][2];
#pragma unroll
    for (int g = 0; g < 2; ++g) { mhat[g] = fb[PAST + 32 * g + r32]; o[g][0] = f32x16{}; o[g][1] = f32x16{}; }
    const int vb = (int)(unsigned)(uintptr_t)Vs + ((lane >> 4) & 1) * 32 + (lane & 3) * 8 + (4 * hi + ((lane & 15) >> 2)) * 64;
#pragma unroll 1
    for (int tl = wid; tl < 17; tl += 8) {
        if (tl < 16) {
            const f32x4* ksrc = (const f32x4*)(cK + ((size_t)(b * NH + h) * PAST + tl * 64) * HD); const f32x4* vsrc = (const f32x4*)(cV + ((size_t)(b * NH + h) * PAST + tl * 64) * HD);
#pragma unroll 1
            for (int hb = 0; hb < 16; hb += 8) {
                f32x4 kva[8], vva[8];
#pragma unroll
                for (int i = 0; i < 8; ++i) { kva[i] = __builtin_nontemporal_load(ksrc + (hb + i) * 64 + lane); vva[i] = __builtin_nontemporal_load(vsrc + (hb + i) * 64 + lane); }
#pragma unroll
                for (int i = 0; i < 8; ++i) { const int key = 4 * (hb + i) + (lane >> 4), d = (lane & 15) * 4; const f32x4 kv = kva[i], vv = vva[i];
                    v2u kw, vw; kw.x = pk2(kv.x, kv.y); kw.y = pk2(kv.z, kv.w); vw.x = pk2(vv.x, vv.y); vw.y = pk2(vv.z, vv.w);
                    *(LAS v2u*)(Ks + (d >> 3) * 1024 + key * 16 + (d & 7) * 2) = kw;
                    *(LAS v2u*)(Vs + ((d >> 5) * 4 + (key >> 4)) * 1024 + (key & 15) * 64 + (d & 31) * 2) = vw; }
            }
        } else {
#pragma unroll 1
            for (int hb = 0; hb < 8; hb += 4) {
                v4u kvb[4], vvb[4];
#pragma unroll
                for (int i = 0; i < 4; ++i) { const int key = 8 * (hb + i) + (lane >> 3), ch = lane & 7; const size_t off = (rowbase + key) * DM + h * HD + ch * 8; kvb[i] = *(const v4u*)(KB + off); vvb[i] = *(const v4u*)(VB + off); }
#pragma unroll
                for (int i = 0; i < 4; ++i) { const int key = 8 * (hb + i) + (lane >> 3), ch = lane & 7;
                    *(LAS v4u*)(Ks + ch * 1024 + key * 16) = kvb[i];
                    *(LAS v4u*)(Vs + ((ch >> 2) * 4 + (key >> 4)) * 1024 + (key & 15) * 64 + (ch & 3) * 16) = vvb[i]; }
            }
        }
        LDS_WAIT();
#pragma unroll
        for (int g = 0; g < 2; ++g) {
            __builtin_amdgcn_sched_barrier(0);
            f32x16 p0, p1;
            { const LAS float* fp = fb + 64 * tl + 4 * hi;
#pragma unroll
              for (int i = 0; i < 4; ++i) { const f32x4 x = *(const LAS f32x4*)(fp + 8 * i), y = *(const LAS f32x4*)(fp + 32 + 8 * i);
#pragma unroll
                  for (int e = 0; e < 4; ++e) { p0[4 * i + e] = x[e] - mhat[g]; p1[4 * i + e] = y[e] - mhat[g]; } } }
            { const LAS unsigned char* kb = Ks + hi * 1024 + r32 * 16;
#pragma unroll
              for (int d0 = 0; d0 < 4; ++d0) { const bf16x8 b0 = *(const LAS bf16x8*)(kb + d0 * 2048), b1 = *(const LAS bf16x8*)(kb + d0 * 2048 + 512);
                  const bf16x8 qf = *(const LAS bf16x8*)(QL + (32 * g + r32) * 144 + d0 * 32 + hi * 16);
                  p0 = __builtin_amdgcn_mfma_f32_32x32x16_bf16(b0, qf, p0, 0, 0, 0); p1 = __builtin_amdgcn_mfma_f32_32x32x16_bf16(b1, qf, p1, 0, 0, 0); } }
            if (tl == 16) { const int qi = 32 * g + r32;
#pragma unroll
                for (int r = 0; r < 16; ++r) { const int kj = crow(r, hi); if (kj > qi) p0[r] = -INFINITY; if (kj + 32 > qi) p1[r] = -INFINITY; } }
            float rm = p0[0];
#pragma unroll
            for (int r = 1; r < 16; ++r) rm = fmaxf(rm, p0[r]);
#pragma unroll
            for (int r = 0; r < 16; ++r) rm = fmaxf(rm, p1[r]);
            rm = fmaxf(rm, __shfl_xor(rm, 32));
            const float dl = fmaxf(rm, 0.f);
            mhat[g] += dl;
            const float f = __builtin_amdgcn_exp2f(-dl);
            float sacc = 0.f;
#pragma unroll
            for (int r = 0; r < 16; ++r) { p0[r] = __builtin_amdgcn_exp2f(p0[r] - dl); p1[r] = __builtin_amdgcn_exp2f(p1[r] - dl); sacc += p0[r] + p1[r]; }
            lsum[g] = lsum[g] * f + sacc;
            if (hi == 0) wsf[32 * g + r32] = f;
            LDS_WAIT();
#pragma unroll
            for (int r = 0; r < 16; ++r) { const float fr_ = wsf[32 * g + crow(r, hi)]; o[g][0][r] *= fr_; o[g][1][r] *= fr_; }
            v4u pw0, pw1, pw2, pw3;
#define PKW(P, B) attn_body::cvtpk_s(P[B], P[B + 1])
            pw0 = (v4u){PKW(p0, 0), PKW(p0, 2), PKW(p0, 4), PKW(p0, 6)}; pw1 = (v4u){PKW(p0, 8), PKW(p0, 10), PKW(p0, 12), PKW(p0, 14)};
            pw2 = (v4u){PKW(p1, 0), PKW(p1, 2), PKW(p1, 4), PKW(p1, 6)}; pw3 = (v4u){PKW(p1, 8), PKW(p1, 10), PKW(p1, 12), PKW(p1, 14)};
#undef PKW
            attn_body::pv(o[g], vb, __builtin_bit_cast(bf16x8, pw0), __builtin_bit_cast(bf16x8, pw1), __builtin_bit_cast(bf16x8, pw2), __builtin_bit_cast(bf16x8, pw3));
        }
        LDS_WAIT();
    }
#pragma unroll
    for (int g = 0; g < 2; ++g) { const float lt = lsum[g] + __shfl_xor(lsum[g], 32); if (hi == 0) { stats[wid * 64 + 32 * g + r32] = mhat[g]; stats[512 + wid * 64 + 32 * g + r32] = lt; } }
    __syncthreads();
    LAS float* Op = (LAS float*)(ring + wid * 16384);
#pragma unroll
    for (int g = 0; g < 2; ++g)
#pragma unroll
        for (int r = 0; r < 16; ++r) { const int q = 32 * g + crow(r, hi); float mx = stats[q];
#pragma unroll
            for (int w = 1; w < 8; ++w) mx = fmaxf(mx, stats[w * 64 + q]);
            const float scl = __builtin_amdgcn_exp2f(stats[wid * 64 + q] - mx);
            Op[q * 64 + r32] = o[g][0][r] * scl; Op[q * 64 + 32 + r32] = o[g][1][r] * scl; }
    __syncthreads();
    { const int q = tid >> 3, d0 = (tid & 7) * 8; float mx = stats[q];
#pragma unroll
      for (int w = 1; w < 8; ++w) mx = fmaxf(mx, stats[w * 64 + q]);
      float Lq = 0.f; f32x4 s0 = (f32x4){0.f, 0.f, 0.f, 0.f}, s1 = s0;
#pragma unroll
      for (int w = 0; w < 8; ++w) { Lq += stats[512 + w * 64 + q] * __builtin_amdgcn_exp2f(stats[w * 64 + q] - mx);
          const LAS float* p = (const LAS float*)(ring + w * 16384) + q * 64 + d0; s0 += *(const LAS f32x4*)p; s1 += *(const LAS f32x4*)(p + 4); }
      const float rl = 1.0f / Lq; s0 = s0 * rl; s1 = s1 * rl;
      v4u w; w.x = pk2(s0.x, s0.y); w.y = pk2(s0.z, s0.w); w.z = pk2(s1.x, s1.y); w.w = pk2(s1.z, s1.w);
      merge_store8(mc, rowbase + q, q, false, b, h * HD + d0, w); }
    __syncthreads();
}

__global__ void __launch_bounds__(NTHREADS, 2) fwd_mega(Args args) {
    extern __shared__ __attribute__((aligned(16))) unsigned char lds[];
    cg::grid_group grid = cg::this_grid();
    LAS unsigned char* L = (LAS unsigned char*)lds;
    const int G = gridDim.x; const int bx = blockIdx.x; const int vcu = (G % 8 == 0) ? (bx % 8) * (G / 8) + bx / 8 : bx;
    unsigned char* ws = args.ws; float* out = args.out; const float* mod = (const float*)(ws + WS_MOD);
    bf16* Hb = (bf16*)(ws + WS_H); bf16* ACT = (bf16*)(ws + WS_ACT);
    float* XR = out + O_Y;
    const int lo = args.ph_lo, hi = args.ph_hi;
#ifndef PH_MASK
#define PH_MASK 0x1fff
#endif
#define IN(k) (((PH_MASK >> (k)) & 1) && lo <= (k) && (k) < hi)
#define SEAM(k) do { if (IN(k) && IN((k) + 1)) xcd_barrier(bar); } while (0)

    unsigned* barw = (unsigned*)(ws + WS_BAR);
    volatile LAS unsigned* bst = (volatile LAS unsigned*)(L + STAT_OFF + 8000);
    unsigned* cntw = (unsigned*)(ws + WS_CNT);
    if (bx == 0) { for (int i = threadIdx.x; i < XCD_BAR_WORDS; i += NTHREADS) __hip_atomic_store(barw + i, 0u, __ATOMIC_RELAXED, __HIP_MEMORY_SCOPE_AGENT);
                   for (int i = threadIdx.x; i < CNT_WORDS; i += NTHREADS) __hip_atomic_store(cntw + i, 0u, __ATOMIC_RELAXED, __HIP_MEMORY_SCOPE_AGENT); }
    const bool fuse_rows = (G == 256);
    const int wv = threadIdx.x >> 6, ln = threadIdx.x & 63;
    bf16* Hb2 = (bf16*)(ws + WS_GAB);
#define HANDOFF(inst, S) pg8::Unit hu; S.next(0, hu); const int rt_ = vcu >> 4, ct_ = vcu & 15; \
        panel_handoff(cntw + ((inst) * 80 + hu.pm) * 16, cntw + ((inst) * 80 + 64 + rt_) * 16)
    if (IN(0)) { p0_mod(args, L, vcu, G); p0_weights(args, L, vcu, G); }
    if (threadIdx.x < 2) bst[threadIdx.x] = 0u;
    grid.sync();
    const XcdBarrier bar = xcd_barrier_post(barw, bst);
    if (IN(1)) norm_mod_rows(args.in[0], args.in[1], args.in[10], mod, 0 * DM, 1 * DM, Hb, vcu, G);
    SEAM(1);
    if (IN(2)) { pg8::Gemm g{Hb, (const bf16*)(ws + WS_W1IN), MT, 2 * DFF, DM}; pg8::StaticOrder S; S.init(MT, 2 * DFF, G, bx);
        pg8::EpiSwiGLU E{ACT, DFF}; pg8::gemm_phase<pg8::EpiSwiGLU, pg8::StaticOrder, PG8_ALIGN, PG8_SP2>(L + RING_OFF, g, S, E);
        constexpr int NF = (68 * 22) % 256;
        if (G == 256 && bx >= NF) weight_items_tail(args, L, WCUT0, WCUT1, (bx - NF) * NWAVES + (int)(threadIdx.x >> 6), (256 - NF) * NWAVES); }
    SEAM(2);
    if (IN(3)) { pg8::Gemm g{ACT, (const bf16*)(ws + WS_W1OUT), MP, DM, DFF}; pg8::StaticOrder S; S.init(MP, DM, G, bx);
        pg8::EpiResid<true> E{args.in[0], args.in[1], XR, mod + 2 * DM, 0.5f}; pg8::gemm_phase<pg8::EpiResid<true>, pg8::StaticOrder, false, PG8_SP2>(L + RING_OFF, g, S, E);
        small_gemm_sample(ACT + (size_t)MP * DFF, (const bf16*)(ws + WS_W1OUT), DFF, args.in[1], XR + (size_t)MP * DM, mod + 2 * DM, 0.5f, L + RING_OFF, vcu, G);
        if (fuse_rows) { HANDOFF(0, S);
            norm_rows4<false, false, 8>(hu.pm * 256 + hu.pn * 64 + wv * 8, XR, XR + (size_t)MP * DM, args.in[13], mod, 3 * DM, 4 * DM, Hb, nullptr, ln);
            if (wv == 0) norm_rows4<false>(MP + rt_ * 64 + ct_ * 4, XR, XR + (size_t)MP * DM, args.in[13], mod, 3 * DM, 4 * DM, Hb, nullptr, ln); } }
    if (!fuse_rows) { SEAM(3); if (IN(4)) norm_mod_rows(XR, XR + (size_t)MP * DM, args.in[13], mod, 3 * DM, 4 * DM, Hb, vcu, G); }
    SEAM(4);
    if (IN(5)) { pg8::Gemm g{Hb, (const bf16*)(ws + WS_WIN), MT, NINP, DM}; pg8::StaticOrder S; S.init(MT, NINP, G, bx);
        pg8::EpiMix E{(bf16*)(ws + WS_QB), out, args.in[15], attn_body::C2};
        pg8::gemm_phase<pg8::EpiMix, pg8::StaticOrder, PG8_ALIGN, PG8_SP2>(L + RING_OFF, g, S, E);
        constexpr int NF = (68 * 33) % 256;
        if (G == 256 && bx >= NF) weight_items_tail(args, L, WCUT1, WITEMS, (bx - NF) * NWAVES + (int)(threadIdx.x >> 6), (256 - NF) * NWAVES); }
    SEAM(5);
    if (IN(6)) {
        const attn_body::bf16* Q = (const attn_body::bf16*)(ws + WS_QB); const attn_body::bf16* K = (const attn_body::bf16*)(ws + WS_KB); const attn_body::bf16* V = (const attn_body::bf16*)(ws + WS_VB);
        LAS float* fb = (LAS float*)(L + FB_OFF); LAS float* stats = (LAS float*)(L + STAT_OFF);
        const attn_body::MergeCtx mc{(const bf16*)(ws + WS_GAB), (const bf16*)(ws + WS_G2B), (const bf16*)(ws + WS_UB), args.in[16], args.in[5], Hb};
#pragma unroll 1
        for (int pass = 0; pass < 2; ++pass) {
        const bool do_sample = ((vcu & 1) != 0) == (pass == 0);
        if (!do_sample) {
        for (int it = vcu; it < 512; it += G) {
            const int bh = it >> 2, k = it & 3;
            stage_fb(fb, stats, out + O_LFP + (size_t)bh * TP, TP, nullptr, 0);
#pragma unroll 1
            for (int j = 0; j < 2; ++j) attn_body::attn_unit<8>(bh >> 4, bh & 15, j ? k : 7 - k, Q, K, V, mc, (char*)lds + RING_OFF, fb);
        }
        } else {
        for (int it = vcu; it < 256; it += G) {
            const int b = it >> 4, h = it & 15;
            stage_fb(fb, stats, args.in[4] + (size_t)it * PAST, PAST, out + O_LFS + (size_t)it * TS, TS);
            attn_sample_unit(b, h, args.in[2], args.in[3], (const bf16*)(ws + WS_QB), (const bf16*)(ws + WS_KB), (const bf16*)(ws + WS_VB), mc, L + RING_OFF, fb, stats);
        }
        }
        }
    }
    SEAM(6);
    if (IN(8)) { pg8::Gemm g{Hb, (const bf16*)(ws + WS_WOUT), MP, DM, DM}; pg8::StaticOrder S; S.init(MP, DM, G, bx);
        pg8::EpiResid<false> E{XR, XR + (size_t)MP * DM, XR, mod + 5 * DM, 1.0f}; pg8::gemm_phase<pg8::EpiResid<false>, pg8::StaticOrder, false, PG8_SP2>(L + RING_OFF, g, S, E);
        small_gemm_sample(Hb + (size_t)MP * DM, (const bf16*)(ws + WS_WOUT), DM, XR + (size_t)MP * DM, XR + (size_t)MP * DM, mod + 5 * DM, 1.0f, L + RING_OFF, vcu, G);
        if (fuse_rows) { HANDOFF(1, S);
            norm_rows4<false, false, 8>(hu.pm * 256 + hu.pn * 64 + wv * 8, XR, XR + (size_t)MP * DM, args.in[18], mod, 6 * DM, 7 * DM, Hb2, nullptr, ln);
            if (wv == 0) norm_rows4<false>(MP + rt_ * 64 + ct_ * 4, XR, XR + (size_t)MP * DM, args.in[18], mod, 6 * DM, 7 * DM, Hb2, nullptr, ln); } }
    if (!fuse_rows) { SEAM(8); if (IN(9)) norm_mod_rows(XR, XR + (size_t)MP * DM, args.in[18], mod, 6 * DM, 7 * DM, Hb2, vcu, G); }
    SEAM(9);
    if (IN(10)) { pg8::Gemm g{Hb2, (const bf16*)(ws + WS_W2IN), MT, 2 * DFF, DM}; pg8::StaticOrder S; S.init(MT, 2 * DFF, G, bx);
        pg8::EpiSwiGLU E{ACT, DFF}; pg8::gemm_phase<pg8::EpiSwiGLU, pg8::StaticOrder, PG8_ALIGN, PG8_SP2>(L + RING_OFF, g, S, E); }
    SEAM(10);
    if (IN(11)) { pg8::Gemm g{ACT, (const bf16*)(ws + WS_W2OUT), MP, DM, DFF}; pg8::StaticOrder S; S.init(MP, DM, G, bx);
        pg8::EpiResid<false> E{XR, XR + (size_t)MP * DM, XR, mod + 8 * DM, 0.5f}; pg8::gemm_phase<pg8::EpiResid<false>, pg8::StaticOrder, false, PG8_SP2>(L + RING_OFF, g, S, E);
        small_gemm_sample(ACT + (size_t)MP * DFF, (const bf16*)(ws + WS_W2OUT), DFF, XR + (size_t)MP * DM, XR + (size_t)MP * DM, mod + 8 * DM, 0.5f, L + RING_OFF, vcu, G);
        if (fuse_rows) { HANDOFF(2, S);
            norm_rows4<true, false, 8>(hu.pm * 256 + hu.pn * 64 + wv * 8, XR, XR + (size_t)MP * DM, args.in[21], nullptr, 0, 0, nullptr, XR, ln);
            if (wv == 0) norm_rows4<true>(MP + rt_ * 64 + ct_ * 4, XR, XR + (size_t)MP * DM, args.in[21], nullptr, 0, 0, nullptr, XR, ln); } }
    if (!fuse_rows) { SEAM(11); if (IN(12)) final_norm_rows(XR, args.in[21], vcu, G); }
#undef IN
#undef SEAM
}

#ifndef MK_N_LAUNCHES
#define MK_N_LAUNCHES 1
#endif
constexpr int N_PHASES = 13;
extern "C" void kernel_launch(void* const* d_in, const int* in_sizes, int n_in, void* d_out, int out_size, void* d_ws, size_t ws_size, hipStream_t stream) {
    static int grid = 0;
    if (grid == 0) {
        if (n_in != 22 || out_size != (int)O_END || ws_size < WS_END) { fprintf(stderr, "kernel_launch: unexpected sizes n_in %d out %d ws %zu; nothing launched\n", n_in, out_size, ws_size); grid = -1; return; }
        int dev = 0, cus = 0, per_cu = 0;
        if (hipGetDevice(&dev) != hipSuccess || hipDeviceGetAttribute(&cus, hipDeviceAttributeMultiprocessorCount, dev) != hipSuccess) { grid = -1; return; }
        if (hipFuncSetAttribute((const void*)fwd_mega, hipFuncAttributeMaxDynamicSharedMemorySize, LDS_BYTES) != hipSuccess) { fprintf(stderr, "kernel_launch: hipFuncSetAttribute failed\n"); grid = -1; return; }
        if (hipOccupancyMaxActiveBlocksPerMultiprocessor(&per_cu, (const void*)fwd_mega, NTHREADS, LDS_BYTES) != hipSuccess || per_cu < 1) { fprintf(stderr, "kernel_launch: occupancy query says %d\n", per_cu); (void)hipGetLastError(); grid = -1; return; }
        grid = cus * 1;
        fprintf(stderr, "kernel_launch: grid %d (cus %d, per_cu %d), ws %zu\n", grid, cus, per_cu, ws_size);
    }
    if (grid < 0) return;
    Args a{};
    for (int i = 0; i < 22; ++i) a.in[i] = (const float*)d_in[i];
    a.out = (float*)d_out; a.ws = (unsigned char*)d_ws;
#if MK_N_LAUNCHES == 1
    a.ph_lo = 0; a.ph_hi = N_PHASES;
    void* kargs[] = {&a};
    hipError_t e = hipLaunchCooperativeKernel((const void*)fwd_mega, dim3(grid), dim3(NTHREADS), kargs, LDS_BYTES, stream);
    if (e != hipSuccess) fprintf(stderr, "kernel_launch: cooperative launch failed: %s (grid %d)\n", hipGetErrorString(e), grid);
#else
    for (int p = 0; p < N_PHASES; ++p) { a.ph_lo = p; a.ph_hi = p + 1; void* kargs[] = {&a};
        hipError_t e = hipLaunchCooperativeKernel((const void*)fwd_mega, dim3(grid), dim3(NTHREADS), kargs, LDS_BYTES, stream);
        if (e != hipSuccess) { fprintf(stderr, "kernel_launch: launch %d failed: %s\n", p, hipGetErrorString(e)); break; } }
#endif
}
```

```cpp
#include <hip/hip_runtime.h>
#include <hip/hip_cooperative_groups.h>
#include <cstdio>
#include <cstdint>
constexpr int MODLD = 9216;
constexpr int DM = 1024, MP = 16384, MS = 1024, MT = MP + MS, TP = 2048, TS = 64, PAST = 1024, NH = 16, HD = 64, DFF = 2816, NIN = 8208, NINP = 8448, NMOD = 9;
constexpr int OFF_Q = 0, OFF_K = 1024, OFF_V = 2048, OFF_F = 3072, OFF_B = 3088, OFF_C = 4112, OFF_X = 5136, OFF_GA = 6160, OFF_GC = 7184;
constexpr float EPS = 1e-6f;
constexpr size_t O_Y = 0, O_KP = (size_t)MT * DM, O_VP = O_KP + (size_t)MP * DM, O_LFP = O_VP + (size_t)MP * DM, O_CVP = O_LFP + 8 * 16 * 2048, O_KS = O_CVP + 8 * 2 * 1024,
                 O_VS = O_KS + (size_t)MS * DM, O_LFS = O_VS + (size_t)MS * DM, O_CVS = O_LFS + 16 * 16 * 64, O_END = O_CVS + 16 * 2 * 1024;
static_assert(O_END == 53805056, "d_out map");
namespace pg8 {
#define PG8_LAS __attribute__((address_space(3)))
typedef unsigned short bf16_t;
typedef short bf16x8 __attribute__((ext_vector_type(8)));
typedef float f32x4 __attribute__((ext_vector_type(4)));
typedef unsigned u32x4 __attribute__((ext_vector_type(4)));
constexpr int BM = 256, BK = 64, HALF = 128, HTB = HALF * BK * 2  , STAGE_BYTES = 8 * HTB, NXCD = 8, WGM = 8;

__host__ __device__ __forceinline__ int lds_byte(int r, int c) { const int st = (r >> 4) * 2 + (c >> 5), rr = r & 15, cc = c & 31, ob = rr * 64 + cc * 2; return st * 1024 + (ob ^ (((ob >> 9) & 1) << 5)); }
__host__ __device__ __forceinline__ void stage_rc(int b, int& R, int& C) { const int st = b / 1024, sb = b % 1024, swz = sb ^ (((sb >> 9) & 1) << 5); R = (st >> 1) * 16 + swz / 64; C = (st & 1) * 32 + (swz % 64) / 2; }
__host__ __device__ __forceinline__ int perm32(int rho) { const int n = rho >> 4, i = rho & 15; return 8 * (i >> 2) + 4 * n + (i & 3); }

struct Unit { int pm, pn; };
struct Gemm { const bf16_t* A; const bf16_t* Bt; int M, N, K; };

struct StaticOrder {
    int nM, nN, nwg, G, c;
    __host__ __device__ void init(int M, int N, int G_, int c_) { nM = M / BM; nN = N / BM; nwg = nM * nN; G = G_; c = c_; }
    __host__ __device__ bool next(int i, Unit& u) const {
        const long L = (long)i * G + c; if (L >= nwg) return false;
        int wgid = (int)L; { const int q = nwg / NXCD, r = nwg % NXCD, xcd = wgid % NXCD, off = wgid / NXCD; wgid = (xcd < r ? xcd * (q + 1) : r * (q + 1) + (xcd - r) * q) + off; }
        const int nig = WGM * nN, gid = wgid / nig, fm = gid * WGM, gsz = (nM - fm) < WGM ? (nM - fm) : WGM;
        u.pm = fm + ((wgid % nig) % gsz); u.pn = (wgid % nig) / gsz; return true;
    }
    __device__ __forceinline__ void a_ready(const Unit&) const {}
    __device__ __forceinline__ void done(const Unit&) const {}
};

__device__ __forceinline__ unsigned cvt_pk_bf16(float lo, float hi) { unsigned r; asm volatile("v_cvt_pk_bf16_f32 %0, %1, %2" : "=v"(r) : "v"(lo), "v"(hi)); return r; }

constexpr int MPROMPT = 16384;
__device__ __forceinline__ int mod_batch(int pm, int ai, int wr) { return pm < 64 ? (pm >> 3) : 8 + (pm - 64) * 4 + 2 * ai + wr; }
__device__ __forceinline__ float sigmoid_f(float x) { return __builtin_amdgcn_rcpf(1.0f + __builtin_amdgcn_exp2f(-1.4426950408889634f * x)); }
__device__ __forceinline__ f32x4 sigmoid4(f32x4 x) { return (f32x4){sigmoid_f(x[0]), sigmoid_f(x[1]), sigmoid_f(x[2]), sigmoid_f(x[3])}; }
__device__ __forceinline__ u32x4 pack8(f32x4 v0, f32x4 v1) { u32x4 w; w.x = cvt_pk_bf16(v0[0], v0[1]); w.y = cvt_pk_bf16(v0[2], v0[3]); w.z = cvt_pk_bf16(v1[0], v1[1]); w.w = cvt_pk_bf16(v1[2], v1[3]); return w; }

struct EpiSwiGLU {
    static constexpr bool PERM = true, AFTER_DRAIN = false;
    bf16_t* O; int ldc;
    __device__ __forceinline__ void operator()(const f32x4 (&acc)[2][2][4][2], const Unit& u, int wr, int wc, int fr, int fq) const {
        const int row0 = u.pm * BM + wr * 64 + fr, col0 = u.pn * HALF + wc * 32 + 8 * fq;
#pragma unroll
        for (int ai = 0; ai < 2; ++ai)
#pragma unroll
            for (int m = 0; m < 4; ++m) {
                const f32x4 a0 = acc[ai][0][m][0], a1 = acc[ai][0][m][1];
                const f32x4 v0 = a0 * sigmoid4(a0) * acc[ai][1][m][0], v1 = a1 * sigmoid4(a1) * acc[ai][1][m][1];
                *(u32x4*)(O + (size_t)(row0 + ai * HALF + m * 16) * ldc + col0) = pack8(v0, v1);
            }
    }
};
template <bool NTB> struct EpiResid {
    static constexpr bool PERM = true, AFTER_DRAIN = false;
    const float* baseP; const float* baseS; float* out; const float* gate; float coef;
    __device__ __forceinline__ void operator()(const f32x4 (&acc)[2][2][4][2], const Unit& u, int wr, int wc, int fr, int fq) const {
        const int col0 = u.pn * BM + wc * 32 + 8 * fq;
#pragma unroll
        for (int ai = 0; ai < 2; ++ai) {
            const float* gp = gate + (size_t)mod_batch(u.pm, ai, wr) * MODLD + col0;
            f32x4 g[2][2];
#pragma unroll
            for (int bj = 0; bj < 2; ++bj)
#pragma unroll
                for (int n = 0; n < 2; ++n) g[bj][n] = *(const f32x4*)(gp + bj * HALF + 4 * n) * coef;
            f32x4 bsv[4][2][2];
#pragma unroll
            for (int m = 0; m < 4; ++m) {
                const int row = u.pm * BM + ai * HALF + wr * 64 + m * 16 + fr;
                const float* bp = (u.pm < 64 ? baseP + (size_t)row * 1024 : baseS + (size_t)(row - MPROMPT) * 1024) + col0;
#pragma unroll
                for (int bj = 0; bj < 2; ++bj)
#pragma unroll
                    for (int n = 0; n < 2; ++n) { const f32x4* p = (const f32x4*)(bp + bj * HALF + 4 * n); bsv[m][bj][n] = NTB ? __builtin_nontemporal_load(p) : *p; }
            }
            asm volatile("" ::: "memory");
#pragma unroll
            for (int m = 0; m < 4; ++m) {
                const int row = u.pm * BM + ai * HALF + wr * 64 + m * 16 + fr;
                float* op = out + (size_t)row * 1024 + col0;
#pragma unroll
                for (int bj = 0; bj < 2; ++bj)
#pragma unroll
                    for (int n = 0; n < 2; ++n) *(f32x4*)(op + bj * HALF + 4 * n) = bsv[m][bj][n] + g[bj][n] * acc[ai][bj][m][n];
            }
        }
    }
};
struct EpiMix {
    static constexpr bool PERM = true, AFTER_DRAIN = false;
    bf16_t* QB; float* outp; const float* b_f; float qscale;
    static constexpr size_t BSTRIDE = (size_t)MT * DM;
    __device__ __forceinline__ void operator()(const f32x4 (&acc)[2][2][4][2], const Unit& u, int wr, int wc, int fr, int fq) const {
        const int pn = u.pn; const bool prm = u.pm < 64;
        const int row0 = u.pm * BM + wr * 64 + fr;
        if (pn < 16) {
            const int seg = pn >> 2, colt = (pn & 3) * BM + wc * 32 + 8 * fq;
            bf16_t* dst = QB + (size_t)seg * BSTRIDE;
            const float sc = seg == 0 ? qscale : 1.f;
            float* fo = outp + (seg == 1 ? (prm ? O_KP : O_KS) : (prm ? O_VP : O_VS));
#pragma unroll
            for (int ai = 0; ai < 2; ++ai)
#pragma unroll
                for (int m = 0; m < 4; ++m) {
                    const int row = row0 + ai * HALF + m * 16;
                    const int rr = prm ? row : row - MPROMPT; const int bb = prm ? (rr >> 11) : (rr >> 6), tt = prm ? (rr & 2047) : (rr & 63), TT = prm ? 2048 : 64;
#pragma unroll
                    for (int bj = 0; bj < 2; ++bj) {
                        f32x4 v0 = acc[ai][bj][m][0], v1 = acc[ai][bj][m][1]; const int col = colt + bj * HALF;
                        if (seg == 1 || seg == 2) { float* p = fo + ((size_t)(bb * 16 + (col >> 6)) * TT + tt) * 64 + (col & 63); __builtin_nontemporal_store(v0, (f32x4*)p); __builtin_nontemporal_store(v1, (f32x4*)(p + 4)); }
                        if (seg == 3) { v0 = sigmoid4(v0); v1 = sigmoid4(v1); }
                        v0 = v0 * sc; v1 = v1 * sc;
                        *(u32x4*)(dst + (size_t)row * 1024 + col) = pack8(v0, v1);
                    }
                }
        } else if (pn < 32) {
            const bool cx = pn >= 24; const int col = ((pn - 16) & 7) * HALF + wc * 32 + 8 * fq;
            bf16_t* dst = QB + (size_t)(cx ? 5 : 4) * BSTRIDE;
#pragma unroll
            for (int ai = 0; ai < 2; ++ai)
#pragma unroll
                for (int m = 0; m < 4; ++m) {
                    const int row = row0 + ai * HALF + m * 16;
                    f32x4 v0, v1;
                    if (cx) { v0 = acc[ai][0][m][0] * acc[ai][1][m][0]; v1 = acc[ai][0][m][1] * acc[ai][1][m][1]; }
                    else { v0 = acc[ai][0][m][0] * sigmoid4(acc[ai][1][m][0]); v1 = acc[ai][0][m][1] * sigmoid4(acc[ai][1][m][1]); }
                    *(u32x4*)(dst + (size_t)row * 1024 + col) = pack8(v0, v1);
                    if (cx) {
                        const int rr = prm ? row : row - MPROMPT; const int bb = prm ? (rr >> 11) : (rr >> 6), tt = prm ? (rr & 2047) : (rr & 63), TT = prm ? 2048 : 64;
                        if (tt >= TT - 2) { float* p = outp + (prm ? O_CVP : O_CVS) + (size_t)(bb * 2 + (tt - (TT - 2))) * 1024 + col; *(f32x4*)p = v0; *(f32x4*)(p + 4) = v1; }
                    }
                }
        } else {
            if (wc == 0 && fq < 2) {
                const f32x4 bf0 = *(const f32x4*)(b_f + 8 * fq), bf1 = *(const f32x4*)(b_f + 8 * fq + 4);
                asm volatile("" ::: "memory");
#pragma unroll
                for (int ai = 0; ai < 2; ++ai)
#pragma unroll
                    for (int m = 0; m < 4; ++m) {
                        const int row = row0 + ai * HALF + m * 16;
                        const int rr = prm ? row : row - MPROMPT; const int bb = prm ? (rr >> 11) : (rr >> 6), tt = prm ? (rr & 2047) : (rr & 63), TT = prm ? 2048 : 64;
                        float* fo = outp + (prm ? O_LFP : O_LFS);
#pragma unroll
                        for (int n = 0; n < 2; ++n)
#pragma unroll
                            for (int e = 0; e < 4; ++e) {
                                const int hh = 8 * fq + 4 * n + e; const float v = acc[ai][0][m][n][e] + (n ? bf1[e] : bf0[e]);
                                const float ls = fminf(v, 0.f) - __logf(1.0f + __expf(-fabsf(v)));
                                fo[(size_t)(bb * 16 + hh) * TT + tt] = ls;
                            }
                    }
            }
        }
    }
};
template <class Epi, class Sched, bool ALIGN_EPI = false, bool SP2 = false>
__device__ __forceinline__ void gemm_phase(PG8_LAS unsigned char* lds, const Gemm g, const Sched& S, const Epi& E) {
    const int tid = threadIdx.x, wid = __builtin_amdgcn_readfirstlane(tid >> 6), lane = tid & 63, wr = wid >> 2, wc = wid & 3, fr = lane & 15, fq = lane >> 4;
    const int K = g.K, nt = K / BK;
    unsigned voffA[2], voffB[2];
#pragma unroll
    for (int i = 0; i < 2; ++i) { int R, C; stage_rc(tid * 16 + i * 8192, R, C); const int Rb = Epi::PERM ? ((R & ~31) + perm32(R & 31)) : R;
        voffA[i] = (unsigned)(R * K + C) * 2u; voffB[i] = (unsigned)(Rb * K + C) * 2u; }
    const size_t kstep = (size_t)(BK * 2);
    const size_t hstep = (size_t)HALF * K * 2;
    const size_t tstep = 2 * hstep;
    const unsigned ldsw = (unsigned)wid * 1024u;
    const int aoff = lds_byte(wr * 64 + fr, fq * 8), boff = lds_byte(wc * 32 + fr, fq * 8);
#define PG8_SA(b, h) (((b) * 2 + (h)) * HTB)
#define PG8_SB(b, h) ((4 + (b) * 2 + (h)) * HTB)
#define PG8_STAGE(bufoff, gbase, voff) do { _Pragma("unroll") for (int _i = 0; _i < 2; ++_i) \
        __builtin_amdgcn_global_load_lds((const unsigned*)((const char*)(gbase) + (voff)[_i]), (PG8_LAS unsigned*)(lds + (bufoff) + ldsw + _i * 8192), 16, 0, 0); } while (0)
#define PG8_LDA(dst, b, h) do { _Pragma("unroll") for (int m = 0; m < 4; ++m) _Pragma("unroll") for (int k = 0; k < 2; ++k) dst[m][k] = *(const PG8_LAS bf16x8*)(lds + PG8_SA(b, h) + aoff + m * 2048 + k * 1024); } while (0)
#define PG8_LDB(dst, b, h) do { _Pragma("unroll") for (int n = 0; n < 2; ++n) _Pragma("unroll") for (int k = 0; k < 2; ++k) dst[n][k] = *(const PG8_LAS bf16x8*)(lds + PG8_SB(b, h) + boff + n * 2048 + k * 1024); } while (0)
#define PG8_MMA(ai, bj, At, Bt) do { __builtin_amdgcn_s_setprio(1); _Pragma("unroll") for (int m = 0; m < 4; ++m) _Pragma("unroll") for (int n = 0; n < 2; ++n) _Pragma("unroll") for (int k = 0; k < 2; ++k) \
        acc[ai][bj][m][n] = __builtin_amdgcn_mfma_f32_16x16x32_bf16(Bt[n][k], At[m][k], acc[ai][bj][m][n], 0, 0, 0); __builtin_amdgcn_s_setprio(0); } while (0)
#define PG8_WAIT_V(n) asm volatile("s_waitcnt vmcnt(" #n ")" ::: "memory")
#define PG8_WAIT_L(n) asm volatile("s_waitcnt lgkmcnt(" #n ")" ::: "memory")
#define PG8_BAR __builtin_amdgcn_s_barrier()
#define PG8_SCHED __builtin_amdgcn_sched_barrier(0)
    Unit cur, nxt; int ui = 0;
    if (!S.next(0, cur)) return;
    f32x4 acc[2][2][4][2];
#pragma unroll
    for (int a = 0; a < 2; ++a)
#pragma unroll
        for (int b = 0; b < 2; ++b)
#pragma unroll
            for (int m = 0; m < 4; ++m)
#pragma unroll
                for (int n = 0; n < 2; ++n) acc[a][b][m][n] = (f32x4){0.f, 0.f, 0.f, 0.f};
    bf16x8 At[4][2], B0[2][2], B1[2][2];
    const char* cA = (const char*)g.A + (size_t)cur.pm * tstep; const char* cB = (const char*)g.Bt + (size_t)cur.pn * tstep;
    S.a_ready(cur);
    if constexpr (SP2) {
        PG8_STAGE(PG8_SB(0, 0), cB, voffB); PG8_STAGE(PG8_SB(0, 1), cB + hstep, voffB); PG8_STAGE(PG8_SA(0, 0), cA, voffA); PG8_STAGE(PG8_SA(0, 1), cA + hstep, voffA);
        if (wr == 1) PG8_BAR;
        PG8_WAIT_V(2); PG8_BAR;
        PG8_STAGE(PG8_SB(1, 0), cB + kstep, voffB); PG8_STAGE(PG8_SA(1, 0), cA + kstep, voffA); PG8_STAGE(PG8_SB(1, 1), cB + hstep + kstep, voffB);
        PG8_WAIT_V(6); PG8_BAR;
    } else {
        PG8_STAGE(PG8_SB(0, 0), cB, voffB); PG8_STAGE(PG8_SA(0, 0), cA, voffA); PG8_STAGE(PG8_SB(0, 1), cB + hstep, voffB); PG8_STAGE(PG8_SA(0, 1), cA + hstep, voffA);
        if (wr == 1) PG8_BAR;
        PG8_WAIT_V(4); PG8_BAR;
        PG8_STAGE(PG8_SB(1, 0), cB + kstep, voffB); PG8_STAGE(PG8_SA(1, 0), cA + kstep, voffA); PG8_STAGE(PG8_SB(1, 1), cB + hstep + kstep, voffB);
        PG8_WAIT_V(6); PG8_BAR;
    }
    for (;;) {
        const bool has_next = S.next(ui + 1, nxt);
        const char* nA = has_next ? (const char*)g.A + (size_t)nxt.pm * tstep : cA; const char* nB = has_next ? (const char*)g.Bt + (size_t)nxt.pn * tstep : cB;
        for (int t = 0; t < nt; t += 2) {
            const bool last = (t == nt - 2);
            const char* a1 = cA + (size_t)(t + 1) * kstep;
            const char* a2 = last ? nA : cA + (size_t)(t + 2) * kstep; const char* b2 = last ? nB : cB + (size_t)(t + 2) * kstep;
            const char* a3 = a2 + kstep; const char* b3 = b2 + kstep;
            if (last && has_next) S.a_ready(nxt);
            if constexpr (SP2) {
            PG8_LDB(B0, 0, 0); PG8_LDB(B1, 0, 1); PG8_SCHED; PG8_LDA(At, 0, 0); PG8_STAGE(PG8_SA(1, 1), a1 + hstep, voffA);
            PG8_WAIT_V(8); PG8_WAIT_L(0); PG8_BAR; PG8_MMA(0, 0, At, B0); PG8_MMA(0, 1, At, B1); PG8_BAR; PG8_SCHED;
            PG8_LDA(At, 0, 1); PG8_STAGE(PG8_SB(0, 0), b2, voffB); PG8_STAGE(PG8_SB(0, 1), b2 + hstep, voffB); PG8_STAGE(PG8_SA(0, 0), a2, voffA);
            PG8_WAIT_V(8); PG8_WAIT_L(0); PG8_BAR; PG8_MMA(1, 0, At, B0); PG8_MMA(1, 1, At, B1); PG8_BAR; PG8_SCHED;
            PG8_LDB(B0, 1, 0); PG8_LDB(B1, 1, 1); PG8_SCHED; PG8_LDA(At, 1, 0); PG8_STAGE(PG8_SA(0, 1), a2 + hstep, voffA);
            PG8_WAIT_V(8); PG8_WAIT_L(0); PG8_BAR; PG8_MMA(0, 0, At, B0); PG8_MMA(0, 1, At, B1); PG8_BAR; PG8_SCHED;
            PG8_LDA(At, 1, 1); PG8_STAGE(PG8_SB(1, 0), b3, voffB); PG8_STAGE(PG8_SB(1, 1), b3 + hstep, voffB); PG8_STAGE(PG8_SA(1, 0), a3, voffA);
            PG8_WAIT_V(8); PG8_WAIT_L(0); PG8_BAR; PG8_MMA(1, 0, At, B0); PG8_MMA(1, 1, At, B1); PG8_BAR; PG8_SCHED;
            } else {
            PG8_LDB(B0, 0, 0); PG8_SCHED; PG8_LDA(At, 0, 0); PG8_STAGE(PG8_SA(1, 1), a1 + hstep, voffA);
            PG8_WAIT_L(8); PG8_BAR; PG8_WAIT_L(0); PG8_MMA(0, 0, At, B0); PG8_BAR; PG8_SCHED;
            PG8_LDB(B1, 0, 1); PG8_STAGE(PG8_SB(0, 0), b2, voffB);
            PG8_BAR; PG8_WAIT_L(0); PG8_MMA(0, 1, At, B1); PG8_BAR;
            PG8_LDA(At, 0, 1); PG8_STAGE(PG8_SA(0, 0), a2, voffA);
            PG8_BAR; PG8_WAIT_L(0); PG8_MMA(1, 0, At, B0); PG8_BAR; PG8_SCHED;
            PG8_STAGE(PG8_SB(0, 1), b2 + hstep, voffB);
            PG8_WAIT_V(6); PG8_BAR; PG8_MMA(1, 1, At, B1); PG8_BAR;
            PG8_LDB(B0, 1, 0); PG8_SCHED; PG8_LDA(At, 1, 0); PG8_STAGE(PG8_SA(0, 1), a2 + hstep, voffA);
            PG8_WAIT_L(8); PG8_BAR; PG8_WAIT_L(0); PG8_MMA(0, 0, At, B0); PG8_BAR; PG8_SCHED;
            PG8_LDB(B1, 1, 1); PG8_STAGE(PG8_SB(1, 0), b3, voffB);
            PG8_BAR; PG8_WAIT_L(0); PG8_MMA(0, 1, At, B1); PG8_BAR;
            PG8_LDA(At, 1, 1); PG8_STAGE(PG8_SA(1, 0), a3, voffA);
            PG8_BAR; PG8_WAIT_L(0); PG8_MMA(1, 0, At, B0); PG8_BAR; PG8_SCHED;
            PG8_STAGE(PG8_SB(1, 1), b3 + hstep, voffB);
            PG8_WAIT_V(6); PG8_BAR; PG8_MMA(1, 1, At, B1); PG8_BAR;
            }
        }
        if constexpr (ALIGN_EPI) { if (wr == 0) PG8_BAR; }
        if constexpr (!Epi::AFTER_DRAIN) { E(acc, cur, wr, wc, fr, fq); S.done(cur); }
        if (!has_next) break;
#pragma unroll
        for (int a = 0; a < 2; ++a)
#pragma unroll
            for (int b = 0; b < 2; ++b)
#pragma unroll
                for (int m = 0; m < 4; ++m)
#pragma unroll
                    for (int n = 0; n < 2; ++n) acc[a][b][m][n] = (f32x4){0.f, 0.f, 0.f, 0.f};
        cur = nxt; cA = nA; cB = nB; ++ui;
        if constexpr (ALIGN_EPI) { if (wr == 1) PG8_BAR; }
    }
    PG8_WAIT_V(0);
    if constexpr (!ALIGN_EPI) { if (wr == 0) PG8_BAR; }
    PG8_BAR;
    if constexpr (Epi::AFTER_DRAIN) { E.fused(acc, cur, wr, wc, fr, fq, lds, wid, lane); S.done(cur); }
#undef PG8_SA
#undef PG8_SB
#undef PG8_STAGE
#undef PG8_LDA
#undef PG8_LDB
#undef PG8_MMA
#undef PG8_WAIT_V
#undef PG8_WAIT_L
#undef PG8_BAR
#undef PG8_SCHED
}
}

#ifndef PG8_SP2
#define PG8_SP2 true
#endif
#ifndef PG8_ALIGN
#define PG8_ALIGN true
#endif
#include <hip/hip_bf16.h>
#include <cmath>
namespace attn_body {
using bf16=__hip_bfloat16;
using bf16x8=__attribute__((ext_vector_type(8)))short;
using s16x4=__attribute__((ext_vector_type(4)))short;
using f32x16=__attribute__((ext_vector_type(16)))float;
using u32x4=__attribute__((ext_vector_type(4)))unsigned;
using f32x4=__attribute__((ext_vector_type(4)))float;
#define LASF __attribute__((address_space(3)))
constexpr int BATCH=8,NHEAD=16,SEQ=2048,D=64,DM=NHEAD*D;
constexpr int NW=8,QBLK=32,QB=QBLK*NW,KVBLK=64,NQB=SEQ/QB;
constexpr int ATTN_PITCH=DM, ATTN_UNIT_ROWS=QB;
__device__ __forceinline__ int crow(int r,int hi){return (r&3)+8*(r>>2)+4*hi;}
#define SBAR() __builtin_amdgcn_sched_barrier(0)
__device__ __forceinline__ void cmask(f32x16&p0,f32x16&p1,int jb,int qrel,int hi){
  const float NEG=-INFINITY; int kb=64*jb+4*hi;
  #pragma unroll
  for(int r=0;r<16;++r){int kv=kb+(r&3)+8*(r>>2); if(kv>qrel)p0[r]=NEG; if(kv+32>qrel)p1[r]=NEG;}
}

constexpr int NSLOT=3, SLOTB=8192;
constexpr int LDS_K=0, LDS_V=NSLOT*SLOTB, LDS_WS=2*NSLOT*SLOTB, LDS_OST=LDS_WS+NW*64*4, LDS_BYTES=LDS_OST+NW*4096;
constexpr float C2=0.125f*1.4426950408889634f;
__device__ __forceinline__ void glds16(const void*gsrc,unsigned lds_dst){unsigned keep;
  asm volatile("s_mov_b32 %0, m0\n\ts_mov_b32 m0, %2\n\ts_nop 0\n\tglobal_load_lds_dwordx4 %1, off\n\ts_mov_b32 m0, %0":"=&s"(keep):"v"(gsrc),"s"(lds_dst):"memory");}
__device__ __forceinline__ float max3f(float a,float b,float c){float r;asm("v_max3_f32 %0, %1, %2, %3":"=v"(r):"v"(a),"v"(b),"v"(c));return r;}
__device__ __forceinline__ float max2f(float a,float b){float r;asm("v_max_f32_e32 %0, %1, %2":"=v"(r):"v"(a),"v"(b));return r;}
__device__ __forceinline__ float fadd_s(float a,float b){float r;asm("v_add_f32_e32 %0, %1, %2":"=v"(r):"v"(a),"v"(b));return r;}
__device__ __forceinline__ float fsub_s(float a,float b){float r;asm("v_sub_f32_e32 %0, %1, %2":"=v"(r):"v"(a),"v"(b));return r;}
typedef float f32x2_t __attribute__((ext_vector_type(2))); typedef __bf16 bf16x2_t __attribute__((ext_vector_type(2)));
__device__ __forceinline__ unsigned cvtpk_s(float lo,float hi){f32x2_t v={lo,hi};bf16x2_t b=__builtin_convertvector(v,bf16x2_t);return __builtin_bit_cast(unsigned,b);}
#define WAIT_BAR(N) asm volatile("s_waitcnt vmcnt(" #N ") lgkmcnt(0)\n\ts_barrier":::"memory")

__device__ __forceinline__ void qkt(f32x16&p0,f32x16&p1,const char*Kslot,const bf16x8*qr,int r32,int hi){
  const char*kb=Kslot+hi*1024+r32*16;
  #pragma unroll
  for(int d0=0;d0<4;++d0){
    const bf16x8 b0=*reinterpret_cast<const bf16x8*>(kb+d0*2048);
    const bf16x8 b1=*reinterpret_cast<const bf16x8*>(kb+d0*2048+512);
    p0=__builtin_amdgcn_mfma_f32_32x32x16_bf16(b0,qr[d0],p0,0,0,0);p1=__builtin_amdgcn_mfma_f32_32x32x16_bf16(b1,qr[d0],p1,0,0,0);}
}
typedef __attribute__((address_space(3))) const char* lds_cptr;
typedef short v4i16_t __attribute__((ext_vector_type(4)));
__device__ __forceinline__ void kload8(bf16x8*kf,lds_cptr kp){
  kf[0]=*(const __attribute__((address_space(3))) bf16x8*)(kp);      kf[1]=*(const __attribute__((address_space(3))) bf16x8*)(kp+512);
  kf[2]=*(const __attribute__((address_space(3))) bf16x8*)(kp+2048); kf[3]=*(const __attribute__((address_space(3))) bf16x8*)(kp+2560);
  kf[4]=*(const __attribute__((address_space(3))) bf16x8*)(kp+4096); kf[5]=*(const __attribute__((address_space(3))) bf16x8*)(kp+4608);
  kf[6]=*(const __attribute__((address_space(3))) bf16x8*)(kp+6144); kf[7]=*(const __attribute__((address_space(3))) bf16x8*)(kp+6656);
}
__device__ __forceinline__ void kload2(bf16x8*kf,lds_cptr kp,int j){ kf[2*j]=*(const __attribute__((address_space(3))) bf16x8*)(kp+j*2048); kf[2*j+1]=*(const __attribute__((address_space(3))) bf16x8*)(kp+j*2048+512); }
__device__ __forceinline__ s16x4 vtr(lds_cptr p){ return __builtin_bit_cast(s16x4,__builtin_amdgcn_ds_read_tr16_b64_v4i16((__attribute__((address_space(3))) v4i16_t*)p)); }
__device__ __forceinline__ float rowmax(const f32x16&p0,const f32x16&p1){
  float a=max3f(p0[0],p0[1],p1[0]),b=max3f(p0[2],p0[3],p1[1]);a=max3f(a,p1[2],p1[3]);
  #pragma unroll
  for(int r=4;r<16;r+=4){a=max3f(a,p0[r],p0[r+1]);b=max3f(b,p0[r+2],p0[r+3]);a=max3f(a,p1[r],p1[r+1]);b=max3f(b,p1[r+2],p1[r+3]);}
  const float m=max2f(a,b);
  auto rr=__builtin_amdgcn_permlane32_swap(__float_as_uint(m),__float_as_uint(m),false,false);
  return max2f(__uint_as_float(rr[0]),__uint_as_float(rr[1]));
}
__device__ __forceinline__ void pv(f32x16*o,int vb,bf16x8 pa0,bf16x8 pa1,bf16x8 pa2,bf16x8 pa3){
  #pragma unroll
  for(int d0=0;d0<2;++d0){s16x4 lo[4],hi[4];
    #pragma unroll
    for(int ks=0;ks<4;++ks){
      asm volatile("ds_read_b64_tr_b16 %0,%1 offset:%c2":"=&v"(lo[ks]):"v"(vb),"i"(d0*4096+ks*1024):"memory");
      asm volatile("ds_read_b64_tr_b16 %0,%1 offset:%c2":"=&v"(hi[ks]):"v"(vb),"i"(d0*4096+ks*1024+512):"memory");}
    asm volatile("s_waitcnt lgkmcnt(0)":::"memory");SBAR();
    #define PK(k) (bf16x8){lo[k][0],lo[k][1],lo[k][2],lo[k][3],hi[k][0],hi[k][1],hi[k][2],hi[k][3]}
    o[d0]=__builtin_amdgcn_mfma_f32_32x32x16_bf16(pa0,PK(0),o[d0],0,0,0);
    o[d0]=__builtin_amdgcn_mfma_f32_32x32x16_bf16(pa1,PK(1),o[d0],0,0,0);
    o[d0]=__builtin_amdgcn_mfma_f32_32x32x16_bf16(pa2,PK(2),o[d0],0,0,0);
    o[d0]=__builtin_amdgcn_mfma_f32_32x32x16_bf16(pa3,PK(3),o[d0],0,0,0);
    #undef PK
  }
}


struct MergeCtx { const unsigned short* GA; const unsigned short* G2; const unsigned short* U; const float* cw; const float* st; unsigned short* out; };
__device__ __forceinline__ float mbflo(unsigned w){return __builtin_bit_cast(float,w<<16);}
__device__ __forceinline__ float mbfhi(unsigned w){return __builtin_bit_cast(float,w&0xffff0000u);}
__device__ __forceinline__ void munpack8(u32x4 w,float*f){f[0]=mbflo(w.x);f[1]=mbfhi(w.x);f[2]=mbflo(w.y);f[3]=mbfhi(w.y);f[4]=mbflo(w.z);f[5]=mbfhi(w.z);f[6]=mbflo(w.w);f[7]=mbfhi(w.w);}
__device__ __forceinline__ void merge_store8(const MergeCtx&c,size_t grow,int t,bool prm,int bb,int col,u32x4 ov){
  const size_t off=grow*1024+col; float ga[8],o[8],g2[8],u0[8],u1[8],u2[8];
  munpack8(*(const u32x4*)(c.GA+off),ga); munpack8(ov,o); munpack8(*(const u32x4*)(c.G2+off),g2); munpack8(*(const u32x4*)(c.U+off),u2);
  if(t>=1)munpack8(*(const u32x4*)(c.U+off-1024),u1);
  else if(prm){_Pragma("unroll") for(int e=0;e<8;++e)u1[e]=0.f;} else {const float*p=c.st+(size_t)(bb*2+1)*1024+col; _Pragma("unroll") for(int e=0;e<8;++e)u1[e]=p[e];}
  if(t>=2)munpack8(*(const u32x4*)(c.U+off-2048),u0);
  else if(prm){_Pragma("unroll") for(int e=0;e<8;++e)u0[e]=0.f;} else {const float*p=c.st+(size_t)(bb*2+t)*1024+col; _Pragma("unroll") for(int e=0;e<8;++e)u0[e]=p[e];}
  float r[8];
  _Pragma("unroll") for(int e=0;e<8;++e){const float cy=c.cw[col+e]*u0[e]+c.cw[1024+col+e]*u1[e]+c.cw[2048+col+e]*u2[e]; r[e]=ga[e]*o[e]+g2[e]*cy;}
  u32x4 w; w.x=cvtpk_s(r[0],r[1]); w.y=cvtpk_s(r[2],r[3]); w.z=cvtpk_s(r[4],r[5]); w.w=cvtpk_s(r[6],r[7]);
  *(u32x4*)(c.out+off)=w;
}
#ifndef ATTN_STORE16
#define ATTN_STORE16(p,v) (*(u32x4*)(p)=(v))
#endif
template<int THRL> __device__ __forceinline__ void attn_unit(int b,int h,int qb,const bf16*Q,const bf16*__restrict__ K,const bf16*__restrict__ V,const MergeCtx&mc,char*shm,const LASF float*fb){
  int tid_=threadIdx.x; asm volatile("":"+v"(tid_));
  const int tid=tid_,lane=tid&63,r32=lane&31,hi=lane>>5; const int wid=__builtin_amdgcn_readfirstlane(tid>>6);
  const long rowbase=(long)b*SEQ; const int q0=qb*QB;
  const bf16*Qw=Q+(rowbase+q0+wid*QBLK)*DM+h*D;
  const bf16*Kh=K+rowbase*DM+h*D,*Vh=V+rowbase*DM+h*D;
  const unsigned lds0=(unsigned)(uintptr_t)shm;
  float*wsf=(float*)(shm+LDS_WS)+wid*64;
  const bf16*ksrc=Kh+(long)lane*DM+wid*8;
  const bf16*vsrc=Vh+(long)(16*(wid&3)+(lane>>2))*DM+(wid>>2)*32+(lane&3)*8;
  const unsigned kdst=lds0+LDS_K+wid*1024, vdst=lds0+LDS_V+wid*1024;
  #define DMA_K(t,slot) glds16(ksrc+(long)(t)*KVBLK*DM,(unsigned)__builtin_amdgcn_readfirstlane(kdst+(slot)))
  #define DMA_V(t,slot) glds16(vsrc+(long)(t)*KVBLK*DM,(unsigned)__builtin_amdgcn_readfirstlane(vdst+(slot)))
  const int vb0=(int)(lds0+LDS_V)+((lane>>4)&1)*32+(lane&3)*8+(4*hi+((lane&15)>>2))*64;
  const char*Kbase=shm+LDS_K; bf16x8 kf[8];
  const lds_cptr shm3=(lds_cptr)shm; const lds_cptr kp0=shm3+LDS_K+hi*1024+r32*16; const lds_cptr vp0=shm3+LDS_V+((lane>>4)&1)*32+(lane&3)*8+(4*hi+((lane&15)>>2))*64;
  const int NT=(q0+QB)/KVBLK;
  DMA_K(0,0);DMA_V(0,0);DMA_K(1,SLOTB);
  bf16x8 qr[4];
  #pragma unroll
  for(int d0=0;d0<4;++d0)qr[d0]=*reinterpret_cast<const bf16x8*>(&Qw[(long)r32*DM+d0*16+hi*8]);
  float mhat=fb[q0+wid*QBLK+r32],l_reg=0.f;f32x16 o[2];o[0]=f32x16{};o[1]=f32x16{};
  #define FBINIT(C0,C1,t) do{ const LASF float*fp_=fb+64*(t)+4*hi; \
    _Pragma("unroll") for(int i_=0;i_<4;++i_){ const f32x4 a_=*(const LASF f32x4*)(fp_+8*i_),b_=*(const LASF f32x4*)(fp_+32+8*i_); \
      C0[4*i_]=a_[0]-mhat;C0[4*i_+1]=a_[1]-mhat;C0[4*i_+2]=a_[2]-mhat;C0[4*i_+3]=a_[3]-mhat; \
      C1[4*i_]=b_[0]-mhat;C1[4*i_+1]=b_[1]-mhat;C1[4*i_+2]=b_[2]-mhat;C1[4*i_+3]=b_[3]-mhat; } }while(0)
  #define FBLOAD(P0,P1,tn) do{ const LASF float*fp_=fb+64*(tn)+4*hi; \
    _Pragma("unroll") for(int i_=0;i_<4;++i_){ const f32x4 a_=*(const LASF f32x4*)(fp_+8*i_),b_=*(const LASF f32x4*)(fp_+32+8*i_); \
      P0[4*i_]=a_[0];P0[4*i_+1]=a_[1];P0[4*i_+2]=a_[2];P0[4*i_+3]=a_[3]; P1[4*i_]=b_[0];P1[4*i_+1]=b_[1];P1[4*i_+2]=b_[2];P1[4*i_+3]=b_[3]; } }while(0)
  #define FBSUB(X,B) do{ X[B]-=mhat; X[B+1]-=mhat; X[B+2]-=mhat; X[B+3]-=mhat; }while(0)
  const int qrel=wid*QBLK+r32;
  #define CMASK(P0,P1,t) do{int jb_=(t)-(NT-4); if(jb_>=0)cmask(P0,P1,jb_,qrel,hi);}while(0)
  bool resc=false;
  #define START(P0,P1) do{ const float rm=rowmax(P0,P1); resc=false; \
    if(__any(rm>(float)THRL)){ const float dl=__builtin_fmaxf(rm,0.f); mhat=fadd_s(mhat,dl); \
      _Pragma("unroll") for(int r=0;r<16;++r){P0[r]=fsub_s(P0[r],dl);P1[r]=fsub_s(P1[r],dl);} } \
    _Pragma("unroll") for(int r=0;r<16;++r)P0[r]=__builtin_amdgcn_exp2f(P0[r]); }while(0)
  #define RESC() do{ if(resc){ asm volatile("s_waitcnt lgkmcnt(0)":::"memory"); \
      _Pragma("unroll") for(int d_=0;d_<2;++d_) _Pragma("unroll") for(int r=0;r<16;++r)o[d_][r]*=wsf[crow(r,hi)]; } }while(0)
  f32x16 pA0,pA1,pB0,pB1;
  int sl_prev=0,sl_cur=0,sl_next=SLOTB;
  #define ROT() do{sl_prev=sl_cur;sl_cur=sl_next;sl_next=(sl_next==(NSLOT-1)*SLOTB)?0:sl_next+SLOTB;}while(0)
  DMA_K(2,2*SLOTB);
  WAIT_BAR(3);
  FBINIT(pA0,pA1,0);
  qkt(pA0,pA1,Kbase,qr,r32,hi);asm volatile("s_nop 15\n\ts_nop 7":"+v"(pA0),"+v"(pA1));CMASK(pA0,pA1,0);
  START(pA0,pA1);
  _Pragma("unroll") for(int r=0;r<16;++r)pA1[r]=__builtin_amdgcn_exp2f(pA1[r]);
  FBINIT(pB0,pB1,1);
  WAIT_BAR(0);
  DMA_K(3,0);DMA_V(1,SLOTB);
  ROT();
  kload8(kf,kp0+sl_cur);
  WAIT_BAR(2);
  s16x4 vlo[8],vhi[8]; u32x4 pw0,pw1,pw2,pw3;
  #define PKW(P,B) cvtpk_s(P[B],P[B+1])
  #define PAF(k) __builtin_bit_cast(bf16x8,pw##k)
  #define VFR(i) (bf16x8){vlo[i][0],vlo[i][1],vlo[i][2],vlo[i][3],vhi[i][0],vhi[i][1],vhi[i][2],vhi[i][3]}
  #define PIN(x) asm volatile("":"+v"(x))
  #define MX3(a,b,c) __builtin_fmaxf(__builtin_fmaxf((a),(b)),(c))
  #define GAPA(MF,A0,A1,A2,A3,W0,W1,PW) do{ MF; sacc+=A0; sacc+=A1; sacc+=A2; sacc+=A3; PIN(sacc); W0; W1; PIN(PW); SBAR(); }while(0)
  #define EX(v) __builtin_amdgcn_exp2f(v)
  #define GAPB(MF,X,B,Y,YB) do{ MF; X[B]=EX(X[B]); X[B+1]=EX(X[B+1]); X[B+2]=EX(X[B+2]); X[B+3]=EX(X[B+3]); PIN(X); FBSUB(Y,YB); PIN(Y); SBAR(); }while(0)
  #define VRD(i) do{ vlo[i]=vtr(vp_+(((i)>>2)*4096+((i)&3)*1024)); vhi[i]=vtr(vp_+(((i)>>2)*4096+((i)&3)*1024+512)); }while(0)
  #define KRD(G,j) do{ if(G){ kload2(kf,kp0+sl_next,j); SBAR(); } }while(0)
  #define STEP(C0,C1,P0,P1,t,GK,GV,GL) do{ SBAR(); \
    const lds_cptr vp_=vp0+sl_prev; \
    VRD(0); SBAR(); float sacc=(P0[0]+P0[1]); \
    GAPA(C0=__builtin_amdgcn_mfma_f32_32x32x16_bf16(kf[0],qr[0],C0,0,0,0), P0[2],P0[3],P0[4],P0[5],     pw0[0]=PKW(P0,0), pw0[1]=PKW(P0,2), pw0); \
    VRD(4); SBAR(); GAPA(C1=__builtin_amdgcn_mfma_f32_32x32x16_bf16(kf[1],qr[0],C1,0,0,0), P0[6],P0[7],P0[8],P0[9],     pw0[2]=PKW(P0,4), pw0[3]=PKW(P0,6), pw0); \
    VRD(1); SBAR(); GAPA(C0=__builtin_amdgcn_mfma_f32_32x32x16_bf16(kf[2],qr[1],C0,0,0,0),   P0[10],P0[11],P0[12],P0[13], pw1[0]=PKW(P0,8), pw1[1]=PKW(P0,10), pw1); \
    VRD(5); SBAR(); GAPA(C1=__builtin_amdgcn_mfma_f32_32x32x16_bf16(kf[3],qr[1],C1,0,0,0),   P0[14],P0[15],P1[0],P1[1],   pw1[2]=PKW(P0,12),pw1[3]=PKW(P0,14), pw1); \
    VRD(2); SBAR(); GAPA(C0=__builtin_amdgcn_mfma_f32_32x32x16_bf16(kf[4],qr[2],C0,0,0,0),   P1[2],P1[3],P1[4],P1[5],     pw2[0]=PKW(P1,0), pw2[1]=PKW(P1,2), pw2); \
    VRD(6); SBAR(); GAPA(C1=__builtin_amdgcn_mfma_f32_32x32x16_bf16(kf[5],qr[2],C1,0,0,0),   P1[6],P1[7],P1[8],P1[9],     pw2[2]=PKW(P1,4), pw2[3]=PKW(P1,6), pw2); \
    VRD(3); SBAR(); GAPA(C0=__builtin_amdgcn_mfma_f32_32x32x16_bf16(kf[6],qr[3],C0,0,0,0),   P1[10],P1[11],P1[12],P1[13], pw3[0]=PKW(P1,8), pw3[1]=PKW(P1,10), pw3); \
    VRD(7); SBAR(); GAPA(C1=__builtin_amdgcn_mfma_f32_32x32x16_bf16(kf[7],qr[3],C1,0,0,0),   P1[14],P1[15],0.f,0.f,       pw3[2]=PKW(P1,12),pw3[3]=PKW(P1,14), pw3); \
    l_reg+=sacc; \
    if(GK){DMA_K((t)+3,sl_cur);} if(GV){DMA_V((t)+1,sl_next);} \
    CMASK(C0,C1,t); \
    { float a=MX3(C0[0],C0[1],C1[0]),b=MX3(C0[2],C0[3],C1[1]); a=MX3(a,C1[2],C1[3]); \
      _Pragma("unroll") for(int r=4;r<16;r+=4){a=MX3(a,C0[r],C0[r+1]);b=MX3(b,C0[r+2],C0[r+3]);a=MX3(a,C1[r],C1[r+1]);b=MX3(b,C1[r+2],C1[r+3]);} \
      float rm=__builtin_fmaxf(a,b); { auto rr=__builtin_amdgcn_permlane32_swap(__float_as_uint(rm),__float_as_uint(rm),false,false); rm=__builtin_fmaxf(__uint_as_float(rr[0]),__uint_as_float(rr[1])); } \
      resc=false; \
      if(__builtin_expect(__any(rm>(float)THRL),0)){ const float dl=__builtin_fmaxf(rm,0.f); mhat+=dl; \
        _Pragma("unroll") for(int r=0;r<16;++r){C0[r]-=dl;C1[r]-=dl;} \
        const float f=__builtin_amdgcn_exp2f(-dl); l_reg*=f; if(hi==0)wsf[r32]=f; resc=true; } } \
    SBAR(); FBLOAD(P0,P1,(t)+1); SBAR(); \
    GAPB(o[0]=__builtin_amdgcn_mfma_f32_32x32x16_bf16(PAF(0),VFR(0),o[0],0,0,0), C0,0, P0,0); \
    GAPB(o[1]=__builtin_amdgcn_mfma_f32_32x32x16_bf16(PAF(0),VFR(4),o[1],0,0,0), C0,4, P0,4); \
    KRD(GL,0); GAPB(o[0]=__builtin_amdgcn_mfma_f32_32x32x16_bf16(PAF(1),VFR(1),o[0],0,0,0), C0,8, P0,8); \
    KRD(GL,1); GAPB(o[1]=__builtin_amdgcn_mfma_f32_32x32x16_bf16(PAF(1),VFR(5),o[1],0,0,0), C0,12, P0,12); \
    KRD(GL,2); GAPB(o[0]=__builtin_amdgcn_mfma_f32_32x32x16_bf16(PAF(2),VFR(2),o[0],0,0,0), C1,0, P1,0); \
    KRD(GL,3); GAPB(o[1]=__builtin_amdgcn_mfma_f32_32x32x16_bf16(PAF(2),VFR(6),o[1],0,0,0), C1,4, P1,4); \
    GAPB(o[0]=__builtin_amdgcn_mfma_f32_32x32x16_bf16(PAF(3),VFR(3),o[0],0,0,0), C1,8, P1,8); \
    GAPB(o[1]=__builtin_amdgcn_mfma_f32_32x32x16_bf16(PAF(3),VFR(7),o[1],0,0,0), C1,12, P1,12); \
    }while(0)
  int t=1;
  #undef CMASK
  #define CMASK(P0,P1,t) do{}while(0)
  for(;t+5<NT;t+=2){
    STEP(pB0,pB1,pA0,pA1,t,true,true,true);     WAIT_BAR(2); RESC(); ROT();
    STEP(pA0,pA1,pB0,pB1,t+1,true,true,true);   WAIT_BAR(2); RESC(); ROT();
  }
  #undef CMASK
  #define CMASK(P0,P1,t) do{int jb_=(t)-(NT-4); if(jb_>=0)cmask(P0,P1,jb_,qrel,hi);}while(0)
  #define ENDW(tt) do{ if((tt)+3<NT){WAIT_BAR(2);} else if((tt)+2<NT){WAIT_BAR(1);} else {WAIT_BAR(0);} }while(0)
  for(;t+1<NT;t+=2){
    STEP(pB0,pB1,pA0,pA1,t,(t+3<NT),(t+1<NT),(t+1<NT));       ENDW(t);   RESC(); ROT();
    STEP(pA0,pA1,pB0,pB1,t+1,(t+4<NT),(t+2<NT),(t+2<NT));     ENDW(t+1); RESC(); ROT();
  }
  STEP(pB0,pB1,pA0,pA1,NT-1,false,false,false); RESC();
  u32x4 mg[4][5]; f32x4 mcw[3][2];
  { const int mcol=h*D+(lane&7)*8;
    _Pragma("unroll") for(int j=0;j<3;++j){ mcw[j][0]=*(const f32x4*)(mc.cw+j*1024+mcol); mcw[j][1]=*(const f32x4*)(mc.cw+j*1024+mcol+4); }
    _Pragma("unroll") for(int i=0;i<4;++i){ const int t_=q0+wid*QBLK+i*8+(lane>>3); const size_t off=(size_t)(rowbase+t_)*1024+mcol;
      mg[i][0]=__builtin_nontemporal_load((const u32x4*)(mc.GA+off)); mg[i][1]=__builtin_nontemporal_load((const u32x4*)(mc.G2+off)); mg[i][2]=*(const u32x4*)(mc.U+off);
      mg[i][3]=(t_>=1)?*(const u32x4*)(mc.U+off-1024):(u32x4){0u,0u,0u,0u}; mg[i][4]=(t_>=2)?*(const u32x4*)(mc.U+off-2048):(u32x4){0u,0u,0u,0u}; } }
  { float sacc=pB0[0]+pB0[1]; _Pragma("unroll") for(int r=2;r<16;++r)sacc+=pB0[r]; _Pragma("unroll") for(int r=0;r<16;++r)sacc+=pB1[r]; l_reg+=sacc;
    pw0=(u32x4){PKW(pB0,0),PKW(pB0,2),PKW(pB0,4),PKW(pB0,6)};pw1=(u32x4){PKW(pB0,8),PKW(pB0,10),PKW(pB0,12),PKW(pB0,14)};pw2=(u32x4){PKW(pB1,0),PKW(pB1,2),PKW(pB1,4),PKW(pB1,6)};pw3=(u32x4){PKW(pB1,8),PKW(pB1,10),PKW(pB1,12),PKW(pB1,14)};
    SBAR(); pv(o,vb0+sl_cur,PAF(0),PAF(1),PAF(2),PAF(3)); }
  #undef PKW
  #undef PAF
  #undef VFR
  #undef PIN
  #undef MX3
  #undef GAPA
  #undef GAPB
  #undef EX
  #undef VRD
  #undef KRD
  #undef STEP
  #undef ENDW
  {auto rr=__builtin_amdgcn_permlane32_swap(__float_as_uint(l_reg),__float_as_uint(l_reg),false,false);l_reg=__uint_as_float(rr[0])+__uint_as_float(rr[1]);}
  if(hi==0)wsf[32+r32]=l_reg;asm volatile("s_waitcnt lgkmcnt(0)":::"memory");
  float rli[16];
  #pragma unroll
  for(int r=0;r<16;++r)rli[r]=__builtin_amdgcn_rcpf(wsf[32+crow(r,hi)]);
  { bf16*stg=(bf16*)(shm+LDS_OST)+wid*2048;
    #pragma unroll
    for(int r=0;r<16;++r){const int orow=crow(r,hi);
      #pragma unroll
      for(int d0=0;d0<2;++d0)stg[orow*64+d0*32+r32]=__float2bfloat16(o[d0][r]*rli[r]);}
    asm volatile("s_waitcnt lgkmcnt(0)":::"memory");
    #pragma unroll
    for(int i=0;i<4;++i){const int row=i*8+(lane>>3),ch=lane&7; const u32x4 v=*(const u32x4*)(stg+row*64+ch*8); const int t_=q0+wid*QBLK+row;
      float ga[8],ov[8],g2[8],u2[8],u1[8],u0[8],r[8]; munpack8(mg[i][0],ga); munpack8(v,ov); munpack8(mg[i][1],g2); munpack8(mg[i][2],u2); munpack8(mg[i][3],u1); munpack8(mg[i][4],u0);
      _Pragma("unroll") for(int e=0;e<8;++e){ const float cy=mcw[0][e>>2][e&3]*u0[e]+mcw[1][e>>2][e&3]*u1[e]+mcw[2][e>>2][e&3]*u2[e]; r[e]=ga[e]*ov[e]+g2[e]*cy; }
      u32x4 w; w.x=cvtpk_s(r[0],r[1]); w.y=cvtpk_s(r[2],r[3]); w.z=cvtpk_s(r[4],r[5]); w.w=cvtpk_s(r[6],r[7]);
      *(u32x4*)(mc.out+(size_t)(rowbase+t_)*1024+h*D+ch*8)=w; } }
  asm volatile("s_waitcnt lgkmcnt(0)\n\ts_barrier":::"memory");
  #undef DMA_K
  #undef DMA_V
  #undef CMASK
  #undef START
  #undef RESC
  #undef ROT
  #undef FBINIT
  #undef FBLOAD
  #undef FBSUB
}
constexpr int ATTN_LDS_BYTES=LDS_BYTES;
#undef SBAR
#undef WAIT_BAR
}

#define XB_TMO      128
#define XB_XCNT(j)  (256  + 64 * (j))
#define XB_XSUB(j)  (1280 + 64 * (j))
#define XB_XGEN(j)  (2304 + 64 * (j))
#define XB_TOP      3328
#define XB_TOPGEN   3392
#define XCD_BAR_WORDS 3456
#define XB_SPIN_CAP (1u << 18)

__device__ __forceinline__ unsigned xb_ld(unsigned* p)              { return __hip_atomic_load(p, __ATOMIC_RELAXED, __HIP_MEMORY_SCOPE_AGENT); }
__device__ __forceinline__ unsigned xb_add(unsigned* p, unsigned v) { return __hip_atomic_fetch_add(p, v, __ATOMIC_RELAXED, __HIP_MEMORY_SCOPE_AGENT); }
__device__ __forceinline__ unsigned xb_xcc_id() { return (unsigned)__builtin_amdgcn_s_getreg((3 << 11) | 20) & 0xFu; }
#define XB_SPIN(cond, bar) do { unsigned _sp = 0; while (cond) { __builtin_amdgcn_s_sleep(1); \
    if ((++_sp & 255u) == 0u) { if (xb_ld(&(bar)[XB_TMO])) break; if (_sp > XB_SPIN_CAP) { atomicAdd(&(bar)[XB_TMO], 1u); break; } } } } while (0)

struct XcdBarrier {
    unsigned* bar; unsigned x;
    volatile __attribute__((address_space(3))) unsigned* st;
};

__device__ __forceinline__ XcdBarrier xcd_barrier_post(unsigned* bar, volatile __attribute__((address_space(3))) unsigned* st) {
    XcdBarrier b; b.bar = bar; b.x = xb_xcc_id(); b.st = st;
    if (threadIdx.x == 0) (void)xb_add(&bar[XB_XCNT(b.x)], 1u);
    return b;
}
__device__ __forceinline__ void xcd_barrier_complete(unsigned* bar, unsigned x, unsigned& nloc, unsigned& nx) {
    const unsigned G = gridDim.x * gridDim.y * gridDim.z;
    unsigned sum, cnt, mine, sp = 0u;
    for (;;) {
        sum = 0u; cnt = 0u; mine = 0u;
#pragma unroll
        for (unsigned j = 0; j < 16; ++j) { const unsigned c = xb_ld(&bar[XB_XCNT(j)]); sum += c; cnt += (c > 0u) ? 1u : 0u; mine = (j == x) ? c : mine; }
        if (sum == G) break;
        __builtin_amdgcn_s_sleep(1);
        if ((++sp & 255u) == 0u) { if (xb_ld(&bar[XB_TMO])) break; if (sp > XB_SPIN_CAP) { atomicAdd(&bar[XB_TMO], 1u); break; } }
    }
    nloc = mine > 0u ? mine : 1u; nx = cnt > 0u ? cnt : 1u;
}

__device__ __forceinline__ void xcd_barrier(const XcdBarrier& b) {
    asm volatile("s_waitcnt vmcnt(0)" ::: "memory");
    __syncthreads();
    if (threadIdx.x == 0) {
        unsigned* bar = b.bar;
        __builtin_amdgcn_s_waitcnt(0);
        unsigned nloc = b.st[0], nx = b.st[1];
        if (nloc == 0u) { xcd_barrier_complete(bar, b.x, nloc, nx); b.st[0] = nloc; b.st[1] = nx; }
        const unsigned old = xb_add(&bar[XB_XSUB(b.x)], 1u);
        const unsigned gen = old / nloc;
        if (old + 1u == (gen + 1u) * nloc) {
            __builtin_amdgcn_fence(__ATOMIC_RELEASE, "agent");
            asm volatile("s_waitcnt vmcnt(0)" ::: "memory");
            const unsigned og = xb_add(&bar[XB_TOP], 1u);
            const unsigned tg = og / nx;
            if (og + 1u == (tg + 1u) * nx) xb_add(&bar[XB_TOPGEN], 1u);
            else XB_SPIN(xb_ld(&bar[XB_TOPGEN]) == tg, bar);
            __builtin_amdgcn_fence(__ATOMIC_ACQUIRE, "agent");
            xb_add(&bar[XB_XGEN(b.x)], 1u);
            asm volatile("s_waitcnt vmcnt(0)" ::: "memory");
        } else {
            XB_SPIN(xb_ld(&bar[XB_XGEN(b.x)]) == gen, bar);
            __builtin_amdgcn_fence(__ATOMIC_ACQUIRE, "agent");
            asm volatile("s_waitcnt vmcnt(0)" ::: "memory");
        }
    }
    __syncthreads();
}


namespace cg = cooperative_groups;
constexpr int NWAVES = 8, NTHREADS = 512;
constexpr size_t MiB = 1u << 20;
constexpr size_t WS_CNT = 912 * 1024;
constexpr int CNT_WORDS = 3 * 80 * 16;
constexpr size_t WS_BAR = 896 * 1024;
constexpr size_t WS_MOD = 0, WS_W1IN = 1 * MiB, WS_W1OUT = 12 * MiB, WS_WIN = 18 * MiB, WS_WOUT = 35 * MiB, WS_W2IN = 37 * MiB, WS_W2OUT = 48 * MiB, WS_H = 54 * MiB,
                 WS_QB = 88 * MiB, WS_KB = 122 * MiB, WS_VB = 156 * MiB, WS_GAB = 190 * MiB, WS_G2B = 224 * MiB, WS_UB = 258 * MiB, WS_END = 292 * MiB, WS_ACT = WS_QB;
static_assert((size_t)MT * DM * 2 == 34 * MiB && WS_KB - WS_QB == 34 * MiB && WS_VB - WS_KB == 34 * MiB && WS_GAB - WS_VB == 34 * MiB && WS_G2B - WS_GAB == 34 * MiB && WS_UB - WS_G2B == 34 * MiB && WS_ACT + (size_t)MT * DFF * 2 <= WS_GAB && WS_WIN + (size_t)NINP * DM * 2 <= WS_WOUT && WS_W1IN + (size_t)2 * DFF * DM * 2 <= WS_W1OUT, "d_ws map");
constexpr int RING_OFF = 0, RING_BYTES = 131072, FB_OFF = RING_BYTES, STAT_OFF = FB_OFF + 8192, QL_OFF = STAT_OFF + 8192, LDS_BYTES = 163840;
static_assert(QL_OFF + 64 * 144 <= LDS_BYTES && 98304 + 8 * 8192 <= LDS_BYTES && LDS_BYTES <= 163840 && STAT_OFF + 8192 <= LDS_BYTES && attn_body::LDS_BYTES <= RING_BYTES, "LDS map");

#define LAS __attribute__((address_space(3)))
typedef unsigned short bf16;
typedef unsigned v4u __attribute__((ext_vector_type(4)));
typedef unsigned v2u __attribute__((ext_vector_type(2)));
typedef float f32x4 __attribute__((ext_vector_type(4)));
typedef float f32x16 __attribute__((ext_vector_type(16)));
typedef short bf16x8 __attribute__((ext_vector_type(8)));
#define LDS_WAIT() asm volatile("s_waitcnt lgkmcnt(0)" ::: "memory")
__device__ __forceinline__ unsigned f2bf(float f) { unsigned u = __builtin_bit_cast(unsigned, f); return (u + 0x7fffu + ((u >> 16) & 1u)) >> 16; }
__device__ __forceinline__ unsigned pk2(float lo, float hi) { return attn_body::cvtpk_s(lo, hi); }
__device__ __forceinline__ float bflo(unsigned w) { return __builtin_bit_cast(float, w << 16); }
__device__ __forceinline__ float bfhi(unsigned w) { return __builtin_bit_cast(float, w & 0xffff0000u); }
__device__ __forceinline__ float wave_sum(float v) {
#pragma unroll
    for (int o = 1; o < 64; o <<= 1) v += __shfl_xor(v, o);
    return v;
}

struct Args { const float* in[22]; float* out; unsigned char* ws; int ph_lo, ph_hi; };

__device__ __forceinline__ void p0_mod(const Args& a, LAS unsigned char* lds, int vcu, int G) {
    const int tid = threadIdx.x, lane = tid & 63, wid = tid >> 6, l32 = lane & 31, hi = lane >> 5;
    LAS float* scT = (LAS float*)lds;
    const float* w_ada = a.in[8]; const float* b_ada = a.in[9]; float* mod = (float*)(a.ws + WS_MOD);
    for (int item = vcu; item < MODLD / 64; item += G) {
        for (int i = tid; i < 32 * 1024; i += NTHREADS) { const int b = i & 31, k = i >> 5; float v = 0.f;
            if (b < 24) { const float c = b < 8 ? a.in[6][b * 1024 + k] : a.in[7][(b - 8) * 1024 + k]; v = c / (1.0f + __expf(-c)); }
            scT[i] = v; }
        __syncthreads();
        f32x16 acc0 = f32x16{}, acc1 = f32x16{};
        const float* wp = w_ada + (size_t)(wid * 128 + hi) * MODLD + item * 64 + l32;
        const LAS float* ap = scT + (wid * 128 + hi) * 32 + l32;
        float n0[16], n1[16];
#pragma unroll
        for (int q = 0; q < 16; ++q) { n0[q] = __builtin_nontemporal_load(wp + (size_t)(2 * q) * MODLD); n1[q] = __builtin_nontemporal_load(wp + (size_t)(2 * q) * MODLD + 32); }
#pragma unroll 1
        for (int bt = 0; bt < 4; ++bt) {
            float c0[16], c1[16];
#pragma unroll
            for (int q = 0; q < 16; ++q) { c0[q] = n0[q]; c1[q] = n1[q]; }
            if (bt < 3) {
#pragma unroll
                for (int q = 0; q < 16; ++q) { n0[q] = __builtin_nontemporal_load(wp + (size_t)(2 * (16 * (bt + 1) + q)) * MODLD); n1[q] = __builtin_nontemporal_load(wp + (size_t)(2 * (16 * (bt + 1) + q)) * MODLD + 32); }
            }
#pragma unroll
            for (int q = 0; q < 16; ++q) { const float av = ap[(2 * (16 * bt + q)) * 32];
                acc0 = __builtin_amdgcn_mfma_f32_32x32x2f32(av, c0[q], acc0, 0, 0, 0); acc1 = __builtin_amdgcn_mfma_f32_32x32x2f32(av, c1[q], acc1, 0, 0, 0); }
        }
        __syncthreads();
        { LAS float* P = scT + wid * 2048;
#pragma unroll
          for (int r = 0; r < 16; ++r) { const int b = (r & 3) + 8 * (r >> 2) + 4 * hi; P[b * 64 + l32] = acc0[r]; P[b * 64 + 32 + l32] = acc1[r]; } }
        __syncthreads();
        for (int o = tid; o < 24 * 64; o += NTHREADS) { const int b = o >> 6, c = o & 63; float sum = b_ada[item * 64 + c];
#pragma unroll
            for (int w = 0; w < 8; ++w) sum += scT[w * 2048 + b * 64 + c];
            mod[(size_t)b * MODLD + item * 64 + c] = sum; }
        __syncthreads();
    }
}
__device__ __forceinline__ void p0_transpose_item(const float* W, int K, int N, bf16* WT, int dst_row0, int src_col0, int nvalid, int kb, LAS float* scr, int lane) {
    const int k0 = 64 * kb; const int cl = lane & 31; const bool ok = cl < nvalid;
    float tv[32];
#pragma unroll
    for (int i = 0; i < 32; ++i) { const int kk = 2 * i + (lane >> 5); tv[i] = ok ? __builtin_nontemporal_load(W + (size_t)(k0 + kk) * N + src_col0 + cl) : 0.f; }
#pragma unroll
    for (int i = 0; i < 32; ++i) { const int kk = 2 * i + (lane >> 5); scr[kk * 33 + cl] = tv[i]; }
    LDS_WAIT(); asm volatile("" ::: "memory");
    const int c = lane & 7;
#pragma unroll
    for (int j = 0; j < 4; ++j) { const int n = (lane >> 3) + 8 * j; const LAS float* s = scr + (8 * c) * 33 + n;
        v4u o; o.x = pk2(s[0 * 33], s[1 * 33]); o.y = pk2(s[2 * 33], s[3 * 33]); o.z = pk2(s[4 * 33], s[5 * 33]); o.w = pk2(s[6 * 33], s[7 * 33]);
        *(v4u*)(WT + (size_t)(dst_row0 + n) * K + k0 + 8 * c) = o; }
    LDS_WAIT(); asm volatile("" ::: "memory");
}
__device__ __forceinline__ void map_ffn_in(int db, int& src, int& nv) { const int r = db * 32, t = r >> 8, w = r & 255; src = (w < 128 ? 0 : DFF) + t * 128 + (w & 127); nv = 32; }
__device__ __forceinline__ void map_win(int db, int& src, int& nv) {
    const int r = db * 32; nv = 32;
    if (r < 3072) { src = r; return; }
    if (r < 4096) { src = OFF_GA + (r - 3072); return; }
    if (r < 6144) { const int q = r - 4096, t = q >> 8, w = q & 255; src = (w < 128 ? OFF_B : OFF_GC) + t * 128 + (w & 127); return; }
    if (r < 8192) { const int q = r - 6144, t = q >> 8, w = q & 255; src = (w < 128 ? OFF_C : OFF_X) + t * 128 + (w & 127); return; }
    src = OFF_F; nv = (r == 8192) ? 16 : 0;
}
constexpr int I_1IN = 16 * 176, I_1OUT = 44 * 32, I_WIN = 16 * 264, I_WOUT = 16 * 32, WITEMS = 2 * I_1IN + 2 * I_1OUT + I_WIN + I_WOUT;
constexpr int WCUT0 = 2 * I_1IN + I_WIN, WCUT1 = WCUT0 + I_1OUT;
__device__ __forceinline__ void weight_item(const Args& a, int it, LAS float* scr, int lane) {
    int r = it; int src, nv;
    if (r < I_1IN) { map_ffn_in(r % 176, src, nv); p0_transpose_item(a.in[11], 1024, 2 * DFF, (bf16*)(a.ws + WS_W1IN), (r % 176) * 32, src, nv, r / 176, scr, lane); return; } r -= I_1IN;
    if (r < I_1IN) { map_ffn_in(r % 176, src, nv); p0_transpose_item(a.in[19], 1024, 2 * DFF, (bf16*)(a.ws + WS_W2IN), (r % 176) * 32, src, nv, r / 176, scr, lane); return; } r -= I_1IN;
    if (r < I_WIN) { map_win(r % 264, src, nv); p0_transpose_item(a.in[14], 1024, NIN, (bf16*)(a.ws + WS_WIN), (r % 264) * 32, src, nv, r / 264, scr, lane); return; } r -= I_WIN;
    if (r < I_1OUT) { p0_transpose_item(a.in[12], DFF, 1024, (bf16*)(a.ws + WS_W1OUT), (r % 32) * 32, (r % 32) * 32, 32, r / 32, scr, lane); return; } r -= I_1OUT;
    if (r < I_1OUT) { p0_transpose_item(a.in[20], DFF, 1024, (bf16*)(a.ws + WS_W2OUT), (r % 32) * 32, (r % 32) * 32, 32, r / 32, scr, lane); return; } r -= I_1OUT;
    p0_transpose_item(a.in[17], 1024, 1024, (bf16*)(a.ws + WS_WOUT), (r % 32) * 32, (r % 32) * 32, 32, r / 32, scr, lane);
}
__device__ __forceinline__ void p0_weights(const Args& a, LAS unsigned char* lds, int vcu, int G) {
    const int tid = threadIdx.x, lane = tid & 63, wid = tid >> 6;
    LAS float* scr = (LAS float*)(lds + wid * 16384);
    const int nitems = (G == 256) ? WCUT0 : WITEMS;
    constexpr int NMODWG = MODLD / 64;
    const bool skew = (G > NMODWG);
    const int nslot = skew ? NMODWG * NWAVES + (G - NMODWG) * NWAVES * 2 : G * NWAVES;
    const int slot0 = !skew ? vcu * NWAVES + wid : (vcu < NMODWG ? vcu * NWAVES + wid : NMODWG * NWAVES + ((vcu - NMODWG) * NWAVES + wid) * 2);
    const int nmine = (skew && vcu >= NMODWG) ? 2 : 1;
    for (int sl = 0; sl < nmine; ++sl)
        for (int it = slot0 + sl; it < nitems; it += nslot) weight_item(a, it, scr, lane);
}
__device__ __forceinline__ void weight_items_tail(const Args& a, LAS unsigned char* lds, int first, int last, int wk, int nwk) {
    const int tid = threadIdx.x, lane = tid & 63, wid = tid >> 6;
    LAS float* scr = (LAS float*)(lds + wid * 16384);
    for (int it = first + wk; it < last; it += nwk) weight_item(a, it, scr, lane);
}
template <bool FINAL, bool NT = false, int NR = 4> __device__ __forceinline__ void norm_rows4(int m0, const float* xP, const float* xS, const float* g, const float* mod, int sh_off, int sc_off, bf16* H, float* Y, int lane) {
    const float* x0 = m0 < MP ? xP + (size_t)m0 * DM : xS + (size_t)(m0 - MP) * DM;
    const int mb = m0 < MP ? (m0 >> 11) : 8 + ((m0 - MP) >> 6);
    f32x4 v[NR][4]; float s[NR];
#pragma unroll
    for (int r = 0; r < NR; ++r)
#pragma unroll
        for (int j = 0; j < 4; ++j) { const f32x4* p = (const f32x4*)(x0 + (size_t)r * DM) + lane + 64 * j; v[r][j] = NT ? __builtin_nontemporal_load(p) : *p; }
    f32x4 gg[4], sh[4], sc[4];
#pragma unroll
    for (int j = 0; j < 4; ++j) { gg[j] = ((const f32x4*)g + lane)[64 * j];
        if (!FINAL) { sh[j] = ((const f32x4*)(mod + (size_t)mb * MODLD + sh_off) + lane)[64 * j]; sc[j] = ((const f32x4*)(mod + (size_t)mb * MODLD + sc_off) + lane)[64 * j]; } }
#pragma unroll
    for (int r = 0; r < NR; ++r) { s[r] = 0.f;
#pragma unroll
        for (int j = 0; j < 4; ++j) s[r] += (v[r][j].x * v[r][j].x + v[r][j].y * v[r][j].y) + (v[r][j].z * v[r][j].z + v[r][j].w * v[r][j].w); }
#pragma unroll
    for (int o = 1; o < 64; o <<= 1) {
#pragma unroll
        for (int r = 0; r < NR; ++r) s[r] += __shfl_xor(s[r], o); }
#pragma unroll
    for (int r = 0; r < NR; ++r) { const float rstd = 1.0f / sqrtf(s[r] * (1.f / DM) + EPS);
        if (FINAL) { f32x4* yr = (f32x4*)(Y + (size_t)(m0 + r) * DM) + lane;
#pragma unroll
            for (int j = 0; j < 4; ++j) __builtin_nontemporal_store((v[r][j] * rstd) * gg[j], yr + 64 * j); }
        else { v2u* o8 = (v2u*)(H + (size_t)(m0 + r) * DM) + lane;
#pragma unroll
            for (int j = 0; j < 4; ++j) { const f32x4 y = (v[r][j] * rstd) * gg[j] * (sc[j] + 1.0f) + sh[j]; v2u w; w.x = pk2(y.x, y.y); w.y = pk2(y.z, y.w); o8[64 * j] = w; } } }
}
__device__ __forceinline__ void norm_mod_rows(const float* xP, const float* xS, const float* g, const float* mod, int sh_off, int sc_off, bf16* H, int vcu, int G) {
    const int tid = threadIdx.x, lane = tid & 63, wid = tid >> 6;
    const int gw = vcu * NWAVES + wid, NGW = G * NWAVES;
    for (int q = gw; q < MT / 4; q += NGW) norm_rows4<false, true>(4 * q, xP, xS, g, mod, sh_off, sc_off, H, nullptr, lane);
}
__device__ __forceinline__ void final_norm_rows(float* X, const float* g, int vcu, int G) {
    const int tid = threadIdx.x, lane = tid & 63, wid = tid >> 6;
    const int gw = vcu * NWAVES + wid, NGW = G * NWAVES;
    for (int q = gw; q < MT / 4; q += NGW) norm_rows4<true>(4 * q, X, X + (size_t)MP * DM, g, nullptr, 0, 0, nullptr, X, lane);
}
__device__ __forceinline__ void panel_handoff(unsigned* cP, unsigned* cS) {
    asm volatile("s_waitcnt vmcnt(0)" ::: "memory");
    __syncthreads();
    if (threadIdx.x == 0) {
        __builtin_amdgcn_fence(__ATOMIC_RELEASE, "agent");
        asm volatile("s_waitcnt vmcnt(0)" ::: "memory");
        __hip_atomic_fetch_add(cP, 1u, __ATOMIC_RELAXED, __HIP_MEMORY_SCOPE_AGENT);
        __hip_atomic_fetch_add(cS, 1u, __ATOMIC_RELAXED, __HIP_MEMORY_SCOPE_AGENT);
        unsigned sp = 0;
        while (__hip_atomic_load(cP, __ATOMIC_RELAXED, __HIP_MEMORY_SCOPE_AGENT) < 4u || __hip_atomic_load(cS, __ATOMIC_RELAXED, __HIP_MEMORY_SCOPE_AGENT) < 16u) { __builtin_amdgcn_s_sleep(2); if (++sp > (1u << 22)) break; }
        __builtin_amdgcn_fence(__ATOMIC_ACQUIRE, "agent");
        asm volatile("s_waitcnt vmcnt(0)" ::: "memory");
    }
    __syncthreads();
}
__device__ __forceinline__ void unpack8(v4u w, float* f) { f[0] = bflo(w.x); f[1] = bfhi(w.x); f[2] = bflo(w.y); f[3] = bfhi(w.y); f[4] = bflo(w.z); f[5] = bfhi(w.z); f[6] = bflo(w.w); f[7] = bfhi(w.w); }
__device__ __forceinline__ void merge_phase(const Args& a, int vcu, int G) {
    const bf16* GAB = (const bf16*)(a.ws + WS_GAB); const bf16* OB = (const bf16*)(a.ws + WS_QB); const bf16* G2B = (const bf16*)(a.ws + WS_G2B); const bf16* UB = (const bf16*)(a.ws + WS_UB);
    bf16* Hm = (bf16*)(a.ws + WS_H); const float* cw = a.in[16]; const float* st = a.in[5];
    const size_t total = (size_t)MT * 128, stride = (size_t)G * NTHREADS;
    for (size_t idx = (size_t)vcu * NTHREADS + threadIdx.x; idx < total; idx += stride) {
        const int row = (int)(idx >> 7), c8 = (int)(idx & 127) * 8;
        const bool prm = row < MP; const int rr = prm ? row : row - MP; const int t = prm ? (rr & 2047) : (rr & 63), bb = prm ? (rr >> 11) : (rr >> 6);
        const size_t off = (size_t)row * DM + c8;
        float ga[8], o[8], g2[8], u0[8], u1[8], u2[8];
        unpack8(*(const v4u*)(GAB + off), ga); unpack8(*(const v4u*)(OB + off), o); unpack8(*(const v4u*)(G2B + off), g2); unpack8(*(const v4u*)(UB + off), u2);
        if (t >= 1) unpack8(*(const v4u*)(UB + off - DM), u1);
        else { if (prm) { for (int e = 0; e < 8; ++e) u1[e] = 0.f; } else { const float* p = st + (size_t)(bb * 2 + 1) * 1024 + c8; for (int e = 0; e < 8; ++e) u1[e] = p[e]; } }
        if (t >= 2) unpack8(*(const v4u*)(UB + off - 2 * DM), u0);
        else { if (prm) { for (int e = 0; e < 8; ++e) u0[e] = 0.f; } else { const float* p = st + (size_t)(bb * 2 + t) * 1024 + c8; for (int e = 0; e < 8; ++e) u0[e] = p[e]; } }
        float r[8];
#pragma unroll
        for (int e = 0; e < 8; ++e) { const float cy = cw[c8 + e] * u0[e] + cw[1024 + c8 + e] * u1[e] + cw[2048 + c8 + e] * u2[e]; r[e] = ga[e] * o[e] + g2[e] * cy; }
        v4u w; w.x = pk2(r[0], r[1]); w.y = pk2(r[2], r[3]); w.z = pk2(r[4], r[5]); w.w = pk2(r[6], r[7]);
        *(v4u*)(Hm + off) = w;
    }
}

__device__ __forceinline__ void small_gemm_sample(const bf16* A, const bf16* Wt, int K, const float* base, float* outp, const float* gate, float coef, LAS unsigned char* ring, int vcu, int G) {
    int tid = threadIdx.x; asm volatile("" : "+v"(tid));
    const int lane = tid & 63, wid = tid >> 6, fr = lane & 15, fq = lane >> 4; const int KW = K >> 3;
    for (int item = vcu; item < 256; item += G) {
        const int rt = (item >> 4) * 64, ct = (item & 15) * 64;
        const bf16* ap = A + (size_t)(rt + fr) * K + wid * KW + 8 * fq; const bf16* bp = Wt + (size_t)(ct + fr) * K + wid * KW + 8 * fq;
        const int erow = rt + (tid >> 3), ec0 = ct + 8 * (tid & 7), emb = 8 + (erow >> 6);
        const f32x4 pga = *(const f32x4*)(gate + (size_t)emb * MODLD + ec0), pgb = *(const f32x4*)(gate + (size_t)emb * MODLD + ec0 + 4);
        const f32x4 pr0 = *(const f32x4*)(base + (size_t)erow * DM + ec0), pr1 = *(const f32x4*)(base + (size_t)erow * DM + ec0 + 4);
        f32x4 acc[4][4];
#pragma unroll
        for (int mi = 0; mi < 4; ++mi)
#pragma unroll
            for (int nj = 0; nj < 4; ++nj) acc[mi][nj] = (f32x4){0.f, 0.f, 0.f, 0.f};
#pragma unroll 2
        for (int k0 = 0; k0 < KW; k0 += 32) {
            bf16x8 a[4], b[4];
#pragma unroll
            for (int i = 0; i < 4; ++i) { a[i] = *(const bf16x8*)(ap + (size_t)(16 * i) * K + k0); b[i] = *(const bf16x8*)(bp + (size_t)(16 * i) * K + k0); }
#pragma unroll
            for (int mi = 0; mi < 4; ++mi)
#pragma unroll
                for (int nj = 0; nj < 4; ++nj) acc[mi][nj] = __builtin_amdgcn_mfma_f32_16x16x32_bf16(b[nj], a[mi], acc[mi][nj], 0, 0, 0);
        }
        LAS float* P = (LAS float*)(ring + wid * 16384);
#pragma unroll
        for (int mi = 0; mi < 4; ++mi)
#pragma unroll
            for (int nj = 0; nj < 4; ++nj) { const int row = mi * 16 + fr, grp = (nj * 4 + fq) ^ (row & 15); *(LAS f32x4*)(P + row * 64 + grp * 4) = acc[mi][nj]; }
        __syncthreads();
        { const int row = tid >> 3, j = tid & 7; const int g0 = (2 * j) ^ (row & 15), g1 = (2 * j + 1) ^ (row & 15);
          f32x4 s0 = (f32x4){0.f, 0.f, 0.f, 0.f}, s1 = s0;
#pragma unroll
          for (int w = 0; w < 8; ++w) { const LAS float* p = (const LAS float*)(ring + w * 16384) + row * 64; s0 += *(const LAS f32x4*)(p + g0 * 4); s1 += *(const LAS f32x4*)(p + g1 * 4); }
          const int grow = rt + row, c0 = ct + 8 * j; const int mb = 8 + (grow >> 6);
          const f32x4 ga = pga * coef, gb = pgb * coef; const f32x4 r0 = pr0, r1 = pr1; (void)mb;
          *(f32x4*)(outp + (size_t)grow * DM + c0) = r0 + ga * s0; *(f32x4*)(outp + (size_t)grow * DM + c0 + 4) = r1 + gb * s1; }
        __syncthreads();
    }
}
__device__ __forceinline__ void stage_fb(LAS float* fb, LAS float* wtot, const float* src0, int n0, const float* src1, int n1) {
    int tid = threadIdx.x; asm volatile("" : "+v"(tid)); const int lane = tid & 63, wid = tid >> 6; const int n = n0 + n1, e = 4 * tid;
    f32x4 v = (f32x4){0.f, 0.f, 0.f, 0.f};
    if (e < n) v = (e < n0) ? *(const f32x4*)(src0 + e) : *(const f32x4*)(src1 + (e - n0));
    const float s0 = v[0], s1 = s0 + v[1], s2 = s1 + v[2], s3 = s2 + v[3];
    float inc = s3;
#pragma unroll
    for (int o = 1; o < 64; o <<= 1) { const float t = __shfl_up(inc, o); if (lane >= o) inc += t; }
    if (lane == 63) wtot[wid] = inc;
    __syncthreads();
    float base = inc - s3;
#pragma unroll
    for (int w = 0; w < 8; ++w) { const float tw = wtot[w]; if (w < wid) base += tw; }
    const float c = -1.4426950408889634f;
    if (e < n) *(LAS f32x4*)(fb + e) = (f32x4){(base + s0) * c, (base + s1) * c, (base + s2) * c, (base + s3) * c};
    __syncthreads();
}
__device__ __forceinline__ void attn_sample_unit(int b, int h, const float* cK, const float* cV, const bf16* QB, const bf16* KB, const bf16* VB, const attn_body::MergeCtx& mc,
                                                 LAS unsigned char* ring, const LAS float* fb, LAS float* stats) {
    using attn_body::crow;
    int tid = threadIdx.x; asm volatile("" : "+v"(tid));
    const int lane = tid & 63, r32 = lane & 31, hi = lane >> 5; const int wid = __builtin_amdgcn_readfirstlane(tid >> 6);
    const size_t rowbase = (size_t)MP + (size_t)b * TS;
    LAS unsigned char* Ks = ring + wid * 16384; LAS unsigned char* Vs = Ks + 8192;
    LAS float* wsf = stats + 1024 + wid * 64;
    LAS unsigned char* QL = ring + (QL_OFF - RING_OFF);
    { const int row = tid >> 3, ch = tid & 7; *(LAS v4u*)(QL + row * 144 + ch * 16) = *(const v4u*)(QB + (rowbase + row) * DM + h * HD + ch * 8); }
    __syncthreads();
    float mhat[2], lsum[2] = {0.f, 0.f}; f32x16 o[2][2];
#pragma unroll
    for (int g = 0; g < 2; ++g) { mhat[g] = fb[PAST + 32 * g + r32]; o[g][0] = f32x16{}; o[g][1] = f32x16{}; }
    const int vb = (int)(unsigned)(uintptr_t)Vs + ((lane >> 4) & 1) * 32 + (lane & 3) * 8 + (4 * hi + ((lane & 15) >> 2)) * 64;
#pragma unroll 1
    for (int tl = wid; tl < 17; tl += 8) {
        if (tl < 16) {
            const f32x4* ksrc = (const f32x4*)(cK + ((size_t)(b * NH + h) * PAST + tl * 64) * HD); const f32x4* vsrc = (const f32x4*)(cV + ((size_t)(b * NH + h) * PAST + tl * 64) * HD);
#pragma unroll 1
            for (int hb = 0; hb < 16; hb += 8) {
                f32x4 kva[8], vva[8];
#pragma unroll
                for (int i = 0; i < 8; ++i) { kva[i] = __builtin_nontemporal_load(ksrc + (hb + i) * 64 + lane); vva[i] = __builtin_nontemporal_load(vsrc + (hb + i) * 64 + lane); }
#pragma unroll
                for (int i = 0; i < 8; ++i) { const int key = 4 * (hb + i) + (lane >> 4), d = (lane & 15) * 4; const f32x4 kv = kva[i], vv = vva[i];
                    v2u kw, vw; kw.x = pk2(kv.x, kv.y); kw.y = pk2(kv.z, kv.w); vw.x = pk2(vv.x, vv.y); vw.y = pk2(vv.z, vv.w);
                    *(LAS v2u*)(Ks + (d >> 3) * 1024 + key * 16 + (d & 7) * 2) = kw;
                    *(LAS v2u*)(Vs + ((d >> 5) * 4 + (key >> 4)) * 1024 + (key & 15) * 64 + (d & 31) * 2) = vw; }
            }
        } else {
#pragma unroll 1
            for (int hb = 0; hb < 8; hb += 4) {
                v4u kvb[4], vvb[4];
#pragma unroll
                for (int i = 0; i < 4; ++i) { const int key = 8 * (hb + i) + (lane >> 3), ch = lane & 7; const size_t off = (rowbase + key) * DM + h * HD + ch * 8; kvb[i] = *(const v4u*)(KB + off); vvb[i] = *(const v4u*)(VB + off); }
#pragma unroll
                for (int i = 0; i < 4; ++i) { const int key = 8 * (hb + i) + (lane >> 3), ch = lane & 7;
                    *(LAS v4u*)(Ks + ch * 1024 + key * 16) = kvb[i];
                    *(LAS v4u*)(Vs + ((ch >> 2) * 4 + (key >> 4)) * 1024 + (key & 15) * 64 + (ch & 3) * 16) = vvb[i]; }
            }
        }
        LDS_WAIT();
#pragma unroll
        for (int g = 0; g < 2; ++g) {
            __builtin_amdgcn_sched_barrier(0);
            f32x16 p0, p1;
            { const LAS float* fp = fb + 64 * tl + 4 * hi;
#pragma unroll
              for (int i = 0; i < 4; ++i) { const f32x4 x = *(const LAS f32x4*)(fp + 8 * i), y = *(const LAS f32x4*)(fp + 32 + 8 * i);
#pragma unroll
                  for (int e = 0; e < 4; ++e) { p0[4 * i + e] = x[e] - mhat[g]; p1[4 * i + e] = y[e] - mhat[g]; } } }
            { const LAS unsigned char* kb = Ks + hi * 1024 + r32 * 16;
#pragma unroll
              for (int d0 = 0; d0 < 4; ++d0) { const bf16x8 b0 = *(const LAS bf16x8*)(kb + d0 * 2048), b1 = *(const LAS bf16x8*)(kb + d0 * 2048 + 512);
                  const bf16x8 qf = *(const LAS bf16x8*)(QL + (32 * g + r32) * 144 + d0 * 32 + hi * 16);
                  p0 = __builtin_amdgcn_mfma_f32_32x32x16_bf16(b0, qf, p0, 0, 0, 0); p1 = __builtin_amdgcn_mfma_f32_32x32x16_bf16(b1, qf, p1, 0, 0, 0); } }
            if (tl == 16) { const int qi = 32 * g + r32;
#pragma unroll
                for (int r = 0; r < 16; ++r) { const int kj = crow(r, hi); if (kj > qi) p0[r] = -INFINITY; if (kj + 32 > qi) p1[r] = -INFINITY; } }
            float rm = p0[0];
#pragma unroll
            for (int r = 1; r < 16; ++r) rm = fmaxf(rm, p0[r]);
#pragma unroll
            for (int r = 0; r < 16; ++r) rm = fmaxf(rm, p1[r]);
            rm = fmaxf(rm, __shfl_xor(rm, 32));
            const float dl = fmaxf(rm, 0.f);
            mhat[g] += dl;
            const float f = __builtin_amdgcn_exp2f(-dl);
            float sacc = 0.f;
#pragma unroll
            for (int r = 0; r < 16; ++r) { p0[r] = __builtin_amdgcn_exp2f(p0[r] - dl); p1[r] = __builtin_amdgcn_exp2f(p1[r] - dl); sacc += p0[r] + p1[r]; }
            lsum[g] = lsum[g] * f + sacc;
            if (hi == 0) wsf[32 * g + r32] = f;
            LDS_WAIT();
#pragma unroll
            for (int r = 0; r < 16; ++r) { const float fr_ = wsf[32 * g + crow(r, hi)]; o[g][0][r] *= fr_; o[g][1][r] *= fr_; }
            v4u pw0, pw1, pw2, pw3;
#define PKW(P, B) attn_body::cvtpk_s(P[B], P[B + 1])
            pw0 = (v4u){PKW(p0, 0), PKW(p0, 2), PKW(p0, 4), PKW(p0, 6)}; pw1 = (v4u){PKW(p0, 8), PKW(p0, 10), PKW(p0, 12), PKW(p0, 14)};
            pw2 = (v4u){PKW(p1, 0), PKW(p1, 2), PKW(p1, 4), PKW(p1, 6)}; pw3 = (v4u){PKW(p1, 8), PKW(p1, 10), PKW(p1, 12), PKW(p1, 14)};
#undef PKW
            attn_body::pv(o[g], vb, __builtin_bit_cast(bf16x8, pw0), __builtin_bit_cast(bf16x8, pw1), __builtin_bit_cast(bf16x8, pw2), __builtin_bit_cast(bf16x8, pw3));
        }
        LDS_WAIT();
    }
#pragma unroll
    for (int g = 0; g < 2; ++g) { const float lt = lsum[g] + __shfl_xor(lsum[g], 32); if (hi == 0) { stats[wid * 64 + 32 * g + r32] = mhat[g]; stats[512 + wid * 64 + 32 * g + r32] = lt; } }
    __syncthreads();
    LAS float* Op = (LAS float*)(ring + wid * 16384);
#pragma unroll
    for (int g = 0; g < 2; ++g)
#pragma unroll
        for (int r = 0; r < 16; ++r) { const int q = 32 * g + crow(r, hi); float mx = stats[q];
#pragma unroll
            for (int w = 1; w < 8; ++w) mx = fmaxf(mx, stats[w * 64 + q]);
            const float scl = __builtin_amdgcn_exp2f(stats[wid * 64 + q] - mx);
            Op[q * 64 + r32] = o[g][0][r] * scl; Op[q * 64 + 32 + r32] = o[g][1][r] * scl; }
    __syncthreads();
    { const int q = tid >> 3, d0 = (tid & 7) * 8; float mx = stats[q];
#pragma unroll
      for (int w = 1; w < 8; ++w) mx = fmaxf(mx, stats[w * 64 + q]);
      float Lq = 0.f; f32x4 s0 = (f32x4){0.f, 0.f, 0.f, 0.f}, s1 = s0;
#pragma unroll
      for (int w = 0; w < 8; ++w) { Lq += stats[512 + w * 64 + q] * __builtin_amdgcn_exp2f(stats[w * 64 + q] - mx);
          const LAS float* p = (const LAS float*)(ring + w * 16384) + q * 64 + d0; s0 += *(const LAS f32x4*)p; s1 += *(const LAS f32x4*)(p + 4); }
      const float rl = 1.0f / Lq; s0 = s0 * rl; s1 = s1 * rl;
      v4u w; w.x = pk2(s0.x, s0.y); w.y = pk2(s0.z, s0.w); w.z = pk2(s1.x, s1.y); w.w = pk2(s1.z, s1.w);
      merge_store8(mc, rowbase + q, q, false, b, h * HD + d0, w); }
    __syncthreads();
}

__global__ void __launch_bounds__(NTHREADS, 2) fwd_mega(Args args) {
    extern __shared__ __attribute__((aligned(16))) unsigned char lds[];
    cg::grid_group grid = cg::this_grid();
    LAS unsigned char* L = (LAS unsigned char*)lds;
    const int G = gridDim.x; const int bx = blockIdx.x; const int vcu = (G % 8 == 0) ? (bx % 8) * (G / 8) + bx / 8 : bx;
    unsigned char* ws = args.ws; float* out = args.out; const float* mod = (const float*)(ws + WS_MOD);
    bf16* Hb = (bf16*)(ws + WS_H); bf16* ACT = (bf16*)(ws + WS_ACT);
    float* XR = out + O_Y;
    const int lo = args.ph_lo, hi = args.ph_hi;
#ifndef PH_MASK
#define PH_MASK 0x1fff
#endif
#define IN(k) (((PH_MASK >> (k)) & 1) && lo <= (k) && (k) < hi)
#define SEAM(k) do { if (IN(k) && IN((k) + 1)) xcd_barrier(bar); } while (0)

    unsigned* barw = (unsigned*)(ws + WS_BAR);
    volatile LAS unsigned* bst = (volatile LAS unsigned*)(L + STAT_OFF + 8000);
    unsigned* cntw = (unsigned*)(ws + WS_CNT);
    if (bx == 0) { for (int i = threadIdx.x; i < XCD_BAR_WORDS; i += NTHREADS) __hip_atomic_store(barw + i, 0u, __ATOMIC_RELAXED, __HIP_MEMORY_SCOPE_AGENT);
                   for (int i = threadIdx.x; i < CNT_WORDS; i += NTHREADS) __hip_atomic_store(cntw + i, 0u, __ATOMIC_RELAXED, __HIP_MEMORY_SCOPE_AGENT); }
    const bool fuse_rows = (G == 256);
    const int wv = threadIdx.x >> 6, ln = threadIdx.x & 63;
    bf16* Hb2 = (bf16*)(ws + WS_GAB);
#define HANDOFF(inst, S) pg8::Unit hu; S.next(0, hu); const int rt_ = vcu >> 4, ct_ = vcu & 15; \
        panel_handoff(cntw + ((inst) * 80 + hu.pm) * 16, cntw + ((inst) * 80 + 64 + rt_) * 16)
    if (IN(0)) { p0_mod(args, L, vcu, G); p0_weights(args, L, vcu, G); }
    if (threadIdx.x < 2) bst[threadIdx.x] = 0u;
    grid.sync();
    const XcdBarrier bar = xcd_barrier_post(barw, bst);
    if (IN(1)) norm_mod_rows(args.in[0], args.in[1], args.in[10], mod, 0 * DM, 1 * DM, Hb, vcu, G);
    SEAM(1);
    if (IN(2)) { pg8::Gemm g{Hb, (const bf16*)(ws + WS_W1IN), MT, 2 * DFF, DM}; pg8::StaticOrder S; S.init(MT, 2 * DFF, G, bx);
        pg8::EpiSwiGLU E{ACT, DFF}; pg8::gemm_phase<pg8::EpiSwiGLU, pg8::StaticOrder, PG8_ALIGN, PG8_SP2>(L + RING_OFF, g, S, E);
        constexpr int NF = (68 * 22) % 256;
        if (G == 256 && bx >= NF) weight_items_tail(args, L, WCUT0, WCUT1, (bx - NF) * NWAVES + (int)(threadIdx.x >> 6), (256 - NF) * NWAVES); }
    SEAM(2);
    if (IN(3)) { pg8::Gemm g{ACT, (const bf16*)(ws + WS_W1OUT), MP, DM, DFF}; pg8::StaticOrder S; S.init(MP, DM, G, bx);
        pg8::EpiResid<true> E{args.in[0], args.in[1], XR, mod + 2 * DM, 0.5f}; pg8::gemm_phase<pg8::EpiResid<true>, pg8::StaticOrder, false, PG8_SP2>(L + RING_OFF, g, S, E);
        small_gemm_sample(ACT + (size_t)MP * DFF, (const bf16*)(ws + WS_W1OUT), DFF, args.in[1], XR + (size_t)MP * DM, mod + 2 * DM, 0.5f, L + RING_OFF, vcu, G);
        if (fuse_rows) { HANDOFF(0, S);
            norm_rows4<false, false, 8>(hu.pm * 256 + hu.pn * 64 + wv * 8, XR, XR + (size_t)MP * DM, args.in[13], mod, 3 * DM, 4 * DM, Hb, nullptr, ln);
            if (wv == 0) norm_rows4<false>(MP + rt_ * 64 + ct_ * 4, XR, XR + (size_t)MP * DM, args.in[13], mod, 3 * DM, 4 * DM, Hb, nullptr, ln); } }
    if (!fuse_rows) { SEAM(3); if (IN(4)) norm_mod_rows(XR, XR + (size_t)MP * DM, args.in[13], mod, 3 * DM, 4 * DM, Hb, vcu, G); }
    SEAM(4);
    if (IN(5)) { pg8::Gemm g{Hb, (const bf16*)(ws + WS_WIN), MT, NINP, DM}; pg8::StaticOrder S; S.init(MT, NINP, G, bx);
        pg8::EpiMix E{(bf16*)(ws + WS_QB), out, args.in[15], attn_body::C2};
        pg8::gemm_phase<pg8::EpiMix, pg8::StaticOrder, PG8_ALIGN, PG8_SP2>(L + RING_OFF, g, S, E);
        constexpr int NF = (68 * 33) % 256;
        if (G == 256 && bx >= NF) weight_items_tail(args, L, WCUT1, WITEMS, (bx - NF) * NWAVES + (int)(threadIdx.x >> 6), (256 - NF) * NWAVES); }
    SEAM(5);
    if (IN(6)) {
        const attn_body::bf16* Q = (const attn_body::bf16*)(ws + WS_QB); const attn_body::bf16* K = (const attn_body::bf16*)(ws + WS_KB); const attn_body::bf16* V = (const attn_body::bf16*)(ws + WS_VB);
        LAS float* fb = (LAS float*)(L + FB_OFF); LAS float* stats = (LAS float*)(L + STAT_OFF);
        const attn_body::MergeCtx mc{(const bf16*)(ws + WS_GAB), (const bf16*)(ws + WS_G2B), (const bf16*)(ws + WS_UB), args.in[16], args.in[5], Hb};
#pragma unroll 1
        for (int pass = 0; pass < 2; ++pass) {
        const bool do_sample = ((vcu & 1) != 0) == (pass == 0);
        if (!do_sample) {
        for (int it = vcu; it < 512; it += G) {
            const int bh = it >> 2, k = it & 3;
            stage_fb(fb, stats, out + O_LFP + (size_t)bh * TP, TP, nullptr, 0);
#pragma unroll 1
            for (int j = 0; j < 2; ++j) attn_body::attn_unit<8>(bh >> 4, bh & 15, j ? k : 7 - k, Q, K, V, mc, (char*)lds + RING_OFF, fb);
        }
        } else {
        for (int it = vcu; it < 256; it += G) {
            const int b = it >> 4, h = it & 15;
            stage_fb(fb, stats, args.in[4] + (size_t)it * PAST, PAST, out + O_LFS + (size_t)it * TS, TS);
            attn_sample_unit(b, h, args.in[2], args.in[3], (const bf16*)(ws + WS_QB), (const bf16*)(ws + WS_KB), (const bf16*)(ws + WS_VB), mc, L + RING_OFF, fb, stats);
        }
        }
        }
    }
    SEAM(6);
    if (IN(8)) { pg8::Gemm g{Hb, (const bf16*)(ws + WS_WOUT), MP, DM, DM}; pg8::StaticOrder S; S.init(MP, DM, G, bx);
        pg8::EpiResid<false> E{XR, XR + (size_t)MP * DM, XR, mod + 5 * DM, 1.0f}; pg8::gemm_phase<pg8::EpiResid<false>, pg8::StaticOrder, false, PG8_SP2>(L + RING_OFF, g, S, E);
        small_gemm_sample(Hb + (size_t)MP * DM, (const bf16*)(ws + WS_WOUT), DM, XR + (size_t)MP * DM, XR + (size_t)MP * DM, mod + 5 * DM, 1.0f, L + RING_OFF, vcu, G);
        if (fuse_rows) { HANDOFF(1, S);
            norm_rows4<false, false, 8>(hu.pm * 256 + hu.pn * 64 + wv * 8, XR, XR + (size_t)MP * DM, args.in[18], mod, 6 * DM, 7 * DM, Hb2, nullptr, ln);
            if (wv == 0) norm_rows4<false>(MP + rt_ * 64 + ct_ * 4, XR, XR + (size_t)MP * DM, args.in[18], mod, 6 * DM, 7 * DM, Hb2, nullptr, ln); } }
    if (!fuse_rows) { SEAM(8); if (IN(9)) norm_mod_rows(XR, XR + (size_t)MP * DM, args.in[18], mod, 6 * DM, 7 * DM, Hb2, vcu, G); }
    SEAM(9);
    if (IN(10)) { pg8::Gemm g{Hb2, (const bf16*)(ws + WS_W2IN), MT, 2 * DFF, DM}; pg8::StaticOrder S; S.init(MT, 2 * DFF, G, bx);
        pg8::EpiSwiGLU E{ACT, DFF}; pg8::gemm_phase<pg8::EpiSwiGLU, pg8::StaticOrder, PG8_ALIGN, PG8_SP2>(L + RING_OFF, g, S, E); }
    SEAM(10);
    if (IN(11)) { pg8::Gemm g{ACT, (const bf16*)(ws + WS_W2OUT), MP, DM, DFF}; pg8::StaticOrder S; S.init(MP, DM, G, bx);
        pg8::EpiResid<false> E{XR, XR + (size_t)MP * DM, XR, mod + 8 * DM, 0.5f}; pg8::gemm_phase<pg8::EpiResid<false>, pg8::StaticOrder, false, PG8_SP2>(L + RING_OFF, g, S, E);
        small_gemm_sample(ACT + (size_t)MP * DFF, (const bf16*)(ws + WS_W2OUT), DFF, XR + (size_t)MP * DM, XR + (size_t)MP * DM, mod + 8 * DM, 0.5f, L + RING_OFF, vcu, G);
        if (fuse_rows) { HANDOFF(2, S);
            norm_rows4<true, false, 8>(hu.pm * 256 + hu.pn * 64 + wv * 8, XR, XR + (size_t)MP * DM, args.in[21], nullptr, 0, 0, nullptr, XR, ln);
            if (wv == 0) norm_rows4<true>(MP + rt_ * 64 + ct_ * 4, XR, XR + (size_t)MP * DM, args.in[21], nullptr, 0, 0, nullptr, XR, ln); } }
    if (!fuse_rows) { SEAM(11); if (IN(12)) final_norm_rows(XR, args.in[21], vcu, G); }
#undef IN
#undef SEAM
}

#ifndef MK_N_LAUNCHES
#define MK_N_LAUNCHES 1
#endif
constexpr int N_PHASES = 13;
extern "C" void kernel_launch(void* const* d_in, const int* in_sizes, int n_in, void* d_out, int out_size, void* d_ws, size_t ws_size, hipStream_t stream) {
    static int grid = 0;
    if (grid == 0) {
        if (n_in != 22 || out_size != (int)O_END || ws_size < WS_END) { fprintf(stderr, "kernel_launch: unexpected sizes n_in %d out %d ws %zu; nothing launched\n", n_in, out_size, ws_size); grid = -1; return; }
        int dev = 0, cus = 0, per_cu = 0;
        if (hipGetDevice(&dev) != hipSuccess || hipDeviceGetAttribute(&cus, hipDeviceAttributeMultiprocessorCount, dev) != hipSuccess) { grid = -1; return; }
        if (hipFuncSetAttribute((const void*)fwd_mega, hipFuncAttributeMaxDynamicSharedMemorySize, LDS_BYTES) != hipSuccess) { fprintf(stderr, "kernel_launch: hipFuncSetAttribute failed\n"); grid = -1; return; }
        if (hipOccupancyMaxActiveBlocksPerMultiprocessor(&per_cu, (const void*)fwd_mega, NTHREADS, LDS_BYTES) != hipSuccess || per_cu < 1) { fprintf(stderr, "kernel_launch: occupancy query says %d\n", per_cu); (void)hipGetLastError(); grid = -1; return; }
        grid = cus * 1;
        fprintf(stderr, "kernel_launch: grid %d (cus %d, per_cu %d), ws %zu\n", grid, cus, per_cu, ws_size);
    }
    if (grid < 0) return;
    Args a{};
    for (int i = 0; i < 22; ++i) a.in[i] = (const float*)d_in[i];
    a.out = (float*)d_out; a.ws = (unsigned char*)d_ws;
#if MK_N_LAUNCHES == 1
    a.ph_lo = 0; a.ph_hi = N_PHASES;
    void* kargs[] = {&a};
    hipError_t e = hipLaunchCooperativeKernel((const void*)fwd_mega, dim3(grid), dim3(NTHREADS), kargs, LDS_BYTES, stream);
    if (e != hipSuccess) fprintf(stderr, "kernel_launch: cooperative launch failed: %s (grid %d)\n", hipGetErrorString(e), grid);
#else
    for (int p = 0; p < N_PHASES; ++p) { a.ph_lo = p; a.ph_hi = p + 1; void* kargs[] = {&a};
        hipError_t e = hipLaunchCooperativeKernel((const void*)fwd_mega, dim3(grid), dim3(NTHREADS), kargs, LDS_BYTES, stream);
        if (e != hipSuccess) { fprintf(stderr, "kernel_launch: launch %d failed: %s\n", p, hipGetErrorString(e)); break; } }
#endif
}
```

```cpp
#include <hip/hip_runtime.h>
#include <hip/hip_cooperative_groups.h>
#include <cstdio>
#include <cstdint>
constexpr int MODLD = 9216;
constexpr int DM = 1024, MP = 16384, MS = 1024, MT = MP + MS, TP = 2048, TS = 64, PAST = 1024, NH = 16, HD = 64, DFF = 2816, NIN = 8208, NINP = 8448, NMOD = 9;
constexpr int OFF_Q = 0, OFF_K = 1024, OFF_V = 2048, OFF_F = 3072, OFF_B = 3088, OFF_C = 4112, OFF_X = 5136, OFF_GA = 6160, OFF_GC = 7184;
constexpr float EPS = 1e-6f;
constexpr size_t O_Y = 0, O_KP = (size_t)MT * DM, O_VP = O_KP + (size_t)MP * DM, O_LFP = O_VP + (size_t)MP * DM, O_CVP = O_LFP + 8 * 16 * 2048, O_KS = O_CVP + 8 * 2 * 1024,
                 O_VS = O_KS + (size_t)MS * DM, O_LFS = O_VS + (size_t)MS * DM, O_CVS = O_LFS + 16 * 16 * 64, O_END = O_CVS + 16 * 2 * 1024;
static_assert(O_END == 53805056, "d_out map");
namespace pg8 {
#define PG8_LAS __attribute__((address_space(3)))
typedef unsigned short bf16_t;
typedef short bf16x8 __attribute__((ext_vector_type(8)));
typedef float f32x4 __attribute__((ext_vector_type(4)));
typedef unsigned u32x4 __attribute__((ext_vector_type(4)));
constexpr int BM = 256, BK = 64, HALF = 128, HTB = HALF * BK * 2  , STAGE_BYTES = 8 * HTB, NXCD = 8, WGM = 8;

__host__ __device__ __forceinline__ int lds_byte(int r, int c) { const int st = (r >> 4) * 2 + (c >> 5), rr = r & 15, cc = c & 31, ob = rr * 64 + cc * 2; return st * 1024 + (ob ^ (((ob >> 9) & 1) << 5)); }
__host__ __device__ __forceinline__ void stage_rc(int b, int& R, int& C) { const int st = b / 1024, sb = b % 1024, swz = sb ^ (((sb >> 9) & 1) << 5); R = (st >> 1) * 16 + swz / 64; C = (st & 1) * 32 + (swz % 64) / 2; }
__host__ __device__ __forceinline__ int perm32(int rho) { const int n = rho >> 4, i = rho & 15; return 8 * (i >> 2) + 4 * n + (i & 3); }

struct Unit { int pm, pn; };
struct Gemm { const bf16_t* A; const bf16_t* Bt; int M, N, K; };

struct StaticOrder {
    int nM, nN, nwg, G, c;
    __host__ __device__ void init(int M, int N, int G_, int c_) { nM = M / BM; nN = N / BM; nwg = nM * nN; G = G_; c = c_; }
    __host__ __device__ bool next(int i, Unit& u) const {
        const long L = (long)i * G + c; if (L >= nwg) return false;
        int wgid = (int)L; { const int q = nwg / NXCD, r = nwg % NXCD, xcd = wgid % NXCD, off = wgid / NXCD; wgid = (xcd < r ? xcd * (q + 1) : r * (q + 1) + (xcd - r) * q) + off; }
        const int nig = WGM * nN, gid = wgid / nig, fm = gid * WGM, gsz = (nM - fm) < WGM ? (nM - fm) : WGM;
        u.pm = fm + ((wgid % nig) % gsz); u.pn = (wgid % nig) / gsz; return true;
    }
    __device__ __forceinline__ void a_ready(const Unit&) const {}
    __device__ __forceinline__ void done(const Unit&) const {}
};

__device__ __forceinline__ unsigned cvt_pk_bf16(float lo, float hi) { unsigned r; asm volatile("v_cvt_pk_bf16_f32 %0, %1, %2" : "=v"(r) : "v"(lo), "v"(hi)); return r; }

constexpr int MPROMPT = 16384;
__device__ __forceinline__ int mod_batch(int pm, int ai, int wr) { return pm < 64 ? (pm >> 3) : 8 + (pm - 64) * 4 + 2 * ai + wr; }
__device__ __forceinline__ float sigmoid_f(float x) { return __builtin_amdgcn_rcpf(1.0f + __builtin_amdgcn_exp2f(-1.4426950408889634f * x)); }
__device__ __forceinline__ f32x4 sigmoid4(f32x4 x) { return (f32x4){sigmoid_f(x[0]), sigmoid_f(x[1]), sigmoid_f(x[2]), sigmoid_f(x[3])}; }
__device__ __forceinline__ u32x4 pack8(f32x4 v0, f32x4 v1) { u32x4 w; w.x = cvt_pk_bf16(v0[0], v0[1]); w.y = cvt_pk_bf16(v0[2], v0[3]); w.z = cvt_pk_bf16(v1[0], v1[1]); w.w = cvt_pk_bf16(v1[2], v1[3]); return w; }

struct EpiSwiGLU {
    static constexpr bool PERM = true, AFTER_DRAIN = false;
    bf16_t* O; int ldc;
    __device__ __forceinline__ void operator()(const f32x4 (&acc)[2][2][4][2], const Unit& u, int wr, int wc, int fr, int fq) const {
        const int row0 = u.pm * BM + wr * 64 + fr, col0 = u.pn * HALF + wc * 32 + 8 * fq;
#pragma unroll
        for (int ai = 0; ai < 2; ++ai)
#pragma unroll
            for (int m = 0; m < 4; ++m) {
                const f32x4 a0 = acc[ai][0][m][0], a1 = acc[ai][0][m][1];
                const f32x4 v0 = a0 * sigmoid4(a0) * acc[ai][1][m][0], v1 = a1 * sigmoid4(a1) * acc[ai][1][m][1];
                *(u32x4*)(O + (size_t)(row0 + ai * HALF + m * 16) * ldc + col0) = pack8(v0, v1);
            }
    }
};
template <bool NTB> struct EpiResid {
    static constexpr bool PERM = true, AFTER_DRAIN = false;
    const float* baseP; const float* baseS; float* out; const float* gate; float coef;
    __device__ __forceinline__ void operator()(const f32x4 (&acc)[2][2][4][2], const Unit& u, int wr, int wc, int fr, int fq) const {
        const int col0 = u.pn * BM + wc * 32 + 8 * fq;
#pragma unroll
        for (int ai = 0; ai < 2; ++ai) {
            const float* gp = gate + (size_t)mod_batch(u.pm, ai, wr) * MODLD + col0;
            f32x4 g[2][2];
#pragma unroll
            for (int bj = 0; bj < 2; ++bj)
#pragma unroll
                for (int n = 0; n < 2; ++n) g[bj][n] = *(const f32x4*)(gp + bj * HALF + 4 * n) * coef;
            f32x4 bsv[4][2][2];
#pragma unroll
            for (int m = 0; m < 4; ++m) {
                const int row = u.pm * BM + ai * HALF + wr * 64 + m * 16 + fr;
                const float* bp = (u.pm < 64 ? baseP + (size_t)row * 1024 : baseS + (size_t)(row - MPROMPT) * 1024) + col0;
#pragma unroll
                for (int bj = 0; bj < 2; ++bj)
#pragma unroll
                    for (int n = 0; n < 2; ++n) { const f32x4* p = (const f32x4*)(bp + bj * HALF + 4 * n); bsv[m][bj][n] = NTB ? __builtin_nontemporal_load(p) : *p; }
            }
            asm volatile("" ::: "memory");
#pragma unroll
            for (int m = 0; m < 4; ++m) {
                const int row = u.pm * BM + ai * HALF + wr * 64 + m * 16 + fr;
                float* op = out + (size_t)row * 1024 + col0;
#pragma unroll
                for (int bj = 0; bj < 2; ++bj)
#pragma unroll
                    for (int n = 0; n < 2; ++n) *(f32x4*)(op + bj * HALF + 4 * n) = bsv[m][bj][n] + g[bj][n] * acc[ai][bj][m][n];
            }
        }
    }
};
struct EpiMix {
    static constexpr bool PERM = true, AFTER_DRAIN = false;
    bf16_t* QB; float* outp; const float* b_f; float qscale;
    static constexpr size_t BSTRIDE = (size_t)MT * DM;
    __device__ __forceinline__ void operator()(const f32x4 (&acc)[2][2][4][2], const Unit& u, int wr, int wc, int fr, int fq) const {
        const int pn = u.pn; const bool prm = u.pm < 64;
        const int row0 = u.pm * BM + wr * 64 + fr;
        if (pn < 16) {
            const int seg = pn >> 2, colt = (pn & 3) * BM + wc * 32 + 8 * fq;
            bf16_t* dst = QB + (size_t)seg * BSTRIDE;
            const float sc = seg == 0 ? qscale : 1.f;
            float* fo = outp + (seg == 1 ? (prm ? O_KP : O_KS) : (prm ? O_VP : O_VS));
#pragma unroll
            for (int ai = 0; ai < 2; ++ai)
#pragma unroll
                for (int m = 0; m < 4; ++m) {
                    const int row = row0 + ai * HALF + m * 16;
                    const int rr = prm ? row : row - MPROMPT; const int bb = prm ? (rr >> 11) : (rr >> 6), tt = prm ? (rr & 2047) : (rr & 63), TT = prm ? 2048 : 64;
#pragma unroll
                    for (int bj = 0; bj < 2; ++bj) {
                        f32x4 v0 = acc[ai][bj][m][0], v1 = acc[ai][bj][m][1]; const int col = colt + bj * HALF;
                        if (seg == 1 || seg == 2) { float* p = fo + ((size_t)(bb * 16 + (col >> 6)) * TT + tt) * 64 + (col & 63); __builtin_nontemporal_store(v0, (f32x4*)p); __builtin_nontemporal_store(v1, (f32x4*)(p + 4)); }
                        if (seg == 3) { v0 = sigmoid4(v0); v1 = sigmoid4(v1); }
                        v0 = v0 * sc; v1 = v1 * sc;
                        *(u32x4*)(dst + (size_t)row * 1024 + col) = pack8(v0, v1);
                    }
                }
        } else if (pn < 32) {
            const bool cx = pn >= 24; const int col = ((pn - 16) & 7) * HALF + wc * 32 + 8 * fq;
            bf16_t* dst = QB + (size_t)(cx ? 5 : 4) * BSTRIDE;
#pragma unroll
            for (int ai = 0; ai < 2; ++ai)
#pragma unroll
                for (int m = 0; m < 4; ++m) {
                    const int row = row0 + ai * HALF + m * 16;
                    f32x4 v0, v1;
                    if (cx) { v0 = acc[ai][0][m][0] * acc[ai][1][m][0]; v1 = acc[ai][0][m][1] * acc[ai][1][m][1]; }
                    else { v0 = acc[ai][0][m][0] * sigmoid4(acc[ai][1][m][0]); v1 = acc[ai][0][m][1] * sigmoid4(acc[ai][1][m][1]); }
                    *(u32x4*)(dst + (size_t)row * 1024 + col) = pack8(v0, v1);
                    if (cx) {
                        const int rr = prm ? row : row - MPROMPT; const int bb = prm ? (rr >> 11) : (rr >> 6), tt = prm ? (rr & 2047) : (rr & 63), TT = prm ? 2048 : 64;
                        if (tt >= TT - 2) { float* p = outp + (prm ? O_CVP : O_CVS) + (size_t)(bb * 2 + (tt - (TT - 2))) * 1024 + col; *(f32x4*)p = v0; *(f32x4*)(p + 4) = v1; }
                    }
                }
        } else {
            if (wc == 0 && fq < 2) {
                const f32x4 bf0 = *(const f32x4*)(b_f + 8 * fq), bf1 = *(const f32x4*)(b_f + 8 * fq + 4);
                asm volatile("" ::: "memory");
#pragma unroll
                for (int ai = 0; ai < 2; ++ai)
#pragma unroll
                    for (int m = 0; m < 4; ++m) {
                        const int row = row0 + ai * HALF + m * 16;
                        const int rr = prm ? row : row - MPROMPT; const int bb = prm ? (rr >> 11) : (rr >> 6), tt = prm ? (rr & 2047) : (rr & 63), TT = prm ? 2048 : 64;
                        float* fo = outp + (prm ? O_LFP : O_LFS);
#pragma unroll
                        for (int n = 0; n < 2; ++n)
#pragma unroll
                            for (int e = 0; e < 4; ++e) {
                                const int hh = 8 * fq + 4 * n + e; const float v = acc[ai][0][m][n][e] + (n ? bf1[e] : bf0[e]);
                                const float ls = fminf(v, 0.f) - __logf(1.0f + __expf(-fabsf(v)));
                                fo[(size_t)(bb * 16 + hh) * TT + tt] = ls;
                            }
                    }
            }
        }
    }
};
template <class Epi, class Sched, bool ALIGN_EPI = false, bool SP2 = false>
__device__ __forceinline__ void gemm_phase(PG8_LAS unsigned char* lds, const Gemm g, const Sched& S, const Epi& E) {
    const int tid = threadIdx.x, wid = __builtin_amdgcn_readfirstlane(tid >> 6), lane = tid & 63, wr = wid >> 2, wc = wid & 3, fr = lane & 15, fq = lane >> 4;
    const int K = g.K, nt = K / BK;
    unsigned voffA[2], voffB[2];
#pragma unroll
    for (int i = 0; i < 2; ++i) { int R, C; stage_rc(tid * 16 + i * 8192, R, C); const int Rb = Epi::PERM ? ((R & ~31) + perm32(R & 31)) : R;
        voffA[i] = (unsigned)(R * K + C) * 2u; voffB[i] = (unsigned)(Rb * K + C) * 2u; }
    const size_t kstep = (size_t)(BK * 2);
    const size_t hstep = (size_t)HALF * K * 2;
    const size_t tstep = 2 * hstep;
    const unsigned ldsw = (unsigned)wid * 1024u;
    const int aoff = lds_byte(wr * 64 + fr, fq * 8), boff = lds_byte(wc * 32 + fr, fq * 8);
#define PG8_SA(b, h) (((b) * 2 + (h)) * HTB)
#define PG8_SB(b, h) ((4 + (b) * 2 + (h)) * HTB)
#define PG8_STAGE(bufoff, gbase, voff) do { _Pragma("unroll") for (int _i = 0; _i < 2; ++_i) \
        __builtin_amdgcn_global_load_lds((const unsigned*)((const char*)(gbase) + (voff)[_i]), (PG8_LAS unsigned*)(lds + (bufoff) + ldsw + _i * 8192), 16, 0, 0); } while (0)
#define PG8_LDA(dst, b, h) do { _Pragma("unroll") for (int m = 0; m < 4; ++m) _Pragma("unroll") for (int k = 0; k < 2; ++k) dst[m][k] = *(const PG8_LAS bf16x8*)(lds + PG8_SA(b, h) + aoff + m * 2048 + k * 1024); } while (0)
#define PG8_LDB(dst, b, h) do { _Pragma("unroll") for (int n = 0; n < 2; ++n) _Pragma("unroll") for (int k = 0; k < 2; ++k) dst[n][k] = *(const PG8_LAS bf16x8*)(lds + PG8_SB(b, h) + boff + n * 2048 + k * 1024); } while (0)
#define PG8_MMA(ai, bj, At, Bt) do { __builtin_amdgcn_s_setprio(1); _Pragma("unroll") for (int m = 0; m < 4; ++m) _Pragma("unroll") for (int n = 0; n < 2; ++n) _Pragma("unroll") for (int k = 0; k < 2; ++k) \
        acc[ai][bj][m][n] = __builtin_amdgcn_mfma_f32_16x16x32_bf16(Bt[n][k], At[m][k], acc[ai][bj][m][n], 0, 0, 0); __builtin_amdgcn_s_setprio(0); } while (0)
#define PG8_WAIT_V(n) asm volatile("s_waitcnt vmcnt(" #n ")" ::: "memory")
#define PG8_WAIT_L(n) asm volatile("s_waitcnt lgkmcnt(" #n ")" ::: "memory")
#define PG8_BAR __builtin_amdgcn_s_barrier()
#define PG8_SCHED __builtin_amdgcn_sched_barrier(0)
    Unit cur, nxt; int ui = 0;
    if (!S.next(0, cur)) return;
    f32x4 acc[2][2][4][2];
#pragma unroll
    for (int a = 0; a < 2; ++a)
#pragma unroll
        for (int b = 0; b < 2; ++b)
#pragma unroll
            for (int m = 0; m < 4; ++m)
#pragma unroll
                for (int n = 0; n < 2; ++n) acc[a][b][m][n] = (f32x4){0.f, 0.f, 0.f, 0.f};
    bf16x8 At[4][2], B0[2][2], B1[2][2];
    const char* cA = (const char*)g.A + (size_t)cur.pm * tstep; const char* cB = (const char*)g.Bt + (size_t)cur.pn * tstep;
    S.a_ready(cur);
    if constexpr (SP2) {
        PG8_STAGE(PG8_SB(0, 0), cB, voffB); PG8_STAGE(PG8_SB(0, 1), cB + hstep, voffB); PG8_STAGE(PG8_SA(0, 0), cA, voffA); PG8_STAGE(PG8_SA(0, 1), cA + hstep, voffA);
        if (wr == 1) PG8_BAR;
        PG8_WAIT_V(2); PG8_BAR;
        PG8_STAGE(PG8_SB(1, 0), cB + kstep, voffB); PG8_STAGE(PG8_SA(1, 0), cA + kstep, voffA); PG8_STAGE(PG8_SB(1, 1), cB + hstep + kstep, voffB);
        PG8_WAIT_V(6); PG8_BAR;
    } else {
        PG8_STAGE(PG8_SB(0, 0), cB, voffB); PG8_STAGE(PG8_SA(0, 0), cA, voffA); PG8_STAGE(PG8_SB(0, 1), cB + hstep, voffB); PG8_STAGE(PG8_SA(0, 1), cA + hstep, voffA);
        if (wr == 1) PG8_BAR;
        PG8_WAIT_V(4); PG8_BAR;
        PG8_STAGE(PG8_SB(1, 0), cB + kstep, voffB); PG8_STAGE(PG8_SA(1, 0), cA + kstep, voffA); PG8_STAGE(PG8_SB(1, 1), cB + hstep + kstep, voffB);
        PG8_WAIT_V(6); PG8_BAR;
    }
    for (;;) {
        const bool has_next = S.next(ui + 1, nxt);
        const char* nA = has_next ? (const char*)g.A + (size_t)nxt.pm * tstep : cA; const char* nB = has_next ? (const char*)g.Bt + (size_t)nxt.pn * tstep : cB;
        for (int t = 0; t < nt; t += 2) {
            const bool last = (t == nt - 2);
            const char* a1 = cA + (size_t)(t + 1) * kstep;
            const char* a2 = last ? nA : cA + (size_t)(t + 2) * kstep; const char* b2 = last ? nB : cB + (size_t)(t + 2) * kstep;
            const char* a3 = a2 + kstep; const char* b3 = b2 + kstep;
            if (last && has_next) S.a_ready(nxt);
            if constexpr (SP2) {
            PG8_LDB(B0, 0, 0); PG8_LDB(B1, 0, 1); PG8_SCHED; PG8_LDA(At, 0, 0); PG8_STAGE(PG8_SA(1, 1), a1 + hstep, voffA);
            PG8_WAIT_V(8); PG8_WAIT_L(0); PG8_BAR; PG8_MMA(0, 0, At, B0); PG8_MMA(0, 1, At, B1); PG8_BAR; PG8_SCHED;
            PG8_LDA(At, 0, 1); PG8_STAGE(PG8_SB(0, 0), b2, voffB); PG8_STAGE(PG8_SB(0, 1), b2 + hstep, voffB); PG8_STAGE(PG8_SA(0, 0), a2, voffA);
            PG8_WAIT_V(8); PG8_WAIT_L(0); PG8_BAR; PG8_MMA(1, 0, At, B0); PG8_MMA(1, 1, At, B1); PG8_BAR; PG8_SCHED;
            PG8_LDB(B0, 1, 0); PG8_LDB(B1, 1, 1); PG8_SCHED; PG8_LDA(At, 1, 0); PG8_STAGE(PG8_SA(0, 1), a2 + hstep, voffA);
            PG8_WAIT_V(8); PG8_WAIT_L(0); PG8_BAR; PG8_MMA(0, 0, At, B0); PG8_MMA(0, 1, At, B1); PG8_BAR; PG8_SCHED;
            PG8_LDA(At, 1, 1); PG8_STAGE(PG8_SB(1, 0), b3, voffB); PG8_STAGE(PG8_SB(1, 1), b3 + hstep, voffB); PG8_STAGE(PG8_SA(1, 0), a3, voffA);
            PG8_WAIT_V(8); PG8_WAIT_L(0); PG8_BAR; PG8_MMA(1, 0, At, B0); PG8_MMA(1, 1, At, B1); PG8_BAR; PG8_SCHED;
            } else {
            PG8_LDB(B0, 0, 0); PG8_SCHED; PG8_LDA(At, 0, 0); PG8_STAGE(PG8_SA(1, 1), a1 + hstep, voffA);
            PG8_WAIT_L(8); PG8_BAR; PG8_WAIT_L(0); PG8_MMA(0, 0, At, B0); PG8_BAR; PG8_SCHED;
            PG8_LDB(B1, 0, 1); PG8_STAGE(PG8_SB(0, 0), b2, voffB);
            PG8_BAR; PG8_WAIT_L(0); PG8_MMA(0, 1, At, B1); PG8_BAR;
            PG8_LDA(At, 0, 1); PG8_STAGE(PG8_SA(0, 0), a2, voffA);
            PG8_BAR; PG8_WAIT_L(0); PG8_MMA(1, 0, At, B0); PG8_BAR; PG8_SCHED;
            PG8_STAGE(PG8_SB(0, 1), b2 + hstep, voffB);
            PG8_WAIT_V(6); PG8_BAR; PG8_MMA(1, 1, At, B1); PG8_BAR;
            PG8_LDB(B0, 1, 0); PG8_SCHED; PG8_LDA(At, 1, 0); PG8_STAGE(PG8_SA(0, 1), a2 + hstep, voffA);
            PG8_WAIT_L(8); PG8_BAR; PG8_WAIT_L(0); PG8_MMA(0, 0, At, B0); PG8_BAR; PG8_SCHED;
            PG8_LDB(B1, 1, 1); PG8_STAGE(PG8_SB(1, 0), b3, voffB);
            PG8_BAR; PG8_WAIT_L(0); PG8_MMA(0, 1, At, B1); PG8_BAR;
            PG8_LDA(At, 1, 1); PG8_STAGE(PG8_SA(1, 0), a3, voffA);
            PG8_BAR; PG8_WAIT_L(0); PG8_MMA(1, 0, At, B0); PG8_BAR; PG8_SCHED;
            PG8_STAGE(PG8_SB(1, 1), b3 + hstep, voffB);
            PG8_WAIT_V(6); PG8_BAR; PG8_MMA(1, 1, At, B1); PG8_BAR;
            }
        }
        if constexpr (ALIGN_EPI) { if (wr == 0) PG8_BAR; }
        if constexpr (!Epi::AFTER_DRAIN) { E(acc, cur, wr, wc, fr, fq); S.done(cur); }
        if (!has_next) break;
#pragma unroll
        for (int a = 0; a < 2; ++a)
#pragma unroll
            for (int b = 0; b < 2; ++b)
#pragma unroll
                for (int m = 0; m < 4; ++m)
#pragma unroll
                    for (int n = 0; n < 2; ++n) acc[a][b][m][n] = (f32x4){0.f, 0.f, 0.f, 0.f};
        cur = nxt; cA = nA; cB = nB; ++ui;
        if constexpr (ALIGN_EPI) { if (wr == 1) PG8_BAR; }
    }
    PG8_WAIT_V(0);
    if constexpr (!ALIGN_EPI) { if (wr == 0) PG8_BAR; }
    PG8_BAR;
    if constexpr (Epi::AFTER_DRAIN) { E.fused(acc, cur, wr, wc, fr, fq, lds, wid, lane); S.done(cur); }
#undef PG8_SA
#undef PG8_SB
#undef PG8_STAGE
#undef PG8_LDA
#undef PG8_LDB
#undef PG8_MMA
#undef PG8_WAIT_V
#undef PG8_WAIT_L
#undef PG8_BAR
#undef PG8_SCHED
}
}

#ifndef PG8_SP2
#define PG8_SP2 true
#endif
#ifndef PG8_ALIGN
#define PG8_ALIGN true
#endif
#include <hip/hip_bf16.h>
#include <cmath>
namespace attn_body {
using bf16=__hip_bfloat16;
using bf16x8=__attribute__((ext_vector_type(8)))short;
using s16x4=__attribute__((ext_vector_type(4)))short;
using f32x16=__attribute__((ext_vector_type(16)))float;
using u32x4=__attribute__((ext_vector_type(4)))unsigned;
using f32x4=__attribute__((ext_vector_type(4)))float;
#define LASF __attribute__((address_space(3)))
constexpr int BATCH=8,NHEAD=16,SEQ=2048,D=64,DM=NHEAD*D;
constexpr int NW=8,QBLK=32,QB=QBLK*NW,KVBLK=64,NQB=SEQ/QB;
constexpr int ATTN_PITCH=DM, ATTN_UNIT_ROWS=QB;
__device__ __forceinline__ int crow(int r,int hi){return (r&3)+8*(r>>2)+4*hi;}
#define SBAR() __builtin_amdgcn_sched_barrier(0)
__device__ __forceinline__ void cmask(f32x16&p0,f32x16&p1,int jb,int qrel,int hi){
  const float NEG=-INFINITY; int kb=64*jb+4*hi;
  #pragma unroll
  for(int r=0;r<16;++r){int kv=kb+(r&3)+8*(r>>2); if(kv>qrel)p0[r]=NEG; if(kv+32>qrel)p1[r]=NEG;}
}

constexpr int NSLOT=3, SLOTB=8192;
constexpr int LDS_K=0, LDS_V=NSLOT*SLOTB, LDS_WS=2*NSLOT*SLOTB, LDS_OST=LDS_WS+NW*64*4, LDS_BYTES=LDS_OST+NW*4096;
constexpr float C2=0.125f*1.4426950408889634f;
__device__ __forceinline__ void glds16(const void*gsrc,unsigned lds_dst){unsigned keep;
  asm volatile("s_mov_b32 %0, m0\n\ts_mov_b32 m0, %2\n\ts_nop 0\n\tglobal_load_lds_dwordx4 %1, off\n\ts_mov_b32 m0, %0":"=&s"(keep):"v"(gsrc),"s"(lds_dst):"memory");}
__device__ __forceinline__ float max3f(float a,float b,float c){float r;asm("v_max3_f32 %0, %1, %2, %3":"=v"(r):"v"(a),"v"(b),"v"(c));return r;}
__device__ __forceinline__ float max2f(float a,float b){float r;asm("v_max_f32_e32 %0, %1, %2":"=v"(r):"v"(a),"v"(b));return r;}
__device__ __forceinline__ float fadd_s(float a,float b){float r;asm("v_add_f32_e32 %0, %1, %2":"=v"(r):"v"(a),"v"(b));return r;}
__device__ __forceinline__ float fsub_s(float a,float b){float r;asm("v_sub_f32_e32 %0, %1, %2":"=v"(r):"v"(a),"v"(b));return r;}
typedef float f32x2_t __attribute__((ext_vector_type(2))); typedef __bf16 bf16x2_t __attribute__((ext_vector_type(2)));
__device__ __forceinline__ unsigned cvtpk_s(float lo,float hi){f32x2_t v={lo,hi};bf16x2_t b=__builtin_convertvector(v,bf16x2_t);return __builtin_bit_cast(unsigned,b);}
#define WAIT_BAR(N) asm volatile("s_waitcnt vmcnt(" #N ") lgkmcnt(0)\n\ts_barrier":::"memory")

__device__ __forceinline__ void qkt(f32x16&p0,f32x16&p1,const char*Kslot,const bf16x8*qr,int r32,int hi){
  const char*kb=Kslot+hi*1024+r32*16;
  #pragma unroll
  for(int d0=0;d0<4;++d0){
    const bf16x8 b0=*reinterpret_cast<const bf16x8*>(kb+d0*2048);
    const bf16x8 b1=*reinterpret_cast<const bf16x8*>(kb+d0*2048+512);
    p0=__builtin_amdgcn_mfma_f32_32x32x16_bf16(b0,qr[d0],p0,0,0,0);p1=__builtin_amdgcn_mfma_f32_32x32x16_bf16(b1,qr[d0],p1,0,0,0);}
}
typedef __attribute__((address_space(3))) const char* lds_cptr;
typedef short v4i16_t __attribute__((ext_vector_type(4)));
__device__ __forceinline__ void kload8(bf16x8*kf,lds_cptr kp){
  kf[0]=*(const __attribute__((address_space(3))) bf16x8*)(kp);      kf[1]=*(const __attribute__((address_space(3))) bf16x8*)(kp+512);
  kf[2]=*(const __attribute__((address_space(3))) bf16x8*)(kp+2048); kf[3]=*(const __attribute__((address_space(3))) bf16x8*)(kp+2560);
  kf[4]=*(const __attribute__((address_space(3))) bf16x8*)(kp+4096); kf[5]=*(const __attribute__((address_space(3))) bf16x8*)(kp+4608);
  kf[6]=*(const __attribute__((address_space(3))) bf16x8*)(kp+6144); kf[7]=*(const __attribute__((address_space(3))) bf16x8*)(kp+6656);
}
__device__ __forceinline__ void kload2(bf16x8*kf,lds_cptr kp,int j){ kf[2*j]=*(const __attribute__((address_space(3))) bf16x8*)(kp+j*2048); kf[2*j+1]=*(const __attribute__((address_space(3))) bf16x8*)(kp+j*2048+512); }
__device__ __forceinline__ s16x4 vtr(lds_cptr p){ return __builtin_bit_cast(s16x4,__builtin_amdgcn_ds_read_tr16_b64_v4i16((__attribute__((address_space(3))) v4i16_t*)p)); }
__device__ __forceinline__ float rowmax(const f32x16&p0,const f32x16&p1){
  float a=max3f(p0[0],p0[1],p1[0]),b=max3f(p0[2],p0[3],p1[1]);a=max3f(a,p1[2],p1[3]);
  #pragma unroll
  for(int r=4;r<16;r+=4){a=max3f(a,p0[r],p0[r+1]);b=max3f(b,p0[r+2],p0[r+3]);a=max3f(a,p1[r],p1[r+1]);b=max3f(b,p1[r+2],p1[r+3]);}
  const float m=max2f(a,b);
  auto rr=__builtin_amdgcn_permlane32_swap(__float_as_uint(m),__float_as_uint(m),false,false);
  return max2f(__uint_as_float(rr[0]),__uint_as_float(rr[1]));
}
__device__ __forceinline__ void pv(f32x16*o,int vb,bf16x8 pa0,bf16x8 pa1,bf16x8 pa2,bf16x8 pa3){
  #pragma unroll
  for(int d0=0;d0<2;++d0){s16x4 lo[4],hi[4];
    #pragma unroll
    for(int ks=0;ks<4;++ks){
      asm volatile("ds_read_b64_tr_b16 %0,%1 offset:%c2":"=&v"(lo[ks]):"v"(vb),"i"(d0*4096+ks*1024):"memory");
      asm volatile("ds_read_b64_tr_b16 %0,%1 offset:%c2":"=&v"(hi[ks]):"v"(vb),"i"(d0*4096+ks*1024+512):"memory");}
    asm volatile("s_waitcnt lgkmcnt(0)":::"memory");SBAR();
    #define PK(k) (bf16x8){lo[k][0],lo[k][1],lo[k][2],lo[k][3],hi[k][0],hi[k][1],hi[k][2],hi[k][3]}
    o[d0]=__builtin_amdgcn_mfma_f32_32x32x16_bf16(pa0,PK(0),o[d0],0,0,0);
    o[d0]=__builtin_amdgcn_mfma_f32_32x32x16_bf16(pa1,PK(1),o[d0],0,0,0);
    o[d0]=__builtin_amdgcn_mfma_f32_32x32x16_bf16(pa2,PK(2),o[d0],0,0,0);
    o[d0]=__builtin_amdgcn_mfma_f32_32x32x16_bf16(pa3,PK(3),o[d0],0,0,0);
    #undef PK
  }
}


struct MergeCtx { const unsigned short* GA; const unsigned short* G2; const unsigned short* U; const float* cw; const float* st; unsigned short* out; };
__device__ __forceinline__ float mbflo(unsigned w){return __builtin_bit_cast(float,w<<16);}
__device__ __forceinline__ float mbfhi(unsigned w){return __builtin_bit_cast(float,w&0xffff0000u);}
__device__ __forceinline__ void munpack8(u32x4 w,float*f){f[0]=mbflo(w.x);f[1]=mbfhi(w.x);f[2]=mbflo(w.y);f[3]=mbfhi(w.y);f[4]=mbflo(w.z);f[5]=mbfhi(w.z);f[6]=mbflo(w.w);f[7]=mbfhi(w.w);}
__device__ __forceinline__ void merge_store8(const MergeCtx&c,size_t grow,int t,bool prm,int bb,int col,u32x4 ov){
  const size_t off=grow*1024+col; float ga[8],o[8],g2[8],u0[8],u1[8],u2[8];
  munpack8(*(const u32x4*)(c.GA+off),ga); munpack8(ov,o); munpack8(*(const u32x4*)(c.G2+off),g2); munpack8(*(const u32x4*)(c.U+off),u2);
  if(t>=1)munpack8(*(const u32x4*)(c.U+off-1024),u1);
  else if(prm){_Pragma("unroll") for(int e=0;e<8;++e)u1[e]=0.f;} else {const float*p=c.st+(size_t)(bb*2+1)*1024+col; _Pragma("unroll") for(int e=0;e<8;++e)u1[e]=p[e];}
  if(t>=2)munpack8(*(const u32x4*)(c.U+off-2048),u0);
  else if(prm){_Pragma("unroll") for(int e=0;e<8;++e)u0[e]=0.f;} else {const float*p=c.st+(size_t)(bb*2+t)*1024+col; _Pragma("unroll") for(int e=0;e<8;++e)u0[e]=p[e];}
  float r[8];
  _Pragma("unroll") for(int e=0;e<8;++e){const float cy=c.cw[col+e]*u0[e]+c.cw[1024+col+e]*u1[e]+c.cw[2048+col+e]*u2[e]; r[e]=ga[e]*o[e]+g2[e]*cy;}
  u32x4 w; w.x=cvtpk_s(r[0],r[1]); w.y=cvtpk_s(r[2],r[3]); w.z=cvtpk_s(r[4],r[5]); w.w=cvtpk_s(r[6],r[7]);
  *(u32x4*)(c.out+off)=w;
}
#ifndef ATTN_STORE16
#define ATTN_STORE16(p,v) (*(u32x4*)(p)=(v))
#endif
template<int THRL> __device__ __forceinline__ void attn_unit(int b,int h,int qb,const bf16*Q,const bf16*__restrict__ K,const bf16*__restrict__ V,const MergeCtx&mc,char*shm,const LASF float*fb){
  int tid_=threadIdx.x; asm volatile("":"+v"(tid_));
  const int tid=tid_,lane=tid&63,r32=lane&31,hi=lane>>5; const int wid=__builtin_amdgcn_readfirstlane(tid>>6);
  const long rowbase=(long)b*SEQ; const int q0=qb*QB;
  const bf16*Qw=Q+(rowbase+q0+wid*QBLK)*DM+h*D;
  const bf16*Kh=K+rowbase*DM+h*D,*Vh=V+rowbase*DM+h*D;
  const unsigned lds0=(unsigned)(uintptr_t)shm;
  float*wsf=(float*)(shm+LDS_WS)+wid*64;
  const bf16*ksrc=Kh+(long)lane*DM+wid*8;
  const bf16*vsrc=Vh+(long)(16*(wid&3)+(lane>>2))*DM+(wid>>2)*32+(lane&3)*8;
  const unsigned kdst=lds0+LDS_K+wid*1024, vdst=lds0+LDS_V+wid*1024;
  #define DMA_K(t,slot) glds16(ksrc+(long)(t)*KVBLK*DM,(unsigned)__builtin_amdgcn_readfirstlane(kdst+(slot)))
  #define DMA_V(t,slot) glds16(vsrc+(long)(t)*KVBLK*DM,(unsigned)__builtin_amdgcn_readfirstlane(vdst+(slot)))
  const int vb0=(int)(lds0+LDS_V)+((lane>>4)&1)*32+(lane&3)*8+(4*hi+((lane&15)>>2))*64;
  const char*Kbase=shm+LDS_K; bf16x8 kf[8];
  const lds_cptr shm3=(lds_cptr)shm; const lds_cptr kp0=shm3+LDS_K+hi*1024+r32*16; const lds_cptr vp0=shm3+LDS_V+((lane>>4)&1)*32+(lane&3)*8+(4*hi+((lane&15)>>2))*64;
  const int NT=(q0+QB)/KVBLK;
  DMA_K(0,0);DMA_V(0,0);DMA_K(1,SLOTB);
  bf16x8 qr[4];
  #pragma unroll
  for(int d0=0;d0<4;++d0)qr[d0]=*reinterpret_cast<const bf16x8*>(&Qw[(long)r32*DM+d0*16+hi*8]);
  float mhat=fb[q0+wid*QBLK+r32],l_reg=0.f;f32x16 o[2];o[0]=f32x16{};o[1]=f32x16{};
  #define FBINIT(C0,C1,t) do{ const LASF float*fp_=fb+64*(t)+4*hi; \
    _Pragma("unroll") for(int i_=0;i_<4;++i_){ const f32x4 a_=*(const LASF f32x4*)(fp_+8*i_),b_=*(const LASF f32x4*)(fp_+32+8*i_); \
      C0[4*i_]=a_[0]-mhat;C0[4*i_+1]=a_[1]-mhat;C0[4*i_+2]=a_[2]-mhat;C0[4*i_+3]=a_[3]-mhat; \
      C1[4*i_]=b_[0]-mhat;C1[4*i_+1]=b_[1]-mhat;C1[4*i_+2]=b_[2]-mhat;C1[4*i_+3]=b_[3]-mhat; } }while(0)
  #define FBLOAD(P0,P1,tn) do{ const LASF float*fp_=fb+64*(tn)+4*hi; \
    _Pragma("unroll") for(int i_=0;i_<4;++i_){ const f32x4 a_=*(const LASF f32x4*)(fp_+8*i_),b_=*(const LASF f32x4*)(fp_+32+8*i_); \
      P0[4*i_]=a_[0];P0[4*i_+1]=a_[1];P0[4*i_+2]=a_[2];P0[4*i_+3]=a_[3]; P1[4*i_]=b_[0];P1[4*i_+1]=b_[1];P1[4*i_+2]=b_[2];P1[4*i_+3]=b_[3]; } }while(0)
  #define FBSUB(X,B) do{ X[B]-=mhat; X[B+1]-=mhat; X[B+2]-=mhat; X[B+3]-=mhat; }while(0)
  const int qrel=wid*QBLK+r32;
  #define CMASK(P0,P1,t) do{int jb_=(t)-(NT-4); if(jb_>=0)cmask(P0,P1,jb_,qrel,hi);}while(0)
  bool resc=false;
  #define START(P0,P1) do{ const float rm=rowmax(P0,P1); resc=false; \
    if(__any(rm>(float)THRL)){ const float dl=__builtin_fmaxf(rm,0.f); mhat=fadd_s(mhat,dl); \
      _Pragma("unroll") for(int r=0;r<16;++r){P0[r]=fsub_s(P0[r],dl);P1[r]=fsub_s(P1[r],dl);} } \
    _Pragma("unroll") for(int r=0;r<16;++r)P0[r]=__builtin_amdgcn_exp2f(P0[r]); }while(0)
  #define RESC() do{ if(resc){ asm volatile("s_waitcnt lgkmcnt(0)":::"memory"); \
      _Pragma("unroll") for(int d_=0;d_<2;++d_) _Pragma("unroll") for(int r=0;r<16;++r)o[d_][r]*=wsf[crow(r,hi)]; } }while(0)
  f32x16 pA0,pA1,pB0,pB1;
  int sl_prev=0,sl_cur=0,sl_next=SLOTB;
  #define ROT() do{sl_prev=sl_cur;sl_cur=sl_next;sl_next=(sl_next==(NSLOT-1)*SLOTB)?0:sl_next+SLOTB;}while(0)
  DMA_K(2,2*SLOTB);
  WAIT_BAR(3);
  FBINIT(pA0,pA1,0);
  qkt(pA0,pA1,Kbase,qr,r32,hi);asm volatile("s_nop 15\n\ts_nop 7":"+v"(pA0),"+v"(pA1));CMASK(pA0,pA1,0);
  START(pA0,pA1);
  _Pragma("unroll") for(int r=0;r<16;++r)pA1[r]=__builtin_amdgcn_exp2f(pA1[r]);
  FBINIT(pB0,pB1,1);
  WAIT_BAR(0);
  DMA_K(3,0);DMA_V(1,SLOTB);
  ROT();
  kload8(kf,kp0+sl_cur);
  WAIT_BAR(2);
  s16x4 vlo[8],vhi[8]; u32x4 pw0,pw1,pw2,pw3;
  #define PKW(P,B) cvtpk_s(P[B],P[B+1])
  #define PAF(k) __builtin_bit_cast(bf16x8,pw##k)
  #define VFR(i) (bf16x8){vlo[i][0],vlo[i][1],vlo[i][2],vlo[i][3],vhi[i][0],vhi[i][1],vhi[i][2],vhi[i][3]}
  #define PIN(x) asm volatile("":"+v"(x))
  #define MX3(a,b,c) __builtin_fmaxf(__builtin_fmaxf((a),(b)),(c))
  #define GAPA(MF,A0,A1,A2,A3,W0,W1,PW) do{ MF; sacc+=A0; sacc+=A1; sacc+=A2; sacc+=A3; PIN(sacc); W0; W1; PIN(PW); SBAR(); }while(0)
  #define EX(v) __builtin_amdgcn_exp2f(v)
  #define GAPB(MF,X,B,Y,YB) do{ MF; X[B]=EX(X[B]); X[B+1]=EX(X[B+1]); X[B+2]=EX(X[B+2]); X[B+3]=EX(X[B+3]); PIN(X); FBSUB(Y,YB); PIN(Y); SBAR(); }while(0)
  #define VRD(i) do{ vlo[i]=vtr(vp_+(((i)>>2)*4096+((i)&3)*1024)); vhi[i]=vtr(vp_+(((i)>>2)*4096+((i)&3)*1024+512)); }while(0)
  #define KRD(G,j) do{ if(G){ kload2(kf,kp0+sl_next,j); SBAR(); } }while(0)
  #define STEP(C0,C1,P0,P1,t,GK,GV,GL) do{ SBAR(); \
    const lds_cptr vp_=vp0+sl_prev; \
    VRD(0); SBAR(); float sacc=(P0[0]+P0[1]); \
    GAPA(C0=__builtin_amdgcn_mfma_f32_32x32x16_bf16(kf[0],qr[0],C0,0,0,0), P0[2],P0[3],P0[4],P0[5],     pw0[0]=PKW(P0,0), pw0[1]=PKW(P0,2), pw0); \
    VRD(4); SBAR(); GAPA(C1=__builtin_amdgcn_mfma_f32_32x32x16_bf16(kf[1],qr[0],C1,0,0,0), P0[6],P0[7],P0[8],P0[9],     pw0[2]=PKW(P0,4), pw0[3]=PKW(P0,6), pw0); \
    VRD(1); SBAR(); GAPA(C0=__builtin_amdgcn_mfma_f32_32x32x16_bf16(kf[2],qr[1],C0,0,0,0),   P0[10],P0[11],P0[12],P0[13], pw1[0]=PKW(P0,8), pw1[1]=PKW(P0,10), pw1); \
    VRD(5); SBAR(); GAPA(C1=__builtin_amdgcn_mfma_f32_32x32x16_bf16(kf[3],qr[1],C1,0,0,0),   P0[14],P0[15],P1[0],P1[1],   pw1[2]=PKW(P0,12),pw1[3]=PKW(P0,14), pw1); \
    VRD(2); SBAR(); GAPA(C0=__builtin_amdgcn_mfma_f32_32x32x16_bf16(kf[4],qr[2],C0,0,0,0),   P1[2],P1[3],P1[4],P1[5],     pw2[0]=PKW(P1,0), pw2[1]=PKW(P1,2), pw2); \
    VRD(6); SBAR(); GAPA(C1=__builtin_amdgcn_mfma_f32_32x32x16_bf16(kf[5],qr[2],C1,0,0,0),   P1[6],P1[7],P1[8],P1[9],     pw2[2]=PKW(P1,4), pw2[3]=PKW(P1,6), pw2); \
    VRD(3); SBAR(); GAPA(C0=__builtin_amdgcn_mfma_f32_32x32x16_bf16(kf[6],qr[3],C0,0,0,0),   P1[10],P1[11],P1[12],P1[13], pw3[0]=PKW(P1,8), pw3[1]=PKW(P1,10), pw3); \
    VRD(7); SBAR(); GAPA(C1=__builtin_amdgcn_mfma_f32_32x32x16_bf16(kf[7],qr[3],C1,0,0,0),   P1[14],P1[15],0.f,0.f,       pw3[2]=PKW(P1,12),pw3[3]=PKW(P1,14), pw3); \
    l_reg+=sacc; \
    if(GK){DMA_K((t)+3,sl_cur);} if(GV){DMA_V((t)+1,sl_next);} \
    CMASK(C0,C1,t); \
    { float a=MX3(C0[0],C0[1],C1[0]),b=MX3(C0[2],C0[3],C1[1]); a=MX3(a,C1[2],C1[3]); \
      _Pragma("unroll") for(int r=4;r<16;r+=4){a=MX3(a,C0[r],C0[r+1]);b=MX3(b,C0[r+2],C0[r+3]);a=MX3(a,C1[r],C1[r+1]);b=MX3(b,C1[r+2],C1[r+3]);} \
      float rm=__builtin_fmaxf(a,b); { auto rr=__builtin_amdgcn_permlane32_swap(__float_as_uint(rm),__float_as_uint(rm),false,false); rm=__builtin_fmaxf(__uint_as_float(rr[0]),__uint_as_float(rr[1])); } \
      resc=false; \
      if(__builtin_expect(__any(rm>(float)THRL),0)){ const float dl=__builtin_fmaxf(rm,0.f); mhat+=dl; \
        _Pragma("unroll") for(int r=0;r<16;++r){C0[r]-=dl;C1[r]-=dl;} \
        const float f=__builtin_amdgcn_exp2f(-dl); l_reg*=f; if(hi==0)wsf[r32]=f; resc=true; } } \
    SBAR(); FBLOAD(P0,P1,(t)+1); SBAR(); \
    GAPB(o[0]=__builtin_amdgcn_mfma_f32_32x32x16_bf16(PAF(0),VFR(0),o[0],0,0,0), C0,0, P0,0); \
    GAPB(o[1]=__builtin_amdgcn_mfma_f32_32x32x16_bf16(PAF(0),VFR(4),o[1],0,0,0), C0,4, P0,4); \
    KRD(GL,0); GAPB(o[0]=__builtin_amdgcn_mfma_f32_32x32x16_bf16(PAF(1),VFR(1),o[0],0,0,0), C0,8, P0,8); \
    KRD(GL,1); GAPB(o[1]=__builtin_amdgcn_mfma_f32_32x32x16_bf16(PAF(1),VFR(5),o[1],0,0,0), C0,12, P0,12); \
    KRD(GL,2); GAPB(o[0]=__builtin_amdgcn_mfma_f32_32x32x16_bf16(PAF(2),VFR(2),o[0],0,0,0), C1,0, P1,0); \
    KRD(GL,3); GAPB(o[1]=__builtin_amdgcn_mfma_f32_32x32x16_bf16(PAF(2),VFR(6),o[1],0,0,0), C1,4, P1,4); \
    GAPB(o[0]=__builtin_amdgcn_mfma_f32_32x32x16_bf16(PAF(3),VFR(3),o[0],0,0,0), C1,8, P1,8); \
    GAPB(o[1]=__builtin_amdgcn_mfma_f32_32x32x16_bf16(PAF(3),VFR(7),o[1],0,0,0), C1,12, P1,12); \
    }while(0)
  int t=1;
  #undef CMASK
  #define CMASK(P0,P1,t) do{}while(0)
  for(;t+5<NT;t+=2){
    STEP(pB0,pB1,pA0,pA1,t,true,true,true);     WAIT_BAR(2); RESC(); ROT();
    STEP(pA0,pA1,pB0,pB1,t+1,true,true,true);   WAIT_BAR(2); RESC(); ROT();
  }
  #undef CMASK
  #define CMASK(P0,P1,t) do{int jb_=(t)-(NT-4); if(jb_>=0)cmask(P0,P1,jb_,qrel,hi);}while(0)
  #define ENDW(tt) do{ if((tt)+3<NT){WAIT_BAR(2);} else if((tt)+2<NT){WAIT_BAR(1);} else {WAIT_BAR(0);} }while(0)
  for(;t+1<NT;t+=2){
    STEP(pB0,pB1,pA0,pA1,t,(t+3<NT),(t+1<NT),(t+1<NT));       ENDW(t);   RESC(); ROT();
    STEP(pA0,pA1,pB0,pB1,t+1,(t+4<NT),(t+2<NT),(t+2<NT));     ENDW(t+1); RESC(); ROT();
  }
  STEP(pB0,pB1,pA0,pA1,NT-1,false,false,false); RESC();
  u32x4 mg[4][5]; f32x4 mcw[3][2];
  { const int mcol=h*D+(lane&7)*8;
    _Pragma("unroll") for(int j=0;j<3;++j){ mcw[j][0]=*(const f32x4*)(mc.cw+j*1024+mcol); mcw[j][1]=*(const f32x4*)(mc.cw+j*1024+mcol+4); }
    _Pragma("unroll") for(int i=0;i<4;++i){ const int t_=q0+wid*QBLK+i*8+(lane>>3); const size_t off=(size_t)(rowbase+t_)*1024+mcol;
      mg[i][0]=__builtin_nontemporal_load((const u32x4*)(mc.GA+off)); mg[i][1]=__builtin_nontemporal_load((const u32x4*)(mc.G2+off)); mg[i][2]=*(const u32x4*)(mc.U+off);
      mg[i][3]=(t_>=1)?*(const u32x4*)(mc.U+off-1024):(u32x4){0u,0u,0u,0u}; mg[i][4]=(t_>=2)?*(const u32x4*)(mc.U+off-2048):(u32x4){0u,0u,0u,0u}; } }
  { float sacc=pB0[0]+pB0[1]; _Pragma("unroll") for(int r=2;r<16;++r)sacc+=pB0[r]; _Pragma("unroll") for(int r=0;r<16;++r)sacc+=pB1[r]; l_reg+=sacc;
    pw0=(u32x4){PKW(pB0,0),PKW(pB0,2),PKW(pB0,4),PKW(pB0,6)};pw1=(u32x4){PKW(pB0,8),PKW(pB0,10),PKW(pB0,12),PKW(pB0,14)};pw2=(u32x4){PKW(pB1,0),PKW(pB1,2),PKW(pB1,4),PKW(pB1,6)};pw3=(u32x4){PKW(pB1,8),PKW(pB1,10),PKW(pB1,12),PKW(pB1,14)};
    SBAR(); pv(o,vb0+sl_cur,PAF(0),PAF(1),PAF(2),PAF(3)); }
  #undef PKW
  #undef PAF
  #undef VFR
  #undef PIN
  #undef MX3
  #undef GAPA
  #undef GAPB
  #undef EX
  #undef VRD
  #undef KRD
  #undef STEP
  #undef ENDW
  {auto rr=__builtin_amdgcn_permlane32_swap(__float_as_uint(l_reg),__float_as_uint(l_reg),false,false);l_reg=__uint_as_float(rr[0])+__uint_as_float(rr[1]);}
  if(hi==0)wsf[32+r32]=l_reg;asm volatile("s_waitcnt lgkmcnt(0)":::"memory");
  float rli[16];
  #pragma unroll
  for(int r=0;r<16;++r)rli[r]=__builtin_amdgcn_rcpf(wsf[32+crow(r,hi)]);
  { bf16*stg=(bf16*)(shm+LDS_OST)+wid*2048;
    #pragma unroll
    for(int r=0;r<16;++r){const int orow=crow(r,hi);
      #pragma unroll
      for(int d0=0;d0<2;++d0)stg[orow*64+d0*32+r32]=__float2bfloat16(o[d0][r]*rli[r]);}
    asm volatile("s_waitcnt lgkmcnt(0)":::"memory");
    #pragma unroll
    for(int i=0;i<4;++i){const int row=i*8+(lane>>3),ch=lane&7; const u32x4 v=*(const u32x4*)(stg+row*64+ch*8); const int t_=q0+wid*QBLK+row;
      float ga[8],ov[8],g2[8],u2[8],u1[8],u0[8],r[8]; munpack8(mg[i][0],ga); munpack8(v,ov); munpack8(mg[i][1],g2); munpack8(mg[i][2],u2); munpack8(mg[i][3],u1); munpack8(mg[i][4],u0);
      _Pragma("unroll") for(int e=0;e<8;++e){ const float cy=mcw[0][e>>2][e&3]*u0[e]+mcw[1][e>>2][e&3]*u1[e]+mcw[2][e>>2][e&3]*u2[e]; r[e]=ga[e]*ov[e]+g2[e]*cy; }
      u32x4 w; w.x=cvtpk_s(r[0],r[1]); w.y=cvtpk_s(r[2],r[3]); w.z=cvtpk_s(r[4],r[5]); w.w=cvtpk_s(r[6],r[7]);
      *(u32x4*)(mc.out+(size_t)(rowbase+t_)*1024+h*D+ch*8)=w; } }
  asm volatile("s_waitcnt lgkmcnt(0)\n\ts_barrier":::"memory");
  #undef DMA_K
  #undef DMA_V
  #undef CMASK
  #undef START
  #undef RESC
  #undef ROT
  #undef FBINIT
  #undef FBLOAD
  #undef FBSUB
}
constexpr int ATTN_LDS_BYTES=LDS_BYTES;
#undef SBAR
#undef WAIT_BAR
}

#define XB_TMO      128
#define XB_XCNT(j)  (256  + 64 * (j))
#define XB_XSUB(j)  (1280 + 64 * (j))
#define XB_XGEN(j)  (2304 + 64 * (j))
#define XB_TOP      3328
#define XB_TOPGEN   3392
#define XCD_BAR_WORDS 3456
#define XB_SPIN_CAP (1u << 18)

__device__ __forceinline__ unsigned xb_ld(unsigned* p)              { return __hip_atomic_load(p, __ATOMIC_RELAXED, __HIP_MEMORY_SCOPE_AGENT); }
__device__ __forceinline__ unsigned xb_add(unsigned* p, unsigned v) { return __hip_atomic_fetch_add(p, v, __ATOMIC_RELAXED, __HIP_MEMORY_SCOPE_AGENT); }
__device__ __forceinline__ unsigned xb_xcc_id() { return (unsigned)__builtin_amdgcn_s_getreg((3 << 11) | 20) & 0xFu; }
#define XB_SPIN(cond, bar) do { unsigned _sp = 0; while (cond) { __builtin_amdgcn_s_sleep(1); \
    if ((++_sp & 255u) == 0u) { if (xb_ld(&(bar)[XB_TMO])) break; if (_sp > XB_SPIN_CAP) { atomicAdd(&(bar)[XB_TMO], 1u); break; } } } } while (0)

struct XcdBarrier {
    unsigned* bar; unsigned x;
    volatile __attribute__((address_space(3))) unsigned* st;
};

__device__ __forceinline__ XcdBarrier xcd_barrier_post(unsigned* bar, volatile __attribute__((address_space(3))) unsigned* st) {
    XcdBarrier b; b.bar = bar; b.x = xb_xcc_id(); b.st = st;
    if (threadIdx.x == 0) (void)xb_add(&bar[XB_XCNT(b.x)], 1u);
    return b;
}
__device__ __forceinline__ void xcd_barrier_complete(unsigned* bar, unsigned x, unsigned& nloc, unsigned& nx) {
    const unsigned G = gridDim.x * gridDim.y * gridDim.z;
    unsigned sum, cnt, mine, sp = 0u;
    for (;;) {
        sum = 0u; cnt = 0u; mine = 0u;
#pragma unroll
        for (unsigned j = 0; j < 16; ++j) { const unsigned c = xb_ld(&bar[XB_XCNT(j)]); sum += c; cnt += (c > 0u) ? 1u : 0u; mine = (j == x) ? c : mine; }
        if (sum == G) break;
        __builtin_amdgcn_s_sleep(1);
        if ((++sp & 255u) == 0u) { if (xb_ld(&bar[XB_TMO])) break; if (sp > XB_SPIN_CAP) { atomicAdd(&bar[XB_TMO], 1u); break; } }
    }
    nloc = mine > 0u ? mine : 1u; nx = cnt > 0u ? cnt : 1u;
}

__device__ __forceinline__ void xcd_barrier(const XcdBarrier& b) {
    asm volatile("s_waitcnt vmcnt(0)" ::: "memory");
    __syncthreads();
    if (threadIdx.x == 0) {
        unsigned* bar = b.bar;
        __builtin_amdgcn_s_waitcnt(0);
        unsigned nloc = b.st[0], nx = b.st[1];
        if (nloc == 0u) { xcd_barrier_complete(bar, b.x, nloc, nx); b.st[0] = nloc; b.st[1] = nx; }
        const unsigned old = xb_add(&bar[XB_XSUB(b.x)], 1u);
        const unsigned gen = old / nloc;
        if (old + 1u == (gen + 1u) * nloc) {
            __builtin_amdgcn_fence(__ATOMIC_RELEASE, "agent");
            asm volatile("s_waitcnt vmcnt(0)" ::: "memory");
            const unsigned og = xb_add(&bar[XB_TOP], 1u);
            const unsigned tg = og / nx;
            if (og + 1u == (tg + 1u) * nx) xb_add(&bar[XB_TOPGEN], 1u);
            else XB_SPIN(xb_ld(&bar[XB_TOPGEN]) == tg, bar);
            __builtin_amdgcn_fence(__ATOMIC_ACQUIRE, "agent");
            xb_add(&bar[XB_XGEN(b.x)], 1u);
            asm volatile("s_waitcnt vmcnt(0)" ::: "memory");
        } else {
            XB_SPIN(xb_ld(&bar[XB_XGEN(b.x)]) == gen, bar);
            __builtin_amdgcn_fence(__ATOMIC_ACQUIRE, "agent");
            asm volatile("s_waitcnt vmcnt(0)" ::: "memory");
        }
    }
    __syncthreads();
}


namespace cg = cooperative_groups;
constexpr int NWAVES = 8, NTHREADS = 512;
constexpr size_t MiB = 1u << 20;
constexpr size_t WS_CNT = 912 * 1024;
constexpr int CNT_WORDS = 3 * 80 * 16;
constexpr size_t WS_BAR = 896 * 1024;
constexpr size_t WS_MOD = 0, WS_W1IN = 1 * MiB, WS_W1OUT = 12 * MiB, WS_WIN = 18 * MiB, WS_WOUT = 35 * MiB, WS_W2IN = 37 * MiB, WS_W2OUT = 48 * MiB, WS_H = 54 * MiB,
                 WS_QB = 88 * MiB, WS_KB = 122 * MiB, WS_VB = 156 * MiB, WS_GAB = 190 * MiB, WS_G2B = 224 * MiB, WS_UB = 258 * MiB, WS_END = 292 * MiB, WS_ACT = WS_QB;
static_assert((size_t)MT * DM * 2 == 34 * MiB && WS_KB - WS_QB == 34 * MiB && WS_VB - WS_KB == 34 * MiB && WS_GAB - WS_VB == 34 * MiB && WS_G2B - WS_GAB == 34 * MiB && WS_UB - WS_G2B == 34 * MiB && WS_ACT + (size_t)MT * DFF * 2 <= WS_GAB && WS_WIN + (size_t)NINP * DM * 2 <= WS_WOUT && WS_W1IN + (size_t)2 * DFF * DM * 2 <= WS_W1OUT, "d_ws map");
constexpr int RING_OFF = 0, RING_BYTES = 131072, FB_OFF = RING_BYTES, STAT_OFF = FB_OFF + 8192, QL_OFF = STAT_OFF + 8192, LDS_BYTES = 163840;
static_assert(QL_OFF + 64 * 144 <= LDS_BYTES && 98304 + 8 * 8192 <= LDS_BYTES && LDS_BYTES <= 163840 && STAT_OFF + 8192 <= LDS_BYTES && attn_body::LDS_BYTES <= RING_BYTES, "LDS map");

#define LAS __attribute__((address_space(3)))
typedef unsigned short bf16;
typedef unsigned v4u __attribute__((ext_vector_type(4)));
typedef unsigned v2u __attribute__((ext_vector_type(2)));
typedef float f32x4 __attribute__((ext_vector_type(4)));
typedef float f32x16 __attribute__((ext_vector_type(16)));
typedef short bf16x8 __attribute__((ext_vector_type(8)));
#define LDS_WAIT() asm volatile("s_waitcnt lgkmcnt(0)" ::: "memory")
__device__ __forceinline__ unsigned f2bf(float f) { unsigned u = __builtin_bit_cast(unsigned, f); return (u + 0x7fffu + ((u >> 16) & 1u)) >> 16; }
__device__ __forceinline__ unsigned pk2(float lo, float hi) { return attn_body::cvtpk_s(lo, hi); }
__device__ __forceinline__ float bflo(unsigned w) { return __builtin_bit_cast(float, w << 16); }
__device__ __forceinline__ float bfhi(unsigned w) { return __builtin_bit_cast(float, w & 0xffff0000u); }
__device__ __forceinline__ float wave_sum(float v) {
#pragma unroll
    for (int o = 1; o < 64; o <<= 1) v += __shfl_xor(v, o);
    return v;
}

struct Args { const float* in[22]; float* out; unsigned char* ws; int ph_lo, ph_hi; };

__device__ __forceinline__ void p0_mod(const Args& a, LAS unsigned char* lds, int vcu, int G) {
    const int tid = threadIdx.x, lane = tid & 63, wid = tid >> 6, l32 = lane & 31, hi = lane >> 5;
    LAS float* scT = (LAS float*)lds;
    const float* w_ada = a.in[8]; const float* b_ada = a.in[9]; float* mod = (float*)(a.ws + WS_MOD);
    for (int item = vcu; item < MODLD / 64; item += G) {
#pragma unroll 8
        for (int i = tid; i < 24 * 1024; i += NTHREADS) { const int b = i >> 10, k = i & 1023;
            const float c = b < 8 ? a.in[6][b * 1024 + k] : a.in[7][(b - 8) * 1024 + k]; scT[k * 32 + b] = c / (1.0f + __expf(-c)); }
        for (int i = tid; i < 8 * 1024; i += NTHREADS) scT[(i >> 3) * 32 + 24 + (i & 7)] = 0.f;
        __syncthreads();
        f32x16 acc0 = f32x16{}, acc1 = f32x16{};
        const float* wp = w_ada + (size_t)(wid * 128 + hi) * MODLD + item * 64 + l32;
        const LAS float* ap = scT + (wid * 128 + hi) * 32 + l32;
        float n0[16], n1[16];
#pragma unroll
        for (int q = 0; q < 16; ++q) { n0[q] = __builtin_nontemporal_load(wp + (size_t)(2 * q) * MODLD); n1[q] = __builtin_nontemporal_load(wp + (size_t)(2 * q) * MODLD + 32); }
#pragma unroll 1
        for (int bt = 0; bt < 4; ++bt) {
            float c0[16], c1[16];
#pragma unroll
            for (int q = 0; q < 16; ++q) { c0[q] = n0[q]; c1[q] = n1[q]; }
            if (bt < 3) {
#pragma unroll
                for (int q = 0; q < 16; ++q) { n0[q] = __builtin_nontemporal_load(wp + (size_t)(2 * (16 * (bt + 1) + q)) * MODLD); n1[q] = __builtin_nontemporal_load(wp + (size_t)(2 * (16 * (bt + 1) + q)) * MODLD + 32); }
            }
#pragma unroll
            for (int q = 0; q < 16; ++q) { const float av = ap[(2 * (16 * bt + q)) * 32];
                acc0 = __builtin_amdgcn_mfma_f32_32x32x2f32(av, c0[q], acc0, 0, 0, 0); acc1 = __builtin_amdgcn_mfma_f32_32x32x2f32(av, c1[q], acc1, 0, 0, 0); }
        }
        __syncthreads();
        { LAS float* P = scT + wid * 2048;
#pragma unroll
          for (int r = 0; r < 16; ++r) { const int b = (r & 3) + 8 * (r >> 2) + 4 * hi; P[b * 64 + l32] = acc0[r]; P[b * 64 + 32 + l32] = acc1[r]; } }
        __syncthreads();
        for (int o = tid; o < 24 * 64; o += NTHREADS) { const int b = o >> 6, c = o & 63; float sum = b_ada[item * 64 + c];
#pragma unroll
            for (int w = 0; w < 8; ++w) sum += scT[w * 2048 + b * 64 + c];
            mod[(size_t)b * MODLD + item * 64 + c] = sum; }
        __syncthreads();
    }
}
__device__ __forceinline__ void p0_transpose_item(const float* W, int K, int N, bf16* WT, int dst_row0, int src_col0, int nvalid, int kb, LAS float* scr, int lane) {
    const int k0 = 64 * kb; const int cl = lane & 31; const bool ok = cl < nvalid;
    float tv[32];
#pragma unroll
    for (int i = 0; i < 32; ++i) { const int kk = 2 * i + (lane >> 5); tv[i] = ok ? __builtin_nontemporal_load(W + (size_t)(k0 + kk) * N + src_col0 + cl) : 0.f; }
#pragma unroll
    for (int i = 0; i < 32; ++i) { const int kk = 2 * i + (lane >> 5); scr[kk * 33 + cl] = tv[i]; }
    LDS_WAIT(); asm volatile("" ::: "memory");
    const int c = lane & 7;
#pragma unroll
    for (int j = 0; j < 4; ++j) { const int n = (lane >> 3) + 8 * j; const LAS float* s = scr + (8 * c) * 33 + n;
        v4u o; o.x = pk2(s[0 * 33], s[1 * 33]); o.y = pk2(s[2 * 33], s[3 * 33]); o.z = pk2(s[4 * 33], s[5 * 33]); o.w = pk2(s[6 * 33], s[7 * 33]);
        *(v4u*)(WT + (size_t)(dst_row0 + n) * K + k0 + 8 * c) = o; }
    LDS_WAIT(); asm volatile("" ::: "memory");
}
__device__ __forceinline__ void map_ffn_in(int db, int& src, int& nv) { const int r = db * 32, t = r >> 8, w = r & 255; src = (w < 128 ? 0 : DFF) + t * 128 + (w & 127); nv = 32; }
__device__ __forceinline__ void map_win(int db, int& src, int& nv) {
    const int r = db * 32; nv = 32;
    if (r < 3072) { src = r; return; }
    if (r < 4096) { src = OFF_GA + (r - 3072); return; }
    if (r < 6144) { const int q = r - 4096, t = q >> 8, w = q & 255; src = (w < 128 ? OFF_B : OFF_GC) + t * 128 + (w & 127); return; }
    if (r < 8192) { const int q = r - 6144, t = q >> 8, w = q & 255; src = (w < 128 ? OFF_C : OFF_X) + t * 128 + (w & 127); return; }
    src = OFF_F; nv = (r == 8192) ? 16 : 0;
}
constexpr int I_1IN = 16 * 176, I_1OUT = 44 * 32, I_WIN = 16 * 264, I_WOUT = 16 * 32, WITEMS = 2 * I_1IN + 2 * I_1OUT + I_WIN + I_WOUT;
constexpr int WCUT0 = 2 * I_1IN + I_WIN, WCUT1 = WCUT0 + I_1OUT;
__device__ __forceinline__ void weight_item(const Args& a, int it, LAS float* scr, int lane) {
    int r = it; int src, nv;
    if (r < I_1IN) { map_ffn_in(r % 176, src, nv); p0_transpose_item(a.in[11], 1024, 2 * DFF, (bf16*)(a.ws + WS_W1IN), (r % 176) * 32, src, nv, r / 176, scr, lane); return; } r -= I_1IN;
    if (r < I_1IN) { map_ffn_in(r % 176, src, nv); p0_transpose_item(a.in[19], 1024, 2 * DFF, (bf16*)(a.ws + WS_W2IN), (r % 176) * 32, src, nv, r / 176, scr, lane); return; } r -= I_1IN;
    if (r < I_WIN) { map_win(r % 264, src, nv); p0_transpose_item(a.in[14], 1024, NIN, (bf16*)(a.ws + WS_WIN), (r % 264) * 32, src, nv, r / 264, scr, lane); return; } r -= I_WIN;
    if (r < I_1OUT) { p0_transpose_item(a.in[12], DFF, 1024, (bf16*)(a.ws + WS_W1OUT), (r % 32) * 32, (r % 32) * 32, 32, r / 32, scr, lane); return; } r -= I_1OUT;
    if (r < I_1OUT) { p0_transpose_item(a.in[20], DFF, 1024, (bf16*)(a.ws + WS_W2OUT), (r % 32) * 32, (r % 32) * 32, 32, r / 32, scr, lane); return; } r -= I_1OUT;
    p0_transpose_item(a.in[17], 1024, 1024, (bf16*)(a.ws + WS_WOUT), (r % 32) * 32, (r % 32) * 32, 32, r / 32, scr, lane);
}
__device__ __forceinline__ void p0_weights(const Args& a, LAS unsigned char* lds, int vcu, int G) {
    const int tid = threadIdx.x, lane = tid & 63, wid = tid >> 6;
    LAS float* scr = (LAS float*)(lds + wid * 16384);
    const int nitems = (G == 256) ? WCUT0 : WITEMS;
    constexpr int NMODWG = MODLD / 64;
    const bool skew = (G > NMODWG);
    const int nslot = skew ? NMODWG * NWAVES + (G - NMODWG) * NWAVES * 2 : G * NWAVES;
    const int slot0 = !skew ? vcu * NWAVES + wid : (vcu < NMODWG ? vcu * NWAVES + wid : NMODWG * NWAVES + ((vcu - NMODWG) * NWAVES + wid) * 2);
    const int nmine = (skew && vcu >= NMODWG) ? 2 : 1;
    for (int sl = 0; sl < nmine; ++sl)
        for (int it = slot0 + sl; it < nitems; it += nslot) weight_item(a, it, scr, lane);
}
__device__ __forceinline__ void weight_items_tail(const Args& a, LAS unsigned char* lds, int first, int last, int wk, int nwk) {
    const int tid = threadIdx.x, lane = tid & 63, wid = tid >> 6;
    LAS float* scr = (LAS float*)(lds + wid * 16384);
    for (int it = first + wk; it < last; it += nwk) weight_item(a, it, scr, lane);
}
template <bool FINAL, bool NT = false, int NR = 4> __device__ __forceinline__ void norm_rows4(int m0, const float* xP, const float* xS, const float* g, const float* mod, int sh_off, int sc_off, bf16* H, float* Y, int lane) {
    const float* x0 = m0 < MP ? xP + (size_t)m0 * DM : xS + (size_t)(m0 - MP) * DM;
    const int mb = m0 < MP ? (m0 >> 11) : 8 + ((m0 - MP) >> 6);
    f32x4 v[NR][4]; float s[NR];
#pragma unroll
    for (int r = 0; r < NR; ++r)
#pragma unroll
        for (int j = 0; j < 4; ++j) { const f32x4* p = (const f32x4*)(x0 + (size_t)r * DM) + lane + 64 * j; v[r][j] = NT ? __builtin_nontemporal_load(p) : *p; }
    f32x4 gg[4], sh[4], sc[4];
#pragma unroll
    for (int j = 0; j < 4; ++j) { gg[j] = ((const f32x4*)g + lane)[64 * j];
        if (!FINAL) { sh[j] = ((const f32x4*)(mod + (size_t)mb * MODLD + sh_off) + lane)[64 * j]; sc[j] = ((const f32x4*)(mod + (size_t)mb * MODLD + sc_off) + lane)[64 * j]; } }
#pragma unroll
    for (int r = 0; r < NR; ++r) { s[r] = 0.f;
#pragma unroll
        for (int j = 0; j < 4; ++j) s[r] += (v[r][j].x * v[r][j].x + v[r][j].y * v[r][j].y) + (v[r][j].z * v[r][j].z + v[r][j].w * v[r][j].w); }
#pragma unroll
    for (int o = 1; o < 64; o <<= 1) {
#pragma unroll
        for (int r = 0; r < NR; ++r) s[r] += __shfl_xor(s[r], o); }
#pragma unroll
    for (int r = 0; r < NR; ++r) { const float rstd = 1.0f / sqrtf(s[r] * (1.f / DM) + EPS);
        if (FINAL) { f32x4* yr = (f32x4*)(Y + (size_t)(m0 + r) * DM) + lane;
#pragma unroll
            for (int j = 0; j < 4; ++j) __builtin_nontemporal_store((v[r][j] * rstd) * gg[j], yr + 64 * j); }
        else { v2u* o8 = (v2u*)(H + (size_t)(m0 + r) * DM) + lane;
#pragma unroll
            for (int j = 0; j < 4; ++j) { const f32x4 y = (v[r][j] * rstd) * gg[j] * (sc[j] + 1.0f) + sh[j]; v2u w; w.x = pk2(y.x, y.y); w.y = pk2(y.z, y.w); o8[64 * j] = w; } } }
}
__device__ __forceinline__ void norm_mod_rows(const float* xP, const float* xS, const float* g, const float* mod, int sh_off, int sc_off, bf16* H, int vcu, int G) {
    const int tid = threadIdx.x, lane = tid & 63, wid = tid >> 6;
    const int gw = vcu * NWAVES + wid, NGW = G * NWAVES;
    for (int q = gw; q < MT / 4; q += NGW) norm_rows4<false, true>(4 * q, xP, xS, g, mod, sh_off, sc_off, H, nullptr, lane);
}
__device__ __forceinline__ void final_norm_rows(float* X, const float* g, int vcu, int G) {
    const int tid = threadIdx.x, lane = tid & 63, wid = tid >> 6;
    const int gw = vcu * NWAVES + wid, NGW = G * NWAVES;
    for (int q = gw; q < MT / 4; q += NGW) norm_rows4<true>(4 * q, X, X + (size_t)MP * DM, g, nullptr, 0, 0, nullptr, X, lane);
}
__device__ __forceinline__ void panel_handoff(unsigned* cP, unsigned* cS) {
    asm volatile("s_waitcnt vmcnt(0)" ::: "memory");
    __syncthreads();
    if (threadIdx.x == 0) {
        __builtin_amdgcn_fence(__ATOMIC_RELEASE, "agent");
        asm volatile("s_waitcnt vmcnt(0)" ::: "memory");
        __hip_atomic_fetch_add(cP, 1u, __ATOMIC_RELAXED, __HIP_MEMORY_SCOPE_AGENT);
        __hip_atomic_fetch_add(cS, 1u, __ATOMIC_RELAXED, __HIP_MEMORY_SCOPE_AGENT);
        unsigned sp = 0;
        while (__hip_atomic_load(cP, __ATOMIC_RELAXED, __HIP_MEMORY_SCOPE_AGENT) < 4u || __hip_atomic_load(cS, __ATOMIC_RELAXED, __HIP_MEMORY_SCOPE_AGENT) < 16u) { __builtin_amdgcn_s_sleep(2); if (++sp > (1u << 22)) break; }
        __builtin_amdgcn_fence(__ATOMIC_ACQUIRE, "agent");
        asm volatile("s_waitcnt vmcnt(0)" ::: "memory");
    }
    __syncthreads();
}
__device__ __forceinline__ void unpack8(v4u w, float* f) { f[0] = bflo(w.x); f[1] = bfhi(w.x); f[2] = bflo(w.y); f[3] = bfhi(w.y); f[4] = bflo(w.z); f[5] = bfhi(w.z); f[6] = bflo(w.w); f[7] = bfhi(w.w); }
__device__ __forceinline__ void merge_phase(const Args& a, int vcu, int G) {
    const bf16* GAB = (const bf16*)(a.ws + WS_GAB); const bf16* OB = (const bf16*)(a.ws + WS_QB); const bf16* G2B = (const bf16*)(a.ws + WS_G2B); const bf16* UB = (const bf16*)(a.ws + WS_UB);
    bf16* Hm = (bf16*)(a.ws + WS_H); const float* cw = a.in[16]; const float* st = a.in[5];
    const size_t total = (size_t)MT * 128, stride = (size_t)G * NTHREADS;
    for (size_t idx = (size_t)vcu * NTHREADS + threadIdx.x; idx < total; idx += stride) {
        const int row = (int)(idx >> 7), c8 = (int)(idx & 127) * 8;
        const bool prm = row < MP; const int rr = prm ? row : row - MP; const int t = prm ? (rr & 2047) : (rr & 63), bb = prm ? (rr >> 11) : (rr >> 6);
        const size_t off = (size_t)row * DM + c8;
        float ga[8], o[8], g2[8], u0[8], u1[8], u2[8];
        unpack8(*(const v4u*)(GAB + off), ga); unpack8(*(const v4u*)(OB + off), o); unpack8(*(const v4u*)(G2B + off), g2); unpack8(*(const v4u*)(UB + off), u2);
        if (t >= 1) unpack8(*(const v4u*)(UB + off - DM), u1);
        else { if (prm) { for (int e = 0; e < 8; ++e) u1[e] = 0.f; } else { const float* p = st + (size_t)(bb * 2 + 1) * 1024 + c8; for (int e = 0; e < 8; ++e) u1[e] = p[e]; } }
        if (t >= 2) unpack8(*(const v4u*)(UB + off - 2 * DM), u0);
        else { if (prm) { for (int e = 0; e < 8; ++e) u0[e] = 0.f; } else { const float* p = st + (size_t)(bb * 2 + t) * 1024 + c8; for (int e = 0; e < 8; ++e) u0[e] = p[e]; } }
        float r[8];
#pragma unroll
        for (int e = 0; e < 8; ++e) { const float cy = cw[c8 + e] * u0[e] + cw[1024 + c8 + e] * u1[e] + cw[2048 + c8 + e] * u2[e]; r[e] = ga[e] * o[e] + g2[e] * cy; }
        v4u w; w.x = pk2(r[0], r[1]); w.y = pk2(r[2], r[3]); w.z = pk2(r[4], r[5]); w.w = pk2(r[6], r[7]);
        *(v4u*)(Hm + off) = w;
    }
}

__device__ __forceinline__ void small_gemm_sample(const bf16* A, const bf16* Wt, int K, const float* base, float* outp, const float* gate, float coef, LAS unsigned char* ring, int vcu, int G) {
    int tid = threadIdx.x; asm volatile("" : "+v"(tid));
    const int lane = tid & 63, wid = tid >> 6, fr = lane & 15, fq = lane >> 4; const int KW = K >> 3;
    for (int item = vcu; item < 256; item += G) {
        const int rt = (item >> 4) * 64, ct = (item & 15) * 64;
        const bf16* ap = A + (size_t)(rt + fr) * K + wid * KW + 8 * fq; const bf16* bp = Wt + (size_t)(ct + fr) * K + wid * KW + 8 * fq;
        const int erow = rt + (tid >> 3), ec0 = ct + 8 * (tid & 7), emb = 8 + (erow >> 6);
        const f32x4 pga = *(const f32x4*)(gate + (size_t)emb * MODLD + ec0), pgb = *(const f32x4*)(gate + (size_t)emb * MODLD + ec0 + 4);
        const f32x4 pr0 = *(const f32x4*)(base + (size_t)erow * DM + ec0), pr1 = *(const f32x4*)(base + (size_t)erow * DM + ec0 + 4);
        f32x4 acc[4][4];
#pragma unroll
        for (int mi = 0; mi < 4; ++mi)
#pragma unroll
            for (int nj = 0; nj < 4; ++nj) acc[mi][nj] = (f32x4){0.f, 0.f, 0.f, 0.f};
#pragma unroll 2
        for (int k0 = 0; k0 < KW; k0 += 32) {
            bf16x8 a[4], b[4];
#pragma unroll
            for (int i = 0; i < 4; ++i) { a[i] = *(const bf16x8*)(ap + (size_t)(16 * i) * K + k0); b[i] = *(const bf16x8*)(bp + (size_t)(16 * i) * K + k0); }
#pragma unroll
            for (int mi = 0; mi < 4; ++mi)
#pragma unroll
                for (int nj = 0; nj < 4; ++nj) acc[mi][nj] = __builtin_amdgcn_mfma_f32_16x16x32_bf16(b[nj], a[mi], acc[mi][nj], 0, 0, 0);
        }
        LAS float* P = (LAS float*)(ring + wid * 16384);
#pragma unroll
        for (int mi = 0; mi < 4; ++mi)
#pragma unroll
            for (int nj = 0; nj < 4; ++nj) { const int row = mi * 16 + fr, grp = (nj * 4 + fq) ^ (row & 15); *(LAS f32x4*)(P + row * 64 + grp * 4) = acc[mi][nj]; }
        __syncthreads();
        { const int row = tid >> 3, j = tid & 7; const int g0 = (2 * j) ^ (row & 15), g1 = (2 * j + 1) ^ (row & 15);
          f32x4 s0 = (f32x4){0.f, 0.f, 0.f, 0.f}, s1 = s0;
#pragma unroll
          for (int w = 0; w < 8; ++w) { const LAS float* p = (const LAS float*)(ring + w * 16384) + row * 64; s0 += *(const LAS f32x4*)(p + g0 * 4); s1 += *(const LAS f32x4*)(p + g1 * 4); }
          const int grow = rt + row, c0 = ct + 8 * j; const int mb = 8 + (grow >> 6);
          const f32x4 ga = pga * coef, gb = pgb * coef; const f32x4 r0 = pr0, r1 = pr1; (void)mb;
          *(f32x4*)(outp + (size_t)grow * DM + c0) = r0 + ga * s0; *(f32x4*)(outp + (size_t)grow * DM + c0 + 4) = r1 + gb * s1; }
        __syncthreads();
    }
}
__device__ __forceinline__ void stage_fb(LAS float* fb, LAS float* wtot, const float* src0, int n0, const float* src1, int n1) {
    int tid = threadIdx.x; asm volatile("" : "+v"(tid)); const int lane = tid & 63, wid = tid >> 6; const int n = n0 + n1, e = 4 * tid;
    f32x4 v = (f32x4){0.f, 0.f, 0.f, 0.f};
    if (e < n) v = (e < n0) ? *(const f32x4*)(src0 + e) : *(const f32x4*)(src1 + (e - n0));
    const float s0 = v[0], s1 = s0 + v[1], s2 = s1 + v[2], s3 = s2 + v[3];
    float inc = s3;
#pragma unroll
    for (int o = 1; o < 64; o <<= 1) { const float t = __shfl_up(inc, o); if (lane >= o) inc += t; }
    if (lane == 63) wtot[wid] = inc;
    __syncthreads();
    float base = inc - s3;
#pragma unroll
    for (int w = 0; w < 8; ++w) { const float tw = wtot[w]; if (w < wid) base += tw; }
    const float c = -1.4426950408889634f;
    if (e < n) *(LAS f32x4*)(fb + e) = (f32x4){(base + s0) * c, (base + s1) * c, (base + s2) * c, (base + s3) * c};
    __syncthreads();
}
__device__ __forceinline__ void attn_sample_unit(int b, int h, const float* cK, const float* cV, const bf16* QB, const bf16* KB, const bf16* VB, const attn_body::MergeCtx& mc,
                                                 LAS unsigned char* ring, const LAS float* fb, LAS float* stats) {
    using attn_body::crow;
    int tid = threadIdx.x; asm volatile("" : "+v"(tid));
    const int lane = tid & 63, r32 = lane & 31, hi = lane >> 5; const int wid = __builtin_amdgcn_readfirstlane(tid >> 6);
    const size_t rowbase = (size_t)MP + (size_t)b * TS;
    LAS unsigned char* Ks = ring + wid * 16384; LAS unsigned char* Vs = Ks + 8192;
    LAS float* wsf = stats + 1024 + wid * 64;
    LAS unsigned char* QL = ring + (QL_OFF - RING_OFF);
    { const int row = tid >> 3, ch = tid & 7; *(LAS v4u*)(QL + row * 144 + ch * 16) = *(const v4u*)(QB + (rowbase + row) * DM + h * HD + ch * 8); }
    __syncthreads();
    float mhat[2], lsum[2] = {0.f, 0.f}; f32x16 o[2][2];
#pragma unroll
    for (int g = 0; g < 2; ++g) { mhat[g] = fb[PAST + 32 * g + r32]; o[g][0] = f32x16{}; o[g][1] = f32x16{}; }
    const int vb = (int)(unsigned)(uintptr_t)Vs + ((lane >> 4) & 1) * 32 + (lane & 3) * 8 + (4 * hi + ((lane & 15) >> 2)) * 64;
#pragma unroll 1
    for (int tl = wid; tl < 17; tl += 8) {
        if (tl < 16) {
            const f32x4* ksrc = (const f32x4*)(cK + ((size_t)(b * NH + h) * PAST + tl * 64) * HD); const f32x4* vsrc = (const f32x4*)(cV + ((size_t)(b * NH + h) * PAST + tl * 64) * HD);
#pragma unroll 1
            for (int hb = 0; hb < 16; hb += 8) {
                f32x4 kva[8], vva[8];
#pragma unroll
                for (int i = 0; i < 8; ++i) { kva[i] = __builtin_nontemporal_load(ksrc + (hb + i) * 64 + lane); vva[i] = __builtin_nontemporal_load(vsrc + (hb + i) * 64 + lane); }
#pragma unroll
                for (int i = 0; i < 8; ++i) { const int key = 4 * (hb + i) + (lane >> 4), d = (lane & 15) * 4; const f32x4 kv = kva[i], vv = vva[i];
                    v2u kw, vw; kw.x = pk2(kv.x, kv.y); kw.y = pk2(kv.z, kv.w); vw.x = pk2(vv.x, vv.y); vw.y = pk2(vv.z, vv.w);
                    *(LAS v2u*)(Ks + (d >> 3) * 1024 + key * 16 + (d & 7) * 2) = kw;
                    *(LAS v2u*)(Vs + ((d >> 5) * 4 + (key >> 4)) * 1024 + (key & 15) * 64 + (d & 31) * 2) = vw; }
            }
        } else {
#pragma unroll 1
            for (int hb = 0; hb < 8; hb += 4) {
                v4u kvb[4], vvb[4];
#pragma unroll
                for (int i = 0; i < 4; ++i) { const int key = 8 * (hb + i) + (lane >> 3), ch = lane & 7; const size_t off = (rowbase + key) * DM + h * HD + ch * 8; kvb[i] = *(const v4u*)(KB + off); vvb[i] = *(const v4u*)(VB + off); }
#pragma unroll
                for (int i = 0; i < 4; ++i) { const int key = 8 * (hb + i) + (lane >> 3), ch = lane & 7;
                    *(LAS v4u*)(Ks + ch * 1024 + key * 16) = kvb[i];
                    *(LAS v4u*)(Vs + ((ch >> 2) * 4 + (key >> 4)) * 1024 + (key & 15) * 64 + (ch & 3) * 16) = vvb[i]; }
            }
        }
        LDS_WAIT();
#pragma unroll
        for (int g = 0; g < 2; ++g) {
            __builtin_amdgcn_sched_barrier(0);
            f32x16 p0, p1;
            { const LAS float* fp = fb + 64 * tl + 4 * hi;
#pragma unroll
              for (int i = 0; i < 4; ++i) { const f32x4 x = *(const LAS f32x4*)(fp + 8 * i), y = *(const LAS f32x4*)(fp + 32 + 8 * i);
#pragma unroll
                  for (int e = 0; e < 4; ++e) { p0[4 * i + e] = x[e] - mhat[g]; p1[4 * i + e] = y[e] - mhat[g]; } } }
            { const LAS unsigned char* kb = Ks + hi * 1024 + r32 * 16;
#pragma unroll
              for (int d0 = 0; d0 < 4; ++d0) { const bf16x8 b0 = *(const LAS bf16x8*)(kb + d0 * 2048), b1 = *(const LAS bf16x8*)(kb + d0 * 2048 + 512);
                  const bf16x8 qf = *(const LAS bf16x8*)(QL + (32 * g + r32) * 144 + d0 * 32 + hi * 16);
                  p0 = __builtin_amdgcn_mfma_f32_32x32x16_bf16(b0, qf, p0, 0, 0, 0); p1 = __builtin_amdgcn_mfma_f32_32x32x16_bf16(b1, qf, p1, 0, 0, 0); } }
            if (tl == 16) { const int qi = 32 * g + r32;
#pragma unroll
                for (int r = 0; r < 16; ++r) { const int kj = crow(r, hi); if (kj > qi) p0[r] = -INFINITY; if (kj + 32 > qi) p1[r] = -INFINITY; } }
            float rm = p0[0];
#pragma unroll
            for (int r = 1; r < 16; ++r) rm = fmaxf(rm, p0[r]);
#pragma unroll
            for (int r = 0; r < 16; ++r) rm = fmaxf(rm, p1[r]);
            rm = fmaxf(rm, __shfl_xor(rm, 32));
            const float dl = fmaxf(rm, 0.f);
            mhat[g] += dl;
            const float f = __builtin_amdgcn_exp2f(-dl);
            float sacc = 0.f;
#pragma unroll
            for (int r = 0; r < 16; ++r) { p0[r] = __builtin_amdgcn_exp2f(p0[r] - dl); p1[r] = __builtin_amdgcn_exp2f(p1[r] - dl); sacc += p0[r] + p1[r]; }
            lsum[g] = lsum[g] * f + sacc;
            if (hi == 0) wsf[32 * g + r32] = f;
            LDS_WAIT();
#pragma unroll
            for (int r = 0; r < 16; ++r) { const float fr_ = wsf[32 * g + crow(r, hi)]; o[g][0][r] *= fr_; o[g][1][r] *= fr_; }
            v4u pw0, pw1, pw2, pw3;
#define PKW(P, B) attn_body::cvtpk_s(P[B], P[B + 1])
            pw0 = (v4u){PKW(p0, 0), PKW(p0, 2), PKW(p0, 4), PKW(p0, 6)}; pw1 = (v4u){PKW(p0, 8), PKW(p0, 10), PKW(p0, 12), PKW(p0, 14)};
            pw2 = (v4u){PKW(p1, 0), PKW(p1, 2), PKW(p1, 4), PKW(p1, 6)}; pw3 = (v4u){PKW(p1, 8), PKW(p1, 10), PKW(p1, 12), PKW(p1, 14)};
#undef PKW
            attn_body::pv(o[g], vb, __builtin_bit_cast(bf16x8, pw0), __builtin_bit_cast(bf16x8, pw1), __builtin_bit_cast(bf16x8, pw2), __builtin_bit_cast(bf16x8, pw3));
        }
        LDS_WAIT();
    }
#pragma unroll
    for (int g = 0; g < 2; ++g) { const float lt = lsum[g] + __shfl_xor(lsum[g], 32); if (hi == 0) { stats[wid * 64 + 32 * g + r32] = mhat[g]; stats[512 + wid * 64 + 32 * g + r32] = lt; } }
    __syncthreads();
    LAS float* Op = (LAS float*)(ring + wid * 16384);
#pragma unroll
    for (int g = 0; g < 2; ++g)
#pragma unroll
        for (int r = 0; r < 16; ++r) { const int q = 32 * g + crow(r, hi); float mx = stats[q];
#pragma unroll
            for (int w = 1; w < 8; ++w) mx = fmaxf(mx, stats[w * 64 + q]);
            const float scl = __builtin_amdgcn_exp2f(stats[wid * 64 + q] - mx);
            Op[q * 64 + r32] = o[g][0][r] * scl; Op[q * 64 + 32 + r32] = o[g][1][r] * scl; }
    __syncthreads();
    { const int q = tid >> 3, d0 = (tid & 7) * 8; float mx = stats[q];
#pragma unroll
      for (int w = 1; w < 8; ++w) mx = fmaxf(mx, stats[w * 64 + q]);
      float Lq = 0.f; f32x4 s0 = (f32x4){0.f, 0.f, 0.f, 0.f}, s1 = s0;
#pragma unroll
      for (int w = 0; w < 8; ++w) { Lq += stats[512 + w * 64 + q] * __builtin_amdgcn_exp2f(stats[w * 64 + q] - mx);
          const LAS float* p = (const LAS float*)(ring + w * 16384) + q * 64 + d0; s0 += *(const LAS f32x4*)p; s1 += *(const LAS f32x4*)(p + 4); }
      const float rl = 1.0f / Lq; s0 = s0 * rl; s1 = s1 * rl;
      v4u w; w.x = pk2(s0.x, s0.y); w.y = pk2(s0.z, s0.w); w.z = pk2(s1.x, s1.y); w.w = pk2(s1.z, s1.w);
      merge_store8(mc, rowbase + q, q, false, b, h * HD + d0, w); }
    __syncthreads();
}

__global__ void __launch_bounds__(NTHREADS, 2) fwd_mega(Args args) {
    extern __shared__ __attribute__((aligned(16))) unsigned char lds[];
    cg::grid_group grid = cg::this_grid();
    LAS unsigned char* L = (LAS unsigned char*)lds;
    const int G = gridDim.x; const int bx = blockIdx.x; const int vcu = (G % 8 == 0) ? (bx % 8) * (G / 8) + bx / 8 : bx;
    unsigned char* ws = args.ws; float* out = args.out; const float* mod = (const float*)(ws + WS_MOD);
    bf16* Hb = (bf16*)(ws + WS_H); bf16* ACT = (bf16*)(ws + WS_ACT);
    float* XR = out + O_Y;
    const int lo = args.ph_lo, hi = args.ph_hi;
#ifndef PH_MASK
#define PH_MASK 0x1fff
#endif
#define IN(k) (((PH_MASK >> (k)) & 1) && lo <= (k) && (k) < hi)
#define SEAM(k) do { if (IN(k) && IN((k) + 1)) xcd_barrier(bar); } while (0)

    unsigned* barw = (unsigned*)(ws + WS_BAR);
    volatile LAS unsigned* bst = (volatile LAS unsigned*)(L + STAT_OFF + 8000);
    unsigned* cntw = (unsigned*)(ws + WS_CNT);
    if (bx == 0) { for (int i = threadIdx.x; i < XCD_BAR_WORDS; i += NTHREADS) __hip_atomic_store(barw + i, 0u, __ATOMIC_RELAXED, __HIP_MEMORY_SCOPE_AGENT);
                   for (int i = threadIdx.x; i < CNT_WORDS; i += NTHREADS) __hip_atomic_store(cntw + i, 0u, __ATOMIC_RELAXED, __HIP_MEMORY_SCOPE_AGENT); }
    const bool fuse_rows = (G == 256);
    const int wv = threadIdx.x >> 6, ln = threadIdx.x & 63;
    bf16* Hb2 = (bf16*)(ws + WS_GAB);
#define HANDOFF(inst, S) pg8::Unit hu; S.next(0, hu); const int rt_ = vcu >> 4, ct_ = vcu & 15; \
        panel_handoff(cntw + ((inst) * 80 + hu.pm) * 16, cntw + ((inst) * 80 + 64 + rt_) * 16)
    if (IN(0)) { p0_mod(args, L, vcu, G); p0_weights(args, L, vcu, G); }
    if (threadIdx.x < 2) bst[threadIdx.x] = 0u;
    grid.sync();
    const XcdBarrier bar = xcd_barrier_post(barw, bst);
    if (IN(1)) norm_mod_rows(args.in[0], args.in[1], args.in[10], mod, 0 * DM, 1 * DM, Hb, vcu, G);
    SEAM(1);
    if (IN(2)) { pg8::Gemm g{Hb, (const bf16*)(ws + WS_W1IN), MT, 2 * DFF, DM}; pg8::StaticOrder S; S.init(MT, 2 * DFF, G, bx);
        pg8::EpiSwiGLU E{ACT, DFF}; pg8::gemm_phase<pg8::EpiSwiGLU, pg8::StaticOrder, PG8_ALIGN, PG8_SP2>(L + RING_OFF, g, S, E);
        constexpr int NF = (68 * 22) % 256;
        if (G == 256 && bx >= NF) weight_items_tail(args, L, WCUT0, WCUT1, (bx - NF) * NWAVES + (int)(threadIdx.x >> 6), (256 - NF) * NWAVES); }
    SEAM(2);
    if (IN(3)) { pg8::Gemm g{ACT, (const bf16*)(ws + WS_W1OUT), MP, DM, DFF}; pg8::StaticOrder S; S.init(MP, DM, G, bx);
        pg8::EpiResid<true> E{args.in[0], args.in[1], XR, mod + 2 * DM, 0.5f}; pg8::gemm_phase<pg8::EpiResid<true>, pg8::StaticOrder, false, PG8_SP2>(L + RING_OFF, g, S, E);
        small_gemm_sample(ACT + (size_t)MP * DFF, (const bf16*)(ws + WS_W1OUT), DFF, args.in[1], XR + (size_t)MP * DM, mod + 2 * DM, 0.5f, L + RING_OFF, vcu, G);
        if (fuse_rows) { HANDOFF(0, S);
            norm_rows4<false, false, 8>(hu.pm * 256 + hu.pn * 64 + wv * 8, XR, XR + (size_t)MP * DM, args.in[13], mod, 3 * DM, 4 * DM, Hb, nullptr, ln);
            if (wv == 0) norm_rows4<false>(MP + rt_ * 64 + ct_ * 4, XR, XR + (size_t)MP * DM, args.in[13], mod, 3 * DM, 4 * DM, Hb, nullptr, ln); } }
    if (!fuse_rows) { SEAM(3); if (IN(4)) norm_mod_rows(XR, XR + (size_t)MP * DM, args.in[13], mod, 3 * DM, 4 * DM, Hb, vcu, G); }
    SEAM(4);
    if (IN(5)) { pg8::Gemm g{Hb, (const bf16*)(ws + WS_WIN), MT, NINP, DM}; pg8::StaticOrder S; S.init(MT, NINP, G, bx);
        pg8::EpiMix E{(bf16*)(ws + WS_QB), out, args.in[15], attn_body::C2};
        pg8::gemm_phase<pg8::EpiMix, pg8::StaticOrder, PG8_ALIGN, PG8_SP2>(L + RING_OFF, g, S, E);
        constexpr int NF = (68 * 33) % 256;
        if (G == 256 && bx >= NF) weight_items_tail(args, L, WCUT1, WITEMS, (bx - NF) * NWAVES + (int)(threadIdx.x >> 6), (256 - NF) * NWAVES); }
    SEAM(5);
    if (IN(6)) {
        const attn_body::bf16* Q = (const attn_body::bf16*)(ws + WS_QB); const attn_body::bf16* K = (const attn_body::bf16*)(ws + WS_KB); const attn_body::bf16* V = (const attn_body::bf16*)(ws + WS_VB);
        LAS float* fb = (LAS float*)(L + FB_OFF); LAS float* stats = (LAS float*)(L + STAT_OFF);
        const attn_body::MergeCtx mc{(const bf16*)(ws + WS_GAB), (const bf16*)(ws + WS_G2B), (const bf16*)(ws + WS_UB), args.in[16], args.in[5], Hb};
#pragma unroll 1
        for (int pass = 0; pass < 2; ++pass) {
        const bool do_sample = ((vcu & 1) != 0) == (pass == 0);
        if (!do_sample) {
        for (int it = vcu; it < 512; it += G) {
            const int bh = it >> 2, k = it & 3;
            stage_fb(fb, stats, out + O_LFP + (size_t)bh * TP, TP, nullptr, 0);
#pragma unroll 1
            for (int j = 0; j < 2; ++j) attn_body::attn_unit<8>(bh >> 4, bh & 15, j ? k : 7 - k, Q, K, V, mc, (char*)lds + RING_OFF, fb);
        }
        } else {
        for (int it = vcu; it < 256; it += G) {
            const int b = it >> 4, h = it & 15;
            stage_fb(fb, stats, args.in[4] + (size_t)it * PAST, PAST, out + O_LFS + (size_t)it * TS, TS);
            attn_sample_unit(b, h, args.in[2], args.in[3], (const bf16*)(ws + WS_QB), (const bf16*)(ws + WS_KB), (const bf16*)(ws + WS_VB), mc, L + RING_OFF, fb, stats);
        }
        }
        }
    }
    SEAM(6);
    if (IN(8)) { pg8::Gemm g{Hb, (const bf16*)(ws + WS_WOUT), MP, DM, DM}; pg8::StaticOrder S; S.init(MP, DM, G, bx);
        pg8::EpiResid<false> E{XR, XR + (size_t)MP * DM, XR, mod + 5 * DM, 1.0f}; pg8::gemm_phase<pg8::EpiResid<false>, pg8::StaticOrder, false, PG8_SP2>(L + RING_OFF, g, S, E);
        small_gemm_sample(Hb + (size_t)MP * DM, (const bf16*)(ws + WS_WOUT), DM, XR + (size_t)MP * DM, XR + (size_t)MP * DM, mod + 5 * DM, 1.0f, L + RING_OFF, vcu, G);
        if (fuse_rows) { HANDOFF(1, S);
            norm_rows4<false, false, 8>(hu.pm * 256 + hu.pn * 64 + wv * 8, XR, XR + (size_t)MP * DM, args.in[18], mod, 6 * DM, 7 * DM, Hb2, nullptr, ln);
            if (wv == 0) norm_rows4<false>(MP + rt_ * 64 + ct_ * 4, XR, XR + (size_t)MP * DM, args.in[18], mod, 6 * DM, 7 * DM, Hb2, nullptr, ln); } }
    if (!fuse_rows) { SEAM(8); if (IN(9)) norm_mod_rows(XR, XR + (size_t)MP * DM, args.in[18], mod, 6 * DM, 7 * DM, Hb2, vcu, G); }
    SEAM(9);
    if (IN(10)) { pg8::Gemm g{Hb2, (const bf16*)(ws + WS_W2IN), MT, 2 * DFF, DM}; pg8::StaticOrder S; S.init(MT, 2 * DFF, G, bx);
        pg8::EpiSwiGLU E{ACT, DFF}; pg8::gemm_phase<pg8::EpiSwiGLU, pg8::StaticOrder, PG8_ALIGN, PG8_SP2>(L + RING_OFF, g, S, E); }
    SEAM(10);
    if (IN(11)) { pg8::Gemm g{ACT, (const bf16*)(ws + WS_W2OUT), MP, DM, DFF}; pg8::StaticOrder S; S.init(MP, DM, G, bx);
        pg8::EpiResid<false> E{XR, XR + (size_t)MP * DM, XR, mod + 8 * DM, 0.5f}; pg8::gemm_phase<pg8::EpiResid<false>, pg8::StaticOrder, false, PG8_SP2>(L + RING_OFF, g, S, E);
        small_gemm_sample(ACT + (size_t)MP * DFF, (const bf16*)(ws + WS_W2OUT), DFF, XR + (size_t)MP * DM, XR + (size_t)MP * DM, mod + 8 * DM, 0.5f, L + RING_OFF, vcu, G);
        if (fuse_rows) { HANDOFF(2, S);
            norm_rows4<true, false, 8>(hu.pm * 256 + hu.pn * 64 + wv * 8, XR, XR + (size_t)MP * DM, args.in[21], nullptr, 0, 0, nullptr, XR, ln);
            if (wv == 0) norm_rows4<true>(MP + rt_ * 64 + ct_ * 4, XR, XR + (size_t)MP * DM, args.in[21], nullptr, 0, 0, nullptr, XR, ln); } }
    if (!fuse_rows) { SEAM(11); if (IN(12)) final_norm_rows(XR, args.in[21], vcu, G); }
#undef IN
#undef SEAM
}

#ifndef MK_N_LAUNCHES
#define MK_N_LAUNCHES 1
#endif
constexpr int N_PHASES = 13;
extern "C" void kernel_launch(void* const* d_in, const int* in_sizes, int n_in, void* d_out, int out_size, void* d_ws, size_t ws_size, hipStream_t stream) {
    static int grid = 0;
    if (grid == 0) {
        if (n_in != 22 || out_size != (int)O_END || ws_size < WS_END) { fprintf(stderr, "kernel_launch: unexpected sizes n_in %d out %d ws %zu; nothing launched\n", n_in, out_size, ws_size); grid = -1; return; }
        int dev = 0, cus = 0, per_cu = 0;
        if (hipGetDevice(&dev) != hipSuccess || hipDeviceGetAttribute(&cus, hipDeviceAttributeMultiprocessorCount, dev) != hipSuccess) { grid = -1; return; }
        if (hipFuncSetAttribute((const void*)fwd_mega, hipFuncAttributeMaxDynamicSharedMemorySize, LDS_BYTES) != hipSuccess) { fprintf(stderr, "kernel_launch: hipFuncSetAttribute failed\n"); grid = -1; return; }
        if (hipOccupancyMaxActiveBlocksPerMultiprocessor(&per_cu, (const void*)fwd_mega, NTHREADS, LDS_BYTES) != hipSuccess || per_cu < 1) { fprintf(stderr, "kernel_launch: occupancy query says %d\n", per_cu); (void)hipGetLastError(); grid = -1; return; }
        grid = cus * 1;
        fprintf(stderr, "kernel_launch: grid %d (cus %d, per_cu %d), ws %zu\n", grid, cus, per_cu, ws_size);
    }
    if (grid < 0) return;
    Args a{};
    for (int i = 0; i < 22; ++i) a.in[i] = (const float*)d_in[i];
    a.out = (float*)d_out; a.ws = (unsigned char*)d_ws;
#if MK_N_LAUNCHES == 1
    a.ph_lo = 0; a.ph_hi = N_PHASES;
    void* kargs[] = {&a};
    hipError_t e = hipLaunchCooperativeKernel((const void*)fwd_mega, dim3(grid), dim3(NTHREADS), kargs, LDS_BYTES, stream);
    if (e != hipSuccess) fprintf(stderr, "kernel_launch: cooperative launch failed: %s (grid %d)\n", hipGetErrorString(e), grid);
#else
    for (int p = 0; p < N_PHASES; ++p) { a.ph_lo = p; a.ph_hi = p + 1; void* kargs[] = {&a};
        hipError_t e = hipLaunchCooperativeKernel((const void*)fwd_mega, dim3(grid), dim3(NTHREADS), kargs, LDS_BYTES, stream);
        if (e != hipSuccess) { fprintf(stderr, "kernel_launch: launch %d failed: %s\n", p, hipGetErrorString(e)); break; } }
#endif
}
```

```cpp
#include <hip/hip_runtime.h>
#include <hip/hip_cooperative_groups.h>
#include <cstdio>
#include <cstdint>
constexpr int MODLD = 9216;
constexpr int DM = 1024, MP = 16384, MS = 1024, MT = MP + MS, TP = 2048, TS = 64, PAST = 1024, NH = 16, HD = 64, DFF = 2816, NIN = 8208, NINP = 8448, NMOD = 9;
constexpr int OFF_Q = 0, OFF_K = 1024, OFF_V = 2048, OFF_F = 3072, OFF_B = 3088, OFF_C = 4112, OFF_X = 5136, OFF_GA = 6160, OFF_GC = 7184;
constexpr float EPS = 1e-6f;
constexpr size_t O_Y = 0, O_KP = (size_t)MT * DM, O_VP = O_KP + (size_t)MP * DM, O_LFP = O_VP + (size_t)MP * DM, O_CVP = O_LFP + 8 * 16 * 2048, O_KS = O_CVP + 8 * 2 * 1024,
                 O_VS = O_KS + (size_t)MS * DM, O_LFS = O_VS + (size_t)MS * DM, O_CVS = O_LFS + 16 * 16 * 64, O_END = O_CVS + 16 * 2 * 1024;
static_assert(O_END == 53805056, "d_out map");
namespace pg8 {
#define PG8_LAS __attribute__((address_space(3)))
typedef unsigned short bf16_t;
typedef short bf16x8 __attribute__((ext_vector_type(8)));
typedef float f32x4 __attribute__((ext_vector_type(4)));
typedef unsigned u32x4 __attribute__((ext_vector_type(4)));
constexpr int BM = 256, BK = 64, HALF = 128, HTB = HALF * BK * 2  , STAGE_BYTES = 8 * HTB, NXCD = 8, WGM = 8;

__host__ __device__ __forceinline__ int lds_byte(int r, int c) { const int st = (r >> 4) * 2 + (c >> 5), rr = r & 15, cc = c & 31, ob = rr * 64 + cc * 2; return st * 1024 + (ob ^ (((ob >> 9) & 1) << 5)); }
__host__ __device__ __forceinline__ void stage_rc(int b, int& R, int& C) { const int st = b / 1024, sb = b % 1024, swz = sb ^ (((sb >> 9) & 1) << 5); R = (st >> 1) * 16 + swz / 64; C = (st & 1) * 32 + (swz % 64) / 2; }
__host__ __device__ __forceinline__ int perm32(int rho) { const int n = rho >> 4, i = rho & 15; return 8 * (i >> 2) + 4 * n + (i & 3); }

struct Unit { int pm, pn; };
struct Gemm { const bf16_t* A; const bf16_t* Bt; int M, N, K; };

struct StaticOrder {
    int nM, nN, nwg, G, c;
    __host__ __device__ void init(int M, int N, int G_, int c_) { nM = M / BM; nN = N / BM; nwg = nM * nN; G = G_; c = c_; }
    __host__ __device__ bool next(int i, Unit& u) const {
        const long L = (long)i * G + c; if (L >= nwg) return false;
        int wgid = (int)L; { const int q = nwg / NXCD, r = nwg % NXCD, xcd = wgid % NXCD, off = wgid / NXCD; wgid = (xcd < r ? xcd * (q + 1) : r * (q + 1) + (xcd - r) * q) + off; }
        const int nig = WGM * nN, gid = wgid / nig, fm = gid * WGM, gsz = (nM - fm) < WGM ? (nM - fm) : WGM;
        u.pm = fm + ((wgid % nig) % gsz); u.pn = (wgid % nig) / gsz; return true;
    }
    __device__ __forceinline__ void a_ready(const Unit&) const {}
    __device__ __forceinline__ void done(const Unit&) const {}
};

__device__ __forceinline__ unsigned cvt_pk_bf16(float lo, float hi) { unsigned r; asm volatile("v_cvt_pk_bf16_f32 %0, %1, %2" : "=v"(r) : "v"(lo), "v"(hi)); return r; }

constexpr int MPROMPT = 16384;
__device__ __forceinline__ int mod_batch(int pm, int ai, int wr) { return pm < 64 ? (pm >> 3) : 8 + (pm - 64) * 4 + 2 * ai + wr; }
__device__ __forceinline__ float sigmoid_f(float x) { return __builtin_amdgcn_rcpf(1.0f + __builtin_amdgcn_exp2f(-1.4426950408889634f * x)); }
__device__ __forceinline__ f32x4 sigmoid4(f32x4 x) { return (f32x4){sigmoid_f(x[0]), sigmoid_f(x[1]), sigmoid_f(x[2]), sigmoid_f(x[3])}; }
__device__ __forceinline__ u32x4 pack8(f32x4 v0, f32x4 v1) { u32x4 w; w.x = cvt_pk_bf16(v0[0], v0[1]); w.y = cvt_pk_bf16(v0[2], v0[3]); w.z = cvt_pk_bf16(v1[0], v1[1]); w.w = cvt_pk_bf16(v1[2], v1[3]); return w; }

struct EpiSwiGLU {
    static constexpr bool PERM = true, AFTER_DRAIN = false;
    bf16_t* O; int ldc;
    __device__ __forceinline__ void operator()(const f32x4 (&acc)[2][2][4][2], const Unit& u, int wr, int wc, int fr, int fq) const {
        const int row0 = u.pm * BM + wr * 64 + fr, col0 = u.pn * HALF + wc * 32 + 8 * fq;
#pragma unroll
        for (int ai = 0; ai < 2; ++ai)
#pragma unroll
            for (int m = 0; m < 4; ++m) {
                const f32x4 a0 = acc[ai][0][m][0], a1 = acc[ai][0][m][1];
                const f32x4 v0 = a0 * sigmoid4(a0) * acc[ai][1][m][0], v1 = a1 * sigmoid4(a1) * acc[ai][1][m][1];
                *(u32x4*)(O + (size_t)(row0 + ai * HALF + m * 16) * ldc + col0) = pack8(v0, v1);
            }
    }
};
template <bool NTB> struct EpiResid {
    static constexpr bool PERM = true, AFTER_DRAIN = false;
    const float* baseP; const float* baseS; float* out; const float* gate; float coef;
    __device__ __forceinline__ void operator()(const f32x4 (&acc)[2][2][4][2], const Unit& u, int wr, int wc, int fr, int fq) const {
        const int col0 = u.pn * BM + wc * 32 + 8 * fq;
#pragma unroll
        for (int ai = 0; ai < 2; ++ai) {
            const float* gp = gate + (size_t)mod_batch(u.pm, ai, wr) * MODLD + col0;
            f32x4 g[2][2];
#pragma unroll
            for (int bj = 0; bj < 2; ++bj)
#pragma unroll
                for (int n = 0; n < 2; ++n) g[bj][n] = *(const f32x4*)(gp + bj * HALF + 4 * n) * coef;
            f32x4 bsv[4][2][2];
#pragma unroll
            for (int m = 0; m < 4; ++m) {
                const int row = u.pm * BM + ai * HALF + wr * 64 + m * 16 + fr;
                const float* bp = (u.pm < 64 ? baseP + (size_t)row * 1024 : baseS + (size_t)(row - MPROMPT) * 1024) + col0;
#pragma unroll
                for (int bj = 0; bj < 2; ++bj)
#pragma unroll
                    for (int n = 0; n < 2; ++n) { const f32x4* p = (const f32x4*)(bp + bj * HALF + 4 * n); bsv[m][bj][n] = NTB ? __builtin_nontemporal_load(p) : *p; }
            }
            asm volatile("" ::: "memory");
#pragma unroll
            for (int m = 0; m < 4; ++m) {
                const int row = u.pm * BM + ai * HALF + wr * 64 + m * 16 + fr;
                float* op = out + (size_t)row * 1024 + col0;
#pragma unroll
                for (int bj = 0; bj < 2; ++bj)
#pragma unroll
                    for (int n = 0; n < 2; ++n) *(f32x4*)(op + bj * HALF + 4 * n) = bsv[m][bj][n] + g[bj][n] * acc[ai][bj][m][n];
            }
        }
    }
};
struct EpiMix {
    static constexpr bool PERM = true, AFTER_DRAIN = false;
    bf16_t* QB; float* outp; const float* b_f; float qscale;
    static constexpr size_t BSTRIDE = (size_t)MT * DM;
    __device__ __forceinline__ void operator()(const f32x4 (&acc)[2][2][4][2], const Unit& u, int wr, int wc, int fr, int fq) const {
        const int pn = u.pn; const bool prm = u.pm < 64;
        const int row0 = u.pm * BM + wr * 64 + fr;
        if (pn < 16) {
            const int seg = pn >> 2, colt = (pn & 3) * BM + wc * 32 + 8 * fq;
            bf16_t* dst = QB + (size_t)seg * BSTRIDE;
            const float sc = seg == 0 ? qscale : 1.f;
            float* fo = outp + (seg == 1 ? (prm ? O_KP : O_KS) : (prm ? O_VP : O_VS));
#pragma unroll
            for (int ai = 0; ai < 2; ++ai)
#pragma unroll
                for (int m = 0; m < 4; ++m) {
                    const int row = row0 + ai * HALF + m * 16;
                    const int rr = prm ? row : row - MPROMPT; const int bb = prm ? (rr >> 11) : (rr >> 6), tt = prm ? (rr & 2047) : (rr & 63), TT = prm ? 2048 : 64;
#pragma unroll
                    for (int bj = 0; bj < 2; ++bj) {
                        f32x4 v0 = acc[ai][bj][m][0], v1 = acc[ai][bj][m][1]; const int col = colt + bj * HALF;
                        if (seg == 1 || seg == 2) { float* p = fo + ((size_t)(bb * 16 + (col >> 6)) * TT + tt) * 64 + (col & 63); __builtin_nontemporal_store(v0, (f32x4*)p); __builtin_nontemporal_store(v1, (f32x4*)(p + 4)); }
                        if (seg == 3) { v0 = sigmoid4(v0); v1 = sigmoid4(v1); }
                        v0 = v0 * sc; v1 = v1 * sc;
                        *(u32x4*)(dst + (size_t)row * 1024 + col) = pack8(v0, v1);
                    }
                }
        } else if (pn < 32) {
            const bool cx = pn >= 24; const int col = ((pn - 16) & 7) * HALF + wc * 32 + 8 * fq;
            bf16_t* dst = QB + (size_t)(cx ? 5 : 4) * BSTRIDE;
#pragma unroll
            for (int ai = 0; ai < 2; ++ai)
#pragma unroll
                for (int m = 0; m < 4; ++m) {
                    const int row = row0 + ai * HALF + m * 16;
                    f32x4 v0, v1;
                    if (cx) { v0 = acc[ai][0][m][0] * acc[ai][1][m][0]; v1 = acc[ai][0][m][1] * acc[ai][1][m][1]; }
                    else { v0 = acc[ai][0][m][0] * sigmoid4(acc[ai][1][m][0]); v1 = acc[ai][0][m][1] * sigmoid4(acc[ai][1][m][1]); }
                    *(u32x4*)(dst + (size_t)row * 1024 + col) = pack8(v0, v1);
                    if (cx) {
                        const int rr = prm ? row : row - MPROMPT; const int bb = prm ? (rr >> 11) : (rr >> 6), tt = prm ? (rr & 2047) : (rr & 63), TT = prm ? 2048 : 64;
                        if (tt >= TT - 2) { float* p = outp + (prm ? O_CVP : O_CVS) + (size_t)(bb * 2 + (tt - (TT - 2))) * 1024 + col; *(f32x4*)p = v0; *(f32x4*)(p + 4) = v1; }
                    }
                }
        } else {
            if (wc == 0 && fq < 2) {
                const f32x4 bf0 = *(const f32x4*)(b_f + 8 * fq), bf1 = *(const f32x4*)(b_f + 8 * fq + 4);
                asm volatile("" ::: "memory");
#pragma unroll
                for (int ai = 0; ai < 2; ++ai)
#pragma unroll
                    for (int m = 0; m < 4; ++m) {
                        const int row = row0 + ai * HALF + m * 16;
                        const int rr = prm ? row : row - MPROMPT; const int bb = prm ? (rr >> 11) : (rr >> 6), tt = prm ? (rr & 2047) : (rr & 63), TT = prm ? 2048 : 64;
                        float* fo = outp + (prm ? O_LFP : O_LFS);
#pragma unroll
                        for (int n = 0; n < 2; ++n)
#pragma unroll
                            for (int e = 0; e < 4; ++e) {
                                const int hh = 8 * fq + 4 * n + e; const float v = acc[ai][0][m][n][e] + (n ? bf1[e] : bf0[e]);
                                const float ls = fminf(v, 0.f) - __logf(1.0f + __expf(-fabsf(v)));
                                fo[(size_t)(bb * 16 + hh) * TT + tt] = ls;
                            }
                    }
            }
        }
    }
};
template <class Epi, class Sched, bool ALIGN_EPI = false, bool SP2 = false>
__device__ __forceinline__ void gemm_phase(PG8_LAS unsigned char* lds, const Gemm g, const Sched& S, const Epi& E) {
    const int tid = threadIdx.x, wid = __builtin_amdgcn_readfirstlane(tid >> 6), lane = tid & 63, wr = wid >> 2, wc = wid & 3, fr = lane & 15, fq = lane >> 4;
    const int K = g.K, nt = K / BK;
    unsigned voffA[2], voffB[2];
#pragma unroll
    for (int i = 0; i < 2; ++i) { int R, C; stage_rc(tid * 16 + i * 8192, R, C); const int Rb = Epi::PERM ? ((R & ~31) + perm32(R & 31)) : R;
        voffA[i] = (unsigned)(R * K + C) * 2u; voffB[i] = (unsigned)(Rb * K + C) * 2u; }
    const size_t kstep = (size_t)(BK * 2);
    const size_t hstep = (size_t)HALF * K * 2;
    const size_t tstep = 2 * hstep;
    const unsigned ldsw = (unsigned)wid * 1024u;
    const int aoff = lds_byte(wr * 64 + fr, fq * 8), boff = lds_byte(wc * 32 + fr, fq * 8);
#define PG8_SA(b, h) (((b) * 2 + (h)) * HTB)
#define PG8_SB(b, h) ((4 + (b) * 2 + (h)) * HTB)
#define PG8_STAGE(bufoff, gbase, voff) do { _Pragma("unroll") for (int _i = 0; _i < 2; ++_i) \
        __builtin_amdgcn_global_load_lds((const unsigned*)((const char*)(gbase) + (voff)[_i]), (PG8_LAS unsigned*)(lds + (bufoff) + ldsw + _i * 8192), 16, 0, 0); } while (0)
#define PG8_LDA(dst, b, h) do { _Pragma("unroll") for (int m = 0; m < 4; ++m) _Pragma("unroll") for (int k = 0; k < 2; ++k) dst[m][k] = *(const PG8_LAS bf16x8*)(lds + PG8_SA(b, h) + aoff + m * 2048 + k * 1024); } while (0)
#define PG8_LDB(dst, b, h) do { _Pragma("unroll") for (int n = 0; n < 2; ++n) _Pragma("unroll") for (int k = 0; k < 2; ++k) dst[n][k] = *(const PG8_LAS bf16x8*)(lds + PG8_SB(b, h) + boff + n * 2048 + k * 1024); } while (0)
#define PG8_MMA(ai, bj, At, Bt) do { __builtin_amdgcn_s_setprio(1); _Pragma("unroll") for (int m = 0; m < 4; ++m) _Pragma("unroll") for (int n = 0; n < 2; ++n) _Pragma("unroll") for (int k = 0; k < 2; ++k) \
        acc[ai][bj][m][n] = __builtin_amdgcn_mfma_f32_16x16x32_bf16(Bt[n][k], At[m][k], acc[ai][bj][m][n], 0, 0, 0); __builtin_amdgcn_s_setprio(0); } while (0)
#define PG8_WAIT_V(n) asm volatile("s_waitcnt vmcnt(" #n ")" ::: "memory")
#define PG8_WAIT_L(n) asm volatile("s_waitcnt lgkmcnt(" #n ")" ::: "memory")
#define PG8_BAR __builtin_amdgcn_s_barrier()
#define PG8_SCHED __builtin_amdgcn_sched_barrier(0)
    Unit cur, nxt; int ui = 0;
    if (!S.next(0, cur)) return;
    f32x4 acc[2][2][4][2];
#pragma unroll
    for (int a = 0; a < 2; ++a)
#pragma unroll
        for (int b = 0; b < 2; ++b)
#pragma unroll
            for (int m = 0; m < 4; ++m)
#pragma unroll
                for (int n = 0; n < 2; ++n) acc[a][b][m][n] = (f32x4){0.f, 0.f, 0.f, 0.f};
    bf16x8 At[4][2], B0[2][2], B1[2][2];
    const char* cA = (const char*)g.A + (size_t)cur.pm * tstep; const char* cB = (const char*)g.Bt + (size_t)cur.pn * tstep;
    S.a_ready(cur);
    if constexpr (SP2) {
        PG8_STAGE(PG8_SB(0, 0), cB, voffB); PG8_STAGE(PG8_SB(0, 1), cB + hstep, voffB); PG8_STAGE(PG8_SA(0, 0), cA, voffA); PG8_STAGE(PG8_SA(0, 1), cA + hstep, voffA);
        if (wr == 1) PG8_BAR;
        PG8_WAIT_V(2); PG8_BAR;
        PG8_STAGE(PG8_SB(1, 0), cB + kstep, voffB); PG8_STAGE(PG8_SA(1, 0), cA + kstep, voffA); PG8_STAGE(PG8_SB(1, 1), cB + hstep + kstep, voffB);
        PG8_WAIT_V(6); PG8_BAR;
    } else {
        PG8_STAGE(PG8_SB(0, 0), cB, voffB); PG8_STAGE(PG8_SA(0, 0), cA, voffA); PG8_STAGE(PG8_SB(0, 1), cB + hstep, voffB); PG8_STAGE(PG8_SA(0, 1), cA + hstep, voffA);
        if (wr == 1) PG8_BAR;
        PG8_WAIT_V(4); PG8_BAR;
        PG8_STAGE(PG8_SB(1, 0), cB + kstep, voffB); PG8_STAGE(PG8_SA(1, 0), cA + kstep, voffA); PG8_STAGE(PG8_SB(1, 1), cB + hstep + kstep, voffB);
        PG8_WAIT_V(6); PG8_BAR;
    }
    for (;;) {
        const bool has_next = S.next(ui + 1, nxt);
        const char* nA = has_next ? (const char*)g.A + (size_t)nxt.pm * tstep : cA; const char* nB = has_next ? (const char*)g.Bt + (size_t)nxt.pn * tstep : cB;
        for (int t = 0; t < nt; t += 2) {
            const bool last = (t == nt - 2);
            const char* a1 = cA + (size_t)(t + 1) * kstep;
            const char* a2 = last ? nA : cA + (size_t)(t + 2) * kstep; const char* b2 = last ? nB : cB + (size_t)(t + 2) * kstep;
            const char* a3 = a2 + kstep; const char* b3 = b2 + kstep;
            if (last && has_next) S.a_ready(nxt);
            if constexpr (SP2) {
            PG8_LDB(B0, 0, 0); PG8_LDB(B1, 0, 1); PG8_SCHED; PG8_LDA(At, 0, 0); PG8_STAGE(PG8_SA(1, 1), a1 + hstep, voffA);
            PG8_WAIT_V(8); PG8_WAIT_L(0); PG8_BAR; PG8_MMA(0, 0, At, B0); PG8_MMA(0, 1, At, B1); PG8_BAR; PG8_SCHED;
            PG8_LDA(At, 0, 1); PG8_STAGE(PG8_SB(0, 0), b2, voffB); PG8_STAGE(PG8_SB(0, 1), b2 + hstep, voffB); PG8_STAGE(PG8_SA(0, 0), a2, voffA);
            PG8_WAIT_V(8); PG8_WAIT_L(0); PG8_BAR; PG8_MMA(1, 0, At, B0); PG8_MMA(1, 1, At, B1); PG8_BAR; PG8_SCHED;
            PG8_LDB(B0, 1, 0); PG8_LDB(B1, 1, 1); PG8_SCHED; PG8_LDA(At, 1, 0); PG8_STAGE(PG8_SA(0, 1), a2 + hstep, voffA);
            PG8_WAIT_V(8); PG8_WAIT_L(0); PG8_BAR; PG8_MMA(0, 0, At, B0); PG8_MMA(0, 1, At, B1); PG8_BAR; PG8_SCHED;
            PG8_LDA(At, 1, 1); PG8_STAGE(PG8_SB(1, 0), b3, voffB); PG8_STAGE(PG8_SB(1, 1), b3 + hstep, voffB); PG8_STAGE(PG8_SA(1, 0), a3, voffA);
            PG8_WAIT_V(8); PG8_WAIT_L(0); PG8_BAR; PG8_MMA(1, 0, At, B0); PG8_MMA(1, 1, At, B1); PG8_BAR; PG8_SCHED;
            } else {
            PG8_LDB(B0, 0, 0); PG8_SCHED; PG8_LDA(At, 0, 0); PG8_STAGE(PG8_SA(1, 1), a1 + hstep, voffA);
            PG8_WAIT_L(8); PG8_BAR; PG8_WAIT_L(0); PG8_MMA(0, 0, At, B0); PG8_BAR; PG8_SCHED;
            PG8_LDB(B1, 0, 1); PG8_STAGE(PG8_SB(0, 0), b2, voffB);
            PG8_BAR; PG8_WAIT_L(0); PG8_MMA(0, 1, At, B1); PG8_BAR;
            PG8_LDA(At, 0, 1); PG8_STAGE(PG8_SA(0, 0), a2, voffA);
            PG8_BAR; PG8_WAIT_L(0); PG8_MMA(1, 0, At, B0); PG8_BAR; PG8_SCHED;
            PG8_STAGE(PG8_SB(0, 1), b2 + hstep, voffB);
            PG8_WAIT_V(6); PG8_BAR; PG8_MMA(1, 1, At, B1); PG8_BAR;
            PG8_LDB(B0, 1, 0); PG8_SCHED; PG8_LDA(At, 1, 0); PG8_STAGE(PG8_SA(0, 1), a2 + hstep, voffA);
            PG8_WAIT_L(8); PG8_BAR; PG8_WAIT_L(0); PG8_MMA(0, 0, At, B0); PG8_BAR; PG8_SCHED;
            PG8_LDB(B1, 1, 1); PG8_STAGE(PG8_SB(1, 0), b3, voffB);
            PG8_BAR; PG8_WAIT_L(0); PG8_MMA(0, 1, At, B1); PG8_BAR;
            PG8_LDA(At, 1, 1); PG8_STAGE(PG8_SA(1, 0), a3, voffA);
            PG8_BAR; PG8_WAIT_L(0); PG8_MMA(1, 0, At, B0); PG8_BAR; PG8_SCHED;
            PG8_STAGE(PG8_SB(1, 1), b3 + hstep, voffB);
            PG8_WAIT_V(6); PG8_BAR; PG8_MMA(1, 1, At, B1); PG8_BAR;
            }
        }
        if constexpr (ALIGN_EPI) { if (wr == 0) PG8_BAR; }
        if constexpr (!Epi::AFTER_DRAIN) { E(acc, cur, wr, wc, fr, fq); S.done(cur); }
        if (!has_next) break;
#pragma unroll
        for (int a = 0; a < 2; ++a)
#pragma unroll
            for (int b = 0; b < 2; ++b)
#pragma unroll
                for (int m = 0; m < 4; ++m)
#pragma unroll
                    for (int n = 0; n < 2; ++n) acc[a][b][m][n] = (f32x4){0.f, 0.f, 0.f, 0.f};
        cur = nxt; cA = nA; cB = nB; ++ui;
        if constexpr (ALIGN_EPI) { if (wr == 1) PG8_BAR; }
    }
    PG8_WAIT_V(0);
    if constexpr (!ALIGN_EPI) { if (wr == 0) PG8_BAR; }
    PG8_BAR;
    if constexpr (Epi::AFTER_DRAIN) { E.fused(acc, cur, wr, wc, fr, fq, lds, wid, lane); S.done(cur); }
#undef PG8_SA
#undef PG8_SB
#undef PG8_STAGE
#undef PG8_LDA
#undef PG8_LDB
#undef PG8_MMA
#undef PG8_WAIT_V
#undef PG8_WAIT_L
#undef PG8_BAR
#undef PG8_SCHED
}
}

#ifndef PG8_SP2
#define PG8_SP2 true
#endif
#ifndef PG8_ALIGN
#define PG8_ALIGN true
#endif
#include <hip/hip_bf16.h>
#include <cmath>
namespace attn_body {
using bf16=__hip_bfloat16;
using bf16x8=__attribute__((ext_vector_type(8)))short;
using s16x4=__attribute__((ext_vector_type(4)))short;
using f32x16=__attribute__((ext_vector_type(16)))float;
using u32x4=__attribute__((ext_vector_type(4)))unsigned;
using f32x4=__attribute__((ext_vector_type(4)))float;
#define LASF __attribute__((address_space(3)))
constexpr int BATCH=8,NHEAD=16,SEQ=2048,D=64,DM=NHEAD*D;
constexpr int NW=8,QBLK=32,QB=QBLK*NW,KVBLK=64,NQB=SEQ/QB;
constexpr int ATTN_PITCH=DM, ATTN_UNIT_ROWS=QB;
__device__ __forceinline__ int crow(int r,int hi){return (r&3)+8*(r>>2)+4*hi;}
#define SBAR() __builtin_amdgcn_sched_barrier(0)
__device__ __forceinline__ void cmask(f32x16&p0,f32x16&p1,int jb,int qrel,int hi){
  const float NEG=-INFINITY; int kb=64*jb+4*hi;
  #pragma unroll
  for(int r=0;r<16;++r){int kv=kb+(r&3)+8*(r>>2); if(kv>qrel)p0[r]=NEG; if(kv+32>qrel)p1[r]=NEG;}
}

constexpr int NSLOT=3, SLOTB=8192;
constexpr int LDS_K=0, LDS_V=NSLOT*SLOTB, LDS_WS=2*NSLOT*SLOTB, LDS_OST=LDS_WS+NW*64*4, LDS_BYTES=LDS_OST+NW*4096;
constexpr float C2=0.125f*1.4426950408889634f;
__device__ __forceinline__ void glds16(const void*gsrc,unsigned lds_dst){unsigned keep;
  asm volatile("s_mov_b32 %0, m0\n\ts_mov_b32 m0, %2\n\ts_nop 0\n\tglobal_load_lds_dwordx4 %1, off\n\ts_mov_b32 m0, %0":"=&s"(keep):"v"(gsrc),"s"(lds_dst):"memory");}
__device__ __forceinline__ float max3f(float a,float b,float c){float r;asm("v_max3_f32 %0, %1, %2, %3":"=v"(r):"v"(a),"v"(b),"v"(c));return r;}
__device__ __forceinline__ float max2f(float a,float b){float r;asm("v_max_f32_e32 %0, %1, %2":"=v"(r):"v"(a),"v"(b));return r;}
__device__ __forceinline__ float fadd_s(float a,float b){float r;asm("v_add_f32_e32 %0, %1, %2":"=v"(r):"v"(a),"v"(b));return r;}
__device__ __forceinline__ float fsub_s(float a,float b){float r;asm("v_sub_f32_e32 %0, %1, %2":"=v"(r):"v"(a),"v"(b));return r;}
typedef float f32x2_t __attribute__((ext_vector_type(2))); typedef __bf16 bf16x2_t __attribute__((ext_vector_type(2)));
__device__ __forceinline__ unsigned cvtpk_s(float lo,float hi){f32x2_t v={lo,hi};bf16x2_t b=__builtin_convertvector(v,bf16x2_t);return __builtin_bit_cast(unsigned,b);}
#define WAIT_BAR(N) asm volatile("s_waitcnt vmcnt(" #N ") lgkmcnt(0)\n\ts_barrier":::"memory")

__device__ __forceinline__ void qkt(f32x16&p0,f32x16&p1,const char*Kslot,const bf16x8*qr,int r32,int hi){
  const char*kb=Kslot+hi*1024+r32*16;
  #pragma unroll
  for(int d0=0;d0<4;++d0){
    const bf16x8 b0=*reinterpret_cast<const bf16x8*>(kb+d0*2048);
    const bf16x8 b1=*reinterpret_cast<const bf16x8*>(kb+d0*2048+512);
    p0=__builtin_amdgcn_mfma_f32_32x32x16_bf16(b0,qr[d0],p0,0,0,0);p1=__builtin_amdgcn_mfma_f32_32x32x16_bf16(b1,qr[d0],p1,0,0,0);}
}
typedef __attribute__((address_space(3))) const char* lds_cptr;
typedef short v4i16_t __attribute__((ext_vector_type(4)));
__device__ __forceinline__ void kload8(bf16x8*kf,lds_cptr kp){
  kf[0]=*(const __attribute__((address_space(3))) bf16x8*)(kp);      kf[1]=*(const __attribute__((address_space(3))) bf16x8*)(kp+512);
  kf[2]=*(const __attribute__((address_space(3))) bf16x8*)(kp+2048); kf[3]=*(const __attribute__((address_space(3))) bf16x8*)(kp+2560);
  kf[4]=*(const __attribute__((address_space(3))) bf16x8*)(kp+4096); kf[5]=*(const __attribute__((address_space(3))) bf16x8*)(kp+4608);
  kf[6]=*(const __attribute__((address_space(3))) bf16x8*)(kp+6144); kf[7]=*(const __attribute__((address_space(3))) bf16x8*)(kp+6656);
}
__device__ __forceinline__ void kload2(bf16x8*kf,lds_cptr kp,int j){ kf[2*j]=*(const __attribute__((address_space(3))) bf16x8*)(kp+j*2048); kf[2*j+1]=*(const __attribute__((address_space(3))) bf16x8*)(kp+j*2048+512); }
__device__ __forceinline__ s16x4 vtr(lds_cptr p){ return __builtin_bit_cast(s16x4,__builtin_amdgcn_ds_read_tr16_b64_v4i16((__attribute__((address_space(3))) v4i16_t*)p)); }
__device__ __forceinline__ float rowmax(const f32x16&p0,const f32x16&p1){
  float a=max3f(p0[0],p0[1],p1[0]),b=max3f(p0[2],p0[3],p1[1]);a=max3f(a,p1[2],p1[3]);
  #pragma unroll
  for(int r=4;r<16;r+=4){a=max3f(a,p0[r],p0[r+1]);b=max3f(b,p0[r+2],p0[r+3]);a=max3f(a,p1[r],p1[r+1]);b=max3f(b,p1[r+2],p1[r+3]);}
  const float m=max2f(a,b);
  auto rr=__builtin_amdgcn_permlane32_swap(__float_as_uint(m),__float_as_uint(m),false,false);
  return max2f(__uint_as_float(rr[0]),__uint_as_float(rr[1]));
}
__device__ __forceinline__ void pv(f32x16*o,int vb,bf16x8 pa0,bf16x8 pa1,bf16x8 pa2,bf16x8 pa3){
  #pragma unroll
  for(int d0=0;d0<2;++d0){s16x4 lo[4],hi[4];
    #pragma unroll
    for(int ks=0;ks<4;++ks){
      asm volatile("ds_read_b64_tr_b16 %0,%1 offset:%c2":"=&v"(lo[ks]):"v"(vb),"i"(d0*4096+ks*1024):"memory");
      asm volatile("ds_read_b64_tr_b16 %0,%1 offset:%c2":"=&v"(hi[ks]):"v"(vb),"i"(d0*4096+ks*1024+512):"memory");}
    asm volatile("s_waitcnt lgkmcnt(0)":::"memory");SBAR();
    #define PK(k) (bf16x8){lo[k][0],lo[k][1],lo[k][2],lo[k][3],hi[k][0],hi[k][1],hi[k][2],hi[k][3]}
    o[d0]=__builtin_amdgcn_mfma_f32_32x32x16_bf16(pa0,PK(0),o[d0],0,0,0);
    o[d0]=__builtin_amdgcn_mfma_f32_32x32x16_bf16(pa1,PK(1),o[d0],0,0,0);
    o[d0]=__builtin_amdgcn_mfma_f32_32x32x16_bf16(pa2,PK(2),o[d0],0,0,0);
    o[d0]=__builtin_amdgcn_mfma_f32_32x32x16_bf16(pa3,PK(3),o[d0],0,0,0);
    #undef PK
  }
}


struct MergeCtx { const unsigned short* GA; const unsigned short* G2; const unsigned short* U; const float* cw; const float* st; unsigned short* out; };
__device__ __forceinline__ float mbflo(unsigned w){return __builtin_bit_cast(float,w<<16);}
__device__ __forceinline__ float mbfhi(unsigned w){return __builtin_bit_cast(float,w&0xffff0000u);}
__device__ __forceinline__ void munpack8(u32x4 w,float*f){f[0]=mbflo(w.x);f[1]=mbfhi(w.x);f[2]=mbflo(w.y);f[3]=mbfhi(w.y);f[4]=mbflo(w.z);f[5]=mbfhi(w.z);f[6]=mbflo(w.w);f[7]=mbfhi(w.w);}
__device__ __forceinline__ void merge_store8(const MergeCtx&c,size_t grow,int t,bool prm,int bb,int col,u32x4 ov){
  const size_t off=grow*1024+col; float ga[8],o[8],g2[8],u0[8],u1[8],u2[8];
  munpack8(*(const u32x4*)(c.GA+off),ga); munpack8(ov,o); munpack8(*(const u32x4*)(c.G2+off),g2); munpack8(*(const u32x4*)(c.U+off),u2);
  if(t>=1)munpack8(*(const u32x4*)(c.U+off-1024),u1);
  else if(prm){_Pragma("unroll") for(int e=0;e<8;++e)u1[e]=0.f;} else {const float*p=c.st+(size_t)(bb*2+1)*1024+col; _Pragma("unroll") for(int e=0;e<8;++e)u1[e]=p[e];}
  if(t>=2)munpack8(*(const u32x4*)(c.U+off-2048),u0);
  else if(prm){_Pragma("unroll") for(int e=0;e<8;++e)u0[e]=0.f;} else {const float*p=c.st+(size_t)(bb*2+t)*1024+col; _Pragma("unroll") for(int e=0;e<8;++e)u0[e]=p[e];}
  float r[8];
  _Pragma("unroll") for(int e=0;e<8;++e){const float cy=c.cw[col+e]*u0[e]+c.cw[1024+col+e]*u1[e]+c.cw[2048+col+e]*u2[e]; r[e]=ga[e]*o[e]+g2[e]*cy;}
  u32x4 w; w.x=cvtpk_s(r[0],r[1]); w.y=cvtpk_s(r[2],r[3]); w.z=cvtpk_s(r[4],r[5]); w.w=cvtpk_s(r[6],r[7]);
  *(u32x4*)(c.out+off)=w;
}
#ifndef ATTN_STORE16
#define ATTN_STORE16(p,v) (*(u32x4*)(p)=(v))
#endif
template<int THRL> __device__ __forceinline__ void attn_unit(int b,int h,int qb,const bf16*Q,const bf16*__restrict__ K,const bf16*__restrict__ V,const MergeCtx&mc,char*shm,const LASF float*fb){
  int tid_=threadIdx.x; asm volatile("":"+v"(tid_));
  const int tid=tid_,lane=tid&63,r32=lane&31,hi=lane>>5; const int wid=__builtin_amdgcn_readfirstlane(tid>>6);
  const long rowbase=(long)b*SEQ; const int q0=qb*QB;
  const bf16*Qw=Q+(rowbase+q0+wid*QBLK)*DM+h*D;
  const bf16*Kh=K+rowbase*DM+h*D,*Vh=V+rowbase*DM+h*D;
  const unsigned lds0=(unsigned)(uintptr_t)shm;
  float*wsf=(float*)(shm+LDS_WS)+wid*64;
  const bf16*ksrc=Kh+(long)lane*DM+wid*8;
  const bf16*vsrc=Vh+(long)(16*(wid&3)+(lane>>2))*DM+(wid>>2)*32+(lane&3)*8;
  const unsigned kdst=lds0+LDS_K+wid*1024, vdst=lds0+LDS_V+wid*1024;
  #define DMA_K(t,slot) glds16(ksrc+(long)(t)*KVBLK*DM,(unsigned)__builtin_amdgcn_readfirstlane(kdst+(slot)))
  #define DMA_V(t,slot) glds16(vsrc+(long)(t)*KVBLK*DM,(unsigned)__builtin_amdgcn_readfirstlane(vdst+(slot)))
  const int vb0=(int)(lds0+LDS_V)+((lane>>4)&1)*32+(lane&3)*8+(4*hi+((lane&15)>>2))*64;
  const char*Kbase=shm+LDS_K; bf16x8 kf[8];
  const lds_cptr shm3=(lds_cptr)shm; const lds_cptr kp0=shm3+LDS_K+hi*1024+r32*16; const lds_cptr vp0=shm3+LDS_V+((lane>>4)&1)*32+(lane&3)*8+(4*hi+((lane&15)>>2))*64;
  const int NT=(q0+QB)/KVBLK;
  DMA_K(0,0);DMA_V(0,0);DMA_K(1,SLOTB);
  bf16x8 qr[4];
  #pragma unroll
  for(int d0=0;d0<4;++d0)qr[d0]=*reinterpret_cast<const bf16x8*>(&Qw[(long)r32*DM+d0*16+hi*8]);
  float mhat=fb[q0+wid*QBLK+r32],l_reg=0.f;f32x16 o[2];o[0]=f32x16{};o[1]=f32x16{};
  #define FBINIT(C0,C1,t) do{ const LASF float*fp_=fb+64*(t)+4*hi; \
    _Pragma("unroll") for(int i_=0;i_<4;++i_){ const f32x4 a_=*(const LASF f32x4*)(fp_+8*i_),b_=*(const LASF f32x4*)(fp_+32+8*i_); \
      C0[4*i_]=a_[0]-mhat;C0[4*i_+1]=a_[1]-mhat;C0[4*i_+2]=a_[2]-mhat;C0[4*i_+3]=a_[3]-mhat; \
      C1[4*i_]=b_[0]-mhat;C1[4*i_+1]=b_[1]-mhat;C1[4*i_+2]=b_[2]-mhat;C1[4*i_+3]=b_[3]-mhat; } }while(0)
  #define FBLOAD(P0,P1,tn) do{ const LASF float*fp_=fb+64*(tn)+4*hi; \
    _Pragma("unroll") for(int i_=0;i_<4;++i_){ const f32x4 a_=*(const LASF f32x4*)(fp_+8*i_),b_=*(const LASF f32x4*)(fp_+32+8*i_); \
      P0[4*i_]=a_[0];P0[4*i_+1]=a_[1];P0[4*i_+2]=a_[2];P0[4*i_+3]=a_[3]; P1[4*i_]=b_[0];P1[4*i_+1]=b_[1];P1[4*i_+2]=b_[2];P1[4*i_+3]=b_[3]; } }while(0)
  #define FBSUB(X,B) do{ X[B]-=mhat; X[B+1]-=mhat; X[B+2]-=mhat; X[B+3]-=mhat; }while(0)
  const int qrel=wid*QBLK+r32;
  #define CMASK(P0,P1,t) do{int jb_=(t)-(NT-4); if(jb_>=0)cmask(P0,P1,jb_,qrel,hi);}while(0)
  bool resc=false;
  #define START(P0,P1) do{ const float rm=rowmax(P0,P1); resc=false; \
    if(__any(rm>(float)THRL)){ const float dl=__builtin_fmaxf(rm,0.f); mhat=fadd_s(mhat,dl); \
      _Pragma("unroll") for(int r=0;r<16;++r){P0[r]=fsub_s(P0[r],dl);P1[r]=fsub_s(P1[r],dl);} } \
    _Pragma("unroll") for(int r=0;r<16;++r)P0[r]=__builtin_amdgcn_exp2f(P0[r]); }while(0)
  #define RESC() do{ if(resc){ asm volatile("s_waitcnt lgkmcnt(0)":::"memory"); \
      _Pragma("unroll") for(int d_=0;d_<2;++d_) _Pragma("unroll") for(int r=0;r<16;++r)o[d_][r]*=wsf[crow(r,hi)]; } }while(0)
  f32x16 pA0,pA1,pB0,pB1;
  int sl_prev=0,sl_cur=0,sl_next=SLOTB;
  #define ROT() do{sl_prev=sl_cur;sl_cur=sl_next;sl_next=(sl_next==(NSLOT-1)*SLOTB)?0:sl_next+SLOTB;}while(0)
  DMA_K(2,2*SLOTB);
  WAIT_BAR(3);
  FBINIT(pA0,pA1,0);
  qkt(pA0,pA1,Kbase,qr,r32,hi);asm volatile("s_nop 15\n\ts_nop 7":"+v"(pA0),"+v"(pA1));CMASK(pA0,pA1,0);
  START(pA0,pA1);
  _Pragma("unroll") for(int r=0;r<16;++r)pA1[r]=__builtin_amdgcn_exp2f(pA1[r]);
  FBINIT(pB0,pB1,1);
  WAIT_BAR(0);
  DMA_K(3,0);DMA_V(1,SLOTB);
  ROT();
  kload8(kf,kp0+sl_cur);
  WAIT_BAR(2);
  s16x4 vlo[8],vhi[8]; u32x4 pw0,pw1,pw2,pw3;
  #define PKW(P,B) cvtpk_s(P[B],P[B+1])
  #define PAF(k) __builtin_bit_cast(bf16x8,pw##k)
  #define VFR(i) (bf16x8){vlo[i][0],vlo[i][1],vlo[i][2],vlo[i][3],vhi[i][0],vhi[i][1],vhi[i][2],vhi[i][3]}
  #define PIN(x) asm volatile("":"+v"(x))
  #define MX3(a,b,c) __builtin_fmaxf(__builtin_fmaxf((a),(b)),(c))
  #define GAPA(MF,A0,A1,A2,A3,W0,W1,PW) do{ MF; sacc+=A0; sacc+=A1; sacc+=A2; sacc+=A3; PIN(sacc); W0; W1; PIN(PW); SBAR(); }while(0)
  #define EX(v) __builtin_amdgcn_exp2f(v)
  #define GAPB(MF,X,B,Y,YB) do{ MF; X[B]=EX(X[B]); X[B+1]=EX(X[B+1]); X[B+2]=EX(X[B+2]); X[B+3]=EX(X[B+3]); PIN(X); FBSUB(Y,YB); PIN(Y); SBAR(); }while(0)
  #define VRD(i) do{ vlo[i]=vtr(vp_+(((i)>>2)*4096+((i)&3)*1024)); vhi[i]=vtr(vp_+(((i)>>2)*4096+((i)&3)*1024+512)); }while(0)
  #define KRD(G,j) do{ if(G){ kload2(kf,kp0+sl_next,j); SBAR(); } }while(0)
  #define STEP(C0,C1,P0,P1,t,GK,GV,GL) do{ SBAR(); \
    const lds_cptr vp_=vp0+sl_prev; \
    VRD(0); SBAR(); float sacc=(P0[0]+P0[1]); \
    GAPA(C0=__builtin_amdgcn_mfma_f32_32x32x16_bf16(kf[0],qr[0],C0,0,0,0), P0[2],P0[3],P0[4],P0[5],     pw0[0]=PKW(P0,0), pw0[1]=PKW(P0,2), pw0); \
    VRD(4); SBAR(); GAPA(C1=__builtin_amdgcn_mfma_f32_32x32x16_bf16(kf[1],qr[0],C1,0,0,0), P0[6],P0[7],P0[8],P0[9],     pw0[2]=PKW(P0,4), pw0[3]=PKW(P0,6), pw0); \
    VRD(1); SBAR(); GAPA(C0=__builtin_amdgcn_mfma_f32_32x32x16_bf16(kf[2],qr[1],C0,0,0,0),   P0[10],P0[11],P0[12],P0[13], pw1[0]=PKW(P0,8), pw1[1]=PKW(P0,10), pw1); \
    VRD(5); SBAR(); GAPA(C1=__builtin_amdgcn_mfma_f32_32x32x16_bf16(kf[3],qr[1],C1,0,0,0),   P0[14],P0[15],P1[0],P1[1],   pw1[2]=PKW(P0,12),pw1[3]=PKW(P0,14), pw1); \
    VRD(2); SBAR(); GAPA(C0=__builtin_amdgcn_mfma_f32_32x32x16_bf16(kf[4],qr[2],C0,0,0,0),   P1[2],P1[3],P1[4],P1[5],     pw2[0]=PKW(P1,0), pw2[1]=PKW(P1,2), pw2); \
    VRD(6); SBAR(); GAPA(C1=__builtin_amdgcn_mfma_f32_32x32x16_bf16(kf[5],qr[2],C1,0,0,0),   P1[6],P1[7],P1[8],P1[9],     pw2[2]=PKW(P1,4), pw2[3]=PKW(P1,6), pw2); \
    VRD(3); SBAR(); GAPA(C0=__builtin_amdgcn_mfma_f32_32x32x16_bf16(kf[6],qr[3],C0,0,0,0),   P1[10],P1[11],P1[12],P1[13], pw3[0]=PKW(P1,8), pw3[1]=PKW(P1,10), pw3); \
    VRD(7); SBAR(); GAPA(C1=__builtin_amdgcn_mfma_f32_32x32x16_bf16(kf[7],qr[3],C1,0,0,0),   P1[14],P1[15],0.f,0.f,       pw3[2]=PKW(P1,12),pw3[3]=PKW(P1,14), pw3); \
    l_reg+=sacc; \
    if(GK){DMA_K((t)+3,sl_cur);} if(GV){DMA_V((t)+1,sl_next);} \
    CMASK(C0,C1,t); \
    { float a=MX3(C0[0],C0[1],C1[0]),b=MX3(C0[2],C0[3],C1[1]); a=MX3(a,C1[2],C1[3]); \
      _Pragma("unroll") for(int r=4;r<16;r+=4){a=MX3(a,C0[r],C0[r+1]);b=MX3(b,C0[r+2],C0[r+3]);a=MX3(a,C1[r],C1[r+1]);b=MX3(b,C1[r+2],C1[r+3]);} \
      float rm=__builtin_fmaxf(a,b); { auto rr=__builtin_amdgcn_permlane32_swap(__float_as_uint(rm),__float_as_uint(rm),false,false); rm=__builtin_fmaxf(__uint_as_float(rr[0]),__uint_as_float(rr[1])); } \
      resc=false; \
      if(__builtin_expect(__any(rm>(float)THRL),0)){ const float dl=__builtin_fmaxf(rm,0.f); mhat+=dl; \
        _Pragma("unroll") for(int r=0;r<16;++r){C0[r]-=dl;C1[r]-=dl;} \
        const float f=__builtin_amdgcn_exp2f(-dl); l_reg*=f; if(hi==0)wsf[r32]=f; resc=true; } } \
    SBAR(); FBLOAD(P0,P1,(t)+1); SBAR(); \
    GAPB(o[0]=__builtin_amdgcn_mfma_f32_32x32x16_bf16(PAF(0),VFR(0),o[0],0,0,0), C0,0, P0,0); \
    GAPB(o[1]=__builtin_amdgcn_mfma_f32_32x32x16_bf16(PAF(0),VFR(4),o[1],0,0,0), C0,4, P0,4); \
    KRD(GL,0); GAPB(o[0]=__builtin_amdgcn_mfma_f32_32x32x16_bf16(PAF(1),VFR(1),o[0],0,0,0), C0,8, P0,8); \
    KRD(GL,1); GAPB(o[1]=__builtin_amdgcn_mfma_f32_32x32x16_bf16(PAF(1),VFR(5),o[1],0,0,0), C0,12, P0,12); \
    KRD(GL,2); GAPB(o[0]=__builtin_amdgcn_mfma_f32_32x32x16_bf16(PAF(2),VFR(2),o[0],0,0,0), C1,0, P1,0); \
    KRD(GL,3); GAPB(o[1]=__builtin_amdgcn_mfma_f32_32x32x16_bf16(PAF(2),VFR(6),o[1],0,0,0), C1,4, P1,4); \
    GAPB(o[0]=__builtin_amdgcn_mfma_f32_32x32x16_bf16(PAF(3),VFR(3),o[0],0,0,0), C1,8, P1,8); \
    GAPB(o[1]=__builtin_amdgcn_mfma_f32_32x32x16_bf16(PAF(3),VFR(7),o[1],0,0,0), C1,12, P1,12); \
    }while(0)
  int t=1;
  #undef CMASK
  #define CMASK(P0,P1,t) do{}while(0)
  for(;t+5<NT;t+=2){
    STEP(pB0,pB1,pA0,pA1,t,true,true,true);     WAIT_BAR(2); RESC(); ROT();
    STEP(pA0,pA1,pB0,pB1,t+1,true,true,true);   WAIT_BAR(2); RESC(); ROT();
  }
  #undef CMASK
  #define CMASK(P0,P1,t) do{int jb_=(t)-(NT-4); if(jb_>=0)cmask(P0,P1,jb_,qrel,hi);}while(0)
  #define ENDW(tt) do{ if((tt)+3<NT){WAIT_BAR(2);} else if((tt)+2<NT){WAIT_BAR(1);} else {WAIT_BAR(0);} }while(0)
  for(;t+1<NT;t+=2){
    STEP(pB0,pB1,pA0,pA1,t,(t+3<NT),(t+1<NT),(t+1<NT));       ENDW(t);   RESC(); ROT();
    STEP(pA0,pA1,pB0,pB1,t+1,(t+4<NT),(t+2<NT),(t+2<NT));     ENDW(t+1); RESC(); ROT();
  }
  STEP(pB0,pB1,pA0,pA1,NT-1,false,false,false); RESC();
  u32x4 mg[4][5]; f32x4 mcw[3][2];
  { const int mcol=h*D+(lane&7)*8;
    _Pragma("unroll") for(int j=0;j<3;++j){ mcw[j][0]=*(const f32x4*)(mc.cw+j*1024+mcol); mcw[j][1]=*(const f32x4*)(mc.cw+j*1024+mcol+4); }
    _Pragma("unroll") for(int i=0;i<4;++i){ const int t_=q0+wid*QBLK+i*8+(lane>>3); const size_t off=(size_t)(rowbase+t_)*1024+mcol;
      mg[i][0]=__builtin_nontemporal_load((const u32x4*)(mc.GA+off)); mg[i][1]=__builtin_nontemporal_load((const u32x4*)(mc.G2+off)); mg[i][2]=*(const u32x4*)(mc.U+off);
      mg[i][3]=(t_>=1)?*(const u32x4*)(mc.U+off-1024):(u32x4){0u,0u,0u,0u}; mg[i][4]=(t_>=2)?*(const u32x4*)(mc.U+off-2048):(u32x4){0u,0u,0u,0u}; } }
  { float sacc=pB0[0]+pB0[1]; _Pragma("unroll") for(int r=2;r<16;++r)sacc+=pB0[r]; _Pragma("unroll") for(int r=0;r<16;++r)sacc+=pB1[r]; l_reg+=sacc;
    pw0=(u32x4){PKW(pB0,0),PKW(pB0,2),PKW(pB0,4),PKW(pB0,6)};pw1=(u32x4){PKW(pB0,8),PKW(pB0,10),PKW(pB0,12),PKW(pB0,14)};pw2=(u32x4){PKW(pB1,0),PKW(pB1,2),PKW(pB1,4),PKW(pB1,6)};pw3=(u32x4){PKW(pB1,8),PKW(pB1,10),PKW(pB1,12),PKW(pB1,14)};
    SBAR(); pv(o,vb0+sl_cur,PAF(0),PAF(1),PAF(2),PAF(3)); }
  #undef PKW
  #undef PAF
  #undef VFR
  #undef PIN
  #undef MX3
  #undef GAPA
  #undef GAPB
  #undef EX
  #undef VRD
  #undef KRD
  #undef STEP
  #undef ENDW
  {auto rr=__builtin_amdgcn_permlane32_swap(__float_as_uint(l_reg),__float_as_uint(l_reg),false,false);l_reg=__uint_as_float(rr[0])+__uint_as_float(rr[1]);}
  if(hi==0)wsf[32+r32]=l_reg;asm volatile("s_waitcnt lgkmcnt(0)":::"memory");
  float rli[16];
  #pragma unroll
  for(int r=0;r<16;++r)rli[r]=__builtin_amdgcn_rcpf(wsf[32+crow(r,hi)]);
  { bf16*stg=(bf16*)(shm+LDS_OST)+wid*2048;
    #pragma unroll
    for(int r=0;r<16;++r){const int orow=crow(r,hi);
      #pragma unroll
      for(int d0=0;d0<2;++d0)stg[orow*64+d0*32+r32]=__float2bfloat16(o[d0][r]*rli[r]);}
    asm volatile("s_waitcnt lgkmcnt(0)":::"memory");
    #pragma unroll
    for(int i=0;i<4;++i){const int row=i*8+(lane>>3),ch=lane&7; const u32x4 v=*(const u32x4*)(stg+row*64+ch*8); const int t_=q0+wid*QBLK+row;
      float ga[8],ov[8],g2[8],u2[8],u1[8],u0[8],r[8]; munpack8(mg[i][0],ga); munpack8(v,ov); munpack8(mg[i][1],g2); munpack8(mg[i][2],u2); munpack8(mg[i][3],u1); munpack8(mg[i][4],u0);
      _Pragma("unroll") for(int e=0;e<8;++e){ const float cy=mcw[0][e>>2][e&3]*u0[e]+mcw[1][e>>2][e&3]*u1[e]+mcw[2][e>>2][e&3]*u2[e]; r[e]=ga[e]*ov[e]+g2[e]*cy; }
      u32x4 w; w.x=cvtpk_s(r[0],r[1]); w.y=cvtpk_s(r[2],r[3]); w.z=cvtpk_s(r[4],r[5]); w.w=cvtpk_s(r[6],r[7]);
      *(u32x4*)(mc.out+(size_t)(rowbase+t_)*1024+h*D+ch*8)=w; } }
  asm volatile("s_waitcnt lgkmcnt(0)\n\ts_barrier":::"memory");
  #undef DMA_K
  #undef DMA_V
  #undef CMASK
  #undef START
  #undef RESC
  #undef ROT
  #undef FBINIT
  #undef FBLOAD
  #undef FBSUB
}
constexpr int ATTN_LDS_BYTES=LDS_BYTES;
#undef SBAR
#undef WAIT_BAR
}

#define XB_TMO      128
#define XB_XCNT(j)  (256  + 64 * (j))
#define XB_XSUB(j)  (1280 + 64 * (j))
#define XB_XGEN(j)  (2304 + 64 * (j))
#define XB_TOP      3328
#define XB_TOPGEN   3392
#define XCD_BAR_WORDS 3456
#define XB_SPIN_CAP (1u << 18)

__device__ __forceinline__ unsigned xb_ld(unsigned* p)              { return __hip_atomic_load(p, __ATOMIC_RELAXED, __HIP_MEMORY_SCOPE_AGENT); }
__device__ __forceinline__ unsigned xb_add(unsigned* p, unsigned v) { return __hip_atomic_fetch_add(p, v, __ATOMIC_RELAXED, __HIP_MEMORY_SCOPE_AGENT); }
__device__ __forceinline__ unsigned xb_xcc_id() { return (unsigned)__builtin_amdgcn_s_getreg((3 << 11) | 20) & 0xFu; }
#define XB_SPIN(cond, bar) do { unsigned _sp = 0; while (cond) { __builtin_amdgcn_s_sleep(1); \
    if ((++_sp & 255u) == 0u) { if (xb_ld(&(bar)[XB_TMO])) break; if (_sp > XB_SPIN_CAP) { atomicAdd(&(bar)[XB_TMO], 1u); break; } } } } while (0)

struct XcdBarrier {
    unsigned* bar; unsigned x;
    volatile __attribute__((address_space(3))) unsigned* st;
};

__device__ __forceinline__ XcdBarrier xcd_barrier_post(unsigned* bar, volatile __attribute__((address_space(3))) unsigned* st) {
    XcdBarrier b; b.bar = bar; b.x = xb_xcc_id(); b.st = st;
    if (threadIdx.x == 0) (void)xb_add(&bar[XB_XCNT(b.x)], 1u);
    return b;
}
__device__ __forceinline__ void xcd_barrier_complete(unsigned* bar, unsigned x, unsigned& nloc, unsigned& nx) {
    const unsigned G = gridDim.x * gridDim.y * gridDim.z;
    unsigned sum, cnt, mine, sp = 0u;
    for (;;) {
        sum = 0u; cnt = 0u; mine = 0u;
#pragma unroll
        for (unsigned j = 0; j < 16; ++j) { const unsigned c = xb_ld(&bar[XB_XCNT(j)]); sum += c; cnt += (c > 0u) ? 1u : 0u; mine = (j == x) ? c : mine; }
        if (sum == G) break;
        __builtin_amdgcn_s_sleep(1);
        if ((++sp & 255u) == 0u) { if (xb_ld(&bar[XB_TMO])) break; if (sp > XB_SPIN_CAP) { atomicAdd(&bar[XB_TMO], 1u); break; } }
    }
    nloc = mine > 0u ? mine : 1u; nx = cnt > 0u ? cnt : 1u;
}

__device__ __forceinline__ void xcd_barrier(const XcdBarrier& b) {
    asm volatile("s_waitcnt vmcnt(0)" ::: "memory");
    __syncthreads();
    if (threadIdx.x == 0) {
        unsigned* bar = b.bar;
        __builtin_amdgcn_s_waitcnt(0);
        unsigned nloc = b.st[0], nx = b.st[1];
        if (nloc == 0u) { xcd_barrier_complete(bar, b.x, nloc, nx); b.st[0] = nloc; b.st[1] = nx; }
        const unsigned old = xb_add(&bar[XB_XSUB(b.x)], 1u);
        const unsigned gen = old / nloc;
        if (old + 1u == (gen + 1u) * nloc) {
            __builtin_amdgcn_fence(__ATOMIC_RELEASE, "agent");
            asm volatile("s_waitcnt vmcnt(0)" ::: "memory");
            const unsigned og = xb_add(&bar[XB_TOP], 1u);
            const unsigned tg = og / nx;
            if (og + 1u == (tg + 1u) * nx) xb_add(&bar[XB_TOPGEN], 1u);
            else XB_SPIN(xb_ld(&bar[XB_TOPGEN]) == tg, bar);
            __builtin_amdgcn_fence(__ATOMIC_ACQUIRE, "agent");
            xb_add(&bar[XB_XGEN(b.x)], 1u);
            asm volatile("s_waitcnt vmcnt(0)" ::: "memory");
        } else {
            XB_SPIN(xb_ld(&bar[XB_XGEN(b.x)]) == gen, bar);
            __builtin_amdgcn_fence(__ATOMIC_ACQUIRE, "agent");
            asm volatile("s_waitcnt vmcnt(0)" ::: "memory");
        }
    }
    __syncthreads();
}


namespace cg = cooperative_groups;
constexpr int NWAVES = 8, NTHREADS = 512;
constexpr size_t MiB = 1u << 20;
constexpr size_t WS_CNT = 912 * 1024;
constexpr int CNT_WORDS = 3 * 80 * 16;
constexpr size_t WS_BAR = 896 * 1024;
constexpr size_t WS_MOD = 0, WS_W1IN = 1 * MiB, WS_W1OUT = 12 * MiB, WS_WIN = 18 * MiB, WS_WOUT = 35 * MiB, WS_W2IN = 37 * MiB, WS_W2OUT = 48 * MiB, WS_H = 54 * MiB,
                 WS_QB = 88 * MiB, WS_KB = 122 * MiB, WS_VB = 156 * MiB, WS_GAB = 190 * MiB, WS_G2B = 224 * MiB, WS_UB = 258 * MiB, WS_END = 292 * MiB, WS_ACT = WS_QB;
static_assert((size_t)MT * DM * 2 == 34 * MiB && WS_KB - WS_QB == 34 * MiB && WS_VB - WS_KB == 34 * MiB && WS_GAB - WS_VB == 34 * MiB && WS_G2B - WS_GAB == 34 * MiB && WS_UB - WS_G2B == 34 * MiB && WS_ACT + (size_t)MT * DFF * 2 <= WS_GAB && WS_WIN + (size_t)NINP * DM * 2 <= WS_WOUT && WS_W1IN + (size_t)2 * DFF * DM * 2 <= WS_W1OUT, "d_ws map");
constexpr int RING_OFF = 0, RING_BYTES = 131072, FB_OFF = RING_BYTES, STAT_OFF = FB_OFF + 8192, QL_OFF = STAT_OFF + 8192, LDS_BYTES = 163840;
static_assert(QL_OFF + 64 * 144 <= LDS_BYTES && 98304 + 8 * 8192 <= LDS_BYTES && LDS_BYTES <= 163840 && STAT_OFF + 8192 <= LDS_BYTES && attn_body::LDS_BYTES <= RING_BYTES, "LDS map");

#define LAS __attribute__((address_space(3)))
typedef unsigned short bf16;
typedef unsigned v4u __attribute__((ext_vector_type(4)));
typedef unsigned v2u __attribute__((ext_vector_type(2)));
typedef float f32x4 __attribute__((ext_vector_type(4)));
typedef float f32x16 __attribute__((ext_vector_type(16)));
typedef short bf16x8 __attribute__((ext_vector_type(8)));
#define LDS_WAIT() asm volatile("s_waitcnt lgkmcnt(0)" ::: "memory")
__device__ __forceinline__ unsigned f2bf(float f) { unsigned u = __builtin_bit_cast(unsigned, f); return (u + 0x7fffu + ((u >> 16) & 1u)) >> 16; }
__device__ __forceinline__ unsigned pk2(float lo, float hi) { return attn_body::cvtpk_s(lo, hi); }
__device__ __forceinline__ float bflo(unsigned w) { return __builtin_bit_cast(float, w << 16); }
__device__ __forceinline__ float bfhi(unsigned w) { return __builtin_bit_cast(float, w & 0xffff0000u); }
__device__ __forceinline__ float wave_sum(float v) {
#pragma unroll
    for (int o = 1; o < 64; o <<= 1) v += __shfl_xor(v, o);
    return v;
}

struct Args { const float* in[22]; float* out; unsigned char* ws; int ph_lo, ph_hi; };

__device__ __forceinline__ void p0_mod(const Args& a, LAS unsigned char* lds, int vcu, int G) {
    const int tid = threadIdx.x, lane = tid & 63, wid = tid >> 6, l32 = lane & 31, hi = lane >> 5;
    LAS float* scT = (LAS float*)lds;
    constexpr int SCS = 33;
    const float* w_ada = a.in[8]; const float* b_ada = a.in[9]; float* mod = (float*)(a.ws + WS_MOD);
    for (int item = vcu; item < MODLD / 64; item += G) {
#pragma unroll 8
        for (int i = tid; i < 24 * 1024; i += NTHREADS) { const int b = i >> 10, k = i & 1023;
            const float c = b < 8 ? a.in[6][b * 1024 + k] : a.in[7][(b - 8) * 1024 + k]; scT[k * SCS + b] = c * __builtin_amdgcn_rcpf(1.0f + __expf(-c)); }
        for (int i = tid; i < 8 * 1024; i += NTHREADS) scT[(i >> 3) * SCS + 24 + (i & 7)] = 0.f;
        __syncthreads();
        f32x16 acc0 = f32x16{}, acc1 = f32x16{};
        const float* wp = w_ada + (size_t)(wid * 128 + hi) * MODLD + item * 64 + l32;
        const LAS float* ap = scT + (wid * 128 + hi) * SCS + l32;
        float n0[16], n1[16];
#pragma unroll
        for (int q = 0; q < 16; ++q) { n0[q] = __builtin_nontemporal_load(wp + (size_t)(2 * q) * MODLD); n1[q] = __builtin_nontemporal_load(wp + (size_t)(2 * q) * MODLD + 32); }
#pragma unroll 1
        for (int bt = 0; bt < 4; ++bt) {
            float c0[16], c1[16];
#pragma unroll
            for (int q = 0; q < 16; ++q) { c0[q] = n0[q]; c1[q] = n1[q]; }
            if (bt < 3) {
#pragma unroll
                for (int q = 0; q < 16; ++q) { n0[q] = __builtin_nontemporal_load(wp + (size_t)(2 * (16 * (bt + 1) + q)) * MODLD); n1[q] = __builtin_nontemporal_load(wp + (size_t)(2 * (16 * (bt + 1) + q)) * MODLD + 32); }
            }
#pragma unroll
            for (int q = 0; q < 16; ++q) { const float av = ap[(2 * (16 * bt + q)) * SCS];
                acc0 = __builtin_amdgcn_mfma_f32_32x32x2f32(av, c0[q], acc0, 0, 0, 0); acc1 = __builtin_amdgcn_mfma_f32_32x32x2f32(av, c1[q], acc1, 0, 0, 0); }
        }
        __syncthreads();
        { LAS float* P = scT + wid * 2048;
#pragma unroll
          for (int r = 0; r < 16; ++r) { const int b = (r & 3) + 8 * (r >> 2) + 4 * hi; P[b * 64 + l32] = acc0[r]; P[b * 64 + 32 + l32] = acc1[r]; } }
        __syncthreads();
        for (int o = tid; o < 24 * 64; o += NTHREADS) { const int b = o >> 6, c = o & 63; float sum = b_ada[item * 64 + c];
#pragma unroll
            for (int w = 0; w < 8; ++w) sum += scT[w * 2048 + b * 64 + c];
            mod[(size_t)b * MODLD + item * 64 + c] = sum; }
        __syncthreads();
    }
}
__device__ __forceinline__ void p0_transpose_item(const float* W, int K, int N, bf16* WT, int dst_row0, int src_col0, int nvalid, int kb, LAS float* scr, int lane) {
    const int k0 = 64 * kb; const int cl = lane & 31; const bool ok = cl < nvalid;
    float tv[32];
#pragma unroll
    for (int i = 0; i < 32; ++i) { const int kk = 2 * i + (lane >> 5); tv[i] = ok ? __builtin_nontemporal_load(W + (size_t)(k0 + kk) * N + src_col0 + cl) : 0.f; }
#pragma unroll
    for (int i = 0; i < 32; ++i) { const int kk = 2 * i + (lane >> 5); scr[kk * 33 + cl] = tv[i]; }
    LDS_WAIT(); asm volatile("" ::: "memory");
    const int c = lane & 7;
#pragma unroll
    for (int j = 0; j < 4; ++j) { const int n = (lane >> 3) + 8 * j; const LAS float* s = scr + (8 * c) * 33 + n;
        v4u o; o.x = pk2(s[0 * 33], s[1 * 33]); o.y = pk2(s[2 * 33], s[3 * 33]); o.z = pk2(s[4 * 33], s[5 * 33]); o.w = pk2(s[6 * 33], s[7 * 33]);
        *(v4u*)(WT + (size_t)(dst_row0 + n) * K + k0 + 8 * c) = o; }
    LDS_WAIT(); asm volatile("" ::: "memory");
}
__device__ __forceinline__ void map_ffn_in(int db, int& src, int& nv) { const int r = db * 32, t = r >> 8, w = r & 255; src = (w < 128 ? 0 : DFF) + t * 128 + (w & 127); nv = 32; }
__device__ __forceinline__ void map_win(int db, int& src, int& nv) {
    const int r = db * 32; nv = 32;
    if (r < 3072) { src = r; return; }
    if (r < 4096) { src = OFF_GA + (r - 3072); return; }
    if (r < 6144) { const int q = r - 4096, t = q >> 8, w = q & 255; src = (w < 128 ? OFF_B : OFF_GC) + t * 128 + (w & 127); return; }
    if (r < 8192) { const int q = r - 6144, t = q >> 8, w = q & 255; src = (w < 128 ? OFF_C : OFF_X) + t * 128 + (w & 127); return; }
    src = OFF_F; nv = (r == 8192) ? 16 : 0;
}
constexpr int I_1IN = 16 * 176, I_1OUT = 44 * 32, I_WIN = 16 * 264, I_WOUT = 16 * 32, WITEMS = 2 * I_1IN + 2 * I_1OUT + I_WIN + I_WOUT;
constexpr int WCUT0 = 2 * I_1IN + I_WIN, WCUT1 = WCUT0 + I_1OUT;
__device__ __forceinline__ void weight_item(const Args& a, int it, LAS float* scr, int lane) {
    int r = it; int src, nv;
    if (r < I_1IN) { map_ffn_in(r % 176, src, nv); p0_transpose_item(a.in[11], 1024, 2 * DFF, (bf16*)(a.ws + WS_W1IN), (r % 176) * 32, src, nv, r / 176, scr, lane); return; } r -= I_1IN;
    if (r < I_1IN) { map_ffn_in(r % 176, src, nv); p0_transpose_item(a.in[19], 1024, 2 * DFF, (bf16*)(a.ws + WS_W2IN), (r % 176) * 32, src, nv, r / 176, scr, lane); return; } r -= I_1IN;
    if (r < I_WIN) { map_win(r % 264, src, nv); p0_transpose_item(a.in[14], 1024, NIN, (bf16*)(a.ws + WS_WIN), (r % 264) * 32, src, nv, r / 264, scr, lane); return; } r -= I_WIN;
    if (r < I_1OUT) { p0_transpose_item(a.in[12], DFF, 1024, (bf16*)(a.ws + WS_W1OUT), (r % 32) * 32, (r % 32) * 32, 32, r / 32, scr, lane); return; } r -= I_1OUT;
    if (r < I_1OUT) { p0_transpose_item(a.in[20], DFF, 1024, (bf16*)(a.ws + WS_W2OUT), (r % 32) * 32, (r % 32) * 32, 32, r / 32, scr, lane); return; } r -= I_1OUT;
    p0_transpose_item(a.in[17], 1024, 1024, (bf16*)(a.ws + WS_WOUT), (r % 32) * 32, (r % 32) * 32, 32, r / 32, scr, lane);
}
__device__ __forceinline__ void p0_weights(const Args& a, LAS unsigned char* lds, int vcu, int G) {
    const int tid = threadIdx.x, lane = tid & 63, wid = tid >> 6;
    LAS float* scr = (LAS float*)(lds + wid * 16384);
    const int nitems = (G == 256) ? WCUT0 : WITEMS;
    constexpr int NMODWG = MODLD / 64;
    const bool skew = (G > NMODWG);
    const int nslot = skew ? NMODWG * NWAVES + (G - NMODWG) * NWAVES * 2 : G * NWAVES;
    const int slot0 = !skew ? vcu * NWAVES + wid : (vcu < NMODWG ? vcu * NWAVES + wid : NMODWG * NWAVES + ((vcu - NMODWG) * NWAVES + wid) * 2);
    const int nmine = (skew && vcu >= NMODWG) ? 2 : 1;
    for (int sl = 0; sl < nmine; ++sl)
        for (int it = slot0 + sl; it < nitems; it += nslot) weight_item(a, it, scr, lane);
}
__device__ __forceinline__ void weight_items_tail(const Args& a, LAS unsigned char* lds, int first, int last, int wk, int nwk) {
    const int tid = threadIdx.x, lane = tid & 63, wid = tid >> 6;
    LAS float* scr = (LAS float*)(lds + wid * 16384);
    for (int it = first + wk; it < last; it += nwk) weight_item(a, it, scr, lane);
}
template <bool FINAL, bool NT = false, int NR = 4> __device__ __forceinline__ void norm_rows4(int m0, const float* xP, const float* xS, const float* g, const float* mod, int sh_off, int sc_off, bf16* H, float* Y, int lane) {
    const float* x0 = m0 < MP ? xP + (size_t)m0 * DM : xS + (size_t)(m0 - MP) * DM;
    const int mb = m0 < MP ? (m0 >> 11) : 8 + ((m0 - MP) >> 6);
    f32x4 v[NR][4]; float s[NR];
#pragma unroll
    for (int r = 0; r < NR; ++r)
#pragma unroll
        for (int j = 0; j < 4; ++j) { const f32x4* p = (const f32x4*)(x0 + (size_t)r * DM) + lane + 64 * j; v[r][j] = NT ? __builtin_nontemporal_load(p) : *p; }
    f32x4 gg[4], sh[4], sc[4];
#pragma unroll
    for (int j = 0; j < 4; ++j) { gg[j] = ((const f32x4*)g + lane)[64 * j];
        if (!FINAL) { sh[j] = ((const f32x4*)(mod + (size_t)mb * MODLD + sh_off) + lane)[64 * j]; sc[j] = ((const f32x4*)(mod + (size_t)mb * MODLD + sc_off) + lane)[64 * j]; } }
#pragma unroll
    for (int r = 0; r < NR; ++r) { s[r] = 0.f;
#pragma unroll
        for (int j = 0; j < 4; ++j) s[r] += (v[r][j].x * v[r][j].x + v[r][j].y * v[r][j].y) + (v[r][j].z * v[r][j].z + v[r][j].w * v[r][j].w); }
#pragma unroll
    for (int o = 1; o < 64; o <<= 1) {
#pragma unroll
        for (int r = 0; r < NR; ++r) s[r] += __shfl_xor(s[r], o); }
#pragma unroll
    for (int r = 0; r < NR; ++r) { const float rstd = 1.0f / sqrtf(s[r] * (1.f / DM) + EPS);
        if (FINAL) { f32x4* yr = (f32x4*)(Y + (size_t)(m0 + r) * DM) + lane;
#pragma unroll
            for (int j = 0; j < 4; ++j) __builtin_nontemporal_store((v[r][j] * rstd) * gg[j], yr + 64 * j); }
        else { v2u* o8 = (v2u*)(H + (size_t)(m0 + r) * DM) + lane;
#pragma unroll
            for (int j = 0; j < 4; ++j) { const f32x4 y = (v[r][j] * rstd) * gg[j] * (sc[j] + 1.0f) + sh[j]; v2u w; w.x = pk2(y.x, y.y); w.y = pk2(y.z, y.w); o8[64 * j] = w; } } }
}
__device__ __forceinline__ void norm_mod_rows(const float* xP, const float* xS, const float* g, const float* mod, int sh_off, int sc_off, bf16* H, int vcu, int G) {
    const int tid = threadIdx.x, lane = tid & 63, wid = tid >> 6;
    const int gw = vcu * NWAVES + wid, NGW = G * NWAVES;
    for (int q = gw; q < MT / 4; q += NGW) norm_rows4<false, true>(4 * q, xP, xS, g, mod, sh_off, sc_off, H, nullptr, lane);
}
__device__ __forceinline__ void final_norm_rows(float* X, const float* g, int vcu, int G) {
    const int tid = threadIdx.x, lane = tid & 63, wid = tid >> 6;
    const int gw = vcu * NWAVES + wid, NGW = G * NWAVES;
    for (int q = gw; q < MT / 4; q += NGW) norm_rows4<true>(4 * q, X, X + (size_t)MP * DM, g, nullptr, 0, 0, nullptr, X, lane);
}
__device__ __forceinline__ void panel_handoff(unsigned* cP, unsigned* cS) {
    asm volatile("s_waitcnt vmcnt(0)" ::: "memory");
    __syncthreads();
    if (threadIdx.x == 0) {
        __builtin_amdgcn_fence(__ATOMIC_RELEASE, "agent");
        asm volatile("s_waitcnt vmcnt(0)" ::: "memory");
        __hip_atomic_fetch_add(cP, 1u, __ATOMIC_RELAXED, __HIP_MEMORY_SCOPE_AGENT);
        __hip_atomic_fetch_add(cS, 1u, __ATOMIC_RELAXED, __HIP_MEMORY_SCOPE_AGENT);
        unsigned sp = 0;
        while (__hip_atomic_load(cP, __ATOMIC_RELAXED, __HIP_MEMORY_SCOPE_AGENT) < 4u || __hip_atomic_load(cS, __ATOMIC_RELAXED, __HIP_MEMORY_SCOPE_AGENT) < 16u) { __builtin_amdgcn_s_sleep(2); if (++sp > (1u << 22)) break; }
        __builtin_amdgcn_fence(__ATOMIC_ACQUIRE, "agent");
        asm volatile("s_waitcnt vmcnt(0)" ::: "memory");
    }
    __syncthreads();
}
__device__ __forceinline__ void unpack8(v4u w, float* f) { f[0] = bflo(w.x); f[1] = bfhi(w.x); f[2] = bflo(w.y); f[3] = bfhi(w.y); f[4] = bflo(w.z); f[5] = bfhi(w.z); f[6] = bflo(w.w); f[7] = bfhi(w.w); }
__device__ __forceinline__ void merge_phase(const Args& a, int vcu, int G) {
    const bf16* GAB = (const bf16*)(a.ws + WS_GAB); const bf16* OB = (const bf16*)(a.ws + WS_QB); const bf16* G2B = (const bf16*)(a.ws + WS_G2B); const bf16* UB = (const bf16*)(a.ws + WS_UB);
    bf16* Hm = (bf16*)(a.ws + WS_H); const float* cw = a.in[16]; const float* st = a.in[5];
    const size_t total = (size_t)MT * 128, stride = (size_t)G * NTHREADS;
    for (size_t idx = (size_t)vcu * NTHREADS + threadIdx.x; idx < total; idx += stride) {
        const int row = (int)(idx >> 7), c8 = (int)(idx & 127) * 8;
        const bool prm = row < MP; const int rr = prm ? row : row - MP; const int t = prm ? (rr & 2047) : (rr & 63), bb = prm ? (rr >> 11) : (rr >> 6);
        const size_t off = (size_t)row * DM + c8;
        float ga[8], o[8], g2[8], u0[8], u1[8], u2[8];
        unpack8(*(const v4u*)(GAB + off), ga); unpack8(*(const v4u*)(OB + off), o); unpack8(*(const v4u*)(G2B + off), g2); unpack8(*(const v4u*)(UB + off), u2);
        if (t >= 1) unpack8(*(const v4u*)(UB + off - DM), u1);
        else { if (prm) { for (int e = 0; e < 8; ++e) u1[e] = 0.f; } else { const float* p = st + (size_t)(bb * 2 + 1) * 1024 + c8; for (int e = 0; e < 8; ++e) u1[e] = p[e]; } }
        if (t >= 2) unpack8(*(const v4u*)(UB + off - 2 * DM), u0);
        else { if (prm) { for (int e = 0; e < 8; ++e) u0[e] = 0.f; } else { const float* p = st + (size_t)(bb * 2 + t) * 1024 + c8; for (int e = 0; e < 8; ++e) u0[e] = p[e]; } }
        float r[8];
#pragma unroll
        for (int e = 0; e < 8; ++e) { const float cy = cw[c8 + e] * u0[e] + cw[1024 + c8 + e] * u1[e] + cw[2048 + c8 + e] * u2[e]; r[e] = ga[e] * o[e] + g2[e] * cy; }
        v4u w; w.x = pk2(r[0], r[1]); w.y = pk2(r[2], r[3]); w.z = pk2(r[4], r[5]); w.w = pk2(r[6], r[7]);
        *(v4u*)(Hm + off) = w;
    }
}

__device__ __forceinline__ void small_gemm_sample(const bf16* A, const bf16* Wt, int K, const float* base, float* outp, const float* gate, float coef, LAS unsigned char* ring, int vcu, int G) {
    int tid = threadIdx.x; asm volatile("" : "+v"(tid));
    const int lane = tid & 63, wid = tid >> 6, fr = lane & 15, fq = lane >> 4; const int KW = K >> 3;
    for (int item = vcu; item < 256; item += G) {
        const int rt = (item >> 4) * 64, ct = (item & 15) * 64;
        const bf16* ap = A + (size_t)(rt + fr) * K + wid * KW + 8 * fq; const bf16* bp = Wt + (size_t)(ct + fr) * K + wid * KW + 8 * fq;
        const int erow = rt + (tid >> 3), ec0 = ct + 8 * (tid & 7), emb = 8 + (erow >> 6);
        const f32x4 pga = *(const f32x4*)(gate + (size_t)emb * MODLD + ec0), pgb = *(const f32x4*)(gate + (size_t)emb * MODLD + ec0 + 4);
        const f32x4 pr0 = *(const f32x4*)(base + (size_t)erow * DM + ec0), pr1 = *(const f32x4*)(base + (size_t)erow * DM + ec0 + 4);
        f32x4 acc[4][4];
#pragma unroll
        for (int mi = 0; mi < 4; ++mi)
#pragma unroll
            for (int nj = 0; nj < 4; ++nj) acc[mi][nj] = (f32x4){0.f, 0.f, 0.f, 0.f};
#pragma unroll 2
        for (int k0 = 0; k0 < KW; k0 += 32) {
            bf16x8 a[4], b[4];
#pragma unroll
            for (int i = 0; i < 4; ++i) { a[i] = *(const bf16x8*)(ap + (size_t)(16 * i) * K + k0); b[i] = *(const bf16x8*)(bp + (size_t)(16 * i) * K + k0); }
#pragma unroll
            for (int mi = 0; mi < 4; ++mi)
#pragma unroll
                for (int nj = 0; nj < 4; ++nj) acc[mi][nj] = __builtin_amdgcn_mfma_f32_16x16x32_bf16(b[nj], a[mi], acc[mi][nj], 0, 0, 0);
        }
        LAS float* P = (LAS float*)(ring + wid * 16384);
#pragma unroll
        for (int mi = 0; mi < 4; ++mi)
#pragma unroll
            for (int nj = 0; nj < 4; ++nj) { const int row = mi * 16 + fr, grp = (nj * 4 + fq) ^ (row & 15); *(LAS f32x4*)(P + row * 64 + grp * 4) = acc[mi][nj]; }
        __syncthreads();
        { const int row = tid >> 3, j = tid & 7; const int g0 = (2 * j) ^ (row & 15), g1 = (2 * j + 1) ^ (row & 15);
          f32x4 s0 = (f32x4){0.f, 0.f, 0.f, 0.f}, s1 = s0;
#pragma unroll
          for (int w = 0; w < 8; ++w) { const LAS float* p = (const LAS float*)(ring + w * 16384) + row * 64; s0 += *(const LAS f32x4*)(p + g0 * 4); s1 += *(const LAS f32x4*)(p + g1 * 4); }
          const int grow = rt + row, c0 = ct + 8 * j; const int mb = 8 + (grow >> 6);
          const f32x4 ga = pga * coef, gb = pgb * coef; const f32x4 r0 = pr0, r1 = pr1; (void)mb;
          *(f32x4*)(outp + (size_t)grow * DM + c0) = r0 + ga * s0; *(f32x4*)(outp + (size_t)grow * DM + c0 + 4) = r1 + gb * s1; }
        __syncthreads();
    }
}
__device__ __forceinline__ void stage_fb(LAS float* fb, LAS float* wtot, const float* src0, int n0, const float* src1, int n1) {
    int tid = threadIdx.x; asm volatile("" : "+v"(tid)); const int lane = tid & 63, wid = tid >> 6; const int n = n0 + n1, e = 4 * tid;
    f32x4 v = (f32x4){0.f, 0.f, 0.f, 0.f};
    if (e < n) v = (e < n0) ? *(const f32x4*)(src0 + e) : *(const f32x4*)(src1 + (e - n0));
    const float s0 = v[0], s1 = s0 + v[1], s2 = s1 + v[2], s3 = s2 + v[3];
    float inc = s3;
#pragma unroll
    for (int o = 1; o < 64; o <<= 1) { const float t = __shfl_up(inc, o); if (lane >= o) inc += t; }
    if (lane == 63) wtot[wid] = inc;
    __syncthreads();
    float base = inc - s3;
#pragma unroll
    for (int w = 0; w < 8; ++w) { const float tw = wtot[w]; if (w < wid) base += tw; }
    const float c = -1.4426950408889634f;
    if (e < n) *(LAS f32x4*)(fb + e) = (f32x4){(base + s0) * c, (base + s1) * c, (base + s2) * c, (base + s3) * c};
    __syncthreads();
}
__device__ __forceinline__ void attn_sample_unit(int b, int h, const float* cK, const float* cV, const bf16* QB, const bf16* KB, const bf16* VB, const attn_body::MergeCtx& mc,
                                                 LAS unsigned char* ring, const LAS float* fb, LAS float* stats) {
    using attn_body::crow;
    int tid = threadIdx.x; asm volatile("" : "+v"(tid));
    const int lane = tid & 63, r32 = lane & 31, hi = lane >> 5; const int wid = __builtin_amdgcn_readfirstlane(tid >> 6);
    const size_t rowbase = (size_t)MP + (size_t)b * TS;
    LAS unsigned char* Ks = ring + wid * 16384; LAS unsigned char* Vs = Ks + 8192;
    LAS float* wsf = stats + 1024 + wid * 64;
    LAS unsigned char* QL = ring + (QL_OFF - RING_OFF);
    { const int row = tid >> 3, ch = tid & 7; *(LAS v4u*)(QL + row * 144 + ch * 16) = *(const v4u*)(QB + (rowbase + row) * DM + h * HD + ch * 8); }
    __syncthreads();
    float mhat[2], lsum[2] = {0.f, 0.f}; f32x16 o[2][2];
#pragma unroll
    for (int g = 0; g < 2; ++g) { mhat[g] = fb[PAST + 32 * g + r32]; o[g][0] = f32x16{}; o[g][1] = f32x16{}; }
    const int vb = (int)(unsigned)(uintptr_t)Vs + ((lane >> 4) & 1) * 32 + (lane & 3) * 8 + (4 * hi + ((lane & 15) >> 2)) * 64;
#pragma unroll 1
    for (int tl = wid; tl < 17; tl += 8) {
        if (tl < 16) {
            const f32x4* ksrc = (const f32x4*)(cK + ((size_t)(b * NH + h) * PAST + tl * 64) * HD); const f32x4* vsrc = (const f32x4*)(cV + ((size_t)(b * NH + h) * PAST + tl * 64) * HD);
#pragma unroll 1
            for (int hb = 0; hb < 16; hb += 8) {
                f32x4 kva[8], vva[8];
#pragma unroll
                for (int i = 0; i < 8; ++i) { kva[i] = __builtin_nontemporal_load(ksrc + (hb + i) * 64 + lane); vva[i] = __builtin_nontemporal_load(vsrc + (hb + i) * 64 + lane); }
#pragma unroll
                for (int i = 0; i < 8; ++i) { const int key = 4 * (hb + i) + (lane >> 4), d = (lane & 15) * 4; const f32x4 kv = kva[i], vv = vva[i];
                    v2u kw, vw; kw.x = pk2(kv.x, kv.y); kw.y = pk2(kv.z, kv.w); vw.x = pk2(vv.x, vv.y); vw.y = pk2(vv.z, vv.w);
                    *(LAS v2u*)(Ks + (d >> 3) * 1024 + key * 16 + (d & 7) * 2) = kw;
                    *(LAS v2u*)(Vs + ((d >> 5) * 4 + (key >> 4)) * 1024 + (key & 15) * 64 + (d & 31) * 2) = vw; }
            }
        } else {
#pragma unroll 1
            for (int hb = 0; hb < 8; hb += 4) {
                v4u kvb[4], vvb[4];
#pragma unroll
                for (int i = 0; i < 4; ++i) { const int key = 8 * (hb + i) + (lane >> 3), ch = lane & 7; const size_t off = (rowbase + key) * DM + h * HD + ch * 8; kvb[i] = *(const v4u*)(KB + off); vvb[i] = *(const v4u*)(VB + off); }
#pragma unroll
                for (int i = 0; i < 4; ++i) { const int key = 8 * (hb + i) + (lane >> 3), ch = lane & 7;
                    *(LAS v4u*)(Ks + ch * 1024 + key * 16) = kvb[i];
                    *(LAS v4u*)(Vs + ((ch >> 2) * 4 + (key >> 4)) * 1024 + (key & 15) * 64 + (ch & 3) * 16) = vvb[i]; }
            }
        }
        LDS_WAIT();
#pragma unroll
        for (int g = 0; g < 2; ++g) {
            __builtin_amdgcn_sched_barrier(0);
            f32x16 p0, p1;
            { const LAS float* fp = fb + 64 * tl + 4 * hi;
#pragma unroll
              for (int i = 0; i < 4; ++i) { const f32x4 x = *(const LAS f32x4*)(fp + 8 * i), y = *(const LAS f32x4*)(fp + 32 + 8 * i);
#pragma unroll
                  for (int e = 0; e < 4; ++e) { p0[4 * i + e] = x[e] - mhat[g]; p1[4 * i + e] = y[e] - mhat[g]; } } }
            { const LAS unsigned char* kb = Ks + hi * 1024 + r32 * 16;
#pragma unroll
              for (int d0 = 0; d0 < 4; ++d0) { const bf16x8 b0 = *(const LAS bf16x8*)(kb + d0 * 2048), b1 = *(const LAS bf16x8*)(kb + d0 * 2048 + 512);
                  const bf16x8 qf = *(const LAS bf16x8*)(QL + (32 * g + r32) * 144 + d0 * 32 + hi * 16);
                  p0 = __builtin_amdgcn_mfma_f32_32x32x16_bf16(b0, qf, p0, 0, 0, 0); p1 = __builtin_amdgcn_mfma_f32_32x32x16_bf16(b1, qf, p1, 0, 0, 0); } }
            if (tl == 16) { const int qi = 32 * g + r32;
#pragma unroll
                for (int r = 0; r < 16; ++r) { const int kj = crow(r, hi); if (kj > qi) p0[r] = -INFINITY; if (kj + 32 > qi) p1[r] = -INFINITY; } }
            float rm = p0[0];
#pragma unroll
            for (int r = 1; r < 16; ++r) rm = fmaxf(rm, p0[r]);
#pragma unroll
            for (int r = 0; r < 16; ++r) rm = fmaxf(rm, p1[r]);
            rm = fmaxf(rm, __shfl_xor(rm, 32));
            const float dl = fmaxf(rm, 0.f);
            mhat[g] += dl;
            const float f = __builtin_amdgcn_exp2f(-dl);
            float sacc = 0.f;
#pragma unroll
            for (int r = 0; r < 16; ++r) { p0[r] = __builtin_amdgcn_exp2f(p0[r] - dl); p1[r] = __builtin_amdgcn_exp2f(p1[r] - dl); sacc += p0[r] + p1[r]; }
            lsum[g] = lsum[g] * f + sacc;
            if (hi == 0) wsf[32 * g + r32] = f;
            LDS_WAIT();
#pragma unroll
            for (int r = 0; r < 16; ++r) { const float fr_ = wsf[32 * g + crow(r, hi)]; o[g][0][r] *= fr_; o[g][1][r] *= fr_; }
            v4u pw0, pw1, pw2, pw3;
#define PKW(P, B) attn_body::cvtpk_s(P[B], P[B + 1])
            pw0 = (v4u){PKW(p0, 0), PKW(p0, 2), PKW(p0, 4), PKW(p0, 6)}; pw1 = (v4u){PKW(p0, 8), PKW(p0, 10), PKW(p0, 12), PKW(p0, 14)};
            pw2 = (v4u){PKW(p1, 0), PKW(p1, 2), PKW(p1, 4), PKW(p1, 6)}; pw3 = (v4u){PKW(p1, 8), PKW(p1, 10), PKW(p1, 12), PKW(p1, 14)};
#undef PKW
            attn_body::pv(o[g], vb, __builtin_bit_cast(bf16x8, pw0), __builtin_bit_cast(bf16x8, pw1), __builtin_bit_cast(bf16x8, pw2), __builtin_bit_cast(bf16x8, pw3));
        }
        LDS_WAIT();
    }
#pragma unroll
    for (int g = 0; g < 2; ++g) { const float lt = lsum[g] + __shfl_xor(lsum[g], 32); if (hi == 0) { stats[wid * 64 + 32 * g + r32] = mhat[g]; stats[512 + wid * 64 + 32 * g + r32] = lt; } }
    __syncthreads();
    LAS float* Op = (LAS float*)(ring + wid * 16384);
#pragma unroll
    for (int g = 0; g < 2; ++g)
#pragma unroll
        for (int r = 0; r < 16; ++r) { const int q = 32 * g + crow(r, hi); float mx = stats[q];
#pragma unroll
            for (int w = 1; w < 8; ++w) mx = fmaxf(mx, stats[w * 64 + q]);
            const float scl = __builtin_amdgcn_exp2f(stats[wid * 64 + q] - mx);
            Op[q * 64 + r32] = o[g][0][r] * scl; Op[q * 64 + 32 + r32] = o[g][1][r] * scl; }
    __syncthreads();
    { const int q = tid >> 3, d0 = (tid & 7) * 8; float mx = stats[q];
#pragma unroll
      for (int w = 1; w < 8; ++w) mx = fmaxf(mx, stats[w * 64 + q]);
      float Lq = 0.f; f32x4 s0 = (f32x4){0.f, 0.f, 0.f, 0.f}, s1 = s0;
#pragma unroll
      for (int w = 0; w < 8; ++w) { Lq += stats[512 + w * 64 + q] * __builtin_amdgcn_exp2f(stats[w * 64 + q] - mx);
          const LAS float* p = (const LAS float*)(ring + w * 16384) + q * 64 + d0; s0 += *(const LAS f32x4*)p; s1 += *(const LAS f32x4*)(p + 4); }
      const float rl = 1.0f / Lq; s0 = s0 * rl; s1 = s1 * rl;
      v4u w; w.x = pk2(s0.x, s0.y); w.y = pk2(s0.z, s0.w); w.z = pk2(s1.x, s1.y); w.w = pk2(s1.z, s1.w);
      merge_store8(mc, rowbase + q, q, false, b, h * HD + d0, w); }
    __syncthreads();
}

__global__ void __launch_bounds__(NTHREADS, 2) fwd_mega(Args args) {
    extern __shared__ __attribute__((aligned(16))) unsigned char lds[];
    cg::grid_group grid = cg::this_grid();
    LAS unsigned char* L = (LAS unsigned char*)lds;
    const int G = gridDim.x; const int bx = blockIdx.x; const int vcu = (G % 8 == 0) ? (bx % 8) * (G / 8) + bx / 8 : bx;
    unsigned char* ws = args.ws; float* out = args.out; const float* mod = (const float*)(ws + WS_MOD);
    bf16* Hb = (bf16*)(ws + WS_H); bf16* ACT = (bf16*)(ws + WS_ACT);
    float* XR = out + O_Y;
    const int lo = args.ph_lo, hi = args.ph_hi;
#ifndef PH_MASK
#define PH_MASK 0x1fff
#endif
#define IN(k) (((PH_MASK >> (k)) & 1) && lo <= (k) && (k) < hi)
#define SEAM(k) do { if (IN(k) && IN((k) + 1)) xcd_barrier(bar); } while (0)

    unsigned* barw = (unsigned*)(ws + WS_BAR);
    volatile LAS unsigned* bst = (volatile LAS unsigned*)(L + STAT_OFF + 8000);
    unsigned* cntw = (unsigned*)(ws + WS_CNT);
    if (bx == 0) { for (int i = threadIdx.x; i < XCD_BAR_WORDS; i += NTHREADS) __hip_atomic_store(barw + i, 0u, __ATOMIC_RELAXED, __HIP_MEMORY_SCOPE_AGENT);
                   for (int i = threadIdx.x; i < CNT_WORDS; i += NTHREADS) __hip_atomic_store(cntw + i, 0u, __ATOMIC_RELAXED, __HIP_MEMORY_SCOPE_AGENT); }
    const bool fuse_rows = (G == 256);
    const int wv = threadIdx.x >> 6, ln = threadIdx.x & 63;
    bf16* Hb2 = (bf16*)(ws + WS_GAB);
#define HANDOFF(inst, S) pg8::Unit hu; S.next(0, hu); const int rt_ = vcu >> 4, ct_ = vcu & 15; \
        panel_handoff(cntw + ((inst) * 80 + hu.pm) * 16, cntw + ((inst) * 80 + 64 + rt_) * 16)
    if (IN(0)) { p0_mod(args, L, vcu, G); p0_weights(args, L, vcu, G); }
    if (threadIdx.x < 2) bst[threadIdx.x] = 0u;
    grid.sync();
    const XcdBarrier bar = xcd_barrier_post(barw, bst);
    if (IN(1)) norm_mod_rows(args.in[0], args.in[1], args.in[10], mod, 0 * DM, 1 * DM, Hb, vcu, G);
    SEAM(1);
    if (IN(2)) { pg8::Gemm g{Hb, (const bf16*)(ws + WS_W1IN), MT, 2 * DFF, DM}; pg8::StaticOrder S; S.init(MT, 2 * DFF, G, bx);
        pg8::EpiSwiGLU E{ACT, DFF}; pg8::gemm_phase<pg8::EpiSwiGLU, pg8::StaticOrder, PG8_ALIGN, PG8_SP2>(L + RING_OFF, g, S, E);
        constexpr int NF = (68 * 22) % 256;
        if (G == 256 && bx >= NF) weight_items_tail(args, L, WCUT0, WCUT1, (bx - NF) * NWAVES + (int)(threadIdx.x >> 6), (256 - NF) * NWAVES); }
    SEAM(2);
    if (IN(3)) { pg8::Gemm g{ACT, (const bf16*)(ws + WS_W1OUT), MP, DM, DFF}; pg8::StaticOrder S; S.init(MP, DM, G, bx);
        pg8::EpiResid<true> E{args.in[0], args.in[1], XR, mod + 2 * DM, 0.5f}; pg8::gemm_phase<pg8::EpiResid<true>, pg8::StaticOrder, false, PG8_SP2>(L + RING_OFF, g, S, E);
        small_gemm_sample(ACT + (size_t)MP * DFF, (const bf16*)(ws + WS_W1OUT), DFF, args.in[1], XR + (size_t)MP * DM, mod + 2 * DM, 0.5f, L + RING_OFF, vcu, G);
        if (fuse_rows) { HANDOFF(0, S);
            norm_rows4<false, false, 8>(hu.pm * 256 + hu.pn * 64 + wv * 8, XR, XR + (size_t)MP * DM, args.in[13], mod, 3 * DM, 4 * DM, Hb, nullptr, ln);
            if (wv == 0) norm_rows4<false>(MP + rt_ * 64 + ct_ * 4, XR, XR + (size_t)MP * DM, args.in[13], mod, 3 * DM, 4 * DM, Hb, nullptr, ln); } }
    if (!fuse_rows) { SEAM(3); if (IN(4)) norm_mod_rows(XR, XR + (size_t)MP * DM, args.in[13], mod, 3 * DM, 4 * DM, Hb, vcu, G); }
    SEAM(4);
    if (IN(5)) { pg8::Gemm g{Hb, (const bf16*)(ws + WS_WIN), MT, NINP, DM}; pg8::StaticOrder S; S.init(MT, NINP, G, bx);
        pg8::EpiMix E{(bf16*)(ws + WS_QB), out, args.in[15], attn_body::C2};
        pg8::gemm_phase<pg8::EpiMix, pg8::StaticOrder, PG8_ALIGN, PG8_SP2>(L + RING_OFF, g, S, E);
        constexpr int NF = (68 * 33) % 256;
        if (G == 256 && bx >= NF) weight_items_tail(args, L, WCUT1, WITEMS, (bx - NF) * NWAVES + (int)(threadIdx.x >> 6), (256 - NF) * NWAVES); }
    SEAM(5);
    if (IN(6)) {
        const attn_body::bf16* Q = (const attn_body::bf16*)(ws + WS_QB); const attn_body::bf16* K = (const attn_body::bf16*)(ws + WS_KB); const attn_body::bf16* V = (const attn_body::bf16*)(ws + WS_VB);
        LAS float* fb = (LAS float*)(L + FB_OFF); LAS float* stats = (LAS float*)(L + STAT_OFF);
        const attn_body::MergeCtx mc{(const bf16*)(ws + WS_GAB), (const bf16*)(ws + WS_G2B), (const bf16*)(ws + WS_UB), args.in[16], args.in[5], Hb};
#pragma unroll 1
        for (int pass = 0; pass < 2; ++pass) {
        const bool do_sample = ((vcu & 1) != 0) == (pass == 0);
        if (!do_sample) {
        for (int it = vcu; it < 512; it += G) {
            const int bh = it >> 2, k = it & 3;
            stage_fb(fb, stats, out + O_LFP + (size_t)bh * TP, TP, nullptr, 0);
#pragma unroll 1
            for (int j = 0; j < 2; ++j) attn_body::attn_unit<8>(bh >> 4, bh & 15, j ? k : 7 - k, Q, K, V, mc, (char*)lds + RING_OFF, fb);
        }
        } else {
        for (int it = vcu; it < 256; it += G) {
            const int b = it >> 4, h = it & 15;
            stage_fb(fb, stats, args.in[4] + (size_t)it * PAST, PAST, out + O_LFS + (size_t)it * TS, TS);
            attn_sample_unit(b, h, args.in[2], args.in[3], (const bf16*)(ws + WS_QB), (const bf16*)(ws + WS_KB), (const bf16*)(ws + WS_VB), mc, L + RING_OFF, fb, stats);
        }
        }
        }
    }
    SEAM(6);
    if (IN(8)) { pg8::Gemm g{Hb, (const bf16*)(ws + WS_WOUT), MP, DM, DM}; pg8::StaticOrder S; S.init(MP, DM, G, bx);
        pg8::EpiResid<false> E{XR, XR + (size_t)MP * DM, XR, mod + 5 * DM, 1.0f}; pg8::gemm_phase<pg8::EpiResid<false>, pg8::StaticOrder, false, PG8_SP2>(L + RING_OFF, g, S, E);
        small_gemm_sample(Hb + (size_t)MP * DM, (const bf16*)(ws + WS_WOUT), DM, XR + (size_t)MP * DM, XR + (size_t)MP * DM, mod + 5 * DM, 1.0f, L + RING_OFF, vcu, G);
        if (fuse_rows) { HANDOFF(1, S);
            norm_rows4<false, false, 8>(hu.pm * 256 + hu.pn * 64 + wv * 8, XR, XR + (size_t)MP * DM, args.in[18], mod, 6 * DM, 7 * DM, Hb2, nullptr, ln);
            if (wv == 0) norm_rows4<false>(MP + rt_ * 64 + ct_ * 4, XR, XR + (size_t)MP * DM, args.in[18], mod, 6 * DM, 7 * DM, Hb2, nullptr, ln); } }
    if (!fuse_rows) { SEAM(8); if (IN(9)) norm_mod_rows(XR, XR + (size_t)MP * DM, args.in[18], mod, 6 * DM, 7 * DM, Hb2, vcu, G); }
    SEAM(9);
    if (IN(10)) { pg8::Gemm g{Hb2, (const bf16*)(ws + WS_W2IN), MT, 2 * DFF, DM}; pg8::StaticOrder S; S.init(MT, 2 * DFF, G, bx);
        pg8::EpiSwiGLU E{ACT, DFF}; pg8::gemm_phase<pg8::EpiSwiGLU, pg8::StaticOrder, PG8_ALIGN, PG8_SP2>(L + RING_OFF, g, S, E); }
    SEAM(10);
    if (IN(11)) { pg8::Gemm g{ACT, (const bf16*)(ws + WS_W2OUT), MP, DM, DFF}; pg8::StaticOrder S; S.init(MP, DM, G, bx);
        pg8::EpiResid<false> E{XR, XR + (size_t)MP * DM, XR, mod + 8 * DM, 0.5f}; pg8::gemm_phase<pg8::EpiResid<false>, pg8::StaticOrder, false, PG8_SP2>(L + RING_OFF, g, S, E);
        small_gemm_sample(ACT + (size_t)MP * DFF, (const bf16*)(ws + WS_W2OUT), DFF, XR + (size_t)MP * DM, XR + (size_t)MP * DM, mod + 8 * DM, 0.5f, L + RING_OFF, vcu, G);
        if (fuse_rows) { HANDOFF(2, S);
            norm_rows4<true, false, 8>(hu.pm * 256 + hu.pn * 64 + wv * 8, XR, XR + (size_t)MP * DM, args.in[21], nullptr, 0, 0, nullptr, XR, ln);
            if (wv == 0) norm_rows4<true>(MP + rt_ * 64 + ct_ * 4, XR, XR + (size_t)MP * DM, args.in[21], nullptr, 0, 0, nullptr, XR, ln); } }
    if (!fuse_rows) { SEAM(11); if (IN(12)) final_norm_rows(XR, args.in[21], vcu, G); }
#undef IN
#undef SEAM
}

#ifndef MK_N_LAUNCHES
#define MK_N_LAUNCHES 1
#endif
constexpr int N_PHASES = 13;
extern "C" void kernel_launch(void* const* d_in, const int* in_sizes, int n_in, void* d_out, int out_size, void* d_ws, size_t ws_size, hipStream_t stream) {
    static int grid = 0;
    if (grid == 0) {
        if (n_in != 22 || out_size != (int)O_END || ws_size < WS_END) { fprintf(stderr, "kernel_launch: unexpected sizes n_in %d out %d ws %zu; nothing launched\n", n_in, out_size, ws_size); grid = -1; return; }
        int dev = 0, cus = 0, per_cu = 0;
        if (hipGetDevice(&dev) != hipSuccess || hipDeviceGetAttribute(&cus, hipDeviceAttributeMultiprocessorCount, dev) != hipSuccess) { grid = -1; return; }
        if (hipFuncSetAttribute((const void*)fwd_mega, hipFuncAttributeMaxDynamicSharedMemorySize, LDS_BYTES) != hipSuccess) { fprintf(stderr, "kernel_launch: hipFuncSetAttribute failed\n"); grid = -1; return; }
        if (hipOccupancyMaxActiveBlocksPerMultiprocessor(&per_cu, (const void*)fwd_mega, NTHREADS, LDS_BYTES) != hipSuccess || per_cu < 1) { fprintf(stderr, "kernel_launch: occupancy query says %d\n", per_cu); (void)hipGetLastError(); grid = -1; return; }
        grid = cus * 1;
        fprintf(stderr, "kernel_launch: grid %d (cus %d, per_cu %d), ws %zu\n", grid, cus, per_cu, ws_size);
    }
    if (grid < 0) return;
    Args a{};
    for (int i = 0; i < 22; ++i) a.in[i] = (const float*)d_in[i];
    a.out = (float*)d_out; a.ws = (unsigned char*)d_ws;
#if MK_N_LAUNCHES == 1
    a.ph_lo = 0; a.ph_hi = N_PHASES;
    void* kargs[] = {&a};
    hipError_t e = hipLaunchCooperativeKernel((const void*)fwd_mega, dim3(grid), dim3(NTHREADS), kargs, LDS_BYTES, stream);
    if (e != hipSuccess) fprintf(stderr, "kernel_launch: cooperative launch failed: %s (grid %d)\n", hipGetErrorString(e), grid);
#else
    for (int p = 0; p < N_PHASES; ++p) { a.ph_lo = p; a.ph_hi = p + 1; void* kargs[] = {&a};
        hipError_t e = hipLaunchCooperativeKernel((const void*)fwd_mega, dim3(grid), dim3(NTHREADS), kargs, LDS_BYTES, stream);
        if (e != hipSuccess) { fprintf(stderr, "kernel_launch: launch %d failed: %s\n", p, hipGetErrorString(e)); break; } }
#endif
}
```

```cpp
#include <hip/hip_runtime.h>
#include <hip/hip_cooperative_groups.h>
#include <cstdio>
#include <cstdint>
constexpr int MODLD = 9216;
constexpr int DM = 1024, MP = 16384, MS = 1024, MT = MP + MS, TP = 2048, TS = 64, PAST = 1024, NH = 16, HD = 64, DFF = 2816, NIN = 8208, NINP = 8448, NMOD = 9;
constexpr int OFF_Q = 0, OFF_K = 1024, OFF_V = 2048, OFF_F = 3072, OFF_B = 3088, OFF_C = 4112, OFF_X = 5136, OFF_GA = 6160, OFF_GC = 7184;
constexpr float EPS = 1e-6f;
constexpr size_t O_Y = 0, O_KP = (size_t)MT * DM, O_VP = O_KP + (size_t)MP * DM, O_LFP = O_VP + (size_t)MP * DM, O_CVP = O_LFP + 8 * 16 * 2048, O_KS = O_CVP + 8 * 2 * 1024,
                 O_VS = O_KS + (size_t)MS * DM, O_LFS = O_VS + (size_t)MS * DM, O_CVS = O_LFS + 16 * 16 * 64, O_END = O_CVS + 16 * 2 * 1024;
static_assert(O_END == 53805056, "d_out map");
namespace pg8 {
#define PG8_LAS __attribute__((address_space(3)))
typedef unsigned short bf16_t;
typedef short bf16x8 __attribute__((ext_vector_type(8)));
typedef float f32x4 __attribute__((ext_vector_type(4)));
typedef unsigned u32x4 __attribute__((ext_vector_type(4)));
constexpr int BM = 256, BK = 64, HALF = 128, HTB = HALF * BK * 2  , STAGE_BYTES = 8 * HTB, NXCD = 8, WGM = 8;

__host__ __device__ __forceinline__ int lds_byte(int r, int c) { const int st = (r >> 4) * 2 + (c >> 5), rr = r & 15, cc = c & 31, ob = rr * 64 + cc * 2; return st * 1024 + (ob ^ (((ob >> 9) & 1) << 5)); }
__host__ __device__ __forceinline__ void stage_rc(int b, int& R, int& C) { const int st = b / 1024, sb = b % 1024, swz = sb ^ (((sb >> 9) & 1) << 5); R = (st >> 1) * 16 + swz / 64; C = (st & 1) * 32 + (swz % 64) / 2; }
__host__ __device__ __forceinline__ int perm32(int rho) { const int n = rho >> 4, i = rho & 15; return 8 * (i >> 2) + 4 * n + (i & 3); }

struct Unit { int pm, pn; };
struct Gemm { const bf16_t* A; const bf16_t* Bt; int M, N, K; };

struct StaticOrder {
    int nM, nN, nwg, G, c;
    __host__ __device__ __forceinline__ void init(int M, int N, int G_, int c_) { nM = M / BM; nN = N / BM; nwg = nM * nN; G = G_; c = c_; }
    __host__ __device__ __forceinline__ bool next(int i, Unit& u) const {
        const long L = (long)i * G + c; if (L >= nwg) return false;
        int wgid = (int)L; { const int q = nwg / NXCD, r = nwg % NXCD, xcd = wgid % NXCD, off = wgid / NXCD; wgid = (xcd < r ? xcd * (q + 1) : r * (q + 1) + (xcd - r) * q) + off; }
        const int nig = WGM * nN, gid = wgid / nig, fm = gid * WGM, gsz = (nM - fm) < WGM ? (nM - fm) : WGM;
        u.pm = fm + ((wgid % nig) % gsz); u.pn = (wgid % nig) / gsz; return true;
    }
    __device__ __forceinline__ void a_ready(const Unit&) const {}
    __device__ __forceinline__ void done(const Unit&) const {}
};

__device__ __forceinline__ unsigned cvt_pk_bf16(float lo, float hi) { unsigned r; asm volatile("v_cvt_pk_bf16_f32 %0, %1, %2" : "=v"(r) : "v"(lo), "v"(hi)); return r; }

constexpr int MPROMPT = 16384;
__device__ __forceinline__ int mod_batch(int pm, int ai, int wr) { return pm < 64 ? (pm >> 3) : 8 + (pm - 64) * 4 + 2 * ai + wr; }
__device__ __forceinline__ float sigmoid_f(float x) { return __builtin_amdgcn_rcpf(1.0f + __builtin_amdgcn_exp2f(-1.4426950408889634f * x)); }
__device__ __forceinline__ f32x4 sigmoid4(f32x4 x) { return (f32x4){sigmoid_f(x[0]), sigmoid_f(x[1]), sigmoid_f(x[2]), sigmoid_f(x[3])}; }
__device__ __forceinline__ u32x4 pack8(f32x4 v0, f32x4 v1) { u32x4 w; w.x = cvt_pk_bf16(v0[0], v0[1]); w.y = cvt_pk_bf16(v0[2], v0[3]); w.z = cvt_pk_bf16(v1[0], v1[1]); w.w = cvt_pk_bf16(v1[2], v1[3]); return w; }

struct EpiSwiGLU {
    static constexpr bool PERM = true, AFTER_DRAIN = false;
    bf16_t* O; int ldc;
    __device__ __forceinline__ void operator()(const f32x4 (&acc)[2][2][4][2], const Unit& u, int wr, int wc, int fr, int fq) const {
        const int row0 = u.pm * BM + wr * 64 + fr, col0 = u.pn * HALF + wc * 32 + 8 * fq;
#pragma unroll
        for (int ai = 0; ai < 2; ++ai)
#pragma unroll
            for (int m = 0; m < 4; ++m) {
                const f32x4 a0 = acc[ai][0][m][0], a1 = acc[ai][0][m][1];
                const f32x4 v0 = a0 * sigmoid4(a0) * acc[ai][1][m][0], v1 = a1 * sigmoid4(a1) * acc[ai][1][m][1];
                *(u32x4*)(O + (size_t)(row0 + ai * HALF + m * 16) * ldc + col0) = pack8(v0, v1);
            }
    }
};
template <bool NTB> struct EpiResid {
    static constexpr bool PERM = true, AFTER_DRAIN = false;
    const float* baseP; const float* baseS; float* out; const float* gate; float coef;
    __device__ __forceinline__ void operator()(const f32x4 (&acc)[2][2][4][2], const Unit& u, int wr, int wc, int fr, int fq) const {
        const int col0 = u.pn * BM + wc * 32 + 8 * fq;
#pragma unroll
        for (int ai = 0; ai < 2; ++ai) {
            const float* gp = gate + (size_t)mod_batch(u.pm, ai, wr) * MODLD + col0;
            f32x4 g[2][2];
#pragma unroll
            for (int bj = 0; bj < 2; ++bj)
#pragma unroll
                for (int n = 0; n < 2; ++n) g[bj][n] = *(const f32x4*)(gp + bj * HALF + 4 * n) * coef;
            f32x4 bsv[4][2][2];
#pragma unroll
            for (int m = 0; m < 4; ++m) {
                const int row = u.pm * BM + ai * HALF + wr * 64 + m * 16 + fr;
                const float* bp = (u.pm < 64 ? baseP + (size_t)row * 1024 : baseS + (size_t)(row - MPROMPT) * 1024) + col0;
#pragma unroll
                for (int bj = 0; bj < 2; ++bj)
#pragma unroll
                    for (int n = 0; n < 2; ++n) { const f32x4* p = (const f32x4*)(bp + bj * HALF + 4 * n); bsv[m][bj][n] = NTB ? __builtin_nontemporal_load(p) : *p; }
            }
            asm volatile("" ::: "memory");
#pragma unroll
            for (int m = 0; m < 4; ++m) {
                const int row = u.pm * BM + ai * HALF + wr * 64 + m * 16 + fr;
                float* op = out + (size_t)row * 1024 + col0;
#pragma unroll
                for (int bj = 0; bj < 2; ++bj)
#pragma unroll
                    for (int n = 0; n < 2; ++n) *(f32x4*)(op + bj * HALF + 4 * n) = bsv[m][bj][n] + g[bj][n] * acc[ai][bj][m][n];
            }
        }
    }
};
struct EpiMix {
    static constexpr bool PERM = true, AFTER_DRAIN = false;
    bf16_t* QB; float* outp; const float* b_f; float qscale;
    static constexpr size_t BSTRIDE = (size_t)MT * DM;
    __device__ __forceinline__ void operator()(const f32x4 (&acc)[2][2][4][2], const Unit& u, int wr, int wc, int fr, int fq) const {
        const int pn = u.pn; const bool prm = u.pm < 64;
        const int row0 = u.pm * BM + wr * 64 + fr;
        if (pn < 16) {
            const int seg = pn >> 2, colt = (pn & 3) * BM + wc * 32 + 8 * fq;
            bf16_t* dst = QB + (size_t)seg * BSTRIDE;
            const float sc = seg == 0 ? qscale : 1.f;
            float* fo = outp + (seg == 1 ? (prm ? O_KP : O_KS) : (prm ? O_VP : O_VS));
#pragma unroll
            for (int ai = 0; ai < 2; ++ai)
#pragma unroll
                for (int m = 0; m < 4; ++m) {
                    const int row = row0 + ai * HALF + m * 16;
                    const int rr = prm ? row : row - MPROMPT; const int bb = prm ? (rr >> 11) : (rr >> 6), tt = prm ? (rr & 2047) : (rr & 63), TT = prm ? 2048 : 64;
#pragma unroll
                    for (int bj = 0; bj < 2; ++bj) {
                        f32x4 v0 = acc[ai][bj][m][0], v1 = acc[ai][bj][m][1]; const int col = colt + bj * HALF;
                        if (seg == 1 || seg == 2) { float* p = fo + ((size_t)(bb * 16 + (col >> 6)) * TT + tt) * 64 + (col & 63); __builtin_nontemporal_store(v0, (f32x4*)p); __builtin_nontemporal_store(v1, (f32x4*)(p + 4)); }
                        if (seg == 3) { v0 = sigmoid4(v0); v1 = sigmoid4(v1); }
                        v0 = v0 * sc; v1 = v1 * sc;
                        *(u32x4*)(dst + (size_t)row * 1024 + col) = pack8(v0, v1);
                    }
                }
        } else if (pn < 32) {
            const bool cx = pn >= 24; const int col = ((pn - 16) & 7) * HALF + wc * 32 + 8 * fq;
            bf16_t* dst = QB + (size_t)(cx ? 5 : 4) * BSTRIDE;
#pragma unroll
            for (int ai = 0; ai < 2; ++ai)
#pragma unroll
                for (int m = 0; m < 4; ++m) {
                    const int row = row0 + ai * HALF + m * 16;
                    f32x4 v0, v1;
                    if (cx) { v0 = acc[ai][0][m][0] * acc[ai][1][m][0]; v1 = acc[ai][0][m][1] * acc[ai][1][m][1]; }
                    else { v0 = acc[ai][0][m][0] * sigmoid4(acc[ai][1][m][0]); v1 = acc[ai][0][m][1] * sigmoid4(acc[ai][1][m][1]); }
                    *(u32x4*)(dst + (size_t)row * 1024 + col) = pack8(v0, v1);
                    if (cx) {
                        const int rr = prm ? row : row - MPROMPT; const int bb = prm ? (rr >> 11) : (rr >> 6), tt = prm ? (rr & 2047) : (rr & 63), TT = prm ? 2048 : 64;
                        if (tt >= TT - 2) { float* p = outp + (prm ? O_CVP : O_CVS) + (size_t)(bb * 2 + (tt - (TT - 2))) * 1024 + col; *(f32x4*)p = v0; *(f32x4*)(p + 4) = v1; }
                    }
                }
        } else {
            if (wc == 0 && fq < 2) {
                const f32x4 bf0 = *(const f32x4*)(b_f + 8 * fq), bf1 = *(const f32x4*)(b_f + 8 * fq + 4);
                asm volatile("" ::: "memory");
#pragma unroll
                for (int ai = 0; ai < 2; ++ai)
#pragma unroll
                    for (int m = 0; m < 4; ++m) {
                        const int row = row0 + ai * HALF + m * 16;
                        const int rr = prm ? row : row - MPROMPT; const int bb = prm ? (rr >> 11) : (rr >> 6), tt = prm ? (rr & 2047) : (rr & 63), TT = prm ? 2048 : 64;
                        float* fo = outp + (prm ? O_LFP : O_LFS);
#pragma unroll
                        for (int n = 0; n < 2; ++n)
#pragma unroll
                            for (int e = 0; e < 4; ++e) {
                                const int hh = 8 * fq + 4 * n + e; const float v = acc[ai][0][m][n][e] + (n ? bf1[e] : bf0[e]);
                                const float ls = fminf(v, 0.f) - __logf(1.0f + __expf(-fabsf(v)));
                                fo[(size_t)(bb * 16 + hh) * TT + tt] = ls;
                            }
                    }
            }
        }
    }
};
template <class Epi, class Sched, bool ALIGN_EPI = false, bool SP2 = false>
__device__ __forceinline__ void gemm_phase(PG8_LAS unsigned char* lds, const Gemm g, const Sched& S, const Epi& E) {
    const int tid = threadIdx.x, wid = __builtin_amdgcn_readfirstlane(tid >> 6), lane = tid & 63, wr = wid >> 2, wc = wid & 3, fr = lane & 15, fq = lane >> 4;
    const int K = g.K, nt = K / BK;
    unsigned voffA[2], voffB[2];
#pragma unroll
    for (int i = 0; i < 2; ++i) { int R, C; stage_rc(tid * 16 + i * 8192, R, C); const int Rb = Epi::PERM ? ((R & ~31) + perm32(R & 31)) : R;
        voffA[i] = (unsigned)(R * K + C) * 2u; voffB[i] = (unsigned)(Rb * K + C) * 2u; }
    const size_t kstep = (size_t)(BK * 2);
    const size_t hstep = (size_t)HALF * K * 2;
    const size_t tstep = 2 * hstep;
    const unsigned ldsw = (unsigned)wid * 1024u;
    const int aoff = lds_byte(wr * 64 + fr, fq * 8), boff = lds_byte(wc * 32 + fr, fq * 8);
#define PG8_SA(b, h) (((b) * 2 + (h)) * HTB)
#define PG8_SB(b, h) ((4 + (b) * 2 + (h)) * HTB)
#define PG8_STAGE(bufoff, gbase, voff) do { _Pragma("unroll") for (int _i = 0; _i < 2; ++_i) \
        __builtin_amdgcn_global_load_lds((const unsigned*)((const char*)(gbase) + (voff)[_i]), (PG8_LAS unsigned*)(lds + (bufoff) + ldsw + _i * 8192), 16, 0, 0); } while (0)
#define PG8_LDA(dst, b, h) do { _Pragma("unroll") for (int m = 0; m < 4; ++m) _Pragma("unroll") for (int k = 0; k < 2; ++k) dst[m][k] = *(const PG8_LAS bf16x8*)(lds + PG8_SA(b, h) + aoff + m * 2048 + k * 1024); } while (0)
#define PG8_LDB(dst, b, h) do { _Pragma("unroll") for (int n = 0; n < 2; ++n) _Pragma("unroll") for (int k = 0; k < 2; ++k) dst[n][k] = *(const PG8_LAS bf16x8*)(lds + PG8_SB(b, h) + boff + n * 2048 + k * 1024); } while (0)
#define PG8_MMA(ai, bj, At, Bt) do { __builtin_amdgcn_s_setprio(1); _Pragma("unroll") for (int m = 0; m < 4; ++m) _Pragma("unroll") for (int n = 0; n < 2; ++n) _Pragma("unroll") for (int k = 0; k < 2; ++k) \
        acc[ai][bj][m][n] = __builtin_amdgcn_mfma_f32_16x16x32_bf16(Bt[n][k], At[m][k], acc[ai][bj][m][n], 0, 0, 0); __builtin_amdgcn_s_setprio(0); } while (0)
#define PG8_WAIT_V(n) asm volatile("s_waitcnt vmcnt(" #n ")" ::: "memory")
#define PG8_WAIT_L(n) asm volatile("s_waitcnt lgkmcnt(" #n ")" ::: "memory")
#define PG8_BAR __builtin_amdgcn_s_barrier()
#define PG8_SCHED __builtin_amdgcn_sched_barrier(0)
    Unit cur, nxt; int ui = 0;
    if (!S.next(0, cur)) return;
    f32x4 acc[2][2][4][2];
#pragma unroll
    for (int a = 0; a < 2; ++a)
#pragma unroll
        for (int b = 0; b < 2; ++b)
#pragma unroll
            for (int m = 0; m < 4; ++m)
#pragma unroll
                for (int n = 0; n < 2; ++n) acc[a][b][m][n] = (f32x4){0.f, 0.f, 0.f, 0.f};
    bf16x8 At[4][2], B0[2][2], B1[2][2];
    const char* cA = (const char*)g.A + (size_t)cur.pm * tstep; const char* cB = (const char*)g.Bt + (size_t)cur.pn * tstep;
    S.a_ready(cur);
    if constexpr (SP2) {
        PG8_STAGE(PG8_SB(0, 0), cB, voffB); PG8_STAGE(PG8_SB(0, 1), cB + hstep, voffB); PG8_STAGE(PG8_SA(0, 0), cA, voffA); PG8_STAGE(PG8_SA(0, 1), cA + hstep, voffA);
        if (wr == 1) PG8_BAR;
        PG8_WAIT_V(2); PG8_BAR;
        PG8_STAGE(PG8_SB(1, 0), cB + kstep, voffB); PG8_STAGE(PG8_SA(1, 0), cA + kstep, voffA); PG8_STAGE(PG8_SB(1, 1), cB + hstep + kstep, voffB);
        PG8_WAIT_V(6); PG8_BAR;
    } else {
        PG8_STAGE(PG8_SB(0, 0), cB, voffB); PG8_STAGE(PG8_SA(0, 0), cA, voffA); PG8_STAGE(PG8_SB(0, 1), cB + hstep, voffB); PG8_STAGE(PG8_SA(0, 1), cA + hstep, voffA);
        if (wr == 1) PG8_BAR;
        PG8_WAIT_V(4); PG8_BAR;
        PG8_STAGE(PG8_SB(1, 0), cB + kstep, voffB); PG8_STAGE(PG8_SA(1, 0), cA + kstep, voffA); PG8_STAGE(PG8_SB(1, 1), cB + hstep + kstep, voffB);
        PG8_WAIT_V(6); PG8_BAR;
    }
    for (;;) {
        const bool has_next = S.next(ui + 1, nxt);
        const char* nA = has_next ? (const char*)g.A + (size_t)nxt.pm * tstep : cA; const char* nB = has_next ? (const char*)g.Bt + (size_t)nxt.pn * tstep : cB;
        for (int t = 0; t < nt; t += 2) {
            const bool last = (t == nt - 2);
            const char* a1 = cA + (size_t)(t + 1) * kstep;
            const char* a2 = last ? nA : cA + (size_t)(t + 2) * kstep; const char* b2 = last ? nB : cB + (size_t)(t + 2) * kstep;
            const char* a3 = a2 + kstep; const char* b3 = b2 + kstep;
            if (last && has_next) S.a_ready(nxt);
            if constexpr (SP2) {
            PG8_LDB(B0, 0, 0); PG8_LDB(B1, 0, 1); PG8_SCHED; PG8_LDA(At, 0, 0); PG8_STAGE(PG8_SA(1, 1), a1 + hstep, voffA);
            PG8_WAIT_V(8); PG8_WAIT_L(0); PG8_BAR; PG8_MMA(0, 0, At, B0); PG8_MMA(0, 1, At, B1); PG8_BAR; PG8_SCHED;
            PG8_LDA(At, 0, 1); PG8_STAGE(PG8_SB(0, 0), b2, voffB); PG8_STAGE(PG8_SB(0, 1), b2 + hstep, voffB); PG8_STAGE(PG8_SA(0, 0), a2, voffA);
            PG8_WAIT_V(8); PG8_WAIT_L(0); PG8_BAR; PG8_MMA(1, 0, At, B0); PG8_MMA(1, 1, At, B1); PG8_BAR; PG8_SCHED;
            PG8_LDB(B0, 1, 0); PG8_LDB(B1, 1, 1); PG8_SCHED; PG8_LDA(At, 1, 0); PG8_STAGE(PG8_SA(0, 1), a2 + hstep, voffA);
            PG8_WAIT_V(8); PG8_WAIT_L(0); PG8_BAR; PG8_MMA(0, 0, At, B0); PG8_MMA(0, 1, At, B1); PG8_BAR; PG8_SCHED;
            PG8_LDA(At, 1, 1); PG8_STAGE(PG8_SB(1, 0), b3, voffB); PG8_STAGE(PG8_SB(1, 1), b3 + hstep, voffB); PG8_STAGE(PG8_SA(1, 0), a3, voffA);
            PG8_WAIT_V(8); PG8_WAIT_L(0); PG8_BAR; PG8_MMA(1, 0, At, B0); PG8_MMA(1, 1, At, B1); PG8_BAR; PG8_SCHED;
            } else {
            PG8_LDB(B0, 0, 0); PG8_SCHED; PG8_LDA(At, 0, 0); PG8_STAGE(PG8_SA(1, 1), a1 + hstep, voffA);
            PG8_WAIT_L(8); PG8_BAR; PG8_WAIT_L(0); PG8_MMA(0, 0, At, B0); PG8_BAR; PG8_SCHED;
            PG8_LDB(B1, 0, 1); PG8_STAGE(PG8_SB(0, 0), b2, voffB);
            PG8_BAR; PG8_WAIT_L(0); PG8_MMA(0, 1, At, B1); PG8_BAR;
            PG8_LDA(At, 0, 1); PG8_STAGE(PG8_SA(0, 0), a2, voffA);
            PG8_BAR; PG8_WAIT_L(0); PG8_MMA(1, 0, At, B0); PG8_BAR; PG8_SCHED;
            PG8_STAGE(PG8_SB(0, 1), b2 + hstep, voffB);
            PG8_WAIT_V(6); PG8_BAR; PG8_MMA(1, 1, At, B1); PG8_BAR;
            PG8_LDB(B0, 1, 0); PG8_SCHED; PG8_LDA(At, 1, 0); PG8_STAGE(PG8_SA(0, 1), a2 + hstep, voffA);
            PG8_WAIT_L(8); PG8_BAR; PG8_WAIT_L(0); PG8_MMA(0, 0, At, B0); PG8_BAR; PG8_SCHED;
            PG8_LDB(B1, 1, 1); PG8_STAGE(PG8_SB(1, 0), b3, voffB);
            PG8_BAR; PG8_WAIT_L(0); PG8_MMA(0, 1, At, B1); PG8_BAR;
            PG8_LDA(At, 1, 1); PG8_STAGE(PG8_SA(1, 0), a3, voffA);
            PG8_BAR; PG8_WAIT_L(0); PG8_MMA(1, 0, At, B0); PG8_BAR; PG8_SCHED;
            PG8_STAGE(PG8_SB(1, 1), b3 + hstep, voffB);
            PG8_WAIT_V(6); PG8_BAR; PG8_MMA(1, 1, At, B1); PG8_BAR;
            }
        }
        if constexpr (ALIGN_EPI) { if (wr == 0) PG8_BAR; }
        if constexpr (!Epi::AFTER_DRAIN) { E(acc, cur, wr, wc, fr, fq); S.done(cur); }
        if (!has_next) break;
#pragma unroll
        for (int a = 0; a < 2; ++a)
#pragma unroll
            for (int b = 0; b < 2; ++b)
#pragma unroll
                for (int m = 0; m < 4; ++m)
#pragma unroll
                    for (int n = 0; n < 2; ++n) acc[a][b][m][n] = (f32x4){0.f, 0.f, 0.f, 0.f};
        cur = nxt; cA = nA; cB = nB; ++ui;
        if constexpr (ALIGN_EPI) { if (wr == 1) PG8_BAR; }
    }
    PG8_WAIT_V(0);
    if constexpr (!ALIGN_EPI) { if (wr == 0) PG8_BAR; }
    PG8_BAR;
    if constexpr (Epi::AFTER_DRAIN) { E.fused(acc, cur, wr, wc, fr, fq, lds, wid, lane); S.done(cur); }
#undef PG8_SA
#undef PG8_SB
#undef PG8_STAGE
#undef PG8_LDA
#undef PG8_LDB
#undef PG8_MMA
#undef PG8_WAIT_V
#undef PG8_WAIT_L
#undef PG8_BAR
#undef PG8_SCHED
}
}

#ifndef PG8_SP2
#define PG8_SP2 true
#endif
#ifndef PG8_ALIGN
#define PG8_ALIGN true
#endif
#include <hip/hip_bf16.h>
#include <cmath>
namespace attn_body {
using bf16=__hip_bfloat16;
using bf16x8=__attribute__((ext_vector_type(8)))short;
using s16x4=__attribute__((ext_vector_type(4)))short;
using f32x16=__attribute__((ext_vector_type(16)))float;
using u32x4=__attribute__((ext_vector_type(4)))unsigned;
using f32x4=__attribute__((ext_vector_type(4)))float;
#define LASF __attribute__((address_space(3)))
constexpr int BATCH=8,NHEAD=16,SEQ=2048,D=64,DM=NHEAD*D;
constexpr int NW=8,QBLK=32,QB=QBLK*NW,KVBLK=64,NQB=SEQ/QB;
constexpr int ATTN_PITCH=DM, ATTN_UNIT_ROWS=QB;
__device__ __forceinline__ int crow(int r,int hi){return (r&3)+8*(r>>2)+4*hi;}
#define SBAR() __builtin_amdgcn_sched_barrier(0)
__device__ __forceinline__ void cmask(f32x16&p0,f32x16&p1,int jb,int qrel,int hi){
  const float NEG=-INFINITY; int kb=64*jb+4*hi;
  #pragma unroll
  for(int r=0;r<16;++r){int kv=kb+(r&3)+8*(r>>2); if(kv>qrel)p0[r]=NEG; if(kv+32>qrel)p1[r]=NEG;}
}

constexpr int NSLOT=3, SLOTB=8192;
constexpr int LDS_K=0, LDS_V=NSLOT*SLOTB, LDS_WS=2*NSLOT*SLOTB, LDS_OST=LDS_WS+NW*64*4, LDS_BYTES=LDS_OST+NW*4096;
constexpr float C2=0.125f*1.4426950408889634f;
__device__ __forceinline__ void glds16(const void*gsrc,unsigned lds_dst){unsigned keep;
  asm volatile("s_mov_b32 %0, m0\n\ts_mov_b32 m0, %2\n\ts_nop 0\n\tglobal_load_lds_dwordx4 %1, off\n\ts_mov_b32 m0, %0":"=&s"(keep):"v"(gsrc),"s"(lds_dst):"memory");}
__device__ __forceinline__ float max3f(float a,float b,float c){float r;asm("v_max3_f32 %0, %1, %2, %3":"=v"(r):"v"(a),"v"(b),"v"(c));return r;}
__device__ __forceinline__ float max2f(float a,float b){float r;asm("v_max_f32_e32 %0, %1, %2":"=v"(r):"v"(a),"v"(b));return r;}
__device__ __forceinline__ float fadd_s(float a,float b){float r;asm("v_add_f32_e32 %0, %1, %2":"=v"(r):"v"(a),"v"(b));return r;}
__device__ __forceinline__ float fsub_s(float a,float b){float r;asm("v_sub_f32_e32 %0, %1, %2":"=v"(r):"v"(a),"v"(b));return r;}
typedef float f32x2_t __attribute__((ext_vector_type(2))); typedef __bf16 bf16x2_t __attribute__((ext_vector_type(2)));
__device__ __forceinline__ unsigned cvtpk_s(float lo,float hi){f32x2_t v={lo,hi};bf16x2_t b=__builtin_convertvector(v,bf16x2_t);return __builtin_bit_cast(unsigned,b);}
#define WAIT_BAR(N) asm volatile("s_waitcnt vmcnt(" #N ") lgkmcnt(0)\n\ts_barrier":::"memory")

__device__ __forceinline__ void qkt(f32x16&p0,f32x16&p1,const char*Kslot,const bf16x8*qr,int r32,int hi){
  const char*kb=Kslot+hi*1024+r32*16;
  #pragma unroll
  for(int d0=0;d0<4;++d0){
    const bf16x8 b0=*reinterpret_cast<const bf16x8*>(kb+d0*2048);
    const bf16x8 b1=*reinterpret_cast<const bf16x8*>(kb+d0*2048+512);
    p0=__builtin_amdgcn_mfma_f32_32x32x16_bf16(b0,qr[d0],p0,0,0,0);p1=__builtin_amdgcn_mfma_f32_32x32x16_bf16(b1,qr[d0],p1,0,0,0);}
}
typedef __attribute__((address_space(3))) const char* lds_cptr;
typedef short v4i16_t __attribute__((ext_vector_type(4)));
__device__ __forceinline__ void kload8(bf16x8*kf,lds_cptr kp){
  kf[0]=*(const __attribute__((address_space(3))) bf16x8*)(kp);      kf[1]=*(const __attribute__((address_space(3))) bf16x8*)(kp+512);
  kf[2]=*(const __attribute__((address_space(3))) bf16x8*)(kp+2048); kf[3]=*(const __attribute__((address_space(3))) bf16x8*)(kp+2560);
  kf[4]=*(const __attribute__((address_space(3))) bf16x8*)(kp+4096); kf[5]=*(const __attribute__((address_space(3))) bf16x8*)(kp+4608);
  kf[6]=*(const __attribute__((address_space(3))) bf16x8*)(kp+6144); kf[7]=*(const __attribute__((address_space(3))) bf16x8*)(kp+6656);
}
__device__ __forceinline__ void kload2(bf16x8*kf,lds_cptr kp,int j){ kf[2*j]=*(const __attribute__((address_space(3))) bf16x8*)(kp+j*2048); kf[2*j+1]=*(const __attribute__((address_space(3))) bf16x8*)(kp+j*2048+512); }
__device__ __forceinline__ s16x4 vtr(lds_cptr p){ return __builtin_bit_cast(s16x4,__builtin_amdgcn_ds_read_tr16_b64_v4i16((__attribute__((address_space(3))) v4i16_t*)p)); }
__device__ __forceinline__ float rowmax(const f32x16&p0,const f32x16&p1){
  float a=max3f(p0[0],p0[1],p1[0]),b=max3f(p0[2],p0[3],p1[1]);a=max3f(a,p1[2],p1[3]);
  #pragma unroll
  for(int r=4;r<16;r+=4){a=max3f(a,p0[r],p0[r+1]);b=max3f(b,p0[r+2],p0[r+3]);a=max3f(a,p1[r],p1[r+1]);b=max3f(b,p1[r+2],p1[r+3]);}
  const float m=max2f(a,b);
  auto rr=__builtin_amdgcn_permlane32_swap(__float_as_uint(m),__float_as_uint(m),false,false);
  return max2f(__uint_as_float(rr[0]),__uint_as_float(rr[1]));
}
__device__ __forceinline__ void pv(f32x16*o,int vb,bf16x8 pa0,bf16x8 pa1,bf16x8 pa2,bf16x8 pa3){
  #pragma unroll
  for(int d0=0;d0<2;++d0){s16x4 lo[4],hi[4];
    #pragma unroll
    for(int ks=0;ks<4;++ks){
      asm volatile("ds_read_b64_tr_b16 %0,%1 offset:%c2":"=&v"(lo[ks]):"v"(vb),"i"(d0*4096+ks*1024):"memory");
      asm volatile("ds_read_b64_tr_b16 %0,%1 offset:%c2":"=&v"(hi[ks]):"v"(vb),"i"(d0*4096+ks*1024+512):"memory");}
    asm volatile("s_waitcnt lgkmcnt(0)":::"memory");SBAR();
    #define PK(k) (bf16x8){lo[k][0],lo[k][1],lo[k][2],lo[k][3],hi[k][0],hi[k][1],hi[k][2],hi[k][3]}
    o[d0]=__builtin_amdgcn_mfma_f32_32x32x16_bf16(pa0,PK(0),o[d0],0,0,0);
    o[d0]=__builtin_amdgcn_mfma_f32_32x32x16_bf16(pa1,PK(1),o[d0],0,0,0);
    o[d0]=__builtin_amdgcn_mfma_f32_32x32x16_bf16(pa2,PK(2),o[d0],0,0,0);
    o[d0]=__builtin_amdgcn_mfma_f32_32x32x16_bf16(pa3,PK(3),o[d0],0,0,0);
    #undef PK
  }
}


struct MergeCtx { const unsigned short* GA; const unsigned short* G2; const unsigned short* U; const float* cw; const float* st; unsigned short* out; };
__device__ __forceinline__ float mbflo(unsigned w){return __builtin_bit_cast(float,w<<16);}
__device__ __forceinline__ float mbfhi(unsigned w){return __builtin_bit_cast(float,w&0xffff0000u);}
__device__ __forceinline__ void munpack8(u32x4 w,float*f){f[0]=mbflo(w.x);f[1]=mbfhi(w.x);f[2]=mbflo(w.y);f[3]=mbfhi(w.y);f[4]=mbflo(w.z);f[5]=mbfhi(w.z);f[6]=mbflo(w.w);f[7]=mbfhi(w.w);}
__device__ __forceinline__ void merge_store8(const MergeCtx&c,size_t grow,int t,bool prm,int bb,int col,u32x4 ov){
  const size_t off=grow*1024+col; float ga[8],o[8],g2[8],u0[8],u1[8],u2[8];
  munpack8(*(const u32x4*)(c.GA+off),ga); munpack8(ov,o); munpack8(*(const u32x4*)(c.G2+off),g2); munpack8(*(const u32x4*)(c.U+off),u2);
  if(t>=1)munpack8(*(const u32x4*)(c.U+off-1024),u1);
  else if(prm){_Pragma("unroll") for(int e=0;e<8;++e)u1[e]=0.f;} else {const float*p=c.st+(size_t)(bb*2+1)*1024+col; _Pragma("unroll") for(int e=0;e<8;++e)u1[e]=p[e];}
  if(t>=2)munpack8(*(const u32x4*)(c.U+off-2048),u0);
  else if(prm){_Pragma("unroll") for(int e=0;e<8;++e)u0[e]=0.f;} else {const float*p=c.st+(size_t)(bb*2+t)*1024+col; _Pragma("unroll") for(int e=0;e<8;++e)u0[e]=p[e];}
  float r[8];
  _Pragma("unroll") for(int e=0;e<8;++e){const float cy=c.cw[col+e]*u0[e]+c.cw[1024+col+e]*u1[e]+c.cw[2048+col+e]*u2[e]; r[e]=ga[e]*o[e]+g2[e]*cy;}
  u32x4 w; w.x=cvtpk_s(r[0],r[1]); w.y=cvtpk_s(r[2],r[3]); w.z=cvtpk_s(r[4],r[5]); w.w=cvtpk_s(r[6],r[7]);
  *(u32x4*)(c.out+off)=w;
}
#ifndef ATTN_STORE16
#define ATTN_STORE16(p,v) (*(u32x4*)(p)=(v))
#endif
template<int THRL> __device__ __forceinline__ void attn_unit(int b,int h,int qb,const bf16*Q,const bf16*__restrict__ K,const bf16*__restrict__ V,const MergeCtx&mc,char*shm,const LASF float*fb){
  int tid_=threadIdx.x; asm volatile("":"+v"(tid_));
  const int tid=tid_,lane=tid&63,r32=lane&31,hi=lane>>5; const int wid=__builtin_amdgcn_readfirstlane(tid>>6);
  const long rowbase=(long)b*SEQ; const int q0=qb*QB;
  const bf16*Qw=Q+(rowbase+q0+wid*QBLK)*DM+h*D;
  const bf16*Kh=K+rowbase*DM+h*D,*Vh=V+rowbase*DM+h*D;
  const unsigned lds0=(unsigned)(uintptr_t)shm;
  float*wsf=(float*)(shm+LDS_WS)+wid*64;
  const bf16*ksrc=Kh+(long)lane*DM+wid*8;
  const bf16*vsrc=Vh+(long)(16*(wid&3)+(lane>>2))*DM+(wid>>2)*32+(lane&3)*8;
  const unsigned kdst=lds0+LDS_K+wid*1024, vdst=lds0+LDS_V+wid*1024;
  #define DMA_K(t,slot) glds16(ksrc+(long)(t)*KVBLK*DM,(unsigned)__builtin_amdgcn_readfirstlane(kdst+(slot)))
  #define DMA_V(t,slot) glds16(vsrc+(long)(t)*KVBLK*DM,(unsigned)__builtin_amdgcn_readfirstlane(vdst+(slot)))
  const int vb0=(int)(lds0+LDS_V)+((lane>>4)&1)*32+(lane&3)*8+(4*hi+((lane&15)>>2))*64;
  const char*Kbase=shm+LDS_K; bf16x8 kf[8];
  const lds_cptr shm3=(lds_cptr)shm; const lds_cptr kp0=shm3+LDS_K+hi*1024+r32*16; const lds_cptr vp0=shm3+LDS_V+((lane>>4)&1)*32+(lane&3)*8+(4*hi+((lane&15)>>2))*64;
  const int NT=(q0+QB)/KVBLK;
  DMA_K(0,0);DMA_V(0,0);DMA_K(1,SLOTB);
  bf16x8 qr[4];
  #pragma unroll
  for(int d0=0;d0<4;++d0)qr[d0]=*reinterpret_cast<const bf16x8*>(&Qw[(long)r32*DM+d0*16+hi*8]);
  float mhat=fb[q0+wid*QBLK+r32],l_reg=0.f;f32x16 o[2];o[0]=f32x16{};o[1]=f32x16{};
  #define FBINIT(C0,C1,t) do{ const LASF float*fp_=fb+64*(t)+4*hi; \
    _Pragma("unroll") for(int i_=0;i_<4;++i_){ const f32x4 a_=*(const LASF f32x4*)(fp_+8*i_),b_=*(const LASF f32x4*)(fp_+32+8*i_); \
      C0[4*i_]=a_[0]-mhat;C0[4*i_+1]=a_[1]-mhat;C0[4*i_+2]=a_[2]-mhat;C0[4*i_+3]=a_[3]-mhat; \
      C1[4*i_]=b_[0]-mhat;C1[4*i_+1]=b_[1]-mhat;C1[4*i_+2]=b_[2]-mhat;C1[4*i_+3]=b_[3]-mhat; } }while(0)
  #define FBLOAD(P0,P1,tn) do{ const LASF float*fp_=fb+64*(tn)+4*hi; \
    _Pragma("unroll") for(int i_=0;i_<4;++i_){ const f32x4 a_=*(const LASF f32x4*)(fp_+8*i_),b_=*(const LASF f32x4*)(fp_+32+8*i_); \
      P0[4*i_]=a_[0];P0[4*i_+1]=a_[1];P0[4*i_+2]=a_[2];P0[4*i_+3]=a_[3]; P1[4*i_]=b_[0];P1[4*i_+1]=b_[1];P1[4*i_+2]=b_[2];P1[4*i_+3]=b_[3]; } }while(0)
  #define FBSUB(X,B) do{ X[B]-=mhat; X[B+1]-=mhat; X[B+2]-=mhat; X[B+3]-=mhat; }while(0)
  const int qrel=wid*QBLK+r32;
  #define CMASK(P0,P1,t) do{int jb_=(t)-(NT-4); if(jb_>=0)cmask(P0,P1,jb_,qrel,hi);}while(0)
  bool resc=false;
  #define START(P0,P1) do{ const float rm=rowmax(P0,P1); resc=false; \
    if(__any(rm>(float)THRL)){ const float dl=__builtin_fmaxf(rm,0.f); mhat=fadd_s(mhat,dl); \
      _Pragma("unroll") for(int r=0;r<16;++r){P0[r]=fsub_s(P0[r],dl);P1[r]=fsub_s(P1[r],dl);} } \
    _Pragma("unroll") for(int r=0;r<16;++r)P0[r]=__builtin_amdgcn_exp2f(P0[r]); }while(0)
  #define RESC() do{ if(resc){ asm volatile("s_waitcnt lgkmcnt(0)":::"memory"); \
      _Pragma("unroll") for(int d_=0;d_<2;++d_) _Pragma("unroll") for(int r=0;r<16;++r)o[d_][r]*=wsf[crow(r,hi)]; } }while(0)
  f32x16 pA0,pA1,pB0,pB1;
  int sl_prev=0,sl_cur=0,sl_next=SLOTB;
  #define ROT() do{sl_prev=sl_cur;sl_cur=sl_next;sl_next=(sl_next==(NSLOT-1)*SLOTB)?0:sl_next+SLOTB;}while(0)
  DMA_K(2,2*SLOTB);
  WAIT_BAR(3);
  FBINIT(pA0,pA1,0);
  qkt(pA0,pA1,Kbase,qr,r32,hi);asm volatile("s_nop 15\n\ts_nop 7":"+v"(pA0),"+v"(pA1));CMASK(pA0,pA1,0);
  START(pA0,pA1);
  _Pragma("unroll") for(int r=0;r<16;++r)pA1[r]=__builtin_amdgcn_exp2f(pA1[r]);
  FBINIT(pB0,pB1,1);
  WAIT_BAR(0);
  DMA_K(3,0);DMA_V(1,SLOTB);
  ROT();
  kload8(kf,kp0+sl_cur);
  WAIT_BAR(2);
  s16x4 vlo[8],vhi[8]; u32x4 pw0,pw1,pw2,pw3;
  #define PKW(P,B) cvtpk_s(P[B],P[B+1])
  #define PAF(k) __builtin_bit_cast(bf16x8,pw##k)
  #define VFR(i) (bf16x8){vlo[i][0],vlo[i][1],vlo[i][2],vlo[i][3],vhi[i][0],vhi[i][1],vhi[i][2],vhi[i][3]}
  #define PIN(x) asm volatile("":"+v"(x))
  #define MX3(a,b,c) __builtin_fmaxf(__builtin_fmaxf((a),(b)),(c))
  #define GAPA(MF,A0,A1,A2,A3,W0,W1,PW) do{ MF; sacc+=A0; sacc+=A1; sacc+=A2; sacc+=A3; PIN(sacc); W0; W1; PIN(PW); SBAR(); }while(0)
  #define EX(v) __builtin_amdgcn_exp2f(v)
  #define GAPB(MF,X,B,Y,YB) do{ MF; X[B]=EX(X[B]); X[B+1]=EX(X[B+1]); X[B+2]=EX(X[B+2]); X[B+3]=EX(X[B+3]); PIN(X); FBSUB(Y,YB); PIN(Y); SBAR(); }while(0)
  #define VRD(i) do{ vlo[i]=vtr(vp_+(((i)>>2)*4096+((i)&3)*1024)); vhi[i]=vtr(vp_+(((i)>>2)*4096+((i)&3)*1024+512)); }while(0)
  #define KRD(G,j) do{ if(G){ kload2(kf,kp0+sl_next,j); SBAR(); } }while(0)
  #define STEP(C0,C1,P0,P1,t,GK,GV,GL) do{ SBAR(); \
    const lds_cptr vp_=vp0+sl_prev; \
    VRD(0); SBAR(); float sacc=(P0[0]+P0[1]); \
    GAPA(C0=__builtin_amdgcn_mfma_f32_32x32x16_bf16(kf[0],qr[0],C0,0,0,0), P0[2],P0[3],P0[4],P0[5],     pw0[0]=PKW(P0,0), pw0[1]=PKW(P0,2), pw0); \
    VRD(4); SBAR(); GAPA(C1=__builtin_amdgcn_mfma_f32_32x32x16_bf16(kf[1],qr[0],C1,0,0,0), P0[6],P0[7],P0[8],P0[9],     pw0[2]=PKW(P0,4), pw0[3]=PKW(P0,6), pw0); \
    VRD(1); SBAR(); GAPA(C0=__builtin_amdgcn_mfma_f32_32x32x16_bf16(kf[2],qr[1],C0,0,0,0),   P0[10],P0[11],P0[12],P0[13], pw1[0]=PKW(P0,8), pw1[1]=PKW(P0,10), pw1); \
    VRD(5); SBAR(); GAPA(C1=__builtin_amdgcn_mfma_f32_32x32x16_bf16(kf[3],qr[1],C1,0,0,0),   P0[14],P0[15],P1[0],P1[1],   pw1[2]=PKW(P0,12),pw1[3]=PKW(P0,14), pw1); \
    VRD(2); SBAR(); GAPA(C0=__builtin_amdgcn_mfma_f32_32x32x16_bf16(kf[4],qr[2],C0,0,0,0),   P1[2],P1[3],P1[4],P1[5],     pw2[0]=PKW(P1,0), pw2[1]=PKW(P1,2), pw2); \
    VRD(6); SBAR(); GAPA(C1=__builtin_amdgcn_mfma_f32_32x32x16_bf16(kf[5],qr[2],C1,0,0,0),   P1[6],P1[7],P1[8],P1[9],     pw2[2]=PKW(P1,4), pw2[3]=PKW(P1,6), pw2); \
    VRD(3); SBAR(); GAPA(C0=__builtin_amdgcn_mfma_f32_32x32x16_bf16(kf[6],qr[3],C0,0,0,0),   P1[10],P1[11],P1[12],P1[13], pw3[0]=PKW(P1,8), pw3[1]=PKW(P1,10), pw3); \
    VRD(7); SBAR(); GAPA(C1=__builtin_amdgcn_mfma_f32_32x32x16_bf16(kf[7],qr[3],C1,0,0,0),   P1[14],P1[15],0.f,0.f,       pw3[2]=PKW(P1,12),pw3[3]=PKW(P1,14), pw3); \
    l_reg+=sacc; \
    if(GK){DMA_K((t)+3,sl_cur);} if(GV){DMA_V((t)+1,sl_next);} \
    CMASK(C0,C1,t); \
    { float a=MX3(C0[0],C0[1],C1[0]),b=MX3(C0[2],C0[3],C1[1]); a=MX3(a,C1[2],C1[3]); \
      _Pragma("unroll") for(int r=4;r<16;r+=4){a=MX3(a,C0[r],C0[r+1]);b=MX3(b,C0[r+2],C0[r+3]);a=MX3(a,C1[r],C1[r+1]);b=MX3(b,C1[r+2],C1[r+3]);} \
      float rm=__builtin_fmaxf(a,b); { auto rr=__builtin_amdgcn_permlane32_swap(__float_as_uint(rm),__float_as_uint(rm),false,false); rm=__builtin_fmaxf(__uint_as_float(rr[0]),__uint_as_float(rr[1])); } \
      resc=false; \
      if(__builtin_expect(__any(rm>(float)THRL),0)){ const float dl=__builtin_fmaxf(rm,0.f); mhat+=dl; \
        _Pragma("unroll") for(int r=0;r<16;++r){C0[r]-=dl;C1[r]-=dl;} \
        const float f=__builtin_amdgcn_exp2f(-dl); l_reg*=f; if(hi==0)wsf[r32]=f; resc=true; } } \
    SBAR(); FBLOAD(P0,P1,(t)+1); SBAR(); \
    GAPB(o[0]=__builtin_amdgcn_mfma_f32_32x32x16_bf16(PAF(0),VFR(0),o[0],0,0,0), C0,0, P0,0); \
    GAPB(o[1]=__builtin_amdgcn_mfma_f32_32x32x16_bf16(PAF(0),VFR(4),o[1],0,0,0), C0,4, P0,4); \
    KRD(GL,0); GAPB(o[0]=__builtin_amdgcn_mfma_f32_32x32x16_bf16(PAF(1),VFR(1),o[0],0,0,0), C0,8, P0,8); \
    KRD(GL,1); GAPB(o[1]=__builtin_amdgcn_mfma_f32_32x32x16_bf16(PAF(1),VFR(5),o[1],0,0,0), C0,12, P0,12); \
    KRD(GL,2); GAPB(o[0]=__builtin_amdgcn_mfma_f32_32x32x16_bf16(PAF(2),VFR(2),o[0],0,0,0), C1,0, P1,0); \
    KRD(GL,3); GAPB(o[1]=__builtin_amdgcn_mfma_f32_32x32x16_bf16(PAF(2),VFR(6),o[1],0,0,0), C1,4, P1,4); \
    GAPB(o[0]=__builtin_amdgcn_mfma_f32_32x32x16_bf16(PAF(3),VFR(3),o[0],0,0,0), C1,8, P1,8); \
    GAPB(o[1]=__builtin_amdgcn_mfma_f32_32x32x16_bf16(PAF(3),VFR(7),o[1],0,0,0), C1,12, P1,12); \
    }while(0)
  int t=1;
  #undef CMASK
  #define CMASK(P0,P1,t) do{}while(0)
  for(;t+5<NT;t+=2){
    STEP(pB0,pB1,pA0,pA1,t,true,true,true);     WAIT_BAR(2); RESC(); ROT();
    STEP(pA0,pA1,pB0,pB1,t+1,true,true,true);   WAIT_BAR(2); RESC(); ROT();
  }
  #undef CMASK
  #define CMASK(P0,P1,t) do{int jb_=(t)-(NT-4); if(jb_>=0)cmask(P0,P1,jb_,qrel,hi);}while(0)
  #define ENDW(tt) do{ if((tt)+3<NT){WAIT_BAR(2);} else if((tt)+2<NT){WAIT_BAR(1);} else {WAIT_BAR(0);} }while(0)
  for(;t+1<NT;t+=2){
    STEP(pB0,pB1,pA0,pA1,t,(t+3<NT),(t+1<NT),(t+1<NT));       ENDW(t);   RESC(); ROT();
    STEP(pA0,pA1,pB0,pB1,t+1,(t+4<NT),(t+2<NT),(t+2<NT));     ENDW(t+1); RESC(); ROT();
  }
  STEP(pB0,pB1,pA0,pA1,NT-1,false,false,false); RESC();
  u32x4 mg[4][5]; f32x4 mcw[3][2];
  { const int mcol=h*D+(lane&7)*8;
    _Pragma("unroll") for(int j=0;j<3;++j){ mcw[j][0]=*(const f32x4*)(mc.cw+j*1024+mcol); mcw[j][1]=*(const f32x4*)(mc.cw+j*1024+mcol+4); }
    _Pragma("unroll") for(int i=0;i<4;++i){ const int t_=q0+wid*QBLK+i*8+(lane>>3); const size_t off=(size_t)(rowbase+t_)*1024+mcol;
      mg[i][0]=__builtin_nontemporal_load((const u32x4*)(mc.GA+off)); mg[i][1]=__builtin_nontemporal_load((const u32x4*)(mc.G2+off)); mg[i][2]=*(const u32x4*)(mc.U+off);
      mg[i][3]=(t_>=1)?*(const u32x4*)(mc.U+off-1024):(u32x4){0u,0u,0u,0u}; mg[i][4]=(t_>=2)?*(const u32x4*)(mc.U+off-2048):(u32x4){0u,0u,0u,0u}; } }
  { float sacc=pB0[0]+pB0[1]; _Pragma("unroll") for(int r=2;r<16;++r)sacc+=pB0[r]; _Pragma("unroll") for(int r=0;r<16;++r)sacc+=pB1[r]; l_reg+=sacc;
    pw0=(u32x4){PKW(pB0,0),PKW(pB0,2),PKW(pB0,4),PKW(pB0,6)};pw1=(u32x4){PKW(pB0,8),PKW(pB0,10),PKW(pB0,12),PKW(pB0,14)};pw2=(u32x4){PKW(pB1,0),PKW(pB1,2),PKW(pB1,4),PKW(pB1,6)};pw3=(u32x4){PKW(pB1,8),PKW(pB1,10),PKW(pB1,12),PKW(pB1,14)};
    SBAR(); pv(o,vb0+sl_cur,PAF(0),PAF(1),PAF(2),PAF(3)); }
  #undef PKW
  #undef PAF
  #undef VFR
  #undef PIN
  #undef MX3
  #undef GAPA
  #undef GAPB
  #undef EX
  #undef VRD
  #undef KRD
  #undef STEP
  #undef ENDW
  {auto rr=__builtin_amdgcn_permlane32_swap(__float_as_uint(l_reg),__float_as_uint(l_reg),false,false);l_reg=__uint_as_float(rr[0])+__uint_as_float(rr[1]);}
  if(hi==0)wsf[32+r32]=l_reg;asm volatile("s_waitcnt lgkmcnt(0)":::"memory");
  float rli[16];
  #pragma unroll
  for(int r=0;r<16;++r)rli[r]=__builtin_amdgcn_rcpf(wsf[32+crow(r,hi)]);
  { bf16*stg=(bf16*)(shm+LDS_OST)+wid*2048;
    #pragma unroll
    for(int r=0;r<16;++r){const int orow=crow(r,hi);
      #pragma unroll
      for(int d0=0;d0<2;++d0)stg[orow*64+d0*32+r32]=__float2bfloat16(o[d0][r]*rli[r]);}
    asm volatile("s_waitcnt lgkmcnt(0)":::"memory");
    #pragma unroll
    for(int i=0;i<4;++i){const int row=i*8+(lane>>3),ch=lane&7; const u32x4 v=*(const u32x4*)(stg+row*64+ch*8); const int t_=q0+wid*QBLK+row;
      float ga[8],ov[8],g2[8],u2[8],u1[8],u0[8],r[8]; munpack8(mg[i][0],ga); munpack8(v,ov); munpack8(mg[i][1],g2); munpack8(mg[i][2],u2); munpack8(mg[i][3],u1); munpack8(mg[i][4],u0);
      _Pragma("unroll") for(int e=0;e<8;++e){ const float cy=mcw[0][e>>2][e&3]*u0[e]+mcw[1][e>>2][e&3]*u1[e]+mcw[2][e>>2][e&3]*u2[e]; r[e]=ga[e]*ov[e]+g2[e]*cy; }
      u32x4 w; w.x=cvtpk_s(r[0],r[1]); w.y=cvtpk_s(r[2],r[3]); w.z=cvtpk_s(r[4],r[5]); w.w=cvtpk_s(r[6],r[7]);
      *(u32x4*)(mc.out+(size_t)(rowbase+t_)*1024+h*D+ch*8)=w; } }
  asm volatile("s_waitcnt lgkmcnt(0)\n\ts_barrier":::"memory");
  #undef DMA_K
  #undef DMA_V
  #undef CMASK
  #undef START
  #undef RESC
  #undef ROT
  #undef FBINIT
  #undef FBLOAD
  #undef FBSUB
}
constexpr int ATTN_LDS_BYTES=LDS_BYTES;
#undef SBAR
#undef WAIT_BAR
}

#define XB_TMO      128
#define XB_XCNT(j)  (256  + 64 * (j))
#define XB_XSUB(j)  (1280 + 64 * (j))
#define XB_XGEN(j)  (2304 + 64 * (j))
#define XB_TOP      3328
#define XB_TOPGEN   3392
#define XCD_BAR_WORDS 3456
#define XB_SPIN_CAP (1u << 18)

__device__ __forceinline__ unsigned xb_ld(unsigned* p)              { return __hip_atomic_load(p, __ATOMIC_RELAXED, __HIP_MEMORY_SCOPE_AGENT); }
__device__ __forceinline__ unsigned xb_add(unsigned* p, unsigned v) { return __hip_atomic_fetch_add(p, v, __ATOMIC_RELAXED, __HIP_MEMORY_SCOPE_AGENT); }
__device__ __forceinline__ unsigned xb_xcc_id() { return (unsigned)__builtin_amdgcn_s_getreg((3 << 11) | 20) & 0xFu; }
#define XB_SPIN(cond, bar) do { unsigned _sp = 0; while (cond) { __builtin_amdgcn_s_sleep(1); \
    if ((++_sp & 255u) == 0u) { if (xb_ld(&(bar)[XB_TMO])) break; if (_sp > XB_SPIN_CAP) { atomicAdd(&(bar)[XB_TMO], 1u); break; } } } } while (0)

struct XcdBarrier {
    unsigned* bar; unsigned x;
    volatile __attribute__((address_space(3))) unsigned* st;
};

__device__ __forceinline__ XcdBarrier xcd_barrier_post(unsigned* bar, volatile __attribute__((address_space(3))) unsigned* st) {
    XcdBarrier b; b.bar = bar; b.x = xb_xcc_id(); b.st = st;
    if (threadIdx.x == 0) (void)xb_add(&bar[XB_XCNT(b.x)], 1u);
    return b;
}
__device__ __forceinline__ void xcd_barrier_complete(unsigned* bar, unsigned x, unsigned& nloc, unsigned& nx) {
    const unsigned G = gridDim.x * gridDim.y * gridDim.z;
    unsigned sum, cnt, mine, sp = 0u;
    for (;;) {
        sum = 0u; cnt = 0u; mine = 0u;
#pragma unroll
        for (unsigned j = 0; j < 16; ++j) { const unsigned c = xb_ld(&bar[XB_XCNT(j)]); sum += c; cnt += (c > 0u) ? 1u : 0u; mine = (j == x) ? c : mine; }
        if (sum == G) break;
        __builtin_amdgcn_s_sleep(1);
        if ((++sp & 255u) == 0u) { if (xb_ld(&bar[XB_TMO])) break; if (sp > XB_SPIN_CAP) { atomicAdd(&bar[XB_TMO], 1u); break; } }
    }
    nloc = mine > 0u ? mine : 1u; nx = cnt > 0u ? cnt : 1u;
}

__device__ __forceinline__ void xcd_barrier(const XcdBarrier& b) {
    asm volatile("s_waitcnt vmcnt(0)" ::: "memory");
    __syncthreads();
    if (threadIdx.x == 0) {
        unsigned* bar = b.bar;
        __builtin_amdgcn_s_waitcnt(0);
        unsigned nloc = b.st[0], nx = b.st[1];
        if (nloc == 0u) { xcd_barrier_complete(bar, b.x, nloc, nx); b.st[0] = nloc; b.st[1] = nx; }
        const unsigned old = xb_add(&bar[XB_XSUB(b.x)], 1u);
        const unsigned gen = old / nloc;
        if (old + 1u == (gen + 1u) * nloc) {
            __builtin_amdgcn_fence(__ATOMIC_RELEASE, "agent");
            asm volatile("s_waitcnt vmcnt(0)" ::: "memory");
            const unsigned og = xb_add(&bar[XB_TOP], 1u);
            const unsigned tg = og / nx;
            if (og + 1u == (tg + 1u) * nx) xb_add(&bar[XB_TOPGEN], 1u);
            else XB_SPIN(xb_ld(&bar[XB_TOPGEN]) == tg, bar);
            __builtin_amdgcn_fence(__ATOMIC_ACQUIRE, "agent");
            xb_add(&bar[XB_XGEN(b.x)], 1u);
            asm volatile("s_waitcnt vmcnt(0)" ::: "memory");
        } else {
            XB_SPIN(xb_ld(&bar[XB_XGEN(b.x)]) == gen, bar);
            __builtin_amdgcn_fence(__ATOMIC_ACQUIRE, "agent");
            asm volatile("s_waitcnt vmcnt(0)" ::: "memory");
        }
    }
    __syncthreads();
}


namespace cg = cooperative_groups;
constexpr int NWAVES = 8, NTHREADS = 512;
constexpr size_t MiB = 1u << 20;
constexpr size_t WS_CNT = 912 * 1024;
constexpr int CNT_WORDS = 3 * 80 * 16;
constexpr size_t WS_BAR = 896 * 1024;
constexpr size_t WS_MOD = 0, WS_W1IN = 1 * MiB, WS_W1OUT = 12 * MiB, WS_WIN = 18 * MiB, WS_WOUT = 35 * MiB, WS_W2IN = 37 * MiB, WS_W2OUT = 48 * MiB, WS_H = 54 * MiB,
                 WS_QB = 88 * MiB, WS_KB = 122 * MiB, WS_VB = 156 * MiB, WS_GAB = 190 * MiB, WS_G2B = 224 * MiB, WS_UB = 258 * MiB, WS_END = 292 * MiB, WS_ACT = WS_QB;
static_assert((size_t)MT * DM * 2 == 34 * MiB && WS_KB - WS_QB == 34 * MiB && WS_VB - WS_KB == 34 * MiB && WS_GAB - WS_VB == 34 * MiB && WS_G2B - WS_GAB == 34 * MiB && WS_UB - WS_G2B == 34 * MiB && WS_ACT + (size_t)MT * DFF * 2 <= WS_GAB && WS_WIN + (size_t)NINP * DM * 2 <= WS_WOUT && WS_W1IN + (size_t)2 * DFF * DM * 2 <= WS_W1OUT, "d_ws map");
constexpr int RING_OFF = 0, RING_BYTES = 131072, FB_OFF = RING_BYTES, STAT_OFF = FB_OFF + 8192, QL_OFF = STAT_OFF + 8192, LDS_BYTES = 163840;
static_assert(QL_OFF + 64 * 144 <= LDS_BYTES && 98304 + 8 * 8192 <= LDS_BYTES && LDS_BYTES <= 163840 && STAT_OFF + 8192 <= LDS_BYTES && attn_body::LDS_BYTES <= RING_BYTES, "LDS map");

#define LAS __attribute__((address_space(3)))
typedef unsigned short bf16;
typedef unsigned v4u __attribute__((ext_vector_type(4)));
typedef unsigned v2u __attribute__((ext_vector_type(2)));
typedef float f32x4 __attribute__((ext_vector_type(4)));
typedef float f32x16 __attribute__((ext_vector_type(16)));
typedef short bf16x8 __attribute__((ext_vector_type(8)));
#define LDS_WAIT() asm volatile("s_waitcnt lgkmcnt(0)" ::: "memory")
__device__ __forceinline__ unsigned f2bf(float f) { unsigned u = __builtin_bit_cast(unsigned, f); return (u + 0x7fffu + ((u >> 16) & 1u)) >> 16; }
__device__ __forceinline__ unsigned pk2(float lo, float hi) { return attn_body::cvtpk_s(lo, hi); }
__device__ __forceinline__ float bflo(unsigned w) { return __builtin_bit_cast(float, w << 16); }
__device__ __forceinline__ float bfhi(unsigned w) { return __builtin_bit_cast(float, w & 0xffff0000u); }
__device__ __forceinline__ float wave_sum(float v) {
#pragma unroll
    for (int o = 1; o < 64; o <<= 1) v += __shfl_xor(v, o);
    return v;
}

struct Args { const float* in[22]; float* out; unsigned char* ws; int ph_lo, ph_hi; };

__device__ __forceinline__ void p0_mod(const Args& a, LAS unsigned char* lds, int vcu, int G) {
    const int tid = threadIdx.x, lane = tid & 63, wid = tid >> 6, l32 = lane & 31, hi = lane >> 5;
    LAS float* scT = (LAS float*)lds;
    constexpr int SCS = 33;
    const float* w_ada = a.in[8]; const float* b_ada = a.in[9]; float* mod = (float*)(a.ws + WS_MOD);
    for (int item = vcu; item < MODLD / 64; item += G) {
#pragma unroll 8
        for (int i = tid; i < 24 * 1024; i += NTHREADS) { const int b = i >> 10, k = i & 1023;
            const float c = b < 8 ? a.in[6][b * 1024 + k] : a.in[7][(b - 8) * 1024 + k]; scT[k * SCS + b] = c * __builtin_amdgcn_rcpf(1.0f + __expf(-c)); }
        for (int i = tid; i < 8 * 1024; i += NTHREADS) scT[(i >> 3) * SCS + 24 + (i & 7)] = 0.f;
        __syncthreads();
        f32x16 acc0 = f32x16{}, acc1 = f32x16{};
        const float* wp = w_ada + (size_t)(wid * 128 + hi) * MODLD + item * 64 + l32;
        const LAS float* ap = scT + (wid * 128 + hi) * SCS + l32;
        float n0[16], n1[16];
#pragma unroll
        for (int q = 0; q < 16; ++q) { n0[q] = __builtin_nontemporal_load(wp + (size_t)(2 * q) * MODLD); n1[q] = __builtin_nontemporal_load(wp + (size_t)(2 * q) * MODLD + 32); }
#pragma unroll 1
        for (int bt = 0; bt < 4; ++bt) {
            float c0[16], c1[16];
#pragma unroll
            for (int q = 0; q < 16; ++q) { c0[q] = n0[q]; c1[q] = n1[q]; }
            if (bt < 3) {
#pragma unroll
                for (int q = 0; q < 16; ++q) { n0[q] = __builtin_nontemporal_load(wp + (size_t)(2 * (16 * (bt + 1) + q)) * MODLD); n1[q] = __builtin_nontemporal_load(wp + (size_t)(2 * (16 * (bt + 1) + q)) * MODLD + 32); }
            }
#pragma unroll
            for (int q = 0; q < 16; ++q) { const float av = ap[(2 * (16 * bt + q)) * SCS];
                acc0 = __builtin_amdgcn_mfma_f32_32x32x2f32(av, c0[q], acc0, 0, 0, 0); acc1 = __builtin_amdgcn_mfma_f32_32x32x2f32(av, c1[q], acc1, 0, 0, 0); }
        }
        __syncthreads();
        { LAS float* P = scT + wid * 2048;
#pragma unroll
          for (int r = 0; r < 16; ++r) { const int b = (r & 3) + 8 * (r >> 2) + 4 * hi; P[b * 64 + l32] = acc0[r]; P[b * 64 + 32 + l32] = acc1[r]; } }
        __syncthreads();
        for (int o = tid; o < 24 * 64; o += NTHREADS) { const int b = o >> 6, c = o & 63; float sum = b_ada[item * 64 + c];
#pragma unroll
            for (int w = 0; w < 8; ++w) sum += scT[w * 2048 + b * 64 + c];
            mod[(size_t)b * MODLD + item * 64 + c] = sum; }
        __syncthreads();
    }
}
__device__ __forceinline__ void p0_transpose_item(const float* W, int K, int N, bf16* WT, int dst_row0, int src_col0, int nvalid, int kb, LAS float* scr, int lane) {
    const int k0 = 64 * kb; const int cl = lane & 31; const bool ok = cl < nvalid;
    float tv[32];
#pragma unroll
    for (int i = 0; i < 32; ++i) { const int kk = 2 * i + (lane >> 5); tv[i] = ok ? __builtin_nontemporal_load(W + (size_t)(k0 + kk) * N + src_col0 + cl) : 0.f; }
#pragma unroll
    for (int i = 0; i < 32; ++i) { const int kk = 2 * i + (lane >> 5); scr[kk * 33 + cl] = tv[i]; }
    LDS_WAIT(); asm volatile("" ::: "memory");
    const int c = lane & 7;
#pragma unroll
    for (int j = 0; j < 4; ++j) { const int n = (lane >> 3) + 8 * j; const LAS float* s = scr + (8 * c) * 33 + n;
        v4u o; o.x = pk2(s[0 * 33], s[1 * 33]); o.y = pk2(s[2 * 33], s[3 * 33]); o.z = pk2(s[4 * 33], s[5 * 33]); o.w = pk2(s[6 * 33], s[7 * 33]);
        *(v4u*)(WT + (size_t)(dst_row0 + n) * K + k0 + 8 * c) = o; }
    LDS_WAIT(); asm volatile("" ::: "memory");
}
__device__ __forceinline__ void map_ffn_in(int db, int& src, int& nv) { const int r = db * 32, t = r >> 8, w = r & 255; src = (w < 128 ? 0 : DFF) + t * 128 + (w & 127); nv = 32; }
__device__ __forceinline__ void map_win(int db, int& src, int& nv) {
    const int r = db * 32; nv = 32;
    if (r < 3072) { src = r; return; }
    if (r < 4096) { src = OFF_GA + (r - 3072); return; }
    if (r < 6144) { const int q = r - 4096, t = q >> 8, w = q & 255; src = (w < 128 ? OFF_B : OFF_GC) + t * 128 + (w & 127); return; }
    if (r < 8192) { const int q = r - 6144, t = q >> 8, w = q & 255; src = (w < 128 ? OFF_C : OFF_X) + t * 128 + (w & 127); return; }
    src = OFF_F; nv = (r == 8192) ? 16 : 0;
}
constexpr int I_1IN = 16 * 176, I_1OUT = 44 * 32, I_WIN = 16 * 264, I_WOUT = 16 * 32, WITEMS = 2 * I_1IN + 2 * I_1OUT + I_WIN + I_WOUT;
constexpr int WCUT0 = I_1IN + I_WIN, WCUT1 = WCUT0 + I_1OUT, WCUT2 = WCUT1 + I_1IN + I_WOUT;
__device__ __forceinline__ void weight_item(const Args& a, int it, LAS float* scr, int lane) {
    int r = it; int src, nv;
    if (r < I_1IN) { map_ffn_in(r % 176, src, nv); p0_transpose_item(a.in[11], 1024, 2 * DFF, (bf16*)(a.ws + WS_W1IN), (r % 176) * 32, src, nv, r / 176, scr, lane); return; } r -= I_1IN;
    if (r < I_WIN) { map_win(r % 264, src, nv); p0_transpose_item(a.in[14], 1024, NIN, (bf16*)(a.ws + WS_WIN), (r % 264) * 32, src, nv, r / 264, scr, lane); return; } r -= I_WIN;
    if (r < I_1OUT) { p0_transpose_item(a.in[12], DFF, 1024, (bf16*)(a.ws + WS_W1OUT), (r % 32) * 32, (r % 32) * 32, 32, r / 32, scr, lane); return; } r -= I_1OUT;
    if (r < I_1IN) { map_ffn_in(r % 176, src, nv); p0_transpose_item(a.in[19], 1024, 2 * DFF, (bf16*)(a.ws + WS_W2IN), (r % 176) * 32, src, nv, r / 176, scr, lane); return; } r -= I_1IN;
    if (r < I_WOUT) { p0_transpose_item(a.in[17], 1024, 1024, (bf16*)(a.ws + WS_WOUT), (r % 32) * 32, (r % 32) * 32, 32, r / 32, scr, lane); return; } r -= I_WOUT;
    p0_transpose_item(a.in[20], DFF, 1024, (bf16*)(a.ws + WS_W2OUT), (r % 32) * 32, (r % 32) * 32, 32, r / 32, scr, lane);
}
__device__ __forceinline__ void p0_weights(const Args& a, LAS unsigned char* lds, int vcu, int G) {
    const int tid = threadIdx.x, lane = tid & 63, wid = tid >> 6;
    LAS float* scr = (LAS float*)(lds + wid * 16384);
    const int nitems = (G == 256) ? WCUT0 : WITEMS;
    constexpr int NMODWG = MODLD / 64;
    const bool skew = (G > NMODWG);
    const int nslot = skew ? NMODWG * NWAVES + (G - NMODWG) * NWAVES * 3 : G * NWAVES;
    const int slot0 = !skew ? vcu * NWAVES + wid : (vcu < NMODWG ? vcu * NWAVES + wid : NMODWG * NWAVES + ((vcu - NMODWG) * NWAVES + wid) * 3);
    const int nmine = (skew && vcu >= NMODWG) ? 3 : 1;
    for (int sl = 0; sl < nmine; ++sl)
        for (int it = slot0 + sl; it < nitems; it += nslot) weight_item(a, it, scr, lane);
}
__device__ __forceinline__ void weight_items_tail(const Args& a, LAS unsigned char* lds, int first, int last, int wk, int nwk) {
    const int tid = threadIdx.x, lane = tid & 63, wid = tid >> 6;
    LAS float* scr = (LAS float*)(lds + wid * 16384);
    for (int it = first + wk; it < last; it += nwk) weight_item(a, it, scr, lane);
}
template <bool FINAL, bool NT = false, int NR = 4> __device__ __forceinline__ void norm_rows4(int m0, const float* xP, const float* xS, const float* g, const float* mod, int sh_off, int sc_off, bf16* H, float* Y, int lane) {
    const float* x0 = m0 < MP ? xP + (size_t)m0 * DM : xS + (size_t)(m0 - MP) * DM;
    const int mb = m0 < MP ? (m0 >> 11) : 8 + ((m0 - MP) >> 6);
    f32x4 v[NR][4]; float s[NR];
#pragma unroll
    for (int r = 0; r < NR; ++r)
#pragma unroll
        for (int j = 0; j < 4; ++j) { const f32x4* p = (const f32x4*)(x0 + (size_t)r * DM) + lane + 64 * j; v[r][j] = NT ? __builtin_nontemporal_load(p) : *p; }
    f32x4 gg[4], sh[4], sc[4];
#pragma unroll
    for (int j = 0; j < 4; ++j) { gg[j] = ((const f32x4*)g + lane)[64 * j];
        if (!FINAL) { sh[j] = ((const f32x4*)(mod + (size_t)mb * MODLD + sh_off) + lane)[64 * j]; sc[j] = ((const f32x4*)(mod + (size_t)mb * MODLD + sc_off) + lane)[64 * j]; } }
#pragma unroll
    for (int r = 0; r < NR; ++r) { s[r] = 0.f;
#pragma unroll
        for (int j = 0; j < 4; ++j) s[r] += (v[r][j].x * v[r][j].x + v[r][j].y * v[r][j].y) + (v[r][j].z * v[r][j].z + v[r][j].w * v[r][j].w); }
#pragma unroll
    for (int o = 1; o < 64; o <<= 1) {
#pragma unroll
        for (int r = 0; r < NR; ++r) s[r] += __shfl_xor(s[r], o); }
#pragma unroll
    for (int r = 0; r < NR; ++r) { const float rstd = 1.0f / sqrtf(s[r] * (1.f / DM) + EPS);
        if (FINAL) { f32x4* yr = (f32x4*)(Y + (size_t)(m0 + r) * DM) + lane;
#pragma unroll
            for (int j = 0; j < 4; ++j) __builtin_nontemporal_store((v[r][j] * rstd) * gg[j], yr + 64 * j); }
        else { v2u* o8 = (v2u*)(H + (size_t)(m0 + r) * DM) + lane;
#pragma unroll
            for (int j = 0; j < 4; ++j) { const f32x4 y = (v[r][j] * rstd) * gg[j] * (sc[j] + 1.0f) + sh[j]; v2u w; w.x = pk2(y.x, y.y); w.y = pk2(y.z, y.w); o8[64 * j] = w; } } }
}
__device__ __forceinline__ void norm_mod_rows(const float* xP, const float* xS, const float* g, const float* mod, int sh_off, int sc_off, bf16* H, int vcu, int G) {
    const int tid = threadIdx.x, lane = tid & 63, wid = tid >> 6;
    const int gw = vcu * NWAVES + wid, NGW = G * NWAVES;
    for (int q = gw; q < MT / 4; q += NGW) norm_rows4<false, true>(4 * q, xP, xS, g, mod, sh_off, sc_off, H, nullptr, lane);
}
__device__ __forceinline__ void final_norm_rows(float* X, const float* g, int vcu, int G) {
    const int tid = threadIdx.x, lane = tid & 63, wid = tid >> 6;
    const int gw = vcu * NWAVES + wid, NGW = G * NWAVES;
    for (int q = gw; q < MT / 4; q += NGW) norm_rows4<true>(4 * q, X, X + (size_t)MP * DM, g, nullptr, 0, 0, nullptr, X, lane);
}
__device__ __forceinline__ void panel_handoff(unsigned* cP, unsigned* cS) {
    asm volatile("s_waitcnt vmcnt(0)" ::: "memory");
    __syncthreads();
    if (threadIdx.x == 0) {
        __builtin_amdgcn_fence(__ATOMIC_RELEASE, "agent");
        asm volatile("s_waitcnt vmcnt(0)" ::: "memory");
        __hip_atomic_fetch_add(cP, 1u, __ATOMIC_RELAXED, __HIP_MEMORY_SCOPE_AGENT);
        __hip_atomic_fetch_add(cS, 1u, __ATOMIC_RELAXED, __HIP_MEMORY_SCOPE_AGENT);
        unsigned sp = 0;
        while (__hip_atomic_load(cP, __ATOMIC_RELAXED, __HIP_MEMORY_SCOPE_AGENT) < 4u || __hip_atomic_load(cS, __ATOMIC_RELAXED, __HIP_MEMORY_SCOPE_AGENT) < 16u) { __builtin_amdgcn_s_sleep(2); if (++sp > (1u << 22)) break; }
        __builtin_amdgcn_fence(__ATOMIC_ACQUIRE, "agent");
        asm volatile("s_waitcnt vmcnt(0)" ::: "memory");
    }
    __syncthreads();
}
__device__ __forceinline__ void unpack8(v4u w, float* f) { f[0] = bflo(w.x); f[1] = bfhi(w.x); f[2] = bflo(w.y); f[3] = bfhi(w.y); f[4] = bflo(w.z); f[5] = bfhi(w.z); f[6] = bflo(w.w); f[7] = bfhi(w.w); }
__device__ __forceinline__ void merge_phase(const Args& a, int vcu, int G) {
    const bf16* GAB = (const bf16*)(a.ws + WS_GAB); const bf16* OB = (const bf16*)(a.ws + WS_QB); const bf16* G2B = (const bf16*)(a.ws + WS_G2B); const bf16* UB = (const bf16*)(a.ws + WS_UB);
    bf16* Hm = (bf16*)(a.ws + WS_H); const float* cw = a.in[16]; const float* st = a.in[5];
    const size_t total = (size_t)MT * 128, stride = (size_t)G * NTHREADS;
    for (size_t idx = (size_t)vcu * NTHREADS + threadIdx.x; idx < total; idx += stride) {
        const int row = (int)(idx >> 7), c8 = (int)(idx & 127) * 8;
        const bool prm = row < MP; const int rr = prm ? row : row - MP; const int t = prm ? (rr & 2047) : (rr & 63), bb = prm ? (rr >> 11) : (rr >> 6);
        const size_t off = (size_t)row * DM + c8;
        float ga[8], o[8], g2[8], u0[8], u1[8], u2[8];
        unpack8(*(const v4u*)(GAB + off), ga); unpack8(*(const v4u*)(OB + off), o); unpack8(*(const v4u*)(G2B + off), g2); unpack8(*(const v4u*)(UB + off), u2);
        if (t >= 1) unpack8(*(const v4u*)(UB + off - DM), u1);
        else { if (prm) { for (int e = 0; e < 8; ++e) u1[e] = 0.f; } else { const float* p = st + (size_t)(bb * 2 + 1) * 1024 + c8; for (int e = 0; e < 8; ++e) u1[e] = p[e]; } }
        if (t >= 2) unpack8(*(const v4u*)(UB + off - 2 * DM), u0);
        else { if (prm) { for (int e = 0; e < 8; ++e) u0[e] = 0.f; } else { const float* p = st + (size_t)(bb * 2 + t) * 1024 + c8; for (int e = 0; e < 8; ++e) u0[e] = p[e]; } }
        float r[8];
#pragma unroll
        for (int e = 0; e < 8; ++e) { const float cy = cw[c8 + e] * u0[e] + cw[1024 + c8 + e] * u1[e] + cw[2048 + c8 + e] * u2[e]; r[e] = ga[e] * o[e] + g2[e] * cy; }
        v4u w; w.x = pk2(r[0], r[1]); w.y = pk2(r[2], r[3]); w.z = pk2(r[4], r[5]); w.w = pk2(r[6], r[7]);
        *(v4u*)(Hm + off) = w;
    }
}

__device__ __forceinline__ void small_gemm_sample(const bf16* A, const bf16* Wt, int K, const float* base, float* outp, const float* gate, float coef, LAS unsigned char* ring, int vcu, int G) {
    int tid = threadIdx.x; asm volatile("" : "+v"(tid));
    const int lane = tid & 63, wid = tid >> 6, fr = lane & 15, fq = lane >> 4; const int KW = K >> 3;
    for (int item = vcu; item < 256; item += G) {
        const int rt = (item >> 4) * 64, ct = (item & 15) * 64;
        const bf16* ap = A + (size_t)(rt + fr) * K + wid * KW + 8 * fq; const bf16* bp = Wt + (size_t)(ct + fr) * K + wid * KW + 8 * fq;
        const int erow = rt + (tid >> 3), ec0 = ct + 8 * (tid & 7), emb = 8 + (erow >> 6);
        const f32x4 pga = *(const f32x4*)(gate + (size_t)emb * MODLD + ec0), pgb = *(const f32x4*)(gate + (size_t)emb * MODLD + ec0 + 4);
        const f32x4 pr0 = *(const f32x4*)(base + (size_t)erow * DM + ec0), pr1 = *(const f32x4*)(base + (size_t)erow * DM + ec0 + 4);
        f32x4 acc[4][4];
#pragma unroll
        for (int mi = 0; mi < 4; ++mi)
#pragma unroll
            for (int nj = 0; nj < 4; ++nj) acc[mi][nj] = (f32x4){0.f, 0.f, 0.f, 0.f};
#pragma unroll 2
        for (int k0 = 0; k0 < KW; k0 += 32) {
            bf16x8 a[4], b[4];
#pragma unroll
            for (int i = 0; i < 4; ++i) { a[i] = *(const bf16x8*)(ap + (size_t)(16 * i) * K + k0); b[i] = *(const bf16x8*)(bp + (size_t)(16 * i) * K + k0); }
#pragma unroll
            for (int mi = 0; mi < 4; ++mi)
#pragma unroll
                for (int nj = 0; nj < 4; ++nj) acc[mi][nj] = __builtin_amdgcn_mfma_f32_16x16x32_bf16(b[nj], a[mi], acc[mi][nj], 0, 0, 0);
        }
        LAS float* P = (LAS float*)(ring + wid * 16384);
#pragma unroll
        for (int mi = 0; mi < 4; ++mi)
#pragma unroll
            for (int nj = 0; nj < 4; ++nj) { const int row = mi * 16 + fr, grp = (nj * 4 + fq) ^ (row & 15); *(LAS f32x4*)(P + row * 64 + grp * 4) = acc[mi][nj]; }
        __syncthreads();
        { const int row = tid >> 3, j = tid & 7; const int g0 = (2 * j) ^ (row & 15), g1 = (2 * j + 1) ^ (row & 15);
          f32x4 s0 = (f32x4){0.f, 0.f, 0.f, 0.f}, s1 = s0;
#pragma unroll
          for (int w = 0; w < 8; ++w) { const LAS float* p = (const LAS float*)(ring + w * 16384) + row * 64; s0 += *(const LAS f32x4*)(p + g0 * 4); s1 += *(const LAS f32x4*)(p + g1 * 4); }
          const int grow = rt + row, c0 = ct + 8 * j; const int mb = 8 + (grow >> 6);
          const f32x4 ga = pga * coef, gb = pgb * coef; const f32x4 r0 = pr0, r1 = pr1; (void)mb;
          *(f32x4*)(outp + (size_t)grow * DM + c0) = r0 + ga * s0; *(f32x4*)(outp + (size_t)grow * DM + c0 + 4) = r1 + gb * s1; }
        __syncthreads();
    }
}
__device__ __forceinline__ void stage_fb(LAS float* fb, LAS float* wtot, const float* src0, int n0, const float* src1, int n1) {
    int tid = threadIdx.x; asm volatile("" : "+v"(tid)); const int lane = tid & 63, wid = tid >> 6; const int n = n0 + n1, e = 4 * tid;
    f32x4 v = (f32x4){0.f, 0.f, 0.f, 0.f};
    if (e < n) v = (e < n0) ? *(const f32x4*)(src0 + e) : *(const f32x4*)(src1 + (e - n0));
    const float s0 = v[0], s1 = s0 + v[1], s2 = s1 + v[2], s3 = s2 + v[3];
    float inc = s3;
#pragma unroll
    for (int o = 1; o < 64; o <<= 1) { const float t = __shfl_up(inc, o); if (lane >= o) inc += t; }
    if (lane == 63) wtot[wid] = inc;
    __syncthreads();
    float base = inc - s3;
#pragma unroll
    for (int w = 0; w < 8; ++w) { const float tw = wtot[w]; if (w < wid) base += tw; }
    const float c = -1.4426950408889634f;
    if (e < n) *(LAS f32x4*)(fb + e) = (f32x4){(base + s0) * c, (base + s1) * c, (base + s2) * c, (base + s3) * c};
    __syncthreads();
}
__device__ __forceinline__ void attn_sample_unit(int b, int h, const float* cK, const float* cV, const bf16* QB, const bf16* KB, const bf16* VB, const attn_body::MergeCtx& mc,
                                                 LAS unsigned char* ring, const LAS float* fb, LAS float* stats) {
    using attn_body::crow;
    int tid = threadIdx.x; asm volatile("" : "+v"(tid));
    const int lane = tid & 63, r32 = lane & 31, hi = lane >> 5; const int wid = __builtin_amdgcn_readfirstlane(tid >> 6);
    const size_t rowbase = (size_t)MP + (size_t)b * TS;
    LAS unsigned char* Ks = ring + wid * 16384; LAS unsigned char* Vs = Ks + 8192;
    LAS float* wsf = stats + 1024 + wid * 64;
    LAS unsigned char* QL = ring + (QL_OFF - RING_OFF);
    { const int row = tid >> 3, ch = tid & 7; *(LAS v4u*)(QL + row * 144 + ch * 16) = *(const v4u*)(QB + (rowbase + row) * DM + h * HD + ch * 8); }
    __syncthreads();
    float mhat[2], lsum[2] = {0.f, 0.f}; f32x16 o[2][2];
#pragma unroll
    for (int g = 0; g < 2; ++g) { mhat[g] = fb[PAST + 32 * g + r32]; o[g][0] = f32x16{}; o[g][1] = f32x16{}; }
    const int vb = (int)(unsigned)(uintptr_t)Vs + ((lane >> 4) & 1) * 32 + (lane & 3) * 8 + (4 * hi + ((lane & 15) >> 2)) * 64;
#pragma unroll 1
    for (int tl = wid; tl < 17; tl += 8) {
        if (tl < 16) {
            const f32x4* ksrc = (const f32x4*)(cK + ((size_t)(b * NH + h) * PAST + tl * 64) * HD); const f32x4* vsrc = (const f32x4*)(cV + ((size_t)(b * NH + h) * PAST + tl * 64) * HD);
#pragma unroll 1
            for (int hb = 0; hb < 16; hb += 8) {
                f32x4 kva[8], vva[8];
#pragma unroll
                for (int i = 0; i < 8; ++i) { kva[i] = __builtin_nontemporal_load(ksrc + (hb + i) * 64 + lane); vva[i] = __builtin_nontemporal_load(vsrc + (hb + i) * 64 + lane); }
#pragma unroll
                for (int i = 0; i < 8; ++i) { const int key = 4 * (hb + i) + (lane >> 4), d = (lane & 15) * 4; const f32x4 kv = kva[i], vv = vva[i];
                    v2u kw, vw; kw.x = pk2(kv.x, kv.y); kw.y = pk2(kv.z, kv.w); vw.x = pk2(vv.x, vv.y); vw.y = pk2(vv.z, vv.w);
                    *(LAS v2u*)(Ks + (d >> 3) * 1024 + key * 16 + (d & 7) * 2) = kw;
                    *(LAS v2u*)(Vs + ((d >> 5) * 4 + (key >> 4)) * 1024 + (key & 15) * 64 + (d & 31) * 2) = vw; }
            }
        } else {
#pragma unroll 1
            for (int hb = 0; hb < 8; hb += 4) {
                v4u kvb[4], vvb[4];
#pragma unroll
                for (int i = 0; i < 4; ++i) { const int key = 8 * (hb + i) + (lane >> 3), ch = lane & 7; const size_t off = (rowbase + key) * DM + h * HD + ch * 8; kvb[i] = *(const v4u*)(KB + off); vvb[i] = *(const v4u*)(VB + off); }
#pragma unroll
                for (int i = 0; i < 4; ++i) { const int key = 8 * (hb + i) + (lane >> 3), ch = lane & 7;
                    *(LAS v4u*)(Ks + ch * 1024 + key * 16) = kvb[i];
                    *(LAS v4u*)(Vs + ((ch >> 2) * 4 + (key >> 4)) * 1024 + (key & 15) * 64 + (ch & 3) * 16) = vvb[i]; }
            }
        }
        LDS_WAIT();
#pragma unroll
        for (int g = 0; g < 2; ++g) {
            __builtin_amdgcn_sched_barrier(0);
            f32x16 p0, p1;
            { const LAS float* fp = fb + 64 * tl + 4 * hi;
#pragma unroll
              for (int i = 0; i < 4; ++i) { const f32x4 x = *(const LAS f32x4*)(fp + 8 * i), y = *(const LAS f32x4*)(fp + 32 + 8 * i);
#pragma unroll
                  for (int e = 0; e < 4; ++e) { p0[4 * i + e] = x[e] - mhat[g]; p1[4 * i + e] = y[e] - mhat[g]; } } }
            { const LAS unsigned char* kb = Ks + hi * 1024 + r32 * 16;
#pragma unroll
              for (int d0 = 0; d0 < 4; ++d0) { const bf16x8 b0 = *(const LAS bf16x8*)(kb + d0 * 2048), b1 = *(const LAS bf16x8*)(kb + d0 * 2048 + 512);
                  const bf16x8 qf = *(const LAS bf16x8*)(QL + (32 * g + r32) * 144 + d0 * 32 + hi * 16);
                  p0 = __builtin_amdgcn_mfma_f32_32x32x16_bf16(b0, qf, p0, 0, 0, 0); p1 = __builtin_amdgcn_mfma_f32_32x32x16_bf16(b1, qf, p1, 0, 0, 0); } }
            if (tl == 16) { const int qi = 32 * g + r32;
#pragma unroll
                for (int r = 0; r < 16; ++r) { const int kj = crow(r, hi); if (kj > qi) p0[r] = -INFINITY; if (kj + 32 > qi) p1[r] = -INFINITY; } }
            float rm = p0[0];
#pragma unroll
            for (int r = 1; r < 16; ++r) rm = fmaxf(rm, p0[r]);
#pragma unroll
            for (int r = 0; r < 16; ++r) rm = fmaxf(rm, p1[r]);
            rm = fmaxf(rm, __shfl_xor(rm, 32));
            const float dl = fmaxf(rm, 0.f);
            mhat[g] += dl;
            const float f = __builtin_amdgcn_exp2f(-dl);
            float sacc = 0.f;
#pragma unroll
            for (int r = 0; r < 16; ++r) { p0[r] = __builtin_amdgcn_exp2f(p0[r] - dl); p1[r] = __builtin_amdgcn_exp2f(p1[r] - dl); sacc += p0[r] + p1[r]; }
            lsum[g] = lsum[g] * f + sacc;
            if (hi == 0) wsf[32 * g + r32] = f;
            LDS_WAIT();
#pragma unroll
            for (int r = 0; r < 16; ++r) { const float fr_ = wsf[32 * g + crow(r, hi)]; o[g][0][r] *= fr_; o[g][1][r] *= fr_; }
            v4u pw0, pw1, pw2, pw3;
#define PKW(P, B) attn_body::cvtpk_s(P[B], P[B + 1])
            pw0 = (v4u){PKW(p0, 0), PKW(p0, 2), PKW(p0, 4), PKW(p0, 6)}; pw1 = (v4u){PKW(p0, 8), PKW(p0, 10), PKW(p0, 12), PKW(p0, 14)};
            pw2 = (v4u){PKW(p1, 0), PKW(p1, 2), PKW(p1, 4), PKW(p1, 6)}; pw3 = (v4u){PKW(p1, 8), PKW(p1, 10), PKW(p1, 12), PKW(p1, 14)};
#undef PKW
            attn_body::pv(o[g], vb, __builtin_bit_cast(bf16x8, pw0), __builtin_bit_cast(bf16x8, pw1), __builtin_bit_cast(bf16x8, pw2), __builtin_bit_cast(bf16x8, pw3));
        }
        LDS_WAIT();
    }
#pragma unroll
    for (int g = 0; g < 2; ++g) { const float lt = lsum[g] + __shfl_xor(lsum[g], 32); if (hi == 0) { stats[wid * 64 + 32 * g + r32] = mhat[g]; stats[512 + wid * 64 + 32 * g + r32] = lt; } }
    __syncthreads();
    LAS float* Op = (LAS float*)(ring + wid * 16384);
#pragma unroll
    for (int g = 0; g < 2; ++g)
#pragma unroll
        for (int r = 0; r < 16; ++r) { const int q = 32 * g + crow(r, hi); float mx = stats[q];
#pragma unroll
            for (int w = 1; w < 8; ++w) mx = fmaxf(mx, stats[w * 64 + q]);
            const float scl = __builtin_amdgcn_exp2f(stats[wid * 64 + q] - mx);
            Op[q * 64 + r32] = o[g][0][r] * scl; Op[q * 64 + 32 + r32] = o[g][1][r] * scl; }
    __syncthreads();
    { const int q = tid >> 3, d0 = (tid & 7) * 8; float mx = stats[q];
#pragma unroll
      for (int w = 1; w < 8; ++w) mx = fmaxf(mx, stats[w * 64 + q]);
      float Lq = 0.f; f32x4 s0 = (f32x4){0.f, 0.f, 0.f, 0.f}, s1 = s0;
#pragma unroll
      for (int w = 0; w < 8; ++w) { Lq += stats[512 + w * 64 + q] * __builtin_amdgcn_exp2f(stats[w * 64 + q] - mx);
          const LAS float* p = (const LAS float*)(ring + w * 16384) + q * 64 + d0; s0 += *(const LAS f32x4*)p; s1 += *(const LAS f32x4*)(p + 4); }
      const float rl = 1.0f / Lq; s0 = s0 * rl; s1 = s1 * rl;
      v4u w; w.x = pk2(s0.x, s0.y); w.y = pk2(s0.z, s0.w); w.z = pk2(s1.x, s1.y); w.w = pk2(s1.z, s1.w);
      merge_store8(mc, rowbase + q, q, false, b, h * HD + d0, w); }
    __syncthreads();
}

__global__ void __launch_bounds__(NTHREADS, 2) fwd_mega(Args args) {
    extern __shared__ __attribute__((aligned(16))) unsigned char lds[];
    cg::grid_group grid = cg::this_grid();
    LAS unsigned char* L = (LAS unsigned char*)lds;
    const int G = gridDim.x; const int bx = blockIdx.x; const int vcu = (G % 8 == 0) ? (bx % 8) * (G / 8) + bx / 8 : bx;
    unsigned char* ws = args.ws; float* out = args.out; const float* mod = (const float*)(ws + WS_MOD);
    bf16* Hb = (bf16*)(ws + WS_H); bf16* ACT = (bf16*)(ws + WS_ACT);
    float* XR = out + O_Y;
    const int lo = args.ph_lo, hi = args.ph_hi;
#ifndef PH_MASK
#define PH_MASK 0x1fff
#endif
#define IN(k) (((PH_MASK >> (k)) & 1) && lo <= (k) && (k) < hi)
#define SEAM(k) do { if (IN(k) && IN((k) + 1)) xcd_barrier(bar); } while (0)

    unsigned* barw = (unsigned*)(ws + WS_BAR);
    volatile LAS unsigned* bst = (volatile LAS unsigned*)(L + STAT_OFF + 8000);
    unsigned* cntw = (unsigned*)(ws + WS_CNT);
    if (bx == 0) { for (int i = threadIdx.x; i < XCD_BAR_WORDS; i += NTHREADS) __hip_atomic_store(barw + i, 0u, __ATOMIC_RELAXED, __HIP_MEMORY_SCOPE_AGENT);
                   for (int i = threadIdx.x; i < CNT_WORDS; i += NTHREADS) __hip_atomic_store(cntw + i, 0u, __ATOMIC_RELAXED, __HIP_MEMORY_SCOPE_AGENT); }
    const bool fuse_rows = (G == 256);
    const int wv = threadIdx.x >> 6, ln = threadIdx.x & 63;
    bf16* Hb2 = (bf16*)(ws + WS_GAB);
#define HANDOFF(inst, S) pg8::Unit hu; S.next(0, hu); const int rt_ = vcu >> 4, ct_ = vcu & 15; \
        panel_handoff(cntw + ((inst) * 80 + hu.pm) * 16, cntw + ((inst) * 80 + 64 + rt_) * 16)
    if (IN(0)) { p0_mod(args, L, vcu, G); p0_weights(args, L, vcu, G); }
    if (threadIdx.x < 2) bst[threadIdx.x] = 0u;
    grid.sync();
    const XcdBarrier bar = xcd_barrier_post(barw, bst);
    if (IN(1)) norm_mod_rows(args.in[0], args.in[1], args.in[10], mod, 0 * DM, 1 * DM, Hb, vcu, G);
    SEAM(1);
    if (IN(2)) { pg8::Gemm g{Hb, (const bf16*)(ws + WS_W1IN), MT, 2 * DFF, DM}; pg8::StaticOrder S; S.init(MT, 2 * DFF, G, bx);
        pg8::EpiSwiGLU E{ACT, DFF}; pg8::gemm_phase<pg8::EpiSwiGLU, pg8::StaticOrder, PG8_ALIGN, PG8_SP2>(L + RING_OFF, g, S, E);
        constexpr int NF = (68 * 22) % 256;
        if (G == 256 && bx >= NF) weight_items_tail(args, L, WCUT0, WCUT1, (bx - NF) * NWAVES + (int)(threadIdx.x >> 6), (256 - NF) * NWAVES); }
    SEAM(2);
    if (IN(3)) { pg8::Gemm g{ACT, (const bf16*)(ws + WS_W1OUT), MP, DM, DFF}; pg8::StaticOrder S; S.init(MP, DM, G, bx);
        pg8::EpiResid<true> E{args.in[0], args.in[1], XR, mod + 2 * DM, 0.5f}; pg8::gemm_phase<pg8::EpiResid<true>, pg8::StaticOrder, false, PG8_SP2>(L + RING_OFF, g, S, E);
        small_gemm_sample(ACT + (size_t)MP * DFF, (const bf16*)(ws + WS_W1OUT), DFF, args.in[1], XR + (size_t)MP * DM, mod + 2 * DM, 0.5f, L + RING_OFF, vcu, G);
        if (fuse_rows) { HANDOFF(0, S);
            norm_rows4<false, false, 8>(hu.pm * 256 + hu.pn * 64 + wv * 8, XR, XR + (size_t)MP * DM, args.in[13], mod, 3 * DM, 4 * DM, Hb, nullptr, ln);
            if (wv == 0) norm_rows4<false>(MP + rt_ * 64 + ct_ * 4, XR, XR + (size_t)MP * DM, args.in[13], mod, 3 * DM, 4 * DM, Hb, nullptr, ln); } }
    if (!fuse_rows) { SEAM(3); if (IN(4)) norm_mod_rows(XR, XR + (size_t)MP * DM, args.in[13], mod, 3 * DM, 4 * DM, Hb, vcu, G); }
    SEAM(4);
    if (IN(5)) { pg8::Gemm g{Hb, (const bf16*)(ws + WS_WIN), MT, NINP, DM}; pg8::StaticOrder S; S.init(MT, NINP, G, bx);
        pg8::EpiMix E{(bf16*)(ws + WS_QB), out, args.in[15], attn_body::C2};
        pg8::gemm_phase<pg8::EpiMix, pg8::StaticOrder, PG8_ALIGN, PG8_SP2>(L + RING_OFF, g, S, E);
        constexpr int NF = (68 * 33) % 256;
        if (G == 256 && bx >= NF) weight_items_tail(args, L, WCUT1, WCUT2, (bx - NF) * NWAVES + (int)(threadIdx.x >> 6), (256 - NF) * NWAVES); }
    SEAM(5);
    if (IN(6)) {
        const attn_body::bf16* Q = (const attn_body::bf16*)(ws + WS_QB); const attn_body::bf16* K = (const attn_body::bf16*)(ws + WS_KB); const attn_body::bf16* V = (const attn_body::bf16*)(ws + WS_VB);
        LAS float* fb = (LAS float*)(L + FB_OFF); LAS float* stats = (LAS float*)(L + STAT_OFF);
        const attn_body::MergeCtx mc{(const bf16*)(ws + WS_GAB), (const bf16*)(ws + WS_G2B), (const bf16*)(ws + WS_UB), args.in[16], args.in[5], Hb};
#pragma unroll 1
        for (int pass = 0; pass < 2; ++pass) {
        const bool do_sample = ((vcu & 1) != 0) == (pass == 0);
        if (!do_sample) {
        for (int it = vcu; it < 512; it += G) {
            const int bh = it >> 2, k = it & 3;
            stage_fb(fb, stats, out + O_LFP + (size_t)bh * TP, TP, nullptr, 0);
#pragma unroll 1
            for (int j = 0; j < 2; ++j) attn_body::attn_unit<8>(bh >> 4, bh & 15, j ? k : 7 - k, Q, K, V, mc, (char*)lds + RING_OFF, fb);
        }
        } else {
        for (int it = vcu; it < 256; it += G) {
            const int b = it >> 4, h = it & 15;
            stage_fb(fb, stats, args.in[4] + (size_t)it * PAST, PAST, out + O_LFS + (size_t)it * TS, TS);
            attn_sample_unit(b, h, args.in[2], args.in[3], (const bf16*)(ws + WS_QB), (const bf16*)(ws + WS_KB), (const bf16*)(ws + WS_VB), mc, L + RING_OFF, fb, stats);
        }
        }
        }
    }
    SEAM(6);
    if (IN(8)) { pg8::Gemm g{Hb, (const bf16*)(ws + WS_WOUT), MP, DM, DM}; pg8::StaticOrder S; S.init(MP, DM, G, bx);
        pg8::EpiResid<false> E{XR, XR + (size_t)MP * DM, XR, mod + 5 * DM, 1.0f}; pg8::gemm_phase<pg8::EpiResid<false>, pg8::StaticOrder, false, PG8_SP2>(L + RING_OFF, g, S, E);
        small_gemm_sample(Hb + (size_t)MP * DM, (const bf16*)(ws + WS_WOUT), DM, XR + (size_t)MP * DM, XR + (size_t)MP * DM, mod + 5 * DM, 1.0f, L + RING_OFF, vcu, G);
        if (fuse_rows) { HANDOFF(1, S);
            norm_rows4<false, false, 8>(hu.pm * 256 + hu.pn * 64 + wv * 8, XR, XR + (size_t)MP * DM, args.in[18], mod, 6 * DM, 7 * DM, Hb2, nullptr, ln);
            if (wv == 0) norm_rows4<false>(MP + rt_ * 64 + ct_ * 4, XR, XR + (size_t)MP * DM, args.in[18], mod, 6 * DM, 7 * DM, Hb2, nullptr, ln); } }
    if (!fuse_rows) { SEAM(8); if (IN(9)) norm_mod_rows(XR, XR + (size_t)MP * DM, args.in[18], mod, 6 * DM, 7 * DM, Hb2, vcu, G); }
    SEAM(9);
    if (IN(10)) { pg8::Gemm g{Hb2, (const bf16*)(ws + WS_W2IN), MT, 2 * DFF, DM}; pg8::StaticOrder S; S.init(MT, 2 * DFF, G, bx);
        pg8::EpiSwiGLU E{ACT, DFF}; pg8::gemm_phase<pg8::EpiSwiGLU, pg8::StaticOrder, PG8_ALIGN, PG8_SP2>(L + RING_OFF, g, S, E);
        constexpr int NF = (68 * 22) % 256;
        if (G == 256 && bx >= NF) weight_items_tail(args, L, WCUT2, WITEMS, (bx - NF) * NWAVES + (int)(threadIdx.x >> 6), (256 - NF) * NWAVES); }
    SEAM(10);
    if (IN(11)) { pg8::Gemm g{ACT, (const bf16*)(ws + WS_W2OUT), MP, DM, DFF}; pg8::StaticOrder S; S.init(MP, DM, G, bx);
        pg8::EpiResid<false> E{XR, XR + (size_t)MP * DM, XR, mod + 8 * DM, 0.5f}; pg8::gemm_phase<pg8::EpiResid<false>, pg8::StaticOrder, false, PG8_SP2>(L + RING_OFF, g, S, E);
        small_gemm_sample(ACT + (size_t)MP * DFF, (const bf16*)(ws + WS_W2OUT), DFF, XR + (size_t)MP * DM, XR + (size_t)MP * DM, mod + 8 * DM, 0.5f, L + RING_OFF, vcu, G);
        if (fuse_rows) { HANDOFF(2, S);
            norm_rows4<true, false, 8>(hu.pm * 256 + hu.pn * 64 + wv * 8, XR, XR + (size_t)MP * DM, args.in[21], nullptr, 0, 0, nullptr, XR, ln);
            if (wv == 0) norm_rows4<true>(MP + rt_ * 64 + ct_ * 4, XR, XR + (size_t)MP * DM, args.in[21], nullptr, 0, 0, nullptr, XR, ln); } }
    if (!fuse_rows) { SEAM(11); if (IN(12)) final_norm_rows(XR, args.in[21], vcu, G); }
#undef IN
#undef SEAM
}

#ifndef MK_N_LAUNCHES
#define MK_N_LAUNCHES 1
#endif
constexpr int N_PHASES = 13;
extern "C" void kernel_launch(void* const* d_in, const int* in_sizes, int n_in, void* d_out, int out_size, void* d_ws, size_t ws_size, hipStream_t stream) {
    static int grid = 0;
    if (grid == 0) {
        if (n_in != 22 || out_size != (int)O_END || ws_size < WS_END) { fprintf(stderr, "kernel_launch: unexpected sizes n_in %d out %d ws %zu; nothing launched\n", n_in, out_size, ws_size); grid = -1; return; }
        int dev = 0, cus = 0, per_cu = 0;
        if (hipGetDevice(&dev) != hipSuccess || hipDeviceGetAttribute(&cus, hipDeviceAttributeMultiprocessorCount, dev) != hipSuccess) { grid = -1; return; }
        if (hipFuncSetAttribute((const void*)fwd_mega, hipFuncAttributeMaxDynamicSharedMemorySize, LDS_BYTES) != hipSuccess) { fprintf(stderr, "kernel_launch: hipFuncSetAttribute failed\n"); grid = -1; return; }
        if (hipOccupancyMaxActiveBlocksPerMultiprocessor(&per_cu, (const void*)fwd_mega, NTHREADS, LDS_BYTES) != hipSuccess || per_cu < 1) { fprintf(stderr, "kernel_launch: occupancy query says %d\n", per_cu); (void)hipGetLastError(); grid = -1; return; }
        grid = cus * 1;
        fprintf(stderr, "kernel_launch: grid %d (cus %d, per_cu %d), ws %zu\n", grid, cus, per_cu, ws_size);
    }
    if (grid < 0) return;
    Args a{};
    for (int i = 0; i < 22; ++i) a.in[i] = (const float*)d_in[i];
    a.out = (float*)d_out; a.ws = (unsigned char*)d_ws;
#if MK_N_LAUNCHES == 1
    a.ph_lo = 0; a.ph_hi = N_PHASES;
    void* kargs[] = {&a};
    hipError_t e = hipLaunchCooperativeKernel((const void*)fwd_mega, dim3(grid), dim3(NTHREADS), kargs, LDS_BYTES, stream);
    if (e != hipSuccess) fprintf(stderr, "kernel_launch: cooperative launch failed: %s (grid %d)\n", hipGetErrorString(e), grid);
#else
    for (int p = 0; p < N_PHASES; ++p) { a.ph_lo = p; a.ph_hi = p + 1; void* kargs[] = {&a};
        hipError_t e = hipLaunchCooperativeKernel((const void*)fwd_mega, dim3(grid), dim3(NTHREADS), kargs, LDS_BYTES, stream);
        if (e != hipSuccess) { fprintf(stderr, "kernel_launch: launch %d failed: %s\n", p, hipGetErrorString(e)); break; } }
#endif
}
```
